# Optimizing an MI355X kernel written in HIP

```python
import math
import functools
import jax
import jax.numpy as jnp
from jax import lax
import numpy as np

D_MODEL = 1024
BATCH = 8
SEQ = 4096
DEPTH = 4

GRID_W = 64
CTX_LEN = 256
POS_BASE = 10000.0
EPS = 1e-6

GLA_HEADS = 4
GLA_DK = 48
GLA_DV = 96
GLA_RANK = 16
GLA_GATE_NORM = 16.0
GLA_CHUNK = 64

S5_CH = 256
S5_GROUP = 16
S5_GROUPS = S5_CH // S5_GROUP
S5_STATE = 64
S5_DT_MIN = 1e-3
S5_DT_MAX = 1e-1

ML_HEADS = 4
ML_DH = 96
ML_CHUNK = 64
ML_CONV = 3

D_GLA = GLA_HEADS * GLA_DV
D_ML = ML_HEADS * ML_DH
D_MIX = D_GLA + S5_CH + D_ML

D_FF = 2816
N_EXPERTS = 8
TOP_K = 2
D_FF_EXPERT = 2816
MOE_BLOCK = 256

PROJ_SPLITS = (GLA_HEADS * GLA_DK, GLA_HEADS * GLA_DK, D_GLA, GLA_RANK, D_GLA,
               S5_CH,
               D_ML, D_ML, D_ML, D_ML, 4 * ML_HEADS)
D_PROJ = sum(PROJ_SPLITS)

kernel_name = 'hybrid_gla_s5_mlstm_moe_prefix_dit'


def rmsnorm(x, g):
    xf = x.astype(jnp.float32)
    y = xf * lax.rsqrt(jnp.mean(xf * xf, axis=-1, keepdims=True) + EPS)
    return (y * g.astype(jnp.float32)).astype(x.dtype)


def modulation(cond, w, b):
    m = (jax.nn.silu(cond) @ w + b)[..., None, :]
    return jnp.split(m, 6, axis=-1)


def modulate(h, shift, scale):
    return h * (1.0 + scale) + shift


def pos_embed_2d(n_tokens, dtype):
    rows = n_tokens // GRID_W
    row, col = jnp.meshgrid(jnp.arange(rows, dtype=jnp.float32),
                            jnp.arange(GRID_W, dtype=jnp.float32), indexing='ij')
    n_freq = D_MODEL // 4
    omega = jnp.exp(-math.log(POS_BASE) * jnp.arange(n_freq, dtype=jnp.float32) / n_freq)

    def axis_embed(p):
        ang = p.reshape(-1, 1) * omega
        return jnp.concatenate([jnp.sin(ang), jnp.cos(ang)], axis=-1)

    return jnp.concatenate([axis_embed(row), axis_embed(col)], axis=-1).astype(dtype)


def split_heads(t, n):
    b, l, _ = t.shape
    return t.reshape(b, l, n, -1).transpose(0, 2, 1, 3)


def merge_heads(t):
    b, n, l, d = t.shape
    return t.transpose(0, 2, 1, 3).reshape(b, l, n * d)


def to_chunks(t, size):
    b, h, l = t.shape[:3]
    t = t.reshape((b, h, l // size, size) + t.shape[3:])
    return jnp.moveaxis(t, 2, 0)


def from_chunks(t):
    t = jnp.moveaxis(t, 0, 2)
    return t.reshape((t.shape[0], t.shape[1], -1) + t.shape[4:])


def _flip_if(t, rev, axis):
    return jnp.flip(t, axis) if rev else t


def run_bidirectional(scan_fns, ctx_dirs, lat_dirs, init_state, axis):
    out_c, out_l = [], []
    for d, scan_fn in enumerate(scan_fns):
        rev = d == 1
        o_c, s_ctx = scan_fn(*[_flip_if(t, rev, axis) for t in ctx_dirs[d]], init_state)
        o_l, _ = scan_fn(*[_flip_if(t, rev, axis) for t in lat_dirs[d]], s_ctx)
        out_c.append(_flip_if(o_c, rev, axis))
        out_l.append(_flip_if(o_l, rev, axis))
    return out_c[0] + out_c[1], out_l[0] + out_l[1]


def gla_scan(q, k, v, log_a, s0):
    qc, kc, vc, ac = (to_chunks(t, GLA_CHUNK) for t in (q, k, v, log_a))
    b = jnp.cumsum(ac, axis=-2)
    b_last = b[..., -1:, :]
    q_in = qc * jnp.exp(b)
    k_in = kc * jnp.exp(-b)
    k_out = kc * jnp.exp(b_last - b)
    lower = jnp.tril(jnp.ones((GLA_CHUNK, GLA_CHUNK), bool))
    att = jnp.where(lower, jnp.einsum('nbhtd,nbhsd->nbhts', q_in, k_in), 0.0)
    o_intra = jnp.einsum('nbhts,nbhsv->nbhtv', att, vc)

    def step(s, xs):
        qi, ki, vi, di = xs
        o = jnp.einsum('bhtd,bhdv->bhtv', qi, s)
        s = s * di[..., None] + jnp.einsum('bhsd,bhsv->bhdv', ki, vi)
        return s, o

    s_fin, o_inter = lax.scan(step, s0, (q_in, k_out, vc, jnp.exp(b_last[..., 0, :])))
    return from_chunks(o_intra + o_inter), s_fin


def gla_mixer(p_c, p_l, wa2, ba, gain):
    def dirs(p):
        q, k, v, lr, _ = p
        qh = split_heads(q * GLA_DK ** -0.5, GLA_HEADS)
        kh, vh = split_heads(k, GLA_HEADS), split_heads(v, GLA_HEADS)
        return [(qh, kh, vh,
                 split_heads(jax.nn.log_sigmoid(lr @ wa2[d] + ba[d]) / GLA_GATE_NORM, GLA_HEADS))
                for d in (0, 1)]

    bsz = p_c[0].shape[0]
    s0 = jnp.zeros((bsz, GLA_HEADS, GLA_DK, GLA_DV), jnp.float32)
    o_c, o_l = run_bidirectional((gla_scan, gla_scan), dirs(p_c), dirs(p_l), s0, axis=2)

    def out(o, g):
        return merge_heads(rmsnorm(o, gain)) * jax.nn.silu(g)

    return out(o_c, p_c[4]), out(o_l, p_l[4])


def s5_discretise(lam_re, lam_im, log_dt, b_re, b_im):
    dt = jnp.exp(log_dt)[:, None]
    mag = jnp.exp(lam_re * dt)
    abar_re, abar_im = mag * jnp.cos(lam_im * dt), mag * jnp.sin(lam_im * dt)
    den = lam_re * lam_re + lam_im * lam_im
    pr, pi = abar_re - 1.0, abar_im
    coef_re = (pr * lam_re + pi * lam_im) / den
    coef_im = (pi * lam_re - pr * lam_im) / den
    bbar_re = coef_re[..., None] * b_re - coef_im[..., None] * b_im
    bbar_im = coef_re[..., None] * b_im + coef_im[..., None] * b_re
    return abar_re, abar_im, bbar_re, bbar_im


def _complex_affine_combine(e1, e2):
    a1r, a1i, b1r, b1i = e1
    a2r, a2i, b2r, b2i = e2
    return (a1r * a2r - a1i * a2i, a1r * a2i + a1i * a2r,
            a2r * b1r - a2i * b1i + b2r, a2r * b1i + a2i * b1r + b2i)


def s5_scan(u, state, params):
    abar_re, abar_im, bbar_re, bbar_im, c_re, c_im = params
    bu_re = jnp.einsum('blgp,gnp->blgn', u, bbar_re)
    bu_im = jnp.einsum('blgp,gnp->blgn', u, bbar_im)
    s0_re, s0_im = state
    bu_re = bu_re.at[:, 0].add(abar_re * s0_re - abar_im * s0_im)
    bu_im = bu_im.at[:, 0].add(abar_re * s0_im + abar_im * s0_re)
    a_re = jnp.broadcast_to(abar_re, bu_re.shape)
    a_im = jnp.broadcast_to(abar_im, bu_im.shape)
    _, _, s_re, s_im = lax.associative_scan(_complex_affine_combine, (a_re, a_im, bu_re, bu_im), axis=1)
    y = jnp.einsum('blgn,gpn->blgp', s_re, c_re) - jnp.einsum('blgn,gpn->blgp', s_im, c_im)
    return y, (s_re[:, -1], s_im[:, -1])


def s5_mixer(u_c, u_l, lam_re, lam_im, log_dt, b_re, b_im, c_re, c_im, d_skip, glu_w, glu_b):
    f32 = lambda t: t.astype(jnp.float32)
    grp = lambda u: u.reshape(u.shape[0], u.shape[1], S5_GROUPS, S5_GROUP)
    scans = [functools.partial(
        s5_scan,
        params=s5_discretise(f32(lam_re[d]), f32(lam_im[d]), f32(log_dt[d]), f32(b_re), f32(b_im))
        + (f32(c_re), f32(c_im))) for d in (0, 1)]
    bsz = u_c.shape[0]
    zero = jnp.zeros((bsz, S5_GROUPS, S5_STATE), jnp.float32)
    y_c, y_l = run_bidirectional(scans, [(grp(u_c),)] * 2, [(grp(u_l),)] * 2, (zero, zero), axis=1)

    def glu(y, u):
        z = jax.nn.gelu(y.reshape(u.shape) + f32(d_skip) * u)
        return z * jax.nn.sigmoid(z @ f32(glu_w) + f32(glu_b))

    return glu(y_c, u_c), glu(y_l, u_l)


def mlstm_scan(q, k, v, log_i, log_f, state):
    qc, kc, vc, ic, fc = (to_chunks(t, ML_CHUNK) for t in (q, k, v, log_i, log_f))
    lower = jnp.tril(jnp.ones((ML_CHUNK, ML_CHUNK), bool))

    def step(carry, xs):
        s, n, m = carry
        qi, ki, vi, li, lf = xs
        fcum = jnp.cumsum(lf, axis=-1)
        d_log = jnp.where(lower, fcum[..., :, None] - fcum[..., None, :] + li[..., None, :], -jnp.inf)
        prev_log = fcum + m[..., None]
        m_t = jnp.maximum(prev_log, d_log.max(-1))
        w = jnp.exp(d_log - m_t[..., None])
        w_prev = jnp.exp(prev_log - m_t)
        qk = jnp.einsum('bhtd,bhsd->bhts', qi, ki) * w
        num = w_prev[..., None] * jnp.einsum('bhtd,bhdv->bhtv', qi, s) + jnp.einsum('bhts,bhsv->bhtv', qk, vi)
        den = w_prev * jnp.einsum('bhtd,bhd->bht', qi, n) + qk.sum(-1)
        h = num / jnp.maximum(jnp.abs(den), jnp.exp(-m_t))[..., None]
        m_new = m_t[..., -1]
        w_s = jnp.exp(fcum[..., -1:] - fcum + li - m_new[..., None])
        g = jnp.exp(fcum[..., -1] + m - m_new)
        s = g[..., None, None] * s + jnp.einsum('bhs,bhsd,bhsv->bhdv', w_s, ki, vi)
        n = g[..., None] * n + jnp.einsum('bhs,bhsd->bhd', w_s, ki)
        return (s, n, m_new), h

    state, h = lax.scan(step, state, (qc, kc, vc, ic, fc))
    return from_chunks(h), state


def short_conv(x, w, b):
    y = lax.conv_general_dilated(x, w.astype(x.dtype)[:, None, :], window_strides=(1,), padding='SAME',
                                 dimension_numbers=('NWC', 'WIO', 'NWC'),
                                 feature_group_count=x.shape[-1])
    return jax.nn.silu(y + b)


def mlstm_mixer(p_c, p_l, conv_w, conv_b, gate_b, gain):
    def dirs(p):
        q, k, v, _, gates = p
        qk = short_conv(jnp.concatenate([q, k], axis=-1), conv_w, conv_b)
        q, k = jnp.split(qk, 2, axis=-1)
        bsz, l, _ = q.shape
        g = (gates.reshape(bsz, l, 4, ML_HEADS) + gate_b).transpose(2, 0, 3, 1)
        qh = split_heads(q, ML_HEADS)
        kh = split_heads(k, ML_HEADS) * ML_DH ** -0.5
        vh = split_heads(v, ML_HEADS)
        return [(qh, kh, vh, g[0], jax.nn.log_sigmoid(g[1])),
                (qh, kh, vh, g[2], jax.nn.log_sigmoid(g[3]))]

    bsz = p_c[0].shape[0]
    init = (jnp.zeros((bsz, ML_HEADS, ML_DH, ML_DH), jnp.float32),
            jnp.zeros((bsz, ML_HEADS, ML_DH), jnp.float32),
            jnp.zeros((bsz, ML_HEADS), jnp.float32))
    h_c, h_l = run_bidirectional((mlstm_scan, mlstm_scan), dirs(p_c), dirs(p_l), init, axis=2)

    def out(h, o):
        return merge_heads(rmsnorm(h, gain)) * jax.nn.sigmoid(o)

    return out(h_c, p_c[3]), out(h_l, p_l[3])


def token_mixers(a_c, a_l, w_in, w_out, gla_wa2, gla_ba, gla_norm,
                 s5_lam_re, s5_lam_im, s5_log_dt, s5_b_re, s5_b_im, s5_c_re, s5_c_im, s5_d,
                 s5_glu_w, s5_glu_b, ml_conv_w, ml_conv_b, ml_gate_b, ml_norm):
    cuts = np.cumsum(PROJ_SPLITS)[:-1]
    p_c = jnp.split((a_c @ w_in).astype(jnp.float32), cuts, axis=-1)
    p_l = jnp.split((a_l @ w_in).astype(jnp.float32), cuts, axis=-1)
    gla = gla_mixer(p_c[0:5], p_l[0:5], gla_wa2, gla_ba, gla_norm)
    s5 = s5_mixer(p_c[5], p_l[5], s5_lam_re, s5_lam_im, s5_log_dt, s5_b_re, s5_b_im,
                  s5_c_re, s5_c_im, s5_d, s5_glu_w, s5_glu_b)
    ml = mlstm_mixer(p_c[6:11], p_l[6:11], ml_conv_w, ml_conv_b, ml_gate_b, ml_norm)
    out_c = jnp.concatenate([gla[0], s5[0], ml[0]], axis=-1).astype(a_c.dtype) @ w_out
    out_l = jnp.concatenate([gla[1], s5[1], ml[1]], axis=-1).astype(a_l.dtype) @ w_out
    return out_c, out_l


def swiglu(x, w1, w3, w2):
    return (jax.nn.silu(x @ w1) * (x @ w3)) @ w2


def moe_ffn(x, w_router, w1, w3, w2):
    n_tok = x.shape[0]
    logits = (x @ w_router).astype(jnp.float32)
    top_logit, top_idx = lax.top_k(logits, TOP_K)
    top_w = jax.nn.softmax(top_logit, axis=-1)
    flat_e = top_idx.reshape(-1)
    n_assign = n_tok * TOP_K
    order = jnp.argsort(flat_e)
    sorted_e = flat_e[order]
    counts = jnp.bincount(flat_e, length=N_EXPERTS)
    padded = (counts + MOE_BLOCK - 1) // MOE_BLOCK * MOE_BLOCK
    start = jnp.cumsum(counts) - counts
    pend = jnp.cumsum(padded)
    pstart = pend - padded
    dest = pstart[sorted_e] + jnp.arange(n_assign) - start[sorted_e]
    n_blocks = -(-n_assign // MOE_BLOCK) + N_EXPERTS
    n_rows = n_blocks * MOE_BLOCK
    row_token = jnp.zeros((n_rows,), jnp.int32).at[dest].set((order // TOP_K).astype(jnp.int32))
    row_w = jnp.zeros((n_rows,), jnp.float32).at[dest].set(top_w.reshape(-1)[order])
    block_expert = jnp.minimum(
        jnp.searchsorted(pend, jnp.arange(n_blocks) * MOE_BLOCK, side='right'), N_EXPERTS - 1)
    xb = x[row_token].reshape(n_blocks, MOE_BLOCK, -1)

    def expert_block(args):
        xi, e = args
        return swiglu(xi, w1[e], w3[e], w2[e])

    yb = lax.map(expert_block, (xb, block_expert))
    y_rows = (yb.reshape(n_rows, -1).astype(jnp.float32) * row_w[:, None]).astype(x.dtype)
    return jnp.zeros_like(x).at[row_token].add(y_rows)


def channel_mixer(i, t, ffn_w1, ffn_w3, ffn_w2, moe_router, moe_w1, moe_w3, moe_w2):
    j = i // 2
    if i % 2 == 0:
        return swiglu(t, ffn_w1[j], ffn_w3[j], ffn_w2[j])
    return moe_ffn(t, moe_router[j], moe_w1[j], moe_w3[j], moe_w2[j])


def setup_inputs(seed: int = 0) -> dict:
    key = jax.random.key(seed)
    keys = iter(jax.random.split(key, 48))

    def normal(shape, scale):
        return scale * jax.random.normal(next(keys), shape, jnp.float32)

    d = D_MODEL
    n_dense, n_moe = (DEPTH + 1) // 2, DEPTH // 2
    g_, n_, p_ = S5_GROUPS, S5_STATE, S5_GROUP
    ml_gate_b = normal((DEPTH, 4, ML_HEADS), 0.1)
    ml_gate_b = ml_gate_b.at[:, 1::2].add(jnp.linspace(3.0, 6.0, ML_HEADS))
    return {
        'x': normal((BATCH, SEQ, d), 1.0),
        'c': normal((BATCH, d), 1.0),
        'ctx': normal((BATCH, CTX_LEN, d), 1.0),
        'c_ctx': normal((d,), 1.0),
        'w_ada': normal((DEPTH, d, 6 * d), 0.5 * d ** -0.5),
        'b_ada': normal((DEPTH, 6 * d), 0.02),
        'norm1': 1.0 + normal((DEPTH, d), 0.01),
        'norm2': 1.0 + normal((DEPTH, d), 0.01),
        'w_in': normal((DEPTH, d, D_PROJ), d ** -0.5),
        'w_out': normal((DEPTH, D_MIX, d), D_MIX ** -0.5),
        'gla_wa2': normal((DEPTH, 2, GLA_RANK, GLA_HEADS * GLA_DK), GLA_RANK ** -0.5),
        'gla_ba': normal((DEPTH, 2, GLA_HEADS * GLA_DK), 0.1),
        'gla_norm': 1.0 + normal((DEPTH, GLA_DV), 0.01),
        's5_lam_re': -0.5 + normal((DEPTH, 2, g_, n_), 0.01),
        's5_lam_im': jnp.pi * jnp.arange(n_, dtype=jnp.float32) + normal((DEPTH, 2, g_, n_), 0.01),
        's5_log_dt': jax.random.uniform(next(keys), (DEPTH, 2, g_), jnp.float32,
                                        math.log(S5_DT_MIN), math.log(S5_DT_MAX)),
        's5_b_re': normal((DEPTH, g_, n_, p_), (2 * p_) ** -0.5),
        's5_b_im': normal((DEPTH, g_, n_, p_), (2 * p_) ** -0.5),
        's5_c_re': normal((DEPTH, g_, p_, n_), n_ ** -0.5),
        's5_c_im': normal((DEPTH, g_, p_, n_), n_ ** -0.5),
        's5_d': normal((DEPTH, S5_CH), 1.0),
        's5_glu_w': normal((DEPTH, S5_CH, S5_CH), S5_CH ** -0.5),
        's5_glu_b': normal((DEPTH, S5_CH), 0.02),
        'ml_conv_w': normal((DEPTH, ML_CONV, 2 * D_ML), ML_CONV ** -0.5),
        'ml_conv_b': normal((DEPTH, 2 * D_ML), 0.02),
        'ml_gate_b': ml_gate_b,
        'ml_norm': 1.0 + normal((DEPTH, ML_DH), 0.01),
        'ffn_w1': normal((n_dense, d, D_FF), d ** -0.5),
        'ffn_w3': normal((n_dense, d, D_FF), d ** -0.5),
        'ffn_w2': normal((n_dense, D_FF, d), D_FF ** -0.5),
        'moe_router': normal((n_moe, d, N_EXPERTS), d ** -0.5),
        'moe_w1': normal((n_moe, N_EXPERTS, d, D_FF_EXPERT), d ** -0.5),
        'moe_w3': normal((n_moe, N_EXPERTS, d, D_FF_EXPERT), d ** -0.5),
        'moe_w2': normal((n_moe, N_EXPERTS, D_FF_EXPERT, d), D_FF_EXPERT ** -0.5),
        'norm_f': 1.0 + normal((d,), 0.01),
    }


def reference(x, c, ctx, c_ctx, w_ada, b_ada, norm1, norm2, w_in, w_out,
              gla_wa2, gla_ba, gla_norm,
              s5_lam_re, s5_lam_im, s5_log_dt, s5_b_re, s5_b_im, s5_c_re, s5_c_im, s5_d,
              s5_glu_w, s5_glu_b,
              ml_conv_w, ml_conv_b, ml_gate_b, ml_norm,
              ffn_w1, ffn_w3, ffn_w2, moe_router, moe_w1, moe_w3, moe_w2, norm_f):
    bsz, n_lat, d = x.shape
    h_lat = x + pos_embed_2d(n_lat, x.dtype)[None]
    h_ctx = ctx
    for i in range(DEPTH):
        last = i == DEPTH - 1
        sh1_l, sc1_l, g1_l, sh2_l, sc2_l, g2_l = modulation(c, w_ada[i], b_ada[i])
        sh1_c, sc1_c, g1_c, sh2_c, sc2_c, g2_c = modulation(c_ctx, w_ada[i], b_ada[i])
        m_c, m_l = token_mixers(
            modulate(rmsnorm(h_ctx, norm1[i]), sh1_c, sc1_c),
            modulate(rmsnorm(h_lat, norm1[i]), sh1_l, sc1_l),
            w_in[i], w_out[i], gla_wa2[i], gla_ba[i], gla_norm[i],
            s5_lam_re[i], s5_lam_im[i], s5_log_dt[i], s5_b_re[i], s5_b_im[i], s5_c_re[i], s5_c_im[i],
            s5_d[i], s5_glu_w[i], s5_glu_b[i],
            ml_conv_w[i], ml_conv_b[i], ml_gate_b[i], ml_norm[i])
        h_lat = h_lat + g1_l * m_l
        f_l = modulate(rmsnorm(h_lat, norm2[i]), sh2_l, sc2_l).reshape(-1, d)
        if last:
            y_l = channel_mixer(i, f_l, ffn_w1, ffn_w3, ffn_w2, moe_router, moe_w1, moe_w3, moe_w2)
        else:
            h_ctx = h_ctx + g1_c * m_c
            f_c = modulate(rmsnorm(h_ctx, norm2[i]), sh2_c, sc2_c).reshape(-1, d)
            y = channel_mixer(i, jnp.concatenate([f_c, f_l], axis=0),
                              ffn_w1, ffn_w3, ffn_w2, moe_router, moe_w1, moe_w3, moe_w2)
            n_c = f_c.shape[0]
            y_l = y[n_c:]
            h_ctx = h_ctx + g2_c * y[:n_c].reshape(h_ctx.shape)
        h_lat = h_lat + g2_l * y_l.reshape(h_lat.shape)
    return rmsnorm(h_lat, norm_f)
```

```cpp
#ifndef HOST_EMU
#include <hip/hip_runtime.h>
#define HD __host__ __device__ __forceinline__
#else
#include <cmath>
#include <cstdio>
#include <cstdlib>
#include <cstring>
#include <cstdint>
#define HD inline
#endif
#include <math.h>
#include <stdint.h>
#include <stdio.h>

#ifndef CFG_NB
#define CFG_NB 8
#endif
#ifndef CFG_SEQ
#define CFG_SEQ 4096
#endif
#ifndef CFG_CTX
#define CFG_CTX 256
#endif
#ifndef CFG_DEPTH
#define CFG_DEPTH 4
#endif
constexpr int NB = CFG_NB, SEQ = CFG_SEQ, CTX = CFG_CTX, DEPTH = CFG_DEPTH;
constexpr int D = 1024, GRID_W = 64;
constexpr int RPB = CTX + SEQ;
constexpr int NR = NB * RPB;
constexpr int NBLK = RPB / 64, CB = CTX / 64;
constexpr int DPROJ = 2976, PS = 3072;
constexpr int GQ = 0, GK = 192, GV = 384, GLR = 768, GG = 784, SU = 1168, MQ = 1424, MK = 1808, MV = 2192, MO = 2576, MG = 2960;
constexpr int DFF = 2816, NE = 8;
constexpr int NMOD = NB + 1;
constexpr float EPS = 1e-6f;
constexpr int MOE_MAXT = (2 * NR + NE * 255) / 256 + 1;
constexpr int MOE_PASS_T = 140;

typedef unsigned short bf16;
struct __attribute__((aligned(16))) U4 { uint32_t x, y, z, w; };
HD float bf2f(bf16 v) { uint32_t u = ((uint32_t)v) << 16; float f; memcpy(&f, &u, 4); return f; }
HD bf16 f2bf(float f) { uint32_t u; memcpy(&u, &f, 4); u += 0x7fffu + ((u >> 16) & 1u); return (bf16)(u >> 16); }
HD float siluf(float x) { return x / (1.0f + expf(-x)); }
HD float sigmoidf_(float x) { return 1.0f / (1.0f + expf(-x)); }
HD float logsigmoidf_(float x) { return x < 0.f ? x - log1pf(expf(x)) : -log1pf(expf(-x)); }
HD float gelu_tanhf(float x) { return 0.5f * x * (1.0f + tanhf(0.7978845608028654f * (x + 0.044715f * x * x * x))); }
HD int mod_index(int r) { const int b = r / RPB, t = r % RPB; return t < CTX ? NB : b; }
HD int chain_blk(int d, int step) { return d == 0 ? step : (step < CB ? CB - 1 - step : NBLK - 1 - (step - CB)); }
HD int blk_row(int b, int blk, int d, int pp) { return b * RPB + blk * 64 + (d == 0 ? pp : 63 - pp); }

constexpr size_t al256(size_t x) { return (x + 255) & ~(size_t)255; }
struct WsMap {
    size_t ctl, mod, h, abuf, winT, woutT, w13T, w2T, uni, end_fixed;
    size_t pbuf, la, qin, kin, kout, att, st, obuf, qkc, mlF, mlI, s5disc, s5AB, s5K, s5CA, s5st, end_mix;
    size_t act, end_ffn;
    size_t mw13T, mw2T, xs, mact, yrow, rt_e, rt_w, rt_dest, segcnt, ecnt, row_token, tile_e, ntile, end_moe;
    size_t end;
};
constexpr WsMap make_map() {
    WsMap m{}; size_t o = 0;
    m.ctl = o; o += 1 << 20;
    m.mod = o; o += al256((size_t)DEPTH * NMOD * 6 * D * 4);
    m.h = o; o += al256((size_t)NR * D * 4);
    m.abuf = o; o += al256((size_t)NR * D * 2);
    m.winT = o; o += al256((size_t)DEPTH * PS * D * 2);
    m.woutT = o; o += al256((size_t)DEPTH * D * D * 2);
    m.w13T = o; o += al256((size_t)((DEPTH + 1) / 2) * 2 * DFF * D * 2);
    m.w2T = o; o += al256((size_t)((DEPTH + 1) / 2) * D * DFF * 2);
    m.uni = o; m.end_fixed = o;
    o = m.uni;
    m.pbuf = o; o += al256((size_t)NR * PS * 2);
    m.la = o; o += al256((size_t)NR * 192 * 4);
    m.qin = o; o += al256((size_t)NR * 192 * 2);
    m.kin = o; o += al256((size_t)NR * 192 * 2);
    m.kout = o; o += al256((size_t)NR * 192 * 2);
    m.att = o; o += al256((size_t)NB * NBLK * 4 * 4096 * 4);
    m.st = o; o += al256((size_t)NB * NBLK * 4 * 96 * 97 * 4);
    m.obuf = o; o += al256((size_t)NR * 384 * 4);
    m.qkc = o; o += al256((size_t)NR * 768 * 2);
    m.mlF = o; o += al256((size_t)2 * NR * 4 * 4);
    m.mlI = o; o += al256((size_t)2 * NR * 4 * 4);
    m.s5disc = o; o += al256((size_t)2 * 16 * 64 * 4 * 4);
    m.s5AB = o; o += al256((size_t)2 * 16 * 64 * 64 * 16 * 2 * 4);
    m.s5K = o; o += al256((size_t)2 * 16 * 64 * 256 * 4);
    m.s5CA = o; o += al256((size_t)2 * 16 * 64 * 16 * 64 * 2 * 4);
    m.s5st = o; o += al256((size_t)NB * NBLK * 16 * 64 * 2 * 4);
    m.end_mix = o;
    o = m.uni;
    m.act = o; o += al256((size_t)NR * DFF * 2);
    m.end_ffn = o;
    o = m.uni;
    m.mw13T = o; o += al256((size_t)NE * 2 * DFF * D * 2);
    m.mw2T = o; o += al256((size_t)NE * D * DFF * 2);
    m.xs = o; o += al256((size_t)MOE_PASS_T * 256 * D * 2);
    m.mact = o; o += al256((size_t)MOE_PASS_T * 256 * DFF * 2);
    m.yrow = o; o += al256((size_t)MOE_MAXT * 256 * D * 2);
    m.rt_e = o; o += al256((size_t)NR * 2 * 4);
    m.rt_w = o; o += al256((size_t)NR * 2 * 4);
    m.rt_dest = o; o += al256((size_t)NR * 2 * 4);
    m.segcnt = o; o += al256((size_t)NE * (NR / 64 + 1) * 4);
    m.ecnt = o; o += al256((size_t)64 * 4);
    m.row_token = o; o += al256((size_t)MOE_MAXT * 256 * 4);
    m.tile_e = o; o += al256((size_t)MOE_MAXT * 4);
    m.ntile = o; o += 256;
    m.end_moe = o;
    m.end = m.end_mix > m.end_moe ? m.end_mix : m.end_moe; if (m.end_ffn > m.end) m.end = m.end_ffn;
    return m;
}
constexpr WsMap WS = make_map();

struct InitH { long n; const float* x; const float* ctx; float* h;
    HD void operator()(long i) const { const int r = (int)(i / D), c = (int)(i % D); const int b = r / RPB, t = r % RPB;
        if (t < CTX) { h[i] = ctx[((size_t)b * CTX + t) * D + c]; return; }
        const int tl = t - CTX, row = tl / GRID_W, col = tl % GRID_W; const int q = c >> 8, j = c & 255;
        const float omega = expf(-9.210340371976184f * (float)j / 256.0f); const float p = (q < 2) ? (float)row : (float)col; const float ang = p * omega;
        const float pe = (q & 1) ? cosf(ang) : sinf(ang);
        h[i] = x[((size_t)b * SEQ + tl) * D + c] + pe; } };
struct ModK { long n; const float* c; const float* cctx; const float* w_ada; const float* b_ada; float* mod;
    HD void operator()(long i) const { const int l = (int)(i / (6 * D)), j = (int)(i % (6 * D));
        float acc[NMOD];
        for (int m = 0; m < NMOD; ++m) acc[m] = b_ada[(size_t)l * 6 * D + j];
        const float* w = w_ada + (size_t)l * D * 6 * D + j;
        for (int k = 0; k < D; ++k) { const float wv = w[(size_t)k * 6 * D];
            for (int m = 0; m < NMOD; ++m) { const float cv = (m < NB) ? c[m * D + k] : cctx[k]; acc[m] += siluf(cv) * wv; } }
        for (int m = 0; m < NMOD; ++m) mod[((size_t)l * NMOD + m) * 6 * D + j] = acc[m]; } };
struct TransposeK { long n; const float* a; const float* b; bf16* dst; int K, N, NP, pad;
    HD void operator()(long i) const { const int nn = (int)(i / K), k = (int)(i % K);
        float v = 0.f;
        if (b) { const int j = nn >> 1; v = (nn & 1) ? b[(size_t)k * N + j] : a[(size_t)k * N + j]; }
        else if (nn < N) v = a[(size_t)k * N + nn];
        dst[i] = f2bf(v); } };
struct NormModK { long n; const float* h; const float* g; const float* mod; int sh_off, sc_off; bf16* out; const float* wr; int* rt_e; float* rt_w; int skip_ctx, pad;
    HD void operator()(long r) const { const float* hr = h + (size_t)r * D; float ss = 0.f;
        for (int k = 0; k < D; ++k) ss += hr[k] * hr[k];
        const float rstd = 1.0f / sqrtf(ss / D + EPS); const float* m = mod + (size_t)mod_index((int)r) * 6 * D;
        float lg[NE]; for (int e = 0; e < NE; ++e) lg[e] = 0.f;
        for (int k = 0; k < D; ++k) { const float v = hr[k] * rstd * g[k] * (1.0f + m[sc_off + k]) + m[sh_off + k]; out[(size_t)r * D + k] = f2bf(v);
            if (wr) for (int e = 0; e < NE; ++e) lg[e] += v * wr[k * NE + e]; }
        if (wr) { int e0 = 0; float b0 = lg[0]; for (int e = 1; e < NE; ++e) if (lg[e] > b0) { b0 = lg[e]; e0 = e; }
            int e1 = -1; float b1 = -3.0e38f; for (int e = 0; e < NE; ++e) if (e != e0 && lg[e] > b1) { b1 = lg[e]; e1 = e; }
            const float w1 = 1.0f / (1.0f + expf(b1 - b0));
            const bool skip = skip_ctx && ((int)(r % RPB) < CTX);
            rt_e[2 * r] = skip ? -1 : e0; rt_e[2 * r + 1] = skip ? -1 : e1; rt_w[2 * r] = w1; rt_w[2 * r + 1] = 1.0f - w1; } } };

struct GlaLa { long n; const bf16* p; const float* wa2; const float* ba; float* la; int d, pad;
    HD void operator()(long i) const { const int r = (int)(i / 192), j = (int)(i % 192); float z = ba[d * 192 + j];
        for (int q = 0; q < 16; ++q) z += bf2f(p[(size_t)r * PS + GLR + q]) * wa2[((size_t)d * 16 + q) * 192 + j];
        la[i] = logsigmoidf_(z) * (1.0f / 16.0f); } };
struct GlaCum { long n; float* la; int d, pad;
    HD void operator()(long i) const { const int j = (int)(i % 192); const int bb = (int)(i / 192); const int b = bb / NBLK, blk = bb % NBLK; float c = 0.f;
        for (int pp = 0; pp < 64; ++pp) { const size_t o = (size_t)blk_row(b, blk, d, pp) * 192 + j; c += la[o]; la[o] = c; } } };
struct GlaQk { long n; const bf16* p; const float* bc; bf16* qin; bf16* kin; bf16* kout; int d, pad;
    HD void operator()(long i) const { const int r = (int)(i / 192), j = (int)(i % 192); const int b = r / RPB, blk = (r % RPB) / 64;
        const float bt = bc[i], be = bc[(size_t)blk_row(b, blk, d, 63) * 192 + j];
        const float q = bf2f(p[(size_t)r * PS + GQ + j]) * 0.14433756729740643f, k = bf2f(p[(size_t)r * PS + GK + j]);
        qin[i] = f2bf(q * expf(bt)); kin[i] = f2bf(k * expf(-bt)); kout[i] = f2bf(k * expf(be - bt)); } };
struct GlaDs { long n; const bf16* p; const bf16* kout; float* st;
    HD void operator()(long x) const { const int j = (int)(x % 96); long y = x / 96; const int i = (int)(y % 48); y /= 48; const int hh = (int)(y % 4); y /= 4; const int blk = (int)(y % NBLK), b = (int)(y / NBLK);
        float acc = 0.f; const size_t r0 = (size_t)b * RPB + blk * 64;
        for (int s = 0; s < 64; ++s) acc += bf2f(kout[(r0 + s) * 192 + hh * 48 + i]) * bf2f(p[(r0 + s) * PS + GV + hh * 96 + j]);
        st[x] = acc; } };
struct GlaCarry { long n; const float* bc; float* st; int d, pad;
    HD void operator()(long x) const { const int j = (int)(x % 96); long y = x / 96; const int i = (int)(y % 48); y /= 48; const int hh = (int)(y % 4), b = (int)(y / 4);
        float s = 0.f;
        for (int step = 0; step < NBLK; ++step) { const int blk = chain_blk(d, step); const size_t o = ((((size_t)b * NBLK + blk) * 4 + hh) * 48 + i) * 96 + j;
            const float tmp = st[o]; st[o] = s; s = expf(bc[(size_t)blk_row(b, blk, d, 63) * 192 + hh * 48 + i]) * s + tmp; } } };
struct GlaAtt { long n; const bf16* qin; const bf16* kin; float* att; int d, pad;
    HD void operator()(long x) const { const int s = (int)(x % 64); long y = x / 64; const int t = (int)(y % 64); y /= 64; const int hh = (int)(y % 4); y /= 4; const int blk = (int)(y % NBLK), b = (int)(y / NBLK);
        const bool valid = d == 0 ? (s <= t) : (s >= t); float acc = 0.f;
        if (valid) { const size_t r0 = (size_t)b * RPB + blk * 64; for (int q = 0; q < 48; ++q) acc += bf2f(qin[(r0 + t) * 192 + hh * 48 + q]) * bf2f(kin[(r0 + s) * 192 + hh * 48 + q]); }
        att[x] = acc; } };
struct GlaO { long n; const bf16* p; const bf16* qin; const float* att; const float* st; float* obuf; int d, pad;
    HD void operator()(long x) const { const int j = (int)(x % 96); long y = x / 96; const int hh = (int)(y % 4); const int r = (int)(y / 4); const int b = r / RPB, t = r % RPB, blk = t / 64, tt = t % 64;
        const size_t r0 = (size_t)b * RPB + blk * 64; const float* at = att + ((((size_t)b * NBLK + blk) * 4 + hh) * 64 + tt) * 64; float acc = 0.f;
        for (int s = 0; s < 64; ++s) acc += at[s] * bf2f(p[(r0 + s) * PS + GV + hh * 96 + j]);
        const float* sp = st + (((size_t)b * NBLK + blk) * 4 + hh) * 48 * 96 + j;
        for (int q = 0; q < 48; ++q) acc += bf2f(qin[(size_t)r * 192 + hh * 48 + q]) * sp[q * 96];
        if (d == 0) obuf[x] = acc; else obuf[x] += acc; } };
struct HeadFin { long n; const bf16* p; const float* obuf; const float* gain; bf16* mix; int mode, pad;
    HD void operator()(long x) const { const int hh = (int)(x % 4), r = (int)(x / 4); const float* o = obuf + (size_t)r * 384 + hh * 96; float ss = 0.f;
        for (int j = 0; j < 96; ++j) ss += o[j] * o[j];
        const float rstd = 1.0f / sqrtf(ss / 96.0f + EPS);
        for (int j = 0; j < 96; ++j) { const float gv = bf2f(p[(size_t)r * PS + (mode ? MO : GG) + hh * 96 + j]); const float gt = mode ? sigmoidf_(gv) : siluf(gv);
            mix[(size_t)r * D + (mode ? 640 : 0) + hh * 96 + j] = f2bf(o[j] * rstd * gain[j] * gt); } } };

struct MlConv { long n; const bf16* p; const float* cw; const float* cb; bf16* qkc;
    HD void operator()(long i) const { const int r = (int)(i / 768), c = (int)(i % 768); const int t = r % RPB; const bool first = (t == 0 || t == CTX), last = (t == CTX - 1 || t == RPB - 1);
        float y = cw[768 + c] * bf2f(p[(size_t)r * PS + MQ + c]);
        if (!first) y += cw[c] * bf2f(p[(size_t)(r - 1) * PS + MQ + c]);
        if (!last) y += cw[2 * 768 + c] * bf2f(p[(size_t)(r + 1) * PS + MQ + c]);
        float v = siluf(y + cb[c]); if (c >= 384) v *= 0.10206207261596577f; qkc[i] = f2bf(v); } };
struct MlGates { long n; const bf16* p; const float* gb; float* F; float* I;
    HD void operator()(long x) const { const int hh = (int)(x % 4); long y = x / 4; const int blk = (int)(y % NBLK); y /= NBLK; const int b = (int)(y % NB), d = (int)(y / NB); float c = 0.f;
        for (int pp = 0; pp < 64; ++pp) { const int r = blk_row(b, blk, d, pp); const float gi = bf2f(p[(size_t)r * PS + MG + (2 * d) * 4 + hh]) + gb[(2 * d) * 4 + hh];
            const float gf = bf2f(p[(size_t)r * PS + MG + (2 * d + 1) * 4 + hh]) + gb[(2 * d + 1) * 4 + hh]; c += logsigmoidf_(gf);
            F[((size_t)d * NR + r) * 4 + hh] = c; I[((size_t)d * NR + r) * 4 + hh] = gi; } } };
struct MlDs { long n; const bf16* p; const bf16* qkc; const float* F; const float* I; float* st; int d, pad;
    HD void operator()(long x) const { const int j = (int)(x % 97); long y = x / 97; const int i = (int)(y % 96); y /= 96; const int hh = (int)(y % 4); y /= 4; const int blk = (int)(y % NBLK), b = (int)(y / NBLK);
        const float Fe = F[((size_t)d * NR + blk_row(b, blk, d, 63)) * 4 + hh]; float acc = 0.f; const size_t r0 = (size_t)b * RPB + blk * 64;
        for (int s = 0; s < 64; ++s) { const size_t r = r0 + s; const float w = expf(Fe - F[((size_t)d * NR + r) * 4 + hh] + I[((size_t)d * NR + r) * 4 + hh]);
            acc += w * bf2f(qkc[r * 768 + 384 + hh * 96 + i]) * (j < 96 ? bf2f(p[r * PS + MV + hh * 96 + j]) : 1.0f); }
        st[x] = acc; } };
struct MlCarry { long n; const float* F; float* st; int d, pad;
    HD void operator()(long x) const { const int j = (int)(x % 97); long y = x / 97; const int i = (int)(y % 96); y /= 96; const int hh = (int)(y % 4), b = (int)(y / 4); float s = 0.f;
        for (int step = 0; step < NBLK; ++step) { const int blk = chain_blk(d, step); const size_t o = ((((size_t)b * NBLK + blk) * 4 + hh) * 96 + i) * 97 + j;
            const float tmp = st[o]; st[o] = s; s = expf(F[((size_t)d * NR + blk_row(b, blk, d, 63)) * 4 + hh]) * s + tmp; } } };
struct MlAtt { long n; const bf16* qkc; const float* F; const float* I; float* att; int d, pad;
    HD void operator()(long x) const { const int s = (int)(x % 64); long y = x / 64; const int t = (int)(y % 64); y /= 64; const int hh = (int)(y % 4); y /= 4; const int blk = (int)(y % NBLK), b = (int)(y / NBLK);
        const bool valid = d == 0 ? (s <= t) : (s >= t); float acc = 0.f;
        if (valid) { const size_t r0 = (size_t)b * RPB + blk * 64; for (int q = 0; q < 96; ++q) acc += bf2f(qkc[(r0 + t) * 768 + hh * 96 + q]) * bf2f(qkc[(r0 + s) * 768 + 384 + hh * 96 + q]);
            acc *= expf(F[((size_t)d * NR + r0 + t) * 4 + hh] - F[((size_t)d * NR + r0 + s) * 4 + hh] + I[((size_t)d * NR + r0 + s) * 4 + hh]); }
        att[x] = acc; } };
struct MlH { long n; const bf16* p; const bf16* qkc; const float* F; const float* att; const float* st; float* obuf; int d, pad;
    HD void operator()(long x) const { const int j = (int)(x % 96); long y = x / 96; const int hh = (int)(y % 4); const int r = (int)(y / 4); const int b = r / RPB, t = r % RPB, blk = t / 64, tt = t % 64;
        const size_t r0 = (size_t)b * RPB + blk * 64; const float* at = att + ((((size_t)b * NBLK + blk) * 4 + hh) * 64 + tt) * 64; float num = 0.f, den = 0.f;
        for (int s = 0; s < 64; ++s) { num += at[s] * bf2f(p[(r0 + s) * PS + MV + hh * 96 + j]); den += at[s]; }
        const float* sp = st + (((size_t)b * NBLK + blk) * 4 + hh) * 96 * 97; float qs = 0.f, qn = 0.f;
        for (int q = 0; q < 96; ++q) { const float qv = bf2f(qkc[(size_t)r * 768 + hh * 96 + q]); qs += qv * sp[q * 97 + j]; qn += qv * sp[q * 97 + 96]; }
        const float ef = expf(F[((size_t)d * NR + r) * 4 + hh]); num += ef * qs; den += ef * qn;
        const float hv = num / fmaxf(fabsf(den), 1.0f);
        if (d == 0) obuf[x] = hv; else obuf[x] += hv; } };

struct S5Disc { long n; const float* lre; const float* lim; const float* ldt; float* disc;
    HD void operator()(long x) const { const int nn = (int)(x % 64); const int dg = (int)(x / 64); const float dt = expf(ldt[dg]); const float lr = lre[x], li = lim[x];
        const float mag = expf(lr * dt), ar = mag * cosf(li * dt), ai = mag * sinf(li * dt), den = lr * lr + li * li, pr = ar - 1.0f, pi = ai;
        disc[x * 4 + 0] = lr * dt; disc[x * 4 + 1] = li * dt; disc[x * 4 + 2] = (pr * lr + pi * li) / den; disc[x * 4 + 3] = (pi * lr - pr * li) / den; (void)nn; } };
HD void s5_apow(const float* disc4, float tau, float& ar, float& ai) { const float mag = expf(disc4[0] * tau); ar = mag * cosf(disc4[1] * tau); ai = mag * sinf(disc4[1] * tau); }
struct S5AB { long n; const float* disc; const float* bre; const float* bim; float* AB;
    HD void operator()(long x) const { const int pp = (int)(x % 16); long y = x / 16; const int nn = (int)(y % 64); y /= 64; const int tau = (int)(y % 64); y /= 64; const int g = (int)(y % 16), d = (int)(y / 16);
        const float* d4 = disc + (((size_t)d * 16 + g) * 64 + nn) * 4; float ar, ai; s5_apow(d4, (float)tau, ar, ai);
        const float br = bre[((size_t)g * 64 + nn) * 16 + pp], bi = bim[((size_t)g * 64 + nn) * 16 + pp];
        const float bbr = d4[2] * br - d4[3] * bi, bbi = d4[2] * bi + d4[3] * br;
        AB[x * 2] = ar * bbr - ai * bbi; AB[x * 2 + 1] = ar * bbi + ai * bbr; } };
struct S5K { long n; const float* AB; const float* cre; const float* cim; float* Kt;
    HD void operator()(long x) const { const int p2 = (int)(x % 16); long y = x / 16; const int p1 = (int)(y % 16); y /= 16; const int tau = (int)(y % 64); y /= 64; const int g = (int)(y % 16), d = (int)(y / 16);
        const float* ab = AB + ((((size_t)d * 16 + g) * 64 + tau) * 64) * 16 * 2; float acc = 0.f;
        for (int nn = 0; nn < 64; ++nn) acc += cre[((size_t)g * 16 + p1) * 64 + nn] * ab[(nn * 16 + p2) * 2] - cim[((size_t)g * 16 + p1) * 64 + nn] * ab[(nn * 16 + p2) * 2 + 1];
        Kt[x] = acc; } };
struct S5CA { long n; const float* disc; const float* cre; const float* cim; float* CA;
    HD void operator()(long x) const { const int nn = (int)(x % 64); long y = x / 64; const int p1 = (int)(y % 16); y /= 16; const int tau = (int)(y % 64); y /= 64; const int g = (int)(y % 16), d = (int)(y / 16);
        float ar, ai; s5_apow(disc + (((size_t)d * 16 + g) * 64 + nn) * 4, (float)(tau + 1), ar, ai);
        const float cr = cre[((size_t)g * 16 + p1) * 64 + nn], ci = cim[((size_t)g * 16 + p1) * 64 + nn];
        CA[x * 2] = cr * ar - ci * ai; CA[x * 2 + 1] = cr * ai + ci * ar; } };
struct S5E { long n; const bf16* p; const float* AB; float* st; int d, pad;
    HD void operator()(long x) const { const int nn = (int)(x % 64); long y = x / 64; const int g = (int)(y % 16); y /= 16; const int blk = (int)(y % NBLK), b = (int)(y / NBLK); float er = 0.f, ei = 0.f;
        for (int pp = 0; pp < 64; ++pp) { const int r = blk_row(b, blk, d, pp); const float* ab = AB + (((((size_t)d * 16 + g) * 64 + (63 - pp)) * 64 + nn) * 16) * 2;
            for (int q = 0; q < 16; ++q) { const float u = bf2f(p[(size_t)r * PS + SU + g * 16 + q]); er += ab[q * 2] * u; ei += ab[q * 2 + 1] * u; } }
        st[x * 2] = er; st[x * 2 + 1] = ei; } };
struct S5Carry { long n; const float* disc; float* st; int d, pad;
    HD void operator()(long x) const { const int nn = (int)(x % 64); long y = x / 64; const int g = (int)(y % 16), b = (int)(y / 16); float ar, ai; s5_apow(disc + (((size_t)d * 16 + g) * 64 + nn) * 4, 64.0f, ar, ai);
        float sr = 0.f, si = 0.f;
        for (int step = 0; step < NBLK; ++step) { const int blk = chain_blk(d, step); const size_t o = ((((size_t)b * NBLK + blk) * 16 + g) * 64 + nn) * 2;
            const float tr = st[o], ti = st[o + 1]; st[o] = sr; st[o + 1] = si; const float nr = ar * sr - ai * si + tr, ni = ar * si + ai * sr + ti; sr = nr; si = ni; } } };
struct S5Y { long n; const bf16* p; const float* Kt; const float* CA; const float* st; float* ybuf; int d, pad;
    HD void operator()(long x) const { const int p1 = (int)(x % 16); long y = x / 16; const int g = (int)(y % 16); const int r = (int)(y / 16); const int b = r / RPB, t = r % RPB, blk = t / 64, tt = t % 64;
        const int pt = d == 0 ? tt : 63 - tt; float acc = 0.f;
        for (int ps = 0; ps <= pt; ++ps) { const int rs = blk_row(b, blk, d, ps); const float* kk = Kt + ((((size_t)d * 16 + g) * 64 + (pt - ps)) * 16 + p1) * 16;
            for (int q = 0; q < 16; ++q) acc += kk[q] * bf2f(p[(size_t)rs * PS + SU + g * 16 + q]); }
        const float* ca = CA + (((((size_t)d * 16 + g) * 64 + pt) * 16 + p1) * 64) * 2; const float* sp = st + ((((size_t)b * NBLK + blk) * 16 + g) * 64) * 2;
        for (int nn = 0; nn < 64; ++nn) acc += ca[nn * 2] * sp[nn * 2] - ca[nn * 2 + 1] * sp[nn * 2 + 1];
        if (d == 0) ybuf[x] = acc; else ybuf[x] += acc; } };
struct S5Z { long n; const bf16* p; const float* dskip; float* ybuf;
    HD void operator()(long i) const { const int r = (int)(i / 256), c = (int)(i % 256); ybuf[i] = gelu_tanhf(ybuf[i] + dskip[c] * bf2f(p[(size_t)r * PS + SU + c])); } };
struct S5Glu { long n; const float* z; const float* gw; const float* gb; bf16* mix;
    HD void operator()(long i) const { const int r = (int)(i / 256), c = (int)(i % 256); float acc = gb[c]; const float* zr = z + (size_t)r * 256;
        for (int k = 0; k < 256; ++k) acc += zr[k] * gw[k * 256 + c];
        mix[(size_t)r * D + 384 + c] = f2bf(zr[c] * sigmoidf_(acc)); } };

struct MoeSegCount { long n; const int* rt_e; int* segcnt; int nseg, pad;
    HD void operator()(long x) const { const int seg = (int)(x % nseg), e = (int)(x / nseg); int c = 0;
        for (int r = seg * 64; r < seg * 64 + 64 && r < NR; ++r) { c += (rt_e[2 * r] == e) + (rt_e[2 * r + 1] == e); }
        segcnt[(size_t)e * nseg + seg] = c; } };
struct MoePrefix { long n; int* segcnt; int* ecnt; int nseg, pad;
    HD void operator()(long e) const { int c = 0; for (int s = 0; s < nseg; ++s) { const int v = segcnt[(size_t)e * nseg + s]; segcnt[(size_t)e * nseg + s] = c; c += v; } ecnt[e] = c; } };
struct MoeTiles { long n; const int* ecnt; int* tile_e; int* ntile; int* row_token;
    HD void operator()(long) const { int t = 0; for (int e = 0; e < NE; ++e) { const int nt = (ecnt[e] + 255) / 256; for (int q = 0; q < nt; ++q) tile_e[t++] = e; }
        ntile[0] = t; for (int q = t; q < MOE_MAXT; ++q) tile_e[q] = 0; } };
struct MoeFillNeg { long n; int* row_token; HD void operator()(long i) const { row_token[i] = -1; } };
struct MoeAssign { long n; const int* rt_e; const int* segcnt; const int* ecnt; int* rt_dest; int* row_token; int nseg, pad;
    HD void operator()(long x) const { const int seg = (int)(x % nseg), e = (int)(x / nseg); int pstart = 0; for (int q = 0; q < e; ++q) pstart += (ecnt[q] + 255) / 256 * 256;
        int pos = pstart + segcnt[(size_t)e * nseg + seg];
        for (int r = seg * 64; r < seg * 64 + 64 && r < NR; ++r) for (int k = 0; k < 2; ++k) if (rt_e[2 * r + k] == e) { rt_dest[2 * r + k] = pos; row_token[pos] = r; ++pos; } } };
struct MoeGather { long n; const bf16* f; const int* row_token; bf16* xs; int row0, pad;
    HD void operator()(long i) const { const int lr = (int)(i / (D / 8)), c8 = (int)(i % (D / 8)); const int tok = row_token[row0 + lr];
        U4 v; v.x = v.y = v.z = v.w = 0u; if (tok >= 0) v = *(const U4*)(f + (size_t)tok * D + c8 * 8); *(U4*)(xs + (size_t)lr * D + c8 * 8) = v; } };
struct MoeCombine { long n; float* h; const bf16* yrow; const int* rt_e; const float* rt_w; const int* rt_dest; const float* mod; int g_off, pad;
    HD void operator()(long i) const { const int r = (int)(i / D), c = (int)(i % D); if (rt_e[2 * r] < 0) return;
        const float y = rt_w[2 * r] * bf2f(yrow[(size_t)rt_dest[2 * r] * D + c]) + rt_w[2 * r + 1] * bf2f(yrow[(size_t)rt_dest[2 * r + 1] * D + c]);
        h[i] += mod[(size_t)mod_index(r) * 6 * D + g_off + c] * y; } };
struct FinalNorm { long n; const float* h; const float* g; float* out;
    HD void operator()(long x) const { const int b = (int)(x / SEQ), tl = (int)(x % SEQ); const float* hr = h + ((size_t)b * RPB + CTX + tl) * D; float ss = 0.f;
        for (int k = 0; k < D; ++k) ss += hr[k] * hr[k];
        const float rstd = 1.0f / sqrtf(ss / D + EPS); for (int k = 0; k < D; ++k) out[(size_t)x * D + k] = hr[k] * rstd * g[k]; } };

struct EpiStoreBf16 { bf16* out; int ld; int row_off;
    HD void apply8(int row, int col0, const float* v) const { bf16* o = out + (size_t)(row - row_off) * ld + col0; for (int i = 0; i < 8; ++i) o[i] = f2bf(v[i]); } };
struct EpiSwiGLU { bf16* out; int ld; int row_off;
    HD void apply8(int row, int col0, const float* v) const { bf16* o = out + (size_t)(row - row_off) * ld + col0 / 2; for (int i = 0; i < 4; ++i) o[i] = f2bf(siluf(v[2 * i]) * v[2 * i + 1]); } };
struct EpiResid { float* h; const float* mod; int g_off, pad;
    HD void apply8(int row, int col0, const float* v) const { float* o = h + (size_t)row * D + col0; const float* g = mod + (size_t)mod_index(row) * 6 * D + g_off + col0; for (int i = 0; i < 8; ++i) o[i] += g[i] * v[i]; } };

struct GemmDesc { const bf16* A; const bf16* Bt; const int* tile_e; const int* ntile; size_t e_stride; int M, N, K, tile0; };

#ifndef HOST_EMU
namespace pg8 {
#define PG8_LAS __attribute__((address_space(3)))
typedef short bf16x8 __attribute__((ext_vector_type(8)));
typedef float f32x4 __attribute__((ext_vector_type(4)));
constexpr int BM = 256, BK = 64, HALF = 128, HTB = HALF * BK * 2, STAGE_BYTES = 8 * HTB, NXCD = 8, WGM = 8;
__device__ __forceinline__ int lds_byte(int r, int c) { const int st = (r >> 4) * 2 + (c >> 5), rr = r & 15, cc = c & 31, ob = rr * 64 + cc * 2; return st * 1024 + (ob ^ (((ob >> 9) & 1) << 5)); }
__device__ __forceinline__ void stage_rc(int b, int& R, int& C) { const int st = b / 1024, sb = b % 1024, swz = sb ^ (((sb >> 9) & 1) << 5); R = (st >> 1) * 16 + swz / 64; C = (st & 1) * 32 + (swz % 64) / 2; }
__device__ __forceinline__ int perm32(int rho) { const int n = rho >> 4, i = rho & 15; return 8 * (i >> 2) + 4 * n + (i & 3); }
struct Unit { int pm, pn; };
struct StaticOrder {
    int nM, nN, nwg, G, c;
    __device__ void init(int M, int N, int G_, int c_) { nM = M / BM; nN = N / BM; nwg = nM * nN; G = G_; c = c_; }
    __device__ bool next(int i, Unit& u) const {
        const long L = (long)i * G + c; if (L >= nwg) return false;
        int wgid = (int)L; { const int q = nwg / NXCD, r = nwg % NXCD, xcd = wgid % NXCD, off = wgid / NXCD; wgid = (xcd < r ? xcd * (q + 1) : r * (q + 1) + (xcd - r) * q) + off; }
        const int nig = WGM * nN, gid = wgid / nig, fm = gid * WGM, gsz = (nM - fm) < WGM ? (nM - fm) : WGM;
        u.pm = fm + ((wgid % nig) % gsz); u.pn = (wgid % nig) / gsz; return true;
    }
};
template <class F> __device__ __forceinline__ void epi_apply(const F& f, const f32x4 (&acc)[2][2][4][2], const Unit& u, int wr, int wc, int fr, int fq) {
    const int row0 = u.pm * BM + wr * 64 + fr, col0 = u.pn * BM + wc * 32 + 8 * fq;
#pragma unroll
    for (int ai = 0; ai < 2; ++ai)
#pragma unroll
        for (int m = 0; m < 4; ++m)
#pragma unroll
            for (int bj = 0; bj < 2; ++bj) { const f32x4 v0 = acc[ai][bj][m][0], v1 = acc[ai][bj][m][1];
                const float v[8] = {v0[0], v0[1], v0[2], v0[3], v1[0], v1[1], v1[2], v1[3]};
                f.apply8(row0 + ai * HALF + m * 16, col0 + bj * HALF, v); }
}
template <class F>
__device__ __forceinline__ void gemm_phase(PG8_LAS unsigned char* lds, const GemmDesc g, const F& E, int G_, int c_) {
    const int tid = threadIdx.x, wid = __builtin_amdgcn_readfirstlane(tid >> 6), lane = tid & 63, wr = wid >> 2, wc = wid & 3, fr = lane & 15, fq = lane >> 4;
    const int K = g.K, nt = K / BK;
    int M = g.M; if (g.ntile) { int ntl = g.ntile[0] - g.tile0; ntl = ntl < 0 ? 0 : ntl; if (ntl * BM < M) M = ntl * BM; }
    StaticOrder S; S.init(M, g.N, G_, c_);
    unsigned voffA[2], voffB[2];
#pragma unroll
    for (int i = 0; i < 2; ++i) { int R, C; stage_rc(tid * 16 + i * 8192, R, C); const int Rb = (R & ~31) + perm32(R & 31);
        voffA[i] = (unsigned)(R * K + C) * 2u; voffB[i] = (unsigned)(Rb * K + C) * 2u; }
    const size_t kstep = (size_t)(BK * 2);
    const size_t hstep = (size_t)HALF * K * 2;
    const size_t tstep = 2 * hstep;
    const unsigned ldsw = (unsigned)wid * 1024u;
    const int aoff = lds_byte(wr * 64 + fr, fq * 8), boff = lds_byte(wc * 32 + fr, fq * 8);
#define PG8_SA(b, h) (((b) * 2 + (h)) * HTB)
#define PG8_SB(b, h) ((4 + (b) * 2 + (h)) * HTB)
#define PG8_STAGE(bufoff, gbase, voff) do { _Pragma("unroll") for (int _i = 0; _i < 2; ++_i) \
        __builtin_amdgcn_global_load_lds((const unsigned*)((const char*)(gbase) + (voff)[_i]), (PG8_LAS unsigned*)(lds + (bufoff) + ldsw + _i * 8192), 16, 0, 0); } while (0)
#define PG8_LDA(dst, b, h) do { _Pragma("unroll") for (int m = 0; m < 4; ++m) _Pragma("unroll") for (int k = 0; k < 2; ++k) dst[m][k] = *(const PG8_LAS bf16x8*)(lds + PG8_SA(b, h) + aoff + m * 2048 + k * 1024); } while (0)
#define PG8_LDB(dst, b, h) do { _Pragma("unroll") for (int n = 0; n < 2; ++n) _Pragma("unroll") for (int k = 0; k < 2; ++k) dst[n][k] = *(const PG8_LAS bf16x8*)(lds + PG8_SB(b, h) + boff + n * 2048 + k * 1024); } while (0)
#define PG8_MMA(ai, bj, At, Bt) do { __builtin_amdgcn_s_setprio(1); _Pragma("unroll") for (int m = 0; m < 4; ++m) _Pragma("unroll") for (int n = 0; n < 2; ++n) _Pragma("unroll") for (int k = 0; k < 2; ++k) \
        acc[ai][bj][m][n] = __builtin_amdgcn_mfma_f32_16x16x32_bf16(Bt[n][k], At[m][k], acc[ai][bj][m][n], 0, 0, 0); __builtin_amdgcn_s_setprio(0); } while (0)
#define PG8_WAIT_V(n) asm volatile("s_waitcnt vmcnt(" #n ")" ::: "memory")
#define PG8_WAIT_L(n) asm volatile("s_waitcnt lgkmcnt(" #n ")" ::: "memory")
#define PG8_BAR __builtin_amdgcn_s_barrier()
#define PG8_SCHED __builtin_amdgcn_sched_barrier(0)
#define PG8_BBASE(u) ((const char*)g.Bt + (g.tile_e ? (size_t)g.tile_e[g.tile0 + (u).pm] * g.e_stride * 2 : (size_t)0) + (size_t)(u).pn * tstep)
    Unit cur, nxt; int ui = 0;
    if (!S.next(0, cur)) return;
    f32x4 acc[2][2][4][2];
#pragma unroll
    for (int a = 0; a < 2; ++a)
#pragma unroll
        for (int b = 0; b < 2; ++b)
#pragma unroll
            for (int m = 0; m < 4; ++m)
#pragma unroll
                for (int n = 0; n < 2; ++n) acc[a][b][m][n] = (f32x4){0.f, 0.f, 0.f, 0.f};
    bf16x8 At[4][2], B0[2][2], B1[2][2];
    const char* cA = (const char*)g.A + (size_t)cur.pm * tstep; const char* cB = PG8_BBASE(cur);
    PG8_STAGE(PG8_SB(0, 0), cB, voffB); PG8_STAGE(PG8_SA(0, 0), cA, voffA); PG8_STAGE(PG8_SB(0, 1), cB + hstep, voffB); PG8_STAGE(PG8_SA(0, 1), cA + hstep, voffA);
    if (wr == 1) PG8_BAR;
    PG8_WAIT_V(4); PG8_BAR;
    PG8_STAGE(PG8_SB(1, 0), cB + kstep, voffB); PG8_STAGE(PG8_SA(1, 0), cA + kstep, voffA); PG8_STAGE(PG8_SB(1, 1), cB + hstep + kstep, voffB);
    PG8_WAIT_V(6); PG8_BAR;
    for (;;) {
        const bool has_next = S.next(ui + 1, nxt);
        const char* nA = has_next ? (const char*)g.A + (size_t)nxt.pm * tstep : cA; const char* nB = has_next ? PG8_BBASE(nxt) : cB;
        for (int t = 0; t < nt; t += 2) {
            const bool last = (t == nt - 2);
            const char* a1 = cA + (size_t)(t + 1) * kstep;
            const char* a2 = last ? nA : cA + (size_t)(t + 2) * kstep; const char* b2 = last ? nB : cB + (size_t)(t + 2) * kstep;
            const char* a3 = a2 + kstep; const char* b3 = b2 + kstep;
            PG8_LDB(B0, 0, 0); PG8_SCHED; PG8_LDA(At, 0, 0); PG8_STAGE(PG8_SA(1, 1), a1 + hstep, voffA);
            PG8_WAIT_L(8); PG8_BAR; PG8_WAIT_L(0); PG8_MMA(0, 0, At, B0); PG8_BAR; PG8_SCHED;
            PG8_LDB(B1, 0, 1); PG8_STAGE(PG8_SB(0, 0), b2, voffB);
            PG8_BAR; PG8_WAIT_L(0); PG8_MMA(0, 1, At, B1); PG8_BAR;
            PG8_LDA(At, 0, 1); PG8_STAGE(PG8_SA(0, 0), a2, voffA);
            PG8_BAR; PG8_WAIT_L(0); PG8_MMA(1, 0, At, B0); PG8_BAR; PG8_SCHED;
            PG8_STAGE(PG8_SB(0, 1), b2 + hstep, voffB);
            PG8_WAIT_V(6); PG8_BAR; PG8_MMA(1, 1, At, B1); PG8_BAR;
            PG8_LDB(B0, 1, 0); PG8_SCHED; PG8_LDA(At, 1, 0); PG8_STAGE(PG8_SA(0, 1), a2 + hstep, voffA);
            PG8_WAIT_L(8); PG8_BAR; PG8_WAIT_L(0); PG8_MMA(0, 0, At, B0); PG8_BAR; PG8_SCHED;
            PG8_LDB(B1, 1, 1); PG8_STAGE(PG8_SB(1, 0), b3, voffB);
            PG8_BAR; PG8_WAIT_L(0); PG8_MMA(0, 1, At, B1); PG8_BAR;
            PG8_LDA(At, 1, 1); PG8_STAGE(PG8_SA(1, 0), a3, voffA);
            PG8_BAR; PG8_WAIT_L(0); PG8_MMA(1, 0, At, B0); PG8_BAR; PG8_SCHED;
            PG8_STAGE(PG8_SB(1, 1), b3 + hstep, voffB);
            PG8_WAIT_V(6); PG8_BAR; PG8_MMA(1, 1, At, B1); PG8_BAR;
        }
        epi_apply(E, acc, cur, wr, wc, fr, fq);
        if (!has_next) break;
#pragma unroll
        for (int a = 0; a < 2; ++a)
#pragma unroll
            for (int b = 0; b < 2; ++b)
#pragma unroll
                for (int m = 0; m < 4; ++m)
#pragma unroll
                    for (int n = 0; n < 2; ++n) acc[a][b][m][n] = (f32x4){0.f, 0.f, 0.f, 0.f};
        cur = nxt; cA = nA; cB = nB; ++ui;
    }
    PG8_WAIT_V(0);
    if (wr == 0) PG8_BAR;
    PG8_BAR;
#undef PG8_SA
#undef PG8_SB
#undef PG8_STAGE
#undef PG8_LDA
#undef PG8_LDB
#undef PG8_MMA
#undef PG8_WAIT_V
#undef PG8_WAIT_L
#undef PG8_BAR
#undef PG8_SCHED
#undef PG8_BBASE
}
}

template <class F> __global__ void __launch_bounds__(256) k_run(F f) {
    for (long i = (long)blockIdx.x * blockDim.x + threadIdx.x; i < f.n; i += (long)gridDim.x * blockDim.x) f(i);
}
template <class F> __global__ void __launch_bounds__(512, 2) k_gemm(GemmDesc g, F e) {
    extern __shared__ __attribute__((aligned(16))) unsigned char shm[];
    pg8::gemm_phase<F>((PG8_LAS unsigned char*)shm, g, e, (int)gridDim.x, (int)blockIdx.x);
}
struct Ctx { hipStream_t stream; int ncu; };
template <class F> static void run(const Ctx& cx, const F& f) {
    if (f.n <= 0) return; long nb = (f.n + 255) / 256; if (nb > 256L * 32) nb = 256L * 32;
    hipLaunchKernelGGL(k_run<F>, dim3((unsigned)nb), dim3(256), 0, cx.stream, f);
}
template <class F> static void gemm(const Ctx& cx, const GemmDesc& g, const F& e) {
    static bool attr_set = false;
    if (!attr_set) { (void)hipFuncSetAttribute((const void*)k_gemm<F>, hipFuncAttributeMaxDynamicSharedMemorySize, pg8::STAGE_BYTES); attr_set = true; }
    hipLaunchKernelGGL(k_gemm<F>, dim3(cx.ncu), dim3(512), pg8::STAGE_BYTES, cx.stream, g, e);
}
#else
struct Ctx { int dummy; };
template <class F> static void run(const Ctx&, const F& f) {
#pragma omp parallel for schedule(static)
    for (long i = 0; i < f.n; ++i) f(i);
}
template <class F> static void gemm(const Ctx&, const GemmDesc& g, const F& e) {
    int M = g.M; if (g.ntile) { int nt = g.ntile[0] - g.tile0; if (nt < 0) nt = 0; if (nt * 256 < M) M = nt * 256; }
#pragma omp parallel for schedule(dynamic, 4)
    for (int r = 0; r < M; ++r) {
        const bf16* a = g.A + (size_t)r * g.K; const bf16* B = g.Bt + (g.tile_e ? (size_t)g.tile_e[g.tile0 + r / 256] * g.e_stride : 0);
        static thread_local float af[4096]; for (int k = 0; k < g.K; ++k) af[k] = bf2f(a[k]);
        for (int c0 = 0; c0 < g.N; c0 += 8) { float v[8];
            for (int j = 0; j < 8; ++j) { const bf16* bt = B + (size_t)(c0 + j) * g.K; float s = 0.f; for (int k = 0; k < g.K; ++k) s += af[k] * bf2f(bt[k]); v[j] = s; }
            e.apply8(r, c0, v); }
    }
}
#endif

struct Inputs { const float *x, *c, *ctx, *c_ctx, *w_ada, *b_ada, *norm1, *norm2, *w_in, *w_out, *gla_wa2, *gla_ba, *gla_norm, *s5_lam_re, *s5_lam_im, *s5_log_dt, *s5_b_re, *s5_b_im,
    *s5_c_re, *s5_c_im, *s5_d, *s5_glu_w, *s5_glu_b, *ml_conv_w, *ml_conv_b, *ml_gate_b, *ml_norm, *ffn_w1, *ffn_w3, *ffn_w2, *moe_router, *moe_w1, *moe_w3, *moe_w2, *norm_f; };

static void forward(const Ctx& cx, const Inputs& in, float* out, unsigned char* ws) {
    float* mod = (float*)(ws + WS.mod); float* h = (float*)(ws + WS.h); bf16* abuf = (bf16*)(ws + WS.abuf);
    bf16* winT = (bf16*)(ws + WS.winT); bf16* woutT = (bf16*)(ws + WS.woutT); bf16* w13T = (bf16*)(ws + WS.w13T); bf16* w2T = (bf16*)(ws + WS.w2T);
    bf16* pbuf = (bf16*)(ws + WS.pbuf); float* la = (float*)(ws + WS.la); bf16* qin = (bf16*)(ws + WS.qin); bf16* kin = (bf16*)(ws + WS.kin); bf16* kout = (bf16*)(ws + WS.kout);
    float* att = (float*)(ws + WS.att); float* st = (float*)(ws + WS.st); float* obuf = (float*)(ws + WS.obuf); bf16* qkc = (bf16*)(ws + WS.qkc);
    float* mlF = (float*)(ws + WS.mlF); float* mlI = (float*)(ws + WS.mlI); float* s5disc = (float*)(ws + WS.s5disc); float* s5AB = (float*)(ws + WS.s5AB);
    float* s5K = (float*)(ws + WS.s5K); float* s5CA = (float*)(ws + WS.s5CA); float* s5st = (float*)(ws + WS.s5st);
    bf16* act = (bf16*)(ws + WS.act);
    bf16* mw13T = (bf16*)(ws + WS.mw13T); bf16* mw2T = (bf16*)(ws + WS.mw2T); bf16* xs = (bf16*)(ws + WS.xs); bf16* mact = (bf16*)(ws + WS.mact); bf16* yrow = (bf16*)(ws + WS.yrow);
    int* rt_e = (int*)(ws + WS.rt_e); float* rt_w = (float*)(ws + WS.rt_w); int* rt_dest = (int*)(ws + WS.rt_dest); int* segcnt = (int*)(ws + WS.segcnt); int* ecnt = (int*)(ws + WS.ecnt);
    int* row_token = (int*)(ws + WS.row_token); int* tile_e = (int*)(ws + WS.tile_e); int* ntile = (int*)(ws + WS.ntile);

    run(cx, InitH{(long)NR * D, in.x, in.ctx, h});
    run(cx, ModK{(long)DEPTH * 6 * D, in.c, in.c_ctx, in.w_ada, in.b_ada, mod});
    for (int l = 0; l < DEPTH; ++l) {
        run(cx, TransposeK{(long)PS * D, in.w_in + (size_t)l * D * DPROJ, nullptr, winT + (size_t)l * PS * D, D, DPROJ, PS});
        run(cx, TransposeK{(long)D * D, in.w_out + (size_t)l * D * D, nullptr, woutT + (size_t)l * D * D, D, D, D});
        if (l % 2 == 0) { const int j = l / 2;
            run(cx, TransposeK{(long)2 * DFF * D, in.ffn_w1 + (size_t)j * D * DFF, in.ffn_w3 + (size_t)j * D * DFF, w13T + (size_t)j * 2 * DFF * D, D, DFF, 2 * DFF});
            run(cx, TransposeK{(long)D * DFF, in.ffn_w2 + (size_t)j * DFF * D, nullptr, w2T + (size_t)j * D * DFF, DFF, D, D}); }
    }
    for (int l = 0; l < DEPTH; ++l) {
        const bool last = (l == DEPTH - 1);
        const float* modl = mod + (size_t)l * NMOD * 6 * D;
        run(cx, NormModK{(long)NR, h, in.norm1 + (size_t)l * D, modl, 0, D, abuf, nullptr, nullptr, nullptr, 0});
        gemm(cx, GemmDesc{abuf, winT + (size_t)l * PS * D, nullptr, nullptr, 0, NR, PS, D, 0}, EpiStoreBf16{pbuf, PS, 0});
        for (int d = 0; d < 2; ++d) {
            run(cx, GlaLa{(long)NR * 192, pbuf, in.gla_wa2 + (size_t)l * 2 * 16 * 192, in.gla_ba + (size_t)l * 2 * 192, la, d});
            run(cx, GlaCum{(long)NB * NBLK * 192, la, d});
            run(cx, GlaQk{(long)NR * 192, pbuf, la, qin, kin, kout, d});
            run(cx, GlaDs{(long)NB * NBLK * 4 * 48 * 96, pbuf, kout, st});
            run(cx, GlaCarry{(long)NB * 4 * 48 * 96, la, st, d});
            run(cx, GlaAtt{(long)NB * NBLK * 4 * 4096, qin, kin, att, d});
            run(cx, GlaO{(long)NR * 384, pbuf, qin, att, st, obuf, d});
        }
        run(cx, HeadFin{(long)NR * 4, pbuf, obuf, in.gla_norm + (size_t)l * 96, abuf, 0});
        run(cx, MlConv{(long)NR * 768, pbuf, in.ml_conv_w + (size_t)l * 3 * 768, in.ml_conv_b + (size_t)l * 768, qkc});
        run(cx, MlGates{(long)2 * NB * NBLK * 4, pbuf, in.ml_gate_b + (size_t)l * 16, mlF, mlI});
        for (int d = 0; d < 2; ++d) {
            run(cx, MlDs{(long)NB * NBLK * 4 * 96 * 97, pbuf, qkc, mlF, mlI, st, d});
            run(cx, MlCarry{(long)NB * 4 * 96 * 97, mlF, st, d});
            run(cx, MlAtt{(long)NB * NBLK * 4 * 4096, qkc, mlF, mlI, att, d});
            run(cx, MlH{(long)NR * 384, pbuf, qkc, mlF, att, st, obuf, d});
        }
        run(cx, HeadFin{(long)NR * 4, pbuf, obuf, in.ml_norm + (size_t)l * 96, abuf, 1});
        run(cx, S5Disc{(long)2 * 16 * 64, in.s5_lam_re + (size_t)l * 2048, in.s5_lam_im + (size_t)l * 2048, in.s5_log_dt + (size_t)l * 32, s5disc});
        run(cx, S5AB{(long)2 * 16 * 64 * 64 * 16, s5disc, in.s5_b_re + (size_t)l * 16384, in.s5_b_im + (size_t)l * 16384, s5AB});
        run(cx, S5K{(long)2 * 16 * 64 * 256, s5AB, in.s5_c_re + (size_t)l * 16384, in.s5_c_im + (size_t)l * 16384, s5K});
        run(cx, S5CA{(long)2 * 16 * 64 * 16 * 64, s5disc, in.s5_c_re + (size_t)l * 16384, in.s5_c_im + (size_t)l * 16384, s5CA});
        for (int d = 0; d < 2; ++d) {
            run(cx, S5E{(long)NB * NBLK * 16 * 64, pbuf, s5AB, s5st, d});
            run(cx, S5Carry{(long)NB * 16 * 64, s5disc, s5st, d});
            run(cx, S5Y{(long)NR * 256, pbuf, s5K, s5CA, s5st, obuf, d});
        }
        run(cx, S5Z{(long)NR * 256, pbuf, in.s5_d + (size_t)l * 256, obuf});
        run(cx, S5Glu{(long)NR * 256, obuf, in.s5_glu_w + (size_t)l * 65536, in.s5_glu_b + (size_t)l * 256, abuf});
        gemm(cx, GemmDesc{abuf, woutT + (size_t)l * D * D, nullptr, nullptr, 0, NR, D, D, 0}, EpiResid{h, modl, 2 * D});
        if (l % 2 == 0) { const int j = l / 2;
            run(cx, NormModK{(long)NR, h, in.norm2 + (size_t)l * D, modl, 3 * D, 4 * D, abuf, nullptr, nullptr, nullptr, 0});
            gemm(cx, GemmDesc{abuf, w13T + (size_t)j * 2 * DFF * D, nullptr, nullptr, 0, NR, 2 * DFF, D, 0}, EpiSwiGLU{act, DFF, 0});
            gemm(cx, GemmDesc{act, w2T + (size_t)j * D * DFF, nullptr, nullptr, 0, NR, D, DFF, 0}, EpiResid{h, modl, 5 * D});
        } else { const int j = l / 2; const int nseg = (NR + 63) / 64;
            for (int e = 0; e < NE; ++e) { const size_t wo = ((size_t)j * NE + e) * D * DFF;
                run(cx, TransposeK{(long)2 * DFF * D, in.moe_w1 + wo, in.moe_w3 + wo, mw13T + (size_t)e * 2 * DFF * D, D, DFF, 2 * DFF});
                run(cx, TransposeK{(long)D * DFF, in.moe_w2 + wo, nullptr, mw2T + (size_t)e * D * DFF, DFF, D, D}); }
            run(cx, NormModK{(long)NR, h, in.norm2 + (size_t)l * D, modl, 3 * D, 4 * D, abuf, in.moe_router + (size_t)j * D * NE, rt_e, rt_w, last ? 1 : 0});
            run(cx, MoeSegCount{(long)NE * nseg, rt_e, segcnt, nseg});
            run(cx, MoePrefix{(long)NE, segcnt, ecnt, nseg});
            run(cx, MoeFillNeg{(long)MOE_MAXT * 256, row_token});
            run(cx, MoeTiles{1, ecnt, tile_e, ntile, row_token});
            run(cx, MoeAssign{(long)NE * nseg, rt_e, segcnt, ecnt, rt_dest, row_token, nseg});
            for (int t0 = 0; t0 < MOE_MAXT; t0 += MOE_PASS_T) { const int nt = (MOE_MAXT - t0 < MOE_PASS_T) ? MOE_MAXT - t0 : MOE_PASS_T;
                run(cx, MoeGather{(long)nt * 256 * (D / 8), abuf, row_token, xs, t0 * 256});
                gemm(cx, GemmDesc{xs, mw13T, tile_e, ntile, (size_t)2 * DFF * D, nt * 256, 2 * DFF, D, t0}, EpiSwiGLU{mact, DFF, 0});
                gemm(cx, GemmDesc{mact, mw2T, tile_e, ntile, (size_t)D * DFF, nt * 256, D, DFF, t0}, EpiStoreBf16{yrow + (size_t)t0 * 256 * D, D, 0}); }
            run(cx, MoeCombine{(long)NR * D, h, yrow, rt_e, rt_w, rt_dest, modl, 5 * D});
        }
    }
    run(cx, FinalNorm{(long)NB * SEQ, h, in.norm_f, out});
}

#ifndef HOST_EMU
extern "C" void kernel_launch(void* const* d_in, const int* in_sizes, int n_in, void* d_out, int out_size, void* d_ws, size_t ws_size, hipStream_t stream) {
    static int ncu = 0;
    if (ncu == 0) { int dev = 0; hipGetDevice(&dev); hipDeviceGetAttribute(&ncu, hipDeviceAttributeMultiprocessorCount, dev); if (ncu <= 0) ncu = 256; }
    if (n_in != 35 || ws_size < WS.end || out_size != NB * SEQ * D) { fprintf(stderr, "kernel_launch: unexpected sizes n_in %d ws %zu (need %zu) out %d\n", n_in, ws_size, (size_t)WS.end, out_size); return; }
    Inputs in; const float** ip = (const float**)&in; for (int i = 0; i < 35; ++i) ip[i] = (const float*)d_in[i];
    Ctx cx{stream, ncu};
    forward(cx, in, (float*)d_out, (unsigned char*)d_ws);
}
#endif
```

```cpp
#ifndef HOST_EMU
#include <hip/hip_runtime.h>
#define HD __host__ __device__ __forceinline__
#else
#include <cmath>
#include <cstdio>
#include <cstdlib>
#include <cstring>
#include <cstdint>
#define HD inline
#endif
#include <math.h>
#include <stdint.h>
#include <stddef.h>
#include <stdio.h>

#ifndef CFG_NB
#define CFG_NB 8
#endif
#ifndef CFG_SEQ
#define CFG_SEQ 4096
#endif
#ifndef CFG_CTX
#define CFG_CTX 256
#endif
#ifndef CFG_DEPTH
#define CFG_DEPTH 4
#endif
constexpr int NB = CFG_NB, SEQ = CFG_SEQ, CTX = CFG_CTX, DEPTH = CFG_DEPTH;
constexpr int D = 1024, GRID_W = 64;
constexpr int RPB = CTX + SEQ;
constexpr int NR = NB * RPB;
constexpr int NBLK = RPB / 64, CB = CTX / 64;
constexpr int DPROJ = 2976, PS = 3072;
constexpr int GQ = 0, GK = 192, GV = 384, GLR = 768, GG = 784, SU = 1168, MQ = 1424, MK = 1808, MV = 2192, MO = 2576, MG = 2960;
constexpr int DFF = 2816, NE = 8;
constexpr int NMOD = NB + 1;
constexpr float EPS = 1e-6f;
constexpr int MOE_MAXT = (2 * NR + NE * 255) / 256 + 1;
constexpr int MOE_PASS_T = 140;

typedef unsigned short bf16;
struct __attribute__((aligned(16))) U4 { uint32_t x, y, z, w; };
HD float bf2f(bf16 v) { uint32_t u = ((uint32_t)v) << 16; float f; memcpy(&f, &u, 4); return f; }
HD bf16 f2bf(float f) { uint32_t u; memcpy(&u, &f, 4); u += 0x7fffu + ((u >> 16) & 1u); return (bf16)(u >> 16); }
HD float siluf(float x) { return x / (1.0f + expf(-x)); }
HD float sigmoidf_(float x) { return 1.0f / (1.0f + expf(-x)); }
HD float logsigmoidf_(float x) { return x < 0.f ? x - log1pf(expf(x)) : -log1pf(expf(-x)); }
HD float gelu_tanhf(float x) { return 0.5f * x * (1.0f + tanhf(0.7978845608028654f * (x + 0.044715f * x * x * x))); }
HD int mod_index(int r) { const int b = r / RPB, t = r % RPB; return t < CTX ? NB : b; }
HD int chain_blk(int d, int step) { return d == 0 ? step : (step < CB ? CB - 1 - step : NBLK - 1 - (step - CB)); }
HD int blk_row(int b, int blk, int d, int pp) { return b * RPB + blk * 64 + (d == 0 ? pp : 63 - pp); }

constexpr size_t al256(size_t x) { return (x + 255) & ~(size_t)255; }
struct WsMap {
    size_t ctl, mod, h, abuf, winT, woutT, w13T, w2T, uni, end_fixed;
    size_t pbuf, la, qin, kin, kout, att, st, obuf, qkc, mlF, mlI, s5disc, s5AB, s5K, s5CA, s5st, end_mix;
    size_t act, end_ffn;
    size_t mw13T, mw2T, xs, mact, yrow, rt_e, rt_w, rt_dest, segcnt, ecnt, row_token, tile_e, ntile, end_moe;
    size_t end;
};
constexpr WsMap make_map() {
    WsMap m{}; size_t o = 0;
    m.ctl = o; o += 1 << 20;
    m.mod = o; o += al256((size_t)DEPTH * NMOD * 6 * D * 4);
    m.h = o; o += al256((size_t)NR * D * 4);
    m.abuf = o; o += al256((size_t)NR * D * 2);
    m.winT = o; o += al256((size_t)DEPTH * PS * D * 2);
    m.woutT = o; o += al256((size_t)DEPTH * D * D * 2);
    m.w13T = o; o += al256((size_t)((DEPTH + 1) / 2) * 2 * DFF * D * 2);
    m.w2T = o; o += al256((size_t)((DEPTH + 1) / 2) * D * DFF * 2);
    m.uni = o; m.end_fixed = o;
    o = m.uni;
    m.pbuf = o; o += al256((size_t)NR * PS * 2);
    m.la = o; o += al256((size_t)NR * 192 * 4);
    m.qin = o; o += al256((size_t)NR * 192 * 2);
    m.kin = o; o += al256((size_t)NR * 192 * 2);
    m.kout = o; o += al256((size_t)NR * 192 * 2);
    m.att = o; o += al256((size_t)NB * NBLK * 4 * 4096 * 4);
    m.st = o; o += al256((size_t)NB * NBLK * 4 * 96 * 97 * 4);
    m.obuf = o; o += al256((size_t)NR * 384 * 4);
    m.qkc = o; o += al256((size_t)NR * 768 * 2);
    m.mlF = o; o += al256((size_t)2 * NR * 4 * 4);
    m.mlI = o; o += al256((size_t)2 * NR * 4 * 4);
    m.s5disc = o; o += al256((size_t)2 * 16 * 64 * 4 * 4);
    m.s5AB = o; o += al256((size_t)2 * 16 * 64 * 64 * 16 * 2 * 4);
    m.s5K = o; o += al256((size_t)2 * 16 * 64 * 256 * 4);
    m.s5CA = o; o += al256((size_t)2 * 16 * 64 * 16 * 64 * 2 * 4);
    m.s5st = o; o += al256((size_t)NB * NBLK * 16 * 64 * 2 * 4);
    m.end_mix = o;
    o = m.uni;
    m.act = o; o += al256((size_t)NR * DFF * 2);
    m.end_ffn = o;
    o = m.uni;
    m.mw13T = o; o += al256((size_t)NE * 2 * DFF * D * 2);
    m.mw2T = o; o += al256((size_t)NE * D * DFF * 2);
    m.xs = o; o += al256((size_t)MOE_PASS_T * 256 * D * 2);
    m.mact = o; o += al256((size_t)MOE_PASS_T * 256 * DFF * 2);
    m.yrow = o; o += al256((size_t)MOE_MAXT * 256 * D * 2);
    m.rt_e = o; o += al256((size_t)NR * 2 * 4);
    m.rt_w = o; o += al256((size_t)NR * 2 * 4);
    m.rt_dest = o; o += al256((size_t)NR * 2 * 4);
    m.segcnt = o; o += al256((size_t)NE * (NR / 64 + 1) * 4);
    m.ecnt = o; o += al256((size_t)64 * 4);
    m.row_token = o; o += al256((size_t)MOE_MAXT * 256 * 4);
    m.tile_e = o; o += al256((size_t)MOE_MAXT * 4);
    m.ntile = o; o += 256;
    m.end_moe = o;
    m.end = m.end_mix > m.end_moe ? m.end_mix : m.end_moe; if (m.end_ffn > m.end) m.end = m.end_ffn;
    return m;
}
constexpr WsMap WS = make_map();

struct InitH { long n; const float* x; const float* ctx; float* h;
    HD void operator()(long i) const { const int r = (int)(i / D), c = (int)(i % D); const int b = r / RPB, t = r % RPB;
        if (t < CTX) { h[i] = ctx[((size_t)b * CTX + t) * D + c]; return; }
        const int tl = t - CTX, row = tl / GRID_W, col = tl % GRID_W; const int q = c >> 8, j = c & 255;
        const float omega = expf(-9.210340371976184f * (float)j / 256.0f); const float p = (q < 2) ? (float)row : (float)col; const float ang = p * omega;
        const float pe = (q & 1) ? cosf(ang) : sinf(ang);
        h[i] = x[((size_t)b * SEQ + tl) * D + c] + pe; } };
struct ModK { long n; const float* c; const float* cctx; const float* w_ada; const float* b_ada; float* mod;
    HD void operator()(long i) const { const int l = (int)(i / (6 * D)), j = (int)(i % (6 * D));
        float acc[NMOD];
        for (int m = 0; m < NMOD; ++m) acc[m] = b_ada[(size_t)l * 6 * D + j];
        const float* w = w_ada + (size_t)l * D * 6 * D + j;
        for (int k = 0; k < D; ++k) { const float wv = w[(size_t)k * 6 * D];
            for (int m = 0; m < NMOD; ++m) { const float cv = (m < NB) ? c[m * D + k] : cctx[k]; acc[m] += siluf(cv) * wv; } }
        for (int m = 0; m < NMOD; ++m) mod[((size_t)l * NMOD + m) * 6 * D + j] = acc[m]; } };
struct TransposeK { long n; const float* a; const float* b; bf16* dst; int K, N, NP, pad;
    HD void operator()(long i) const { const int nn = (int)(i / K), k = (int)(i % K);
        float v = 0.f;
        if (b) { const int j = nn >> 1; v = (nn & 1) ? b[(size_t)k * N + j] : a[(size_t)k * N + j]; }
        else if (nn < N) v = a[(size_t)k * N + nn];
        dst[i] = f2bf(v); } };
struct NormModK { long n; const float* h; const float* g; const float* mod; int sh_off, sc_off; bf16* out; const float* wr; int* rt_e; float* rt_w; int skip_ctx, pad;
    HD void operator()(long r) const { const float* hr = h + (size_t)r * D; float ss = 0.f;
        for (int k = 0; k < D; ++k) ss += hr[k] * hr[k];
        const float rstd = 1.0f / sqrtf(ss / D + EPS); const float* m = mod + (size_t)mod_index((int)r) * 6 * D;
        float lg[NE]; for (int e = 0; e < NE; ++e) lg[e] = 0.f;
        for (int k = 0; k < D; ++k) { const float v = hr[k] * rstd * g[k] * (1.0f + m[sc_off + k]) + m[sh_off + k]; out[(size_t)r * D + k] = f2bf(v);
            if (wr) for (int e = 0; e < NE; ++e) lg[e] += v * wr[k * NE + e]; }
        if (wr) { int e0 = 0; float b0 = lg[0]; for (int e = 1; e < NE; ++e) if (lg[e] > b0) { b0 = lg[e]; e0 = e; }
            int e1 = -1; float b1 = -3.0e38f; for (int e = 0; e < NE; ++e) if (e != e0 && lg[e] > b1) { b1 = lg[e]; e1 = e; }
            const float w1 = 1.0f / (1.0f + expf(b1 - b0));
            const bool skip = skip_ctx && ((int)(r % RPB) < CTX);
            rt_e[2 * r] = skip ? -1 : e0; rt_e[2 * r + 1] = skip ? -1 : e1; rt_w[2 * r] = w1; rt_w[2 * r + 1] = 1.0f - w1; } } };

struct GlaLa { long n; const bf16* p; const float* wa2; const float* ba; float* la; int d, pad;
    HD void operator()(long i) const { const int r = (int)(i / 192), j = (int)(i % 192); float z = ba[d * 192 + j];
        for (int q = 0; q < 16; ++q) z += bf2f(p[(size_t)r * PS + GLR + q]) * wa2[((size_t)d * 16 + q) * 192 + j];
        la[i] = logsigmoidf_(z) * (1.0f / 16.0f); } };
struct GlaCum { long n; float* la; int d, pad;
    HD void operator()(long i) const { const int j = (int)(i % 192); const int bb = (int)(i / 192); const int b = bb / NBLK, blk = bb % NBLK; float c = 0.f;
        for (int pp = 0; pp < 64; ++pp) { const size_t o = (size_t)blk_row(b, blk, d, pp) * 192 + j; c += la[o]; la[o] = c; } } };
struct GlaQk { long n; const bf16* p; const float* bc; bf16* qin; bf16* kin; bf16* kout; int d, pad;
    HD void operator()(long i) const { const int r = (int)(i / 192), j = (int)(i % 192); const int b = r / RPB, blk = (r % RPB) / 64;
        const float bt = bc[i], be = bc[(size_t)blk_row(b, blk, d, 63) * 192 + j];
        const float q = bf2f(p[(size_t)r * PS + GQ + j]) * 0.14433756729740643f, k = bf2f(p[(size_t)r * PS + GK + j]);
        qin[i] = f2bf(q * expf(bt)); kin[i] = f2bf(k * expf(-bt)); kout[i] = f2bf(k * expf(be - bt)); } };
struct GlaDs { long n; const bf16* p; const bf16* kout; float* st;
    HD void operator()(long x) const { const int j = (int)(x % 96); long y = x / 96; const int i = (int)(y % 48); y /= 48; const int hh = (int)(y % 4); y /= 4; const int blk = (int)(y % NBLK), b = (int)(y / NBLK);
        float acc = 0.f; const size_t r0 = (size_t)b * RPB + blk * 64;
        for (int s = 0; s < 64; ++s) acc += bf2f(kout[(r0 + s) * 192 + hh * 48 + i]) * bf2f(p[(r0 + s) * PS + GV + hh * 96 + j]);
        st[x] = acc; } };
struct GlaCarry { long n; const float* bc; float* st; int d, pad;
    HD void operator()(long x) const { const int j = (int)(x % 96); long y = x / 96; const int i = (int)(y % 48); y /= 48; const int hh = (int)(y % 4), b = (int)(y / 4);
        float s = 0.f;
        for (int step = 0; step < NBLK; ++step) { const int blk = chain_blk(d, step); const size_t o = ((((size_t)b * NBLK + blk) * 4 + hh) * 48 + i) * 96 + j;
            const float tmp = st[o]; st[o] = s; s = expf(bc[(size_t)blk_row(b, blk, d, 63) * 192 + hh * 48 + i]) * s + tmp; } } };
struct GlaAtt { long n; const bf16* qin; const bf16* kin; float* att; int d, pad;
    HD void operator()(long x) const { const int s = (int)(x % 64); long y = x / 64; const int t = (int)(y % 64); y /= 64; const int hh = (int)(y % 4); y /= 4; const int blk = (int)(y % NBLK), b = (int)(y / NBLK);
        const bool valid = d == 0 ? (s <= t) : (s >= t); float acc = 0.f;
        if (valid) { const size_t r0 = (size_t)b * RPB + blk * 64; for (int q = 0; q < 48; ++q) acc += bf2f(qin[(r0 + t) * 192 + hh * 48 + q]) * bf2f(kin[(r0 + s) * 192 + hh * 48 + q]); }
        att[x] = acc; } };
struct GlaO { long n; const bf16* p; const bf16* qin; const float* att; const float* st; float* obuf; int d, pad;
    HD void operator()(long x) const { const int j = (int)(x % 96); long y = x / 96; const int hh = (int)(y % 4); const int r = (int)(y / 4); const int b = r / RPB, t = r % RPB, blk = t / 64, tt = t % 64;
        const size_t r0 = (size_t)b * RPB + blk * 64; const float* at = att + ((((size_t)b * NBLK + blk) * 4 + hh) * 64 + tt) * 64; float acc = 0.f;
        for (int s = 0; s < 64; ++s) acc += at[s] * bf2f(p[(r0 + s) * PS + GV + hh * 96 + j]);
        const float* sp = st + (((size_t)b * NBLK + blk) * 4 + hh) * 48 * 96 + j;
        for (int q = 0; q < 48; ++q) acc += bf2f(qin[(size_t)r * 192 + hh * 48 + q]) * sp[q * 96];
        if (d == 0) obuf[x] = acc; else obuf[x] += acc; } };
struct HeadFin { long n; const bf16* p; const float* obuf; const float* gain; bf16* mix; int mode, pad;
    HD void operator()(long x) const { const int hh = (int)(x % 4), r = (int)(x / 4); const float* o = obuf + (size_t)r * 384 + hh * 96; float ss = 0.f;
        for (int j = 0; j < 96; ++j) ss += o[j] * o[j];
        const float rstd = 1.0f / sqrtf(ss / 96.0f + EPS);
        for (int j = 0; j < 96; ++j) { const float gv = bf2f(p[(size_t)r * PS + (mode ? MO : GG) + hh * 96 + j]); const float gt = mode ? sigmoidf_(gv) : siluf(gv);
            mix[(size_t)r * D + (mode ? 640 : 0) + hh * 96 + j] = f2bf(o[j] * rstd * gain[j] * gt); } } };

struct MlConv { long n; const bf16* p; const float* cw; const float* cb; bf16* qkc;
    HD void operator()(long i) const { const int r = (int)(i / 768), c = (int)(i % 768); const int t = r % RPB; const bool first = (t == 0 || t == CTX), last = (t == CTX - 1 || t == RPB - 1);
        float y = cw[768 + c] * bf2f(p[(size_t)r * PS + MQ + c]);
        if (!first) y += cw[c] * bf2f(p[(size_t)(r - 1) * PS + MQ + c]);
        if (!last) y += cw[2 * 768 + c] * bf2f(p[(size_t)(r + 1) * PS + MQ + c]);
        float v = siluf(y + cb[c]); if (c >= 384) v *= 0.10206207261596577f; qkc[i] = f2bf(v); } };
struct MlGates { long n; const bf16* p; const float* gb; float* F; float* I;
    HD void operator()(long x) const { const int hh = (int)(x % 4); long y = x / 4; const int blk = (int)(y % NBLK); y /= NBLK; const int b = (int)(y % NB), d = (int)(y / NB); float c = 0.f;
        for (int pp = 0; pp < 64; ++pp) { const int r = blk_row(b, blk, d, pp); const float gi = bf2f(p[(size_t)r * PS + MG + (2 * d) * 4 + hh]) + gb[(2 * d) * 4 + hh];
            const float gf = bf2f(p[(size_t)r * PS + MG + (2 * d + 1) * 4 + hh]) + gb[(2 * d + 1) * 4 + hh]; c += logsigmoidf_(gf);
            F[((size_t)d * NR + r) * 4 + hh] = c; I[((size_t)d * NR + r) * 4 + hh] = gi; } } };
struct MlDs { long n; const bf16* p; const bf16* qkc; const float* F; const float* I; float* st; int d, pad;
    HD void operator()(long x) const { const int j = (int)(x % 97); long y = x / 97; const int i = (int)(y % 96); y /= 96; const int hh = (int)(y % 4); y /= 4; const int blk = (int)(y % NBLK), b = (int)(y / NBLK);
        const float Fe = F[((size_t)d * NR + blk_row(b, blk, d, 63)) * 4 + hh]; float acc = 0.f; const size_t r0 = (size_t)b * RPB + blk * 64;
        for (int s = 0; s < 64; ++s) { const size_t r = r0 + s; const float w = expf(Fe - F[((size_t)d * NR + r) * 4 + hh] + I[((size_t)d * NR + r) * 4 + hh]);
            acc += w * bf2f(qkc[r * 768 + 384 + hh * 96 + i]) * (j < 96 ? bf2f(p[r * PS + MV + hh * 96 + j]) : 1.0f); }
        st[x] = acc; } };
struct MlCarry { long n; const float* F; float* st; int d, pad;
    HD void operator()(long x) const { const int j = (int)(x % 97); long y = x / 97; const int i = (int)(y % 96); y /= 96; const int hh = (int)(y % 4), b = (int)(y / 4); float s = 0.f;
        for (int step = 0; step < NBLK; ++step) { const int blk = chain_blk(d, step); const size_t o = ((((size_t)b * NBLK + blk) * 4 + hh) * 96 + i) * 97 + j;
            const float tmp = st[o]; st[o] = s; s = expf(F[((size_t)d * NR + blk_row(b, blk, d, 63)) * 4 + hh]) * s + tmp; } } };
struct MlAtt { long n; const bf16* qkc; const float* F; const float* I; float* att; int d, pad;
    HD void operator()(long x) const { const int s = (int)(x % 64); long y = x / 64; const int t = (int)(y % 64); y /= 64; const int hh = (int)(y % 4); y /= 4; const int blk = (int)(y % NBLK), b = (int)(y / NBLK);
        const bool valid = d == 0 ? (s <= t) : (s >= t); float acc = 0.f;
        if (valid) { const size_t r0 = (size_t)b * RPB + blk * 64; for (int q = 0; q < 96; ++q) acc += bf2f(qkc[(r0 + t) * 768 + hh * 96 + q]) * bf2f(qkc[(r0 + s) * 768 + 384 + hh * 96 + q]);
            acc *= expf(F[((size_t)d * NR + r0 + t) * 4 + hh] - F[((size_t)d * NR + r0 + s) * 4 + hh] + I[((size_t)d * NR + r0 + s) * 4 + hh]); }
        att[x] = acc; } };
struct MlH { long n; const bf16* p; const bf16* qkc; const float* F; const float* att; const float* st; float* obuf; int d, pad;
    HD void operator()(long x) const { const int j = (int)(x % 96); long y = x / 96; const int hh = (int)(y % 4); const int r = (int)(y / 4); const int b = r / RPB, t = r % RPB, blk = t / 64, tt = t % 64;
        const size_t r0 = (size_t)b * RPB + blk * 64; const float* at = att + ((((size_t)b * NBLK + blk) * 4 + hh) * 64 + tt) * 64; float num = 0.f, den = 0.f;
        for (int s = 0; s < 64; ++s) { num += at[s] * bf2f(p[(r0 + s) * PS + MV + hh * 96 + j]); den += at[s]; }
        const float* sp = st + (((size_t)b * NBLK + blk) * 4 + hh) * 96 * 97; float qs = 0.f, qn = 0.f;
        for (int q = 0; q < 96; ++q) { const float qv = bf2f(qkc[(size_t)r * 768 + hh * 96 + q]); qs += qv * sp[q * 97 + j]; qn += qv * sp[q * 97 + 96]; }
        const float ef = expf(F[((size_t)d * NR + r) * 4 + hh]); num += ef * qs; den += ef * qn;
        const float hv = num / fmaxf(fabsf(den), 1.0f);
        if (d == 0) obuf[x] = hv; else obuf[x] += hv; } };

struct S5Disc { long n; const float* lre; const float* lim; const float* ldt; float* disc;
    HD void operator()(long x) const { const int nn = (int)(x % 64); const int dg = (int)(x / 64); const float dt = expf(ldt[dg]); const float lr = lre[x], li = lim[x];
        const float mag = expf(lr * dt), ar = mag * cosf(li * dt), ai = mag * sinf(li * dt), den = lr * lr + li * li, pr = ar - 1.0f, pi = ai;
        disc[x * 4 + 0] = lr * dt; disc[x * 4 + 1] = li * dt; disc[x * 4 + 2] = (pr * lr + pi * li) / den; disc[x * 4 + 3] = (pi * lr - pr * li) / den; (void)nn; } };
HD void s5_apow(const float* disc4, float tau, float& ar, float& ai) { const float mag = expf(disc4[0] * tau); ar = mag * cosf(disc4[1] * tau); ai = mag * sinf(disc4[1] * tau); }
struct S5AB { long n; const float* disc; const float* bre; const float* bim; float* AB;
    HD void operator()(long x) const { const int pp = (int)(x % 16); long y = x / 16; const int nn = (int)(y % 64); y /= 64; const int tau = (int)(y % 64); y /= 64; const int g = (int)(y % 16), d = (int)(y / 16);
        const float* d4 = disc + (((size_t)d * 16 + g) * 64 + nn) * 4; float ar, ai; s5_apow(d4, (float)tau, ar, ai);
        const float br = bre[((size_t)g * 64 + nn) * 16 + pp], bi = bim[((size_t)g * 64 + nn) * 16 + pp];
        const float bbr = d4[2] * br - d4[3] * bi, bbi = d4[2] * bi + d4[3] * br;
        AB[x * 2] = ar * bbr - ai * bbi; AB[x * 2 + 1] = ar * bbi + ai * bbr; } };
struct S5K { long n; const float* AB; const float* cre; const float* cim; float* Kt;
    HD void operator()(long x) const { const int p2 = (int)(x % 16); long y = x / 16; const int p1 = (int)(y % 16); y /= 16; const int tau = (int)(y % 64); y /= 64; const int g = (int)(y % 16), d = (int)(y / 16);
        const float* ab = AB + ((((size_t)d * 16 + g) * 64 + tau) * 64) * 16 * 2; float acc = 0.f;
        for (int nn = 0; nn < 64; ++nn) acc += cre[((size_t)g * 16 + p1) * 64 + nn] * ab[(nn * 16 + p2) * 2] - cim[((size_t)g * 16 + p1) * 64 + nn] * ab[(nn * 16 + p2) * 2 + 1];
        Kt[x] = acc; } };
struct S5CA { long n; const float* disc; const float* cre; const float* cim; float* CA;
    HD void operator()(long x) const { const int nn = (int)(x % 64); long y = x / 64; const int p1 = (int)(y % 16); y /= 16; const int tau = (int)(y % 64); y /= 64; const int g = (int)(y % 16), d = (int)(y / 16);
        float ar, ai; s5_apow(disc + (((size_t)d * 16 + g) * 64 + nn) * 4, (float)(tau + 1), ar, ai);
        const float cr = cre[((size_t)g * 16 + p1) * 64 + nn], ci = cim[((size_t)g * 16 + p1) * 64 + nn];
        CA[x * 2] = cr * ar - ci * ai; CA[x * 2 + 1] = cr * ai + ci * ar; } };
struct S5E { long n; const bf16* p; const float* AB; float* st; int d, pad;
    HD void operator()(long x) const { const int nn = (int)(x % 64); long y = x / 64; const int g = (int)(y % 16); y /= 16; const int blk = (int)(y % NBLK), b = (int)(y / NBLK); float er = 0.f, ei = 0.f;
        for (int pp = 0; pp < 64; ++pp) { const int r = blk_row(b, blk, d, pp); const float* ab = AB + (((((size_t)d * 16 + g) * 64 + (63 - pp)) * 64 + nn) * 16) * 2;
            for (int q = 0; q < 16; ++q) { const float u = bf2f(p[(size_t)r * PS + SU + g * 16 + q]); er += ab[q * 2] * u; ei += ab[q * 2 + 1] * u; } }
        st[x * 2] = er; st[x * 2 + 1] = ei; } };
struct S5Carry { long n; const float* disc; float* st; int d, pad;
    HD void operator()(long x) const { const int nn = (int)(x % 64); long y = x / 64; const int g = (int)(y % 16), b = (int)(y / 16); float ar, ai; s5_apow(disc + (((size_t)d * 16 + g) * 64 + nn) * 4, 64.0f, ar, ai);
        float sr = 0.f, si = 0.f;
        for (int step = 0; step < NBLK; ++step) { const int blk = chain_blk(d, step); const size_t o = ((((size_t)b * NBLK + blk) * 16 + g) * 64 + nn) * 2;
            const float tr = st[o], ti = st[o + 1]; st[o] = sr; st[o + 1] = si; const float nr = ar * sr - ai * si + tr, ni = ar * si + ai * sr + ti; sr = nr; si = ni; } } };
struct S5Y { long n; const bf16* p; const float* Kt; const float* CA; const float* st; float* ybuf; int d, pad;
    HD void operator()(long x) const { const int p1 = (int)(x % 16); long y = x / 16; const int g = (int)(y % 16); const int r = (int)(y / 16); const int b = r / RPB, t = r % RPB, blk = t / 64, tt = t % 64;
        const int pt = d == 0 ? tt : 63 - tt; float acc = 0.f;
        for (int ps = 0; ps <= pt; ++ps) { const int rs = blk_row(b, blk, d, ps); const float* kk = Kt + ((((size_t)d * 16 + g) * 64 + (pt - ps)) * 16 + p1) * 16;
            for (int q = 0; q < 16; ++q) acc += kk[q] * bf2f(p[(size_t)rs * PS + SU + g * 16 + q]); }
        const float* ca = CA + (((((size_t)d * 16 + g) * 64 + pt) * 16 + p1) * 64) * 2; const float* sp = st + ((((size_t)b * NBLK + blk) * 16 + g) * 64) * 2;
        for (int nn = 0; nn < 64; ++nn) acc += ca[nn * 2] * sp[nn * 2] - ca[nn * 2 + 1] * sp[nn * 2 + 1];
        if (d == 0) ybuf[x] = acc; else ybuf[x] += acc; } };
struct S5Z { long n; const bf16* p; const float* dskip; float* ybuf;
    HD void operator()(long i) const { const int r = (int)(i / 256), c = (int)(i % 256); ybuf[i] = gelu_tanhf(ybuf[i] + dskip[c] * bf2f(p[(size_t)r * PS + SU + c])); } };
struct S5Glu { long n; const float* z; const float* gw; const float* gb; bf16* mix;
    HD void operator()(long i) const { const int r = (int)(i / 256), c = (int)(i % 256); float acc = gb[c]; const float* zr = z + (size_t)r * 256;
        for (int k = 0; k < 256; ++k) acc += zr[k] * gw[k * 256 + c];
        mix[(size_t)r * D + 384 + c] = f2bf(zr[c] * sigmoidf_(acc)); } };

struct MoeSegCount { long n; const int* rt_e; int* segcnt; int nseg, pad;
    HD void operator()(long x) const { const int seg = (int)(x % nseg), e = (int)(x / nseg); int c = 0;
        for (int r = seg * 64; r < seg * 64 + 64 && r < NR; ++r) { c += (rt_e[2 * r] == e) + (rt_e[2 * r + 1] == e); }
        segcnt[(size_t)e * nseg + seg] = c; } };
struct MoePrefix { long n; int* segcnt; int* ecnt; int nseg, pad;
    HD void operator()(long e) const { int c = 0; for (int s = 0; s < nseg; ++s) { const int v = segcnt[(size_t)e * nseg + s]; segcnt[(size_t)e * nseg + s] = c; c += v; } ecnt[e] = c; } };
struct MoeTiles { long n; const int* ecnt; int* tile_e; int* ntile; int* row_token;
    HD void operator()(long) const { int t = 0; for (int e = 0; e < NE; ++e) { const int nt = (ecnt[e] + 255) / 256; for (int q = 0; q < nt; ++q) tile_e[t++] = e; }
        ntile[0] = t; for (int q = t; q < MOE_MAXT; ++q) tile_e[q] = 0; } };
struct MoeFillNeg { long n; int* row_token; HD void operator()(long i) const { row_token[i] = -1; } };
struct MoeAssign { long n; const int* rt_e; const int* segcnt; const int* ecnt; int* rt_dest; int* row_token; int nseg, pad;
    HD void operator()(long x) const { const int seg = (int)(x % nseg), e = (int)(x / nseg); int pstart = 0; for (int q = 0; q < e; ++q) pstart += (ecnt[q] + 255) / 256 * 256;
        int pos = pstart + segcnt[(size_t)e * nseg + seg];
        for (int r = seg * 64; r < seg * 64 + 64 && r < NR; ++r) for (int k = 0; k < 2; ++k) if (rt_e[2 * r + k] == e) { rt_dest[2 * r + k] = pos; row_token[pos] = r; ++pos; } } };
struct MoeGather { long n; const bf16* f; const int* row_token; bf16* xs; int row0, pad;
    HD void operator()(long i) const { const int lr = (int)(i / (D / 8)), c8 = (int)(i % (D / 8)); const int tok = row_token[row0 + lr];
        U4 v; v.x = v.y = v.z = v.w = 0u; if (tok >= 0) v = *(const U4*)(f + (size_t)tok * D + c8 * 8); *(U4*)(xs + (size_t)lr * D + c8 * 8) = v; } };
struct MoeCombine { long n; float* h; const bf16* yrow; const int* rt_e; const float* rt_w; const int* rt_dest; const float* mod; int g_off, pad;
    HD void operator()(long i) const { const int r = (int)(i / D), c = (int)(i % D); if (rt_e[2 * r] < 0) return;
        const float y = rt_w[2 * r] * bf2f(yrow[(size_t)rt_dest[2 * r] * D + c]) + rt_w[2 * r + 1] * bf2f(yrow[(size_t)rt_dest[2 * r + 1] * D + c]);
        h[i] += mod[(size_t)mod_index(r) * 6 * D + g_off + c] * y; } };
struct FinalNorm { long n; const float* h; const float* g; float* out;
    HD void operator()(long x) const { const int b = (int)(x / SEQ), tl = (int)(x % SEQ); const float* hr = h + ((size_t)b * RPB + CTX + tl) * D; float ss = 0.f;
        for (int k = 0; k < D; ++k) ss += hr[k] * hr[k];
        const float rstd = 1.0f / sqrtf(ss / D + EPS); for (int k = 0; k < D; ++k) out[(size_t)x * D + k] = hr[k] * rstd * g[k]; } };

struct EpiStoreBf16 { bf16* out; int ld; int row_off;
    HD void apply8(int row, int col0, const float* v) const { bf16* o = out + (size_t)(row - row_off) * ld + col0; for (int i = 0; i < 8; ++i) o[i] = f2bf(v[i]); } };
struct EpiSwiGLU { bf16* out; int ld; int row_off;
    HD void apply8(int row, int col0, const float* v) const { bf16* o = out + (size_t)(row - row_off) * ld + col0 / 2; for (int i = 0; i < 4; ++i) o[i] = f2bf(siluf(v[2 * i]) * v[2 * i + 1]); } };
struct EpiResid { float* h; const float* mod; int g_off, pad;
    HD void apply8(int row, int col0, const float* v) const { float* o = h + (size_t)row * D + col0; const float* g = mod + (size_t)mod_index(row) * 6 * D + g_off + col0; for (int i = 0; i < 8; ++i) o[i] += g[i] * v[i]; } };

struct GemmDesc { const bf16* A; const bf16* Bt; const int* tile_e; const int* ntile; size_t e_stride; int M, N, K, tile0; };

#ifndef HOST_EMU
namespace pg8 {
#define PG8_LAS __attribute__((address_space(3)))
typedef short bf16x8 __attribute__((ext_vector_type(8)));
typedef float f32x4 __attribute__((ext_vector_type(4)));
constexpr int BM = 256, BK = 64, HALF = 128, HTB = HALF * BK * 2, STAGE_BYTES = 8 * HTB, NXCD = 8, WGM = 8;
__device__ __forceinline__ int lds_byte(int r, int c) { const int st = (r >> 4) * 2 + (c >> 5), rr = r & 15, cc = c & 31, ob = rr * 64 + cc * 2; return st * 1024 + (ob ^ (((ob >> 9) & 1) << 5)); }
__device__ __forceinline__ void stage_rc(int b, int& R, int& C) { const int st = b / 1024, sb = b % 1024, swz = sb ^ (((sb >> 9) & 1) << 5); R = (st >> 1) * 16 + swz / 64; C = (st & 1) * 32 + (swz % 64) / 2; }
__device__ __forceinline__ int perm32(int rho) { const int n = rho >> 4, i = rho & 15; return 8 * (i >> 2) + 4 * n + (i & 3); }
struct Unit { int pm, pn; };
struct StaticOrder {
    int nM, nN, nwg, G, c;
    __device__ void init(int M, int N, int G_, int c_) { nM = M / BM; nN = N / BM; nwg = nM * nN; G = G_; c = c_; }
    __device__ bool next(int i, Unit& u) const {
        const long L = (long)i * G + c; if (L >= nwg) return false;
        int wgid = (int)L; { const int q = nwg / NXCD, r = nwg % NXCD, xcd = wgid % NXCD, off = wgid / NXCD; wgid = (xcd < r ? xcd * (q + 1) : r * (q + 1) + (xcd - r) * q) + off; }
        const int nig = WGM * nN, gid = wgid / nig, fm = gid * WGM, gsz = (nM - fm) < WGM ? (nM - fm) : WGM;
        u.pm = fm + ((wgid % nig) % gsz); u.pn = (wgid % nig) / gsz; return true;
    }
};
template <class F> __device__ __forceinline__ void epi_apply(const F& f, const f32x4 (&acc)[2][2][4][2], const Unit& u, int wr, int wc, int fr, int fq) {
    const int row0 = u.pm * BM + wr * 64 + fr, col0 = u.pn * BM + wc * 32 + 8 * fq;
#pragma unroll
    for (int ai = 0; ai < 2; ++ai)
#pragma unroll
        for (int m = 0; m < 4; ++m)
#pragma unroll
            for (int bj = 0; bj < 2; ++bj) { const f32x4 v0 = acc[ai][bj][m][0], v1 = acc[ai][bj][m][1];
                const float v[8] = {v0[0], v0[1], v0[2], v0[3], v1[0], v1[1], v1[2], v1[3]};
                f.apply8(row0 + ai * HALF + m * 16, col0 + bj * HALF, v); }
}
template <class F>
__device__ __forceinline__ void gemm_phase(PG8_LAS unsigned char* lds, const GemmDesc g, const F& E, int G_, int c_) {
    int tid_ = threadIdx.x; asm volatile("" : "+v"(tid_));
    const int tid = tid_, wid = __builtin_amdgcn_readfirstlane(tid >> 6), lane = tid & 63, wr = wid >> 2, wc = wid & 3, fr = lane & 15, fq = lane >> 4;
    const int K = g.K, nt = K / BK;
    int M = g.M; if (g.ntile) { int ntl = g.ntile[0] - g.tile0; ntl = ntl < 0 ? 0 : ntl; if (ntl * BM < M) M = ntl * BM; }
    StaticOrder S; S.init(M, g.N, G_, c_);
    unsigned voffA[2], voffB[2];
#pragma unroll
    for (int i = 0; i < 2; ++i) { int R, C; stage_rc(tid * 16 + i * 8192, R, C); const int Rb = (R & ~31) + perm32(R & 31);
        voffA[i] = (unsigned)(R * K + C) * 2u; voffB[i] = (unsigned)(Rb * K + C) * 2u; }
    const size_t kstep = (size_t)(BK * 2);
    const size_t hstep = (size_t)HALF * K * 2;
    const size_t tstep = 2 * hstep;
    const unsigned ldsw = (unsigned)wid * 1024u;
    const int aoff = lds_byte(wr * 64 + fr, fq * 8), boff = lds_byte(wc * 32 + fr, fq * 8);
#define PG8_SA(b, h) (((b) * 2 + (h)) * HTB)
#define PG8_SB(b, h) ((4 + (b) * 2 + (h)) * HTB)
#define PG8_STAGE(bufoff, gbase, voff) do { _Pragma("unroll") for (int _i = 0; _i < 2; ++_i) \
        __builtin_amdgcn_global_load_lds((const unsigned*)((const char*)(gbase) + (voff)[_i]), (PG8_LAS unsigned*)(lds + (bufoff) + ldsw + _i * 8192), 16, 0, 0); } while (0)
#define PG8_LDA(dst, b, h) do { _Pragma("unroll") for (int m = 0; m < 4; ++m) _Pragma("unroll") for (int k = 0; k < 2; ++k) dst[m][k] = *(const PG8_LAS bf16x8*)(lds + PG8_SA(b, h) + aoff + m * 2048 + k * 1024); } while (0)
#define PG8_LDB(dst, b, h) do { _Pragma("unroll") for (int n = 0; n < 2; ++n) _Pragma("unroll") for (int k = 0; k < 2; ++k) dst[n][k] = *(const PG8_LAS bf16x8*)(lds + PG8_SB(b, h) + boff + n * 2048 + k * 1024); } while (0)
#define PG8_MMA(ai, bj, At, Bt) do { __builtin_amdgcn_s_setprio(1); _Pragma("unroll") for (int m = 0; m < 4; ++m) _Pragma("unroll") for (int n = 0; n < 2; ++n) _Pragma("unroll") for (int k = 0; k < 2; ++k) \
        acc[ai][bj][m][n] = __builtin_amdgcn_mfma_f32_16x16x32_bf16(Bt[n][k], At[m][k], acc[ai][bj][m][n], 0, 0, 0); __builtin_amdgcn_s_setprio(0); } while (0)
#define PG8_WAIT_V(n) asm volatile("s_waitcnt vmcnt(" #n ")" ::: "memory")
#define PG8_WAIT_L(n) asm volatile("s_waitcnt lgkmcnt(" #n ")" ::: "memory")
#define PG8_BAR __builtin_amdgcn_s_barrier()
#define PG8_SCHED __builtin_amdgcn_sched_barrier(0)
#define PG8_BBASE(u) ((const char*)g.Bt + (g.tile_e ? (size_t)g.tile_e[g.tile0 + (u).pm] * g.e_stride * 2 : (size_t)0) + (size_t)(u).pn * tstep)
    Unit cur, nxt; int ui = 0;
    if (!S.next(0, cur)) return;
    f32x4 acc[2][2][4][2];
#pragma unroll
    for (int a = 0; a < 2; ++a)
#pragma unroll
        for (int b = 0; b < 2; ++b)
#pragma unroll
            for (int m = 0; m < 4; ++m)
#pragma unroll
                for (int n = 0; n < 2; ++n) acc[a][b][m][n] = (f32x4){0.f, 0.f, 0.f, 0.f};
    bf16x8 At[4][2], B0[2][2], B1[2][2];
    const char* cA = (const char*)g.A + (size_t)cur.pm * tstep; const char* cB = PG8_BBASE(cur);
    PG8_STAGE(PG8_SB(0, 0), cB, voffB); PG8_STAGE(PG8_SA(0, 0), cA, voffA); PG8_STAGE(PG8_SB(0, 1), cB + hstep, voffB); PG8_STAGE(PG8_SA(0, 1), cA + hstep, voffA);
    if (wr == 1) PG8_BAR;
    PG8_WAIT_V(4); PG8_BAR;
    PG8_STAGE(PG8_SB(1, 0), cB + kstep, voffB); PG8_STAGE(PG8_SA(1, 0), cA + kstep, voffA); PG8_STAGE(PG8_SB(1, 1), cB + hstep + kstep, voffB);
    PG8_WAIT_V(6); PG8_BAR;
    for (;;) {
        const bool has_next = S.next(ui + 1, nxt);
        const char* nA = has_next ? (const char*)g.A + (size_t)nxt.pm * tstep : cA; const char* nB = has_next ? PG8_BBASE(nxt) : cB;
        for (int t = 0; t < nt; t += 2) {
            const bool last = (t == nt - 2);
            const char* a1 = cA + (size_t)(t + 1) * kstep;
            const char* a2 = last ? nA : cA + (size_t)(t + 2) * kstep; const char* b2 = last ? nB : cB + (size_t)(t + 2) * kstep;
            const char* a3 = a2 + kstep; const char* b3 = b2 + kstep;
            PG8_LDB(B0, 0, 0); PG8_SCHED; PG8_LDA(At, 0, 0); PG8_STAGE(PG8_SA(1, 1), a1 + hstep, voffA);
            PG8_WAIT_L(8); PG8_BAR; PG8_WAIT_L(0); PG8_MMA(0, 0, At, B0); PG8_BAR; PG8_SCHED;
            PG8_LDB(B1, 0, 1); PG8_STAGE(PG8_SB(0, 0), b2, voffB);
            PG8_BAR; PG8_WAIT_L(0); PG8_MMA(0, 1, At, B1); PG8_BAR;
            PG8_LDA(At, 0, 1); PG8_STAGE(PG8_SA(0, 0), a2, voffA);
            PG8_BAR; PG8_WAIT_L(0); PG8_MMA(1, 0, At, B0); PG8_BAR; PG8_SCHED;
            PG8_STAGE(PG8_SB(0, 1), b2 + hstep, voffB);
            PG8_WAIT_V(6); PG8_BAR; PG8_MMA(1, 1, At, B1); PG8_BAR;
            PG8_LDB(B0, 1, 0); PG8_SCHED; PG8_LDA(At, 1, 0); PG8_STAGE(PG8_SA(0, 1), a2 + hstep, voffA);
            PG8_WAIT_L(8); PG8_BAR; PG8_WAIT_L(0); PG8_MMA(0, 0, At, B0); PG8_BAR; PG8_SCHED;
            PG8_LDB(B1, 1, 1); PG8_STAGE(PG8_SB(1, 0), b3, voffB);
            PG8_BAR; PG8_WAIT_L(0); PG8_MMA(0, 1, At, B1); PG8_BAR;
            PG8_LDA(At, 1, 1); PG8_STAGE(PG8_SA(1, 0), a3, voffA);
            PG8_BAR; PG8_WAIT_L(0); PG8_MMA(1, 0, At, B0); PG8_BAR; PG8_SCHED;
            PG8_STAGE(PG8_SB(1, 1), b3 + hstep, voffB);
            PG8_WAIT_V(6); PG8_BAR; PG8_MMA(1, 1, At, B1); PG8_BAR;
        }
        epi_apply(E, acc, cur, wr, wc, fr, fq);
        if (!has_next) break;
#pragma unroll
        for (int a = 0; a < 2; ++a)
#pragma unroll
            for (int b = 0; b < 2; ++b)
#pragma unroll
                for (int m = 0; m < 4; ++m)
#pragma unroll
                    for (int n = 0; n < 2; ++n) acc[a][b][m][n] = (f32x4){0.f, 0.f, 0.f, 0.f};
        cur = nxt; cA = nA; cB = nB; ++ui;
    }
    PG8_WAIT_V(0);
    if (wr == 0) PG8_BAR;
    PG8_BAR;
#undef PG8_SA
#undef PG8_SB
#undef PG8_STAGE
#undef PG8_LDA
#undef PG8_LDB
#undef PG8_MMA
#undef PG8_WAIT_V
#undef PG8_WAIT_L
#undef PG8_BAR
#undef PG8_SCHED
#undef PG8_BBASE
}
}

#define XB_TMO      128
#define XB_XCNT(j)  (256  + 64 * (j))
#define XB_XSUB(j)  (1280 + 64 * (j))
#define XB_XGEN(j)  (2304 + 64 * (j))
#define XB_TOP      3328
#define XB_TOPGEN   3392
#define XCD_BAR_WORDS 3456
#define XB_SPIN_CAP (1u << 20)
#define LAS __attribute__((address_space(3)))
__device__ __forceinline__ unsigned xb_ld(unsigned* p)              { return __hip_atomic_load(p, __ATOMIC_RELAXED, __HIP_MEMORY_SCOPE_AGENT); }
__device__ __forceinline__ unsigned xb_add(unsigned* p, unsigned v) { return __hip_atomic_fetch_add(p, v, __ATOMIC_RELAXED, __HIP_MEMORY_SCOPE_AGENT); }
__device__ __forceinline__ unsigned xb_xcc_id() { return (unsigned)__builtin_amdgcn_s_getreg((3 << 11) | 20) & 0xFu; }
#define XB_SPIN(cond, bar) do { unsigned _sp = 0; while (cond) { __builtin_amdgcn_s_sleep(1); \
    if ((++_sp & 255u) == 0u) { if (xb_ld(&(bar)[XB_TMO])) break; if (_sp > XB_SPIN_CAP) { atomicAdd(&(bar)[XB_TMO], 1u); break; } } } } while (0)
struct XcdBarrier { unsigned* bar; unsigned x; volatile LAS unsigned* st; };
__device__ __forceinline__ XcdBarrier xcd_barrier_post(unsigned* bar, volatile LAS unsigned* st) {
    XcdBarrier b; b.bar = bar; b.x = xb_xcc_id(); b.st = st;
    if (threadIdx.x == 0) (void)xb_add(&bar[XB_XCNT(b.x)], 1u);
    return b;
}
__device__ __forceinline__ void xcd_barrier_complete(unsigned* bar, unsigned x, unsigned& nloc, unsigned& nx) {
    const unsigned G = gridDim.x * gridDim.y * gridDim.z;
    unsigned sum, cnt, mine, sp = 0u;
    for (;;) {
        sum = 0u; cnt = 0u; mine = 0u;
#pragma unroll
        for (unsigned j = 0; j < 16; ++j) { const unsigned c = xb_ld(&bar[XB_XCNT(j)]); sum += c; cnt += (c > 0u) ? 1u : 0u; mine = (j == x) ? c : mine; }
        if (sum == G) break;
        __builtin_amdgcn_s_sleep(1);
        if ((++sp & 255u) == 0u) { if (xb_ld(&bar[XB_TMO])) break; if (sp > XB_SPIN_CAP) { atomicAdd(&bar[XB_TMO], 1u); break; } }
    }
    nloc = mine > 0u ? mine : 1u; nx = cnt > 0u ? cnt : 1u;
}
__device__ __forceinline__ void xcd_barrier(const XcdBarrier& b) {
    asm volatile("s_waitcnt vmcnt(0)" ::: "memory");
    __syncthreads();
    if (threadIdx.x == 0) {
        unsigned* bar = b.bar; asm volatile("" : "+s"(bar));
        __builtin_amdgcn_s_waitcnt(0);
        unsigned nloc = b.st[0], nx = b.st[1];
        if (nloc == 0u) { xcd_barrier_complete(bar, b.x, nloc, nx); b.st[0] = nloc; b.st[1] = nx; }
        const unsigned old = xb_add(&bar[XB_XSUB(b.x)], 1u);
        const unsigned gen = old / nloc;
        if (old + 1u == (gen + 1u) * nloc) {
            __builtin_amdgcn_fence(__ATOMIC_RELEASE, "agent");
            asm volatile("s_waitcnt vmcnt(0)" ::: "memory");
            const unsigned og = xb_add(&bar[XB_TOP], 1u);
            const unsigned tg = og / nx;
            if (og + 1u == (tg + 1u) * nx) xb_add(&bar[XB_TOPGEN], 1u);
            else XB_SPIN(xb_ld(&bar[XB_TOPGEN]) == tg, bar);
            __builtin_amdgcn_fence(__ATOMIC_ACQUIRE, "agent");
            xb_add(&bar[XB_XGEN(b.x)], 1u);
            asm volatile("s_waitcnt vmcnt(0)" ::: "memory");
        } else {
            XB_SPIN(xb_ld(&bar[XB_XGEN(b.x)]) == gen, bar);
            __builtin_amdgcn_fence(__ATOMIC_ACQUIRE, "agent");
            asm volatile("s_waitcnt vmcnt(0)" ::: "memory");
        }
    }
    __syncthreads();
}

#ifdef MULTI_LAUNCH
template <class F> __global__ void __launch_bounds__(256) k_run(F f) {
    for (long i = (long)blockIdx.x * blockDim.x + threadIdx.x; i < f.n; i += (long)gridDim.x * blockDim.x) f(i);
}
template <class F> __global__ void __launch_bounds__(512, 2) k_gemm(GemmDesc g, F e) {
    extern __shared__ __attribute__((aligned(16))) unsigned char shm[];
    pg8::gemm_phase<F>((PG8_LAS unsigned char*)shm, g, e, (int)gridDim.x, (int)blockIdx.x);
}
struct Ctx { hipStream_t stream; int ncu; const void* const* tbl;
    template <int I> const float* inp() const { return (const float*)tbl[I]; }
    template <class F> void run(const F& f) {
        if (f.n <= 0) return; long nb = (f.n + 255) / 256; if (nb > 256L * 32) nb = 256L * 32;
        hipLaunchKernelGGL(k_run<F>, dim3((unsigned)nb), dim3(256), 0, stream, f); }
    template <class F> void gemm(const GemmDesc& g, const F& e) {
        static bool attr_set = false;
        if (!attr_set) { (void)hipFuncSetAttribute((const void*)k_gemm<F>, hipFuncAttributeMaxDynamicSharedMemorySize, pg8::STAGE_BYTES); attr_set = true; }
        hipLaunchKernelGGL(k_gemm<F>, dim3(ncu), dim3(512), pg8::STAGE_BYTES, stream, g, e); }
};
#else
struct Ctx { XcdBarrier bar; PG8_LAS unsigned char* lds; long gtid, nthr;
    template <int I> __device__ __forceinline__ const float* inp() const { unsigned off = pg8::STAGE_BYTES + 64 + 8 * I; asm volatile("" : "+v"(off));
        const PG8_LAS unsigned* t = (const PG8_LAS unsigned*)(lds + off);
        const unsigned lo = __builtin_amdgcn_readfirstlane(t[0]), hi = __builtin_amdgcn_readfirstlane(t[1]); return (const float*)(((unsigned long long)hi << 32) | lo); }
    template <class F> __device__ __forceinline__ void run(const F& f) {
        int i0 = (int)gtid; asm volatile("" : "+v"(i0));
        const int n = (int)f.n, st = (int)nthr;
        for (int i = i0; i < n; i += st) f((long)i);
        xcd_barrier(bar); }
    template <class F> __device__ __forceinline__ void gemm(const GemmDesc& g, const F& e) {
        pg8::gemm_phase<F>(lds, g, e, (int)gridDim.x, (int)blockIdx.x);
        xcd_barrier(bar); }
};
#endif
#else
struct Ctx { const void* const* tbl;
template <int I> const float* inp() const { return (const float*)tbl[I]; }
template <class F> void run(const F& f) {
#pragma omp parallel for schedule(static)
    for (long i = 0; i < f.n; ++i) f(i);
}
template <class F> void gemm(const GemmDesc& g, const F& e) {
    int M = g.M; if (g.ntile) { int nt = g.ntile[0] - g.tile0; if (nt < 0) nt = 0; if (nt * 256 < M) M = nt * 256; }
#pragma omp parallel for schedule(dynamic, 4)
    for (int r = 0; r < M; ++r) {
        const bf16* a = g.A + (size_t)r * g.K; const bf16* B = g.Bt + (g.tile_e ? (size_t)g.tile_e[g.tile0 + r / 256] * g.e_stride : 0);
        static thread_local float af[4096]; for (int k = 0; k < g.K; ++k) af[k] = bf2f(a[k]);
        for (int c0 = 0; c0 < g.N; c0 += 8) { float v[8];
            for (int j = 0; j < 8; ++j) { const bf16* bt = B + (size_t)(c0 + j) * g.K; float s = 0.f; for (int k = 0; k < g.K; ++k) s += af[k] * bf2f(bt[k]); v[j] = s; }
            e.apply8(r, c0, v); }
    }
}
};
#endif

struct Inputs { const float *x, *c, *ctx, *c_ctx, *w_ada, *b_ada, *norm1, *norm2, *w_in, *w_out, *gla_wa2, *gla_ba, *gla_norm, *s5_lam_re, *s5_lam_im, *s5_log_dt, *s5_b_re, *s5_b_im,
    *s5_c_re, *s5_c_im, *s5_d, *s5_glu_w, *s5_glu_b, *ml_conv_w, *ml_conv_b, *ml_gate_b, *ml_norm, *ffn_w1, *ffn_w3, *ffn_w2, *moe_router, *moe_w1, *moe_w3, *moe_w2, *norm_f; };

#define INP(name) (cx.template inp<offsetof(Inputs, name) / 8>())
#define WSB ((unsigned char*)cx.template inp<36>())
#define out ((float*)cx.template inp<35>())
#define mod ((float*)(WSB + WS.mod))
#define h ((float*)(WSB + WS.h))
#define abuf ((bf16*)(WSB + WS.abuf))
#define winT ((bf16*)(WSB + WS.winT))
#define woutT ((bf16*)(WSB + WS.woutT))
#define w13T ((bf16*)(WSB + WS.w13T))
#define w2T ((bf16*)(WSB + WS.w2T))
#define pbuf ((bf16*)(WSB + WS.pbuf))
#define la ((float*)(WSB + WS.la))
#define qin ((bf16*)(WSB + WS.qin))
#define kin ((bf16*)(WSB + WS.kin))
#define kout ((bf16*)(WSB + WS.kout))
#define att ((float*)(WSB + WS.att))
#define st ((float*)(WSB + WS.st))
#define obuf ((float*)(WSB + WS.obuf))
#define qkc ((bf16*)(WSB + WS.qkc))
#define mlF ((float*)(WSB + WS.mlF))
#define mlI ((float*)(WSB + WS.mlI))
#define s5disc ((float*)(WSB + WS.s5disc))
#define s5AB ((float*)(WSB + WS.s5AB))
#define s5K ((float*)(WSB + WS.s5K))
#define s5CA ((float*)(WSB + WS.s5CA))
#define s5st ((float*)(WSB + WS.s5st))
#define act ((bf16*)(WSB + WS.act))
#define mw13T ((bf16*)(WSB + WS.mw13T))
#define mw2T ((bf16*)(WSB + WS.mw2T))
#define xs ((bf16*)(WSB + WS.xs))
#define mact ((bf16*)(WSB + WS.mact))
#define yrow ((bf16*)(WSB + WS.yrow))
#define rt_e ((int*)(WSB + WS.rt_e))
#define rt_w ((float*)(WSB + WS.rt_w))
#define rt_dest ((int*)(WSB + WS.rt_dest))
#define segcnt ((int*)(WSB + WS.segcnt))
#define ecnt ((int*)(WSB + WS.ecnt))
#define row_token ((int*)(WSB + WS.row_token))
#define tile_e ((int*)(WSB + WS.tile_e))
#define ntile ((int*)(WSB + WS.ntile))
#define modl (mod + (size_t)l * NMOD * 6 * D)
template <int l, class X> HD void layer_fwd(X& cx) {
    constexpr bool last = (l == DEPTH - 1);
        cx.run(NormModK{(long)NR, h, INP(norm1) + (size_t)l * D, modl, 0, D, abuf, nullptr, nullptr, nullptr, 0});
        cx.gemm(GemmDesc{abuf, winT + (size_t)l * PS * D, nullptr, nullptr, 0, NR, PS, D, 0}, EpiStoreBf16{pbuf, PS, 0});
        for (int d = 0; d < 2; ++d) {
            cx.run(GlaLa{(long)NR * 192, pbuf, INP(gla_wa2) + (size_t)l * 2 * 16 * 192, INP(gla_ba) + (size_t)l * 2 * 192, la, d});
            cx.run(GlaCum{(long)NB * NBLK * 192, la, d});
            cx.run(GlaQk{(long)NR * 192, pbuf, la, qin, kin, kout, d});
            cx.run(GlaDs{(long)NB * NBLK * 4 * 48 * 96, pbuf, kout, st});
            cx.run(GlaCarry{(long)NB * 4 * 48 * 96, la, st, d});
            cx.run(GlaAtt{(long)NB * NBLK * 4 * 4096, qin, kin, att, d});
            cx.run(GlaO{(long)NR * 384, pbuf, qin, att, st, obuf, d});
        }
        cx.run(HeadFin{(long)NR * 4, pbuf, obuf, INP(gla_norm) + (size_t)l * 96, abuf, 0});
        cx.run(MlConv{(long)NR * 768, pbuf, INP(ml_conv_w) + (size_t)l * 3 * 768, INP(ml_conv_b) + (size_t)l * 768, qkc});
        cx.run(MlGates{(long)2 * NB * NBLK * 4, pbuf, INP(ml_gate_b) + (size_t)l * 16, mlF, mlI});
        for (int d = 0; d < 2; ++d) {
            cx.run(MlDs{(long)NB * NBLK * 4 * 96 * 97, pbuf, qkc, mlF, mlI, st, d});
            cx.run(MlCarry{(long)NB * 4 * 96 * 97, mlF, st, d});
            cx.run(MlAtt{(long)NB * NBLK * 4 * 4096, qkc, mlF, mlI, att, d});
            cx.run(MlH{(long)NR * 384, pbuf, qkc, mlF, att, st, obuf, d});
        }
        cx.run(HeadFin{(long)NR * 4, pbuf, obuf, INP(ml_norm) + (size_t)l * 96, abuf, 1});
        cx.run(S5Disc{(long)2 * 16 * 64, INP(s5_lam_re) + (size_t)l * 2048, INP(s5_lam_im) + (size_t)l * 2048, INP(s5_log_dt) + (size_t)l * 32, s5disc});
        cx.run(S5AB{(long)2 * 16 * 64 * 64 * 16, s5disc, INP(s5_b_re) + (size_t)l * 16384, INP(s5_b_im) + (size_t)l * 16384, s5AB});
        cx.run(S5K{(long)2 * 16 * 64 * 256, s5AB, INP(s5_c_re) + (size_t)l * 16384, INP(s5_c_im) + (size_t)l * 16384, s5K});
        cx.run(S5CA{(long)2 * 16 * 64 * 16 * 64, s5disc, INP(s5_c_re) + (size_t)l * 16384, INP(s5_c_im) + (size_t)l * 16384, s5CA});
        for (int d = 0; d < 2; ++d) {
            cx.run(S5E{(long)NB * NBLK * 16 * 64, pbuf, s5AB, s5st, d});
            cx.run(S5Carry{(long)NB * 16 * 64, s5disc, s5st, d});
            cx.run(S5Y{(long)NR * 256, pbuf, s5K, s5CA, s5st, obuf, d});
        }
        cx.run(S5Z{(long)NR * 256, pbuf, INP(s5_d) + (size_t)l * 256, obuf});
        cx.run(S5Glu{(long)NR * 256, obuf, INP(s5_glu_w) + (size_t)l * 65536, INP(s5_glu_b) + (size_t)l * 256, abuf});
        cx.gemm(GemmDesc{abuf, woutT + (size_t)l * D * D, nullptr, nullptr, 0, NR, D, D, 0}, EpiResid{h, modl, 2 * D});
        if constexpr (l % 2 == 0) { constexpr int j = l / 2;
            cx.run(NormModK{(long)NR, h, INP(norm2) + (size_t)l * D, modl, 3 * D, 4 * D, abuf, nullptr, nullptr, nullptr, 0});
            cx.gemm(GemmDesc{abuf, w13T + (size_t)j * 2 * DFF * D, nullptr, nullptr, 0, NR, 2 * DFF, D, 0}, EpiSwiGLU{act, DFF, 0});
            cx.gemm(GemmDesc{act, w2T + (size_t)j * D * DFF, nullptr, nullptr, 0, NR, D, DFF, 0}, EpiResid{h, modl, 5 * D});
        } else { constexpr int j = l / 2; const int nseg = (NR + 63) / 64;
            for (int e = 0; e < NE; ++e) { const size_t wo = ((size_t)j * NE + e) * D * DFF;
                cx.run(TransposeK{(long)2 * DFF * D, INP(moe_w1) + wo, INP(moe_w3) + wo, mw13T + (size_t)e * 2 * DFF * D, D, DFF, 2 * DFF});
                cx.run(TransposeK{(long)D * DFF, INP(moe_w2) + wo, nullptr, mw2T + (size_t)e * D * DFF, DFF, D, D}); }
            cx.run(NormModK{(long)NR, h, INP(norm2) + (size_t)l * D, modl, 3 * D, 4 * D, abuf, INP(moe_router) + (size_t)j * D * NE, rt_e, rt_w, last ? 1 : 0});
            cx.run(MoeSegCount{(long)NE * nseg, rt_e, segcnt, nseg});
            cx.run(MoePrefix{(long)NE, segcnt, ecnt, nseg});
            cx.run(MoeFillNeg{(long)MOE_MAXT * 256, row_token});
            cx.run(MoeTiles{1, ecnt, tile_e, ntile, row_token});
            cx.run(MoeAssign{(long)NE * nseg, rt_e, segcnt, ecnt, rt_dest, row_token, nseg});
            for (int t0 = 0; t0 < MOE_MAXT; t0 += MOE_PASS_T) { const int nt = (MOE_MAXT - t0 < MOE_PASS_T) ? MOE_MAXT - t0 : MOE_PASS_T;
                cx.run(MoeGather{(long)nt * 256 * (D / 8), abuf, row_token, xs, t0 * 256});
                cx.gemm(GemmDesc{xs, mw13T, tile_e, ntile, (size_t)2 * DFF * D, nt * 256, 2 * DFF, D, t0}, EpiSwiGLU{mact, DFF, 0});
                cx.gemm(GemmDesc{mact, mw2T, tile_e, ntile, (size_t)D * DFF, nt * 256, D, DFF, t0}, EpiStoreBf16{yrow + (size_t)t0 * 256 * D, D, 0}); }
            cx.run(MoeCombine{(long)NR * D, h, yrow, rt_e, rt_w, rt_dest, modl, 5 * D});
        }
    }
template <class X> HD void forward(X& cx) {
    cx.run(InitH{(long)NR * D, INP(x), INP(ctx), h});
    cx.run(ModK{(long)DEPTH * 6 * D, INP(c), INP(c_ctx), INP(w_ada), INP(b_ada), mod});
    for (int l = 0; l < DEPTH; ++l) {
        cx.run(TransposeK{(long)PS * D, INP(w_in) + (size_t)l * D * DPROJ, nullptr, winT + (size_t)l * PS * D, D, DPROJ, PS});
        cx.run(TransposeK{(long)D * D, INP(w_out) + (size_t)l * D * D, nullptr, woutT + (size_t)l * D * D, D, D, D});
        if (l % 2 == 0) { const int j = l / 2;
            cx.run(TransposeK{(long)2 * DFF * D, INP(ffn_w1) + (size_t)j * D * DFF, INP(ffn_w3) + (size_t)j * D * DFF, w13T + (size_t)j * 2 * DFF * D, D, DFF, 2 * DFF});
            cx.run(TransposeK{(long)D * DFF, INP(ffn_w2) + (size_t)j * DFF * D, nullptr, w2T + (size_t)j * D * DFF, DFF, D, D}); }
    }
    layer_fwd<0>(cx);
    if constexpr (DEPTH > 1) layer_fwd<1>(cx);
    if constexpr (DEPTH > 2) layer_fwd<2>(cx);
    if constexpr (DEPTH > 3) layer_fwd<3>(cx);
    static_assert(DEPTH <= 4, "unrolled for DEPTH <= 4");
    cx.run(FinalNorm{(long)NB * SEQ, h, INP(norm_f), out});
}

#undef mod
#undef h
#undef abuf
#undef winT
#undef woutT
#undef w13T
#undef w2T
#undef pbuf
#undef la
#undef qin
#undef kin
#undef kout
#undef att
#undef st
#undef obuf
#undef qkc
#undef mlF
#undef mlI
#undef s5disc
#undef s5AB
#undef s5K
#undef s5CA
#undef s5st
#undef act
#undef mw13T
#undef mw2T
#undef xs
#undef mact
#undef yrow
#undef rt_e
#undef rt_w
#undef rt_dest
#undef segcnt
#undef ecnt
#undef row_token
#undef tile_e
#undef ntile
#undef WSB
#undef out
#undef modl
#ifndef HOST_EMU
#ifndef MULTI_LAUNCH
constexpr int MEGA_LDS = pg8::STAGE_BYTES + 512;
struct MegaArgs { const void* p[37]; };
__global__ void __launch_bounds__(512, 2) mega_fwd(MegaArgs a) {
    extern __shared__ __attribute__((aligned(16))) unsigned char shm[];
    PG8_LAS unsigned char* lds = (PG8_LAS unsigned char*)shm;
    volatile LAS unsigned* xbw = (volatile LAS unsigned*)(lds + pg8::STAGE_BYTES);
    if (threadIdx.x < 4) xbw[threadIdx.x] = 0u;
    if (threadIdx.x < 37) ((PG8_LAS unsigned long long*)(lds + pg8::STAGE_BYTES + 64))[threadIdx.x] = (unsigned long long)a.p[threadIdx.x];
    __syncthreads();
    Ctx cx; cx.lds = lds;
    cx.bar = xcd_barrier_post((unsigned*)((unsigned char*)cx.inp<36>() + WS.ctl), xbw);
    cx.gtid = (long)blockIdx.x * blockDim.x + threadIdx.x; cx.nthr = (long)gridDim.x * blockDim.x;
    forward(cx);
}
#endif
extern "C" void kernel_launch(void* const* d_in, const int* in_sizes, int n_in, void* d_out, int out_size, void* d_ws, size_t ws_size, hipStream_t stream) {
    static int ncu = 0;
    if (ncu == 0) { int dev = 0; (void)hipGetDevice(&dev); (void)hipDeviceGetAttribute(&ncu, hipDeviceAttributeMultiprocessorCount, dev); if (ncu <= 0) ncu = 256;
#ifndef MULTI_LAUNCH
        if (hipFuncSetAttribute((const void*)mega_fwd, hipFuncAttributeMaxDynamicSharedMemorySize, MEGA_LDS) != hipSuccess) { fprintf(stderr, "kernel_launch: hipFuncSetAttribute failed\n"); }
#endif
    }
    if (n_in != 35 || ws_size < WS.end || out_size != NB * SEQ * D) { fprintf(stderr, "kernel_launch: unexpected sizes n_in %d ws %zu (need %zu) out %d\n", n_in, ws_size, (size_t)WS.end, out_size); return; }
#ifdef MULTI_LAUNCH
    const void* tbl[37]; for (int i = 0; i < 35; ++i) tbl[i] = d_in[i]; tbl[35] = d_out; tbl[36] = d_ws;
    Ctx cx{stream, ncu, tbl};
    forward(cx);
#else
    (void)hipMemsetAsync((unsigned char*)d_ws + WS.ctl, 0, 1 << 20, stream);
    MegaArgs a{}; for (int i = 0; i < 35; ++i) a.p[i] = d_in[i];
    a.p[35] = d_out; a.p[36] = d_ws;
    hipLaunchKernelGGL(mega_fwd, dim3(ncu), dim3(512), MEGA_LDS, stream, a);
#endif
}
#endif
```

```cpp
#ifndef HOST_EMU
#include <hip/hip_runtime.h>
#define HD __host__ __device__ __forceinline__
#else
#include <cmath>
#include <cstdio>
#include <cstdlib>
#include <cstring>
#include <cstdint>
#define HD inline
#endif
#include <math.h>
#include <stdint.h>
#include <stddef.h>
#include <stdio.h>

#ifndef CFG_NB
#define CFG_NB 8
#endif
#ifndef CFG_SEQ
#define CFG_SEQ 4096
#endif
#ifndef CFG_CTX
#define CFG_CTX 256
#endif
#ifndef CFG_DEPTH
#define CFG_DEPTH 4
#endif
constexpr int NB = CFG_NB, SEQ = CFG_SEQ, CTX = CFG_CTX, DEPTH = CFG_DEPTH;
constexpr int D = 1024, GRID_W = 64;
constexpr int RPB = CTX + SEQ;
constexpr int NR = NB * RPB;
constexpr int NBLK = RPB / 64, CB = CTX / 64;
constexpr int DPROJ = 2976, PS = 3072;
constexpr int GQ = 0, GK = 192, GV = 384, GLR = 768, GG = 784, SU = 1168, MQ = 1424, MK = 1808, MV = 2192, MO = 2576, MG = 2960;
constexpr int DFF = 2816, NE = 8;
constexpr int NMOD = NB + 1;
constexpr float EPS = 1e-6f;
constexpr int MOE_MAXT = (2 * NR + NE * 255) / 256 + 1;
constexpr int MOE_PASS_T = 140;

typedef unsigned short bf16;
struct __attribute__((aligned(16))) U4 { uint32_t x, y, z, w; };
HD float bf2f(bf16 v) { uint32_t u = ((uint32_t)v) << 16; float f; memcpy(&f, &u, 4); return f; }
HD bf16 f2bf(float f) { uint32_t u; memcpy(&u, &f, 4); u += 0x7fffu + ((u >> 16) & 1u); return (bf16)(u >> 16); }
HD float siluf(float x) { return x / (1.0f + expf(-x)); }
HD float sigmoidf_(float x) { return 1.0f / (1.0f + expf(-x)); }
HD float logsigmoidf_(float x) { return x < 0.f ? x - log1pf(expf(x)) : -log1pf(expf(-x)); }
HD float gelu_tanhf(float x) { return 0.5f * x * (1.0f + tanhf(0.7978845608028654f * (x + 0.044715f * x * x * x))); }
HD int mod_index(int r) { const int b = r / RPB, t = r % RPB; return t < CTX ? NB : b; }
HD int chain_blk(int d, int step) { return d == 0 ? step : (step < CB ? CB - 1 - step : NBLK - 1 - (step - CB)); }
HD int blk_row(int b, int blk, int d, int pp) { return b * RPB + blk * 64 + (d == 0 ? pp : 63 - pp); }

constexpr size_t LA_NI = (size_t)NB * NBLK * 4;
template <int DKP, int NV> struct LaLay {
    static constexpr size_t qin = 0;
    static constexpr size_t kin = qin + (size_t)2 * NR * 4 * DKP;
    static constexpr size_t koutT = kin + (size_t)2 * NR * 4 * DKP;
    static constexpr size_t vT = koutT + (size_t)2 * LA_NI * DKP * 64;
    static constexpr size_t sT = vT + LA_NI * NV * 64;
    static constexpr size_t dec = sT + (size_t)2 * LA_NI * NV * DKP;
    static constexpr size_t end = dec + (size_t)2 * 2 * LA_NI * DKP;
};
constexpr size_t al256(size_t x) { return (x + 255) & ~(size_t)255; }
struct WsMap {
    size_t ctl, mod, silc, h, abuf, winT, woutT, w13T, w2T, uni, end_fixed;
    size_t pbuf, lab, obuf, qkc, mlF, mlI, s5disc, s5K, s5TB, s5EB, s5uG, s5est, zbuf, gluT, end_mix;
    size_t act, end_ffn;
    size_t mw13T, mw2T, xs, mact, yrow, rt_e, rt_w, rt_dest, segcnt, ecnt, row_token, tile_e, ntile, end_moe;
    size_t end;
};
constexpr WsMap make_map() {
    WsMap m{}; size_t o = 0;
    m.ctl = o; o += 1 << 20;
    m.mod = o; o += al256((size_t)DEPTH * NMOD * 6 * D * 4);
    m.silc = o; o += al256((size_t)NMOD * D * 4);
    m.h = o; o += al256((size_t)NR * D * 4);
    m.abuf = o; o += al256((size_t)NR * D * 2);
    m.winT = o; o += al256((size_t)DEPTH * PS * D * 2);
    m.woutT = o; o += al256((size_t)DEPTH * D * D * 2);
    m.w13T = o; o += al256((size_t)((DEPTH + 1) / 2) * 2 * DFF * D * 2);
    m.w2T = o; o += al256((size_t)((DEPTH + 1) / 2) * D * DFF * 2);
    m.uni = o; m.end_fixed = o;
    o = m.uni;
    m.pbuf = o; o += al256((size_t)NR * PS * 2);
    m.lab = o;
    { size_t o2 = m.lab;
      m.s5disc = o2; o2 += al256((size_t)2 * 16 * 64 * 4 * 4);
      m.s5K = o2; o2 += al256((size_t)2 * 16 * 64 * 256 * 4);
      m.s5TB = o2; o2 += al256((size_t)16 * 1024 * 1280 * 2);
      m.s5EB = o2; o2 += al256((size_t)16 * 256 * 1024 * 2);
      m.s5uG = o2; o2 += al256((size_t)16 * ((NB * NBLK + 255) / 256 * 256) * 1280 * 2);
      m.s5est = o2; o2 += al256((size_t)16 * ((NB * NBLK + 255) / 256 * 256) * 256 * 4);
      m.zbuf = o2; o2 += al256((size_t)NR * 256 * 2);
      m.gluT = o2; o2 += al256((size_t)256 * 256 * 2);
      const size_t la_bytes = al256(LaLay<96, 112>::end * 2) > al256(LaLay<64, 96>::end * 2) ? al256(LaLay<96, 112>::end * 2) : al256(LaLay<64, 96>::end * 2);
      o = m.lab + (la_bytes > o2 - m.lab ? la_bytes : o2 - m.lab); }
    m.qkc = o; o += al256((size_t)NR * 768 * 2);
    m.mlF = o; o += al256((size_t)2 * NR * 4 * 4);
    m.mlI = o; o += al256((size_t)2 * NR * 4 * 4);
    m.obuf = o; o += al256((size_t)NR * 384 * 4);
    m.end_mix = o;
    o = m.uni;
    m.act = o; o += al256((size_t)NR * DFF * 2);
    m.end_ffn = o;
    o = m.uni;
    m.mw13T = o; o += al256((size_t)NE * 2 * DFF * D * 2);
    m.mw2T = o; o += al256((size_t)NE * D * DFF * 2);
    m.xs = o; o += al256((size_t)MOE_PASS_T * 256 * D * 2);
    m.mact = o; o += al256((size_t)MOE_PASS_T * 256 * DFF * 2);
    m.yrow = o; o += al256((size_t)MOE_MAXT * 256 * D * 2);
    m.rt_e = o; o += al256((size_t)NR * 2 * 4);
    m.rt_w = o; o += al256((size_t)NR * 2 * 4);
    m.rt_dest = o; o += al256((size_t)NR * 2 * 4);
    m.segcnt = o; o += al256((size_t)NE * (NR / 64 + 1) * 4);
    m.ecnt = o; o += al256((size_t)64 * 4);
    m.row_token = o; o += al256((size_t)MOE_MAXT * 256 * 4);
    m.tile_e = o; o += al256((size_t)MOE_MAXT * 4);
    m.ntile = o; o += 256;
    m.end_moe = o;
    m.end = m.end_mix > m.end_moe ? m.end_mix : m.end_moe; if (m.end_ffn > m.end) m.end = m.end_ffn;
    return m;
}
constexpr WsMap WS = make_map();

struct InitH { long n; const float* x; const float* ctx; float* h;
    HD void operator()(long i) const { const int r = (int)(i / D), c = (int)(i % D); const int b = r / RPB, t = r % RPB;
        if (t < CTX) { h[i] = ctx[((size_t)b * CTX + t) * D + c]; return; }
        const int tl = t - CTX, row = tl / GRID_W, col = tl % GRID_W; const int q = c >> 8, j = c & 255;
        const float omega = expf(-9.210340371976184f * (float)j / 256.0f); const float p = (q < 2) ? (float)row : (float)col; const float ang = p * omega;
        const float pe = (q & 1) ? cosf(ang) : sinf(ang);
        h[i] = x[((size_t)b * SEQ + tl) * D + c] + pe; } };
struct ModK { long n; const float* c; const float* cctx; const float* w_ada; const float* b_ada; float* mod;
    HD void operator()(long i) const { const int l = (int)(i / (6 * D)), j = (int)(i % (6 * D));
        float acc[NMOD];
        for (int m = 0; m < NMOD; ++m) acc[m] = b_ada[(size_t)l * 6 * D + j];
        const float* w = w_ada + (size_t)l * D * 6 * D + j;
        for (int k = 0; k < D; ++k) { const float wv = w[(size_t)k * 6 * D];
            for (int m = 0; m < NMOD; ++m) { const float cv = (m < NB) ? c[m * D + k] : cctx[k]; acc[m] += siluf(cv) * wv; } }
        for (int m = 0; m < NMOD; ++m) mod[((size_t)l * NMOD + m) * 6 * D + j] = acc[m]; } };
struct TransposeK { long n; const float* a; const float* b; bf16* dst; int K, N, NP, pad;
    HD void operator()(long i) const { const int nn = (int)(i / K), k = (int)(i % K);
        float v = 0.f;
        if (b) { const int j = nn >> 1; v = (nn & 1) ? b[(size_t)k * N + j] : a[(size_t)k * N + j]; }
        else if (nn < N) v = a[(size_t)k * N + nn];
        dst[i] = f2bf(v); } };
struct NormModK { long n; const float* h; const float* g; const float* mod; int sh_off, sc_off; bf16* out; const float* wr; int* rt_e; float* rt_w; int skip_ctx, pad;
    HD void operator()(long r) const { const float* hr = h + (size_t)r * D; float ss = 0.f;
        for (int k = 0; k < D; ++k) ss += hr[k] * hr[k];
        const float rstd = 1.0f / sqrtf(ss / D + EPS); const float* m = mod + (size_t)mod_index((int)r) * 6 * D;
        float lg[NE]; for (int e = 0; e < NE; ++e) lg[e] = 0.f;
        for (int k = 0; k < D; ++k) { const float v = hr[k] * rstd * g[k] * (1.0f + m[sc_off + k]) + m[sh_off + k]; out[(size_t)r * D + k] = f2bf(v);
            if (wr) for (int e = 0; e < NE; ++e) lg[e] += v * wr[k * NE + e]; }
        if (wr) { int e0 = 0; float b0 = lg[0]; for (int e = 1; e < NE; ++e) if (lg[e] > b0) { b0 = lg[e]; e0 = e; }
            int e1 = -1; float b1 = -3.0e38f; for (int e = 0; e < NE; ++e) if (e != e0 && lg[e] > b1) { b1 = lg[e]; e1 = e; }
            const float w1 = 1.0f / (1.0f + expf(b1 - b0));
            const bool skip = skip_ctx && ((int)(r % RPB) < CTX);
            rt_e[2 * r] = skip ? -1 : e0; rt_e[2 * r + 1] = skip ? -1 : e1; rt_w[2 * r] = w1; rt_w[2 * r + 1] = 1.0f - w1; } } };

struct SiluC { long n; const float* c; const float* cctx; float* sc;
    HD void operator()(long i) const { const int m = (int)(i / D), k = (int)(i % D); sc[i] = siluf(m < NB ? c[m * D + k] : cctx[k]); } };
constexpr int MODKC = 8;
struct ModPart { long n; const float* sc; const float* w_ada; float* part;
    HD void operator()(long i) const { const int j = (int)(i % (6 * D)); long y = i / (6 * D); const int l = (int)(y % DEPTH), kc = (int)(y / DEPTH);
        float acc[NMOD]; for (int m = 0; m < NMOD; ++m) acc[m] = 0.f;
        const float* w = w_ada + ((size_t)l * D + (size_t)kc * (D / MODKC)) * 6 * D + j; const float* s0 = sc + kc * (D / MODKC);
        for (int k = 0; k < D / MODKC; ++k) { const float wv = w[(size_t)k * 6 * D];
            for (int m = 0; m < NMOD; ++m) acc[m] += s0[m * D + k] * wv; }
        for (int m = 0; m < NMOD; ++m) part[(((size_t)kc * DEPTH + l) * NMOD + m) * 6 * D + j] = acc[m]; } };
struct ModReduce { long n; const float* part; const float* b_ada; float* mod;
    HD void operator()(long i) const { const int j = (int)(i % (6 * D)); long y = i / (6 * D); const int m = (int)(y % NMOD), l = (int)(y / NMOD); float a = b_ada[(size_t)l * 6 * D + j];
        for (int kc = 0; kc < MODKC; ++kc) a += part[(((size_t)kc * DEPTH + l) * NMOD + m) * 6 * D + j];
        mod[i] = a; } };
struct ZeroBf16 { long n; bf16* p; HD void operator()(long i) const { p[i] = 0; } };
struct GlaLa { long n; const bf16* p; const float* wa2; const float* ba; float* la; int d, pad;
    HD void operator()(long i) const { const int r = (int)(i / 192), j = (int)(i % 192); float z = ba[d * 192 + j];
        for (int q = 0; q < 16; ++q) z += bf2f(p[(size_t)r * PS + GLR + q]) * wa2[((size_t)d * 16 + q) * 192 + j];
        la[i] = logsigmoidf_(z) * (1.0f / 16.0f); } };
struct GlaCum { long n; float* la; int d, pad;
    HD void operator()(long i) const { const int j = (int)(i % 192); const int bb = (int)(i / 192); const int b = bb / NBLK, blk = bb % NBLK; float c = 0.f;
        for (int pp = 0; pp < 64; ++pp) { const size_t o = (size_t)blk_row(b, blk, d, pp) * 192 + j; c += la[o]; la[o] = c; } } };
struct GlaPrep { long n; const bf16* p; const float* la; bf16* lab;
    HD void operator()(long x) const { typedef LaLay<64, 96> L; const int i = (int)(x % 64); long y = x / 64; const int hh = (int)(y % 4); y /= 4; const int r = (int)(y % NR), d = (int)(y / NR);
        const int b = r / RPB, t = r % RPB, blk = t / 64, sx = t % 64; const size_t item = ((size_t)b * NBLK + blk) * 4 + hh; float qv = 0.f, kv = 0.f, ko = 0.f, dc = 0.f;
        if (i < 48) { const float bt = la[((size_t)d * NR + r) * 192 + hh * 48 + i], be = la[((size_t)d * NR + blk_row(b, blk, d, 63)) * 192 + hh * 48 + i];
            const float q = bf2f(p[(size_t)r * PS + GQ + hh * 48 + i]) * 0.14433756729740643f, k = bf2f(p[(size_t)r * PS + GK + hh * 48 + i]);
            qv = q * expf(bt); kv = k * expf(-bt); ko = k * expf(be - bt); dc = expf(be); }
        lab[L::qin + (((size_t)d * NR + r) * 4 + hh) * 64 + i] = f2bf(qv); lab[L::kin + (((size_t)d * NR + r) * 4 + hh) * 64 + i] = f2bf(kv);
        lab[L::koutT + (((size_t)d * LA_NI + item) * 64 + i) * 64 + sx] = f2bf(ko);
        if (sx == (d == 0 ? 63 : 0)) ((float*)(lab + L::dec))[((size_t)d * LA_NI + item) * 64 + i] = dc; } };
struct GlaVT { long n; const bf16* p; bf16* vT;
    HD void operator()(long x) const { const int sx = (int)(x % 64); long y = x / 64; const int j = (int)(y % 96); const size_t item = (size_t)(y / 96); const int hh = (int)(item % 4); const size_t bb = item / 4;
        vT[x] = p[((bb / NBLK) * RPB + (bb % NBLK) * 64 + sx) * PS + GV + hh * 96 + j]; } };
struct MlPrep { long n; const bf16* qkc; const float* F; const float* I; bf16* lab;
    HD void operator()(long x) const { typedef LaLay<96, 112> L; const int i = (int)(x % 96); long y = x / 96; const int hh = (int)(y % 4); y /= 4; const int r = (int)(y % NR), d = (int)(y / NR);
        const int b = r / RPB, t = r % RPB, blk = t / 64, sx = t % 64; const size_t item = ((size_t)b * NBLK + blk) * 4 + hh;
        const float Ft = F[((size_t)d * NR + r) * 4 + hh], It = I[((size_t)d * NR + r) * 4 + hh], Fe = F[((size_t)d * NR + blk_row(b, blk, d, 63)) * 4 + hh];
        const float q = bf2f(qkc[(size_t)r * 768 + hh * 96 + i]), k = bf2f(qkc[(size_t)r * 768 + 384 + hh * 96 + i]);
        lab[L::qin + (((size_t)d * NR + r) * 4 + hh) * 96 + i] = f2bf(q * expf(Ft)); lab[L::kin + (((size_t)d * NR + r) * 4 + hh) * 96 + i] = f2bf(k * expf(It - Ft));
        lab[L::koutT + (((size_t)d * LA_NI + item) * 96 + i) * 64 + sx] = f2bf(k * expf(Fe - Ft + It));
        if (sx == (d == 0 ? 63 : 0)) ((float*)(lab + L::dec))[((size_t)d * LA_NI + item) * 96 + i] = expf(Fe); } };
struct MlVT { long n; const bf16* p; bf16* vT;
    HD void operator()(long x) const { const int sx = (int)(x % 64); long y = x / 64; const int j = (int)(y % 112); const size_t item = (size_t)(y / 112); const int hh = (int)(item % 4); const size_t bb = item / 4;
        vT[x] = j < 96 ? p[((bb / NBLK) * RPB + (bb % NBLK) * 64 + sx) * PS + MV + hh * 96 + j] : (j == 96 ? (bf16)0x3f80 : (bf16)0); } };
template <int DKP, int NV> struct StatesRef { long n; bf16* lab;
    HD void operator()(long x) const { typedef LaLay<DKP, NV> L; const int i = (int)(x % DKP); long y = x / DKP; const int j = (int)(y % NV); y /= NV; const size_t item = (size_t)(y % LA_NI); const int d = (int)(y / LA_NI);
        const bf16* a = lab + L::vT + (item * NV + j) * 64; const bf16* k = lab + L::koutT + (((size_t)d * LA_NI + item) * DKP + i) * 64; float acc = 0.f;
        for (int sx = 0; sx < 64; ++sx) acc += bf2f(a[sx]) * bf2f(k[sx]);
        lab[L::sT + (((size_t)d * LA_NI + item) * NV + j) * DKP + i] = f2bf(acc); } };
template <int DKP, int NV> struct CarryT { long n; bf16* lab;
    HD void operator()(long x) const { typedef LaLay<DKP, NV> L; const int i = (int)(x % DKP); long y = x / DKP; const int j = (int)(y % NV); y /= NV; const int hh = (int)(y % 4); y /= 4; const int b = (int)(y % NB), d = (int)(y / NB);
        const float* dec = (const float*)(lab + L::dec); float sv = 0.f;
        for (int step = 0; step < NBLK; ++step) { const int blk = chain_blk(d, step); const size_t item = ((size_t)b * NBLK + blk) * 4 + hh; const size_t o = L::sT + (((size_t)d * LA_NI + item) * NV + j) * DKP + i;
            const float tmp = bf2f(lab[o]); lab[o] = f2bf(sv); sv = dec[((size_t)d * LA_NI + item) * DKP + i] * sv + tmp; } } };
template <int DKP, int NV, bool ISML> struct OutRef { long n; const bf16* lab; float* obuf;
    HD void operator()(long x) const { typedef LaLay<DKP, NV> L; const int j = (int)(x % 96); long y = x / 96; const int hh = (int)(y % 4); const int r = (int)(y / 4); const int b = r / RPB, t = r % RPB, blk = t / 64, tt = t % 64;
        const size_t item = ((size_t)b * NBLK + blk) * 4 + hh; const size_t r0 = (size_t)b * RPB + blk * 64; float hv = 0.f;
        for (int d = 0; d < 2; ++d) { float num = 0.f, den = 0.f; const bf16* q = lab + L::qin + (((size_t)d * NR + r) * 4 + hh) * DKP;
            for (int sx = 0; sx < 64; ++sx) { const bool valid = d == 0 ? (sx <= tt) : (sx >= tt); if (!valid) continue;
                const bf16* k = lab + L::kin + (((size_t)d * NR + r0 + sx) * 4 + hh) * DKP; float a = 0.f; for (int i = 0; i < DKP; ++i) a += bf2f(q[i]) * bf2f(k[i]);
                a = bf2f(f2bf(a)); num += a * bf2f(lab[L::vT + (item * NV + j) * 64 + sx]); if (ISML) den += a * bf2f(lab[L::vT + (item * NV + 96) * 64 + sx]); }
            const bf16* st = lab + L::sT + ((size_t)d * LA_NI + item) * NV * DKP;
            for (int i = 0; i < DKP; ++i) { num += bf2f(q[i]) * bf2f(st[(size_t)j * DKP + i]); if (ISML) den += bf2f(q[i]) * bf2f(st[(size_t)96 * DKP + i]); }
            hv += ISML ? num / fmaxf(fabsf(den), 1.0f) : num; }
        obuf[x] = hv; } };
struct HeadFin { long n; const bf16* p; const float* obuf; const float* gain; bf16* mix; int mode, pad;
    HD void operator()(long x) const { const int hh = (int)(x % 4), r = (int)(x / 4); const float* o = obuf + (size_t)r * 384 + hh * 96; float ss = 0.f;
        for (int j = 0; j < 96; ++j) ss += o[j] * o[j];
        const float rstd = 1.0f / sqrtf(ss / 96.0f + EPS);
        for (int j = 0; j < 96; ++j) { const float gv = bf2f(p[(size_t)r * PS + (mode ? MO : GG) + hh * 96 + j]); const float gt = mode ? sigmoidf_(gv) : siluf(gv);
            mix[(size_t)r * D + (mode ? 640 : 0) + hh * 96 + j] = f2bf(o[j] * rstd * gain[j] * gt); } } };

struct MlConv { long n; const bf16* p; const float* cw; const float* cb; bf16* qkc;
    HD void operator()(long i) const { const int r = (int)(i / 768), c = (int)(i % 768); const int t = r % RPB; const bool first = (t == 0 || t == CTX), last = (t == CTX - 1 || t == RPB - 1);
        float y = cw[768 + c] * bf2f(p[(size_t)r * PS + MQ + c]);
        if (!first) y += cw[c] * bf2f(p[(size_t)(r - 1) * PS + MQ + c]);
        if (!last) y += cw[2 * 768 + c] * bf2f(p[(size_t)(r + 1) * PS + MQ + c]);
        float v = siluf(y + cb[c]); if (c >= 384) v *= 0.10206207261596577f; qkc[i] = f2bf(v); } };
struct MlGates { long n; const bf16* p; const float* gb; float* F; float* I;
    HD void operator()(long x) const { const int hh = (int)(x % 4); long y = x / 4; const int blk = (int)(y % NBLK); y /= NBLK; const int b = (int)(y % NB), d = (int)(y / NB); float c = 0.f;
        for (int pp = 0; pp < 64; ++pp) { const int r = blk_row(b, blk, d, pp); const float gi = bf2f(p[(size_t)r * PS + MG + (2 * d) * 4 + hh]) + gb[(2 * d) * 4 + hh];
            const float gf = bf2f(p[(size_t)r * PS + MG + (2 * d + 1) * 4 + hh]) + gb[(2 * d + 1) * 4 + hh]; c += logsigmoidf_(gf);
            F[((size_t)d * NR + r) * 4 + hh] = c; I[((size_t)d * NR + r) * 4 + hh] = gi; } } };
struct S5Disc { long n; const float* lre; const float* lim; const float* ldt; float* disc;
    HD void operator()(long x) const { const int nn = (int)(x % 64); const int dg = (int)(x / 64); const float dt = expf(ldt[dg]); const float lr = lre[x], li = lim[x];
        const float mag = expf(lr * dt), ar = mag * cosf(li * dt), ai = mag * sinf(li * dt), den = lr * lr + li * li, pr = ar - 1.0f, pi = ai;
        disc[x * 4 + 0] = lr * dt; disc[x * 4 + 1] = li * dt; disc[x * 4 + 2] = (pr * lr + pi * li) / den; disc[x * 4 + 3] = (pi * lr - pr * li) / den; (void)nn; } };
HD void s5_apow(const float* disc4, float tau, float& ar, float& ai) { const float mag = expf(disc4[0] * tau); ar = mag * cosf(disc4[1] * tau); ai = mag * sinf(disc4[1] * tau); }
struct MoeSegCount { long n; const int* rt_e; int* segcnt; int nseg, pad;
    HD void operator()(long x) const { const int seg = (int)(x % nseg), e = (int)(x / nseg); int c = 0;
        for (int r = seg * 64; r < seg * 64 + 64 && r < NR; ++r) { c += (rt_e[2 * r] == e) + (rt_e[2 * r + 1] == e); }
        segcnt[(size_t)e * nseg + seg] = c; } };
struct MoePrefix { long n; int* segcnt; int* ecnt; int nseg, pad;
    HD void operator()(long e) const { int c = 0; for (int s = 0; s < nseg; ++s) { const int v = segcnt[(size_t)e * nseg + s]; segcnt[(size_t)e * nseg + s] = c; c += v; } ecnt[e] = c; } };
struct MoeTiles { long n; const int* ecnt; int* tile_e; int* ntile; int* row_token;
    HD void operator()(long) const { int t = 0; for (int e = 0; e < NE; ++e) { const int nt = (ecnt[e] + 255) / 256; for (int q = 0; q < nt; ++q) tile_e[t++] = e; }
        ntile[0] = t; for (int q = t; q < MOE_MAXT; ++q) tile_e[q] = 0; } };
struct MoeFillNeg { long n; int* row_token; HD void operator()(long i) const { row_token[i] = -1; } };
struct MoeAssign { long n; const int* rt_e; const int* segcnt; const int* ecnt; int* rt_dest; int* row_token; int nseg, pad;
    HD void operator()(long x) const { const int seg = (int)(x % nseg), e = (int)(x / nseg); int pstart = 0; for (int q = 0; q < e; ++q) pstart += (ecnt[q] + 255) / 256 * 256;
        int pos = pstart + segcnt[(size_t)e * nseg + seg];
        for (int r = seg * 64; r < seg * 64 + 64 && r < NR; ++r) for (int k = 0; k < 2; ++k) if (rt_e[2 * r + k] == e) { rt_dest[2 * r + k] = pos; row_token[pos] = r; ++pos; } } };
struct MoeGather { long n; const bf16* f; const int* row_token; bf16* xs; int row0, pad;
    HD void operator()(long i) const { const int lr = (int)(i / (D / 8)), c8 = (int)(i % (D / 8)); const int tok = row_token[row0 + lr];
        U4 v; v.x = v.y = v.z = v.w = 0u; if (tok >= 0) v = *(const U4*)(f + (size_t)tok * D + c8 * 8); *(U4*)(xs + (size_t)lr * D + c8 * 8) = v; } };
struct MoeCombine { long n; float* h; const bf16* yrow; const int* rt_e; const float* rt_w; const int* rt_dest; const float* mod; int g_off, pad;
    HD void operator()(long i) const { const int r = (int)(i / D), c = (int)(i % D); if (rt_e[2 * r] < 0) return;
        const float y = rt_w[2 * r] * bf2f(yrow[(size_t)rt_dest[2 * r] * D + c]) + rt_w[2 * r + 1] * bf2f(yrow[(size_t)rt_dest[2 * r + 1] * D + c]);
        h[i] += mod[(size_t)mod_index(r) * 6 * D + g_off + c] * y; } };
struct FinalNorm { long n; const float* h; const float* g; float* out;
    HD void operator()(long x) const { const int b = (int)(x / SEQ), tl = (int)(x % SEQ); const float* hr = h + ((size_t)b * RPB + CTX + tl) * D; float ss = 0.f;
        for (int k = 0; k < D; ++k) ss += hr[k] * hr[k];
        const float rstd = 1.0f / sqrtf(ss / D + EPS); for (int k = 0; k < D; ++k) out[(size_t)x * D + k] = hr[k] * rstd * g[k]; } };

struct EpiStoreBf16 { bf16* out; int ld; int row_off;
    HD void apply8(int row, int col0, const float* v) const { bf16* o = out + (size_t)(row - row_off) * ld + col0; for (int i = 0; i < 8; ++i) o[i] = f2bf(v[i]); } };
struct EpiSwiGLU { bf16* out; int ld; int row_off;
    HD void apply8(int row, int col0, const float* v) const { bf16* o = out + (size_t)(row - row_off) * ld + col0 / 2; for (int i = 0; i < 4; ++i) o[i] = f2bf(siluf(v[2 * i]) * v[2 * i + 1]); } };
struct EpiResid { float* h; const float* mod; int g_off, pad;
    HD void apply8(int row, int col0, const float* v) const { float* o = h + (size_t)row * D + col0; const float* g = mod + (size_t)mod_index(row) * 6 * D + g_off + col0; for (int i = 0; i < 8; ++i) o[i] += g[i] * v[i]; } };

struct GemmDesc { const bf16* A; const bf16* Bt; const int* tile_e; const int* ntile; size_t e_stride; int M, N, K, tile0, lda, ldb, tdiv, pad; };
HD GemmDesc mk_gemm(const bf16* A, int lda, const bf16* Bt, int ldb, int M, int N, int K) { return GemmDesc{A, Bt, nullptr, nullptr, 0, M, N, K, 0, lda, ldb, 0, 0}; }

constexpr int S5RB = NB * NBLK;
constexpr int S5RG = (S5RB + 255) / 256 * 256;
constexpr int S5K_ = 1280;
HD void s5_bbar(const float* d4, float br, float bi, float& bbr, float& bbi) { bbr = d4[2] * br - d4[3] * bi; bbi = d4[2] * bi + d4[3] * br; }
struct S5K2 { long n; const float* disc; const float* bre; const float* bim; const float* cre; const float* cim; float* Kt;
    HD void operator()(long x) const { const int p2 = (int)(x % 16); long y = x / 16; const int p1 = (int)(y % 16); y /= 16; const int tau = (int)(y % 64); y /= 64; const int g = (int)(y % 16), d = (int)(y / 16); float acc = 0.f;
        for (int nn = 0; nn < 64; ++nn) { const float* d4 = disc + (((size_t)d * 16 + g) * 64 + nn) * 4; float ar, ai, bbr, bbi; s5_apow(d4, (float)tau, ar, ai);
            s5_bbar(d4, bre[((size_t)g * 64 + nn) * 16 + p2], bim[((size_t)g * 64 + nn) * 16 + p2], bbr, bbi);
            acc += cre[((size_t)g * 16 + p1) * 64 + nn] * (ar * bbr - ai * bbi) - cim[((size_t)g * 16 + p1) * 64 + nn] * (ar * bbi + ai * bbr); }
        Kt[x] = acc; } };
struct S5BuildTB { long n; const float* disc; const float* cre; const float* cim; const float* Kt; bf16* TB;
    HD void operator()(long x) const { const int k = (int)(x % S5K_); long y = x / S5K_; const int tp = (int)(y % 1024), g = (int)(y / 1024); const int t = tp >> 4, p1 = tp & 15; float v;
        if (k < 1024) { const int sx = k >> 4, p2 = k & 15; v = 0.f;
            if (sx <= t) v += Kt[((((size_t)0 * 16 + g) * 64 + (t - sx)) * 16 + p1) * 16 + p2];
            if (sx >= t) v += Kt[((((size_t)1 * 16 + g) * 64 + (sx - t)) * 16 + p1) * 16 + p2];
        } else { const int kk = k - 1024, d = kk >> 7, nn = (kk & 127) >> 1, ri = kk & 1; const int pt = d == 0 ? t : 63 - t; float ar, ai; s5_apow(disc + (((size_t)d * 16 + g) * 64 + nn) * 4, (float)(pt + 1), ar, ai);
            const float cr = cre[((size_t)g * 16 + p1) * 64 + nn], ci = cim[((size_t)g * 16 + p1) * 64 + nn]; v = ri == 0 ? (cr * ar - ci * ai) : -(cr * ai + ci * ar); }
        TB[x] = f2bf(v); } };
struct S5BuildEB { long n; const float* disc; const float* bre; const float* bim; bf16* EB;
    HD void operator()(long x) const { const int k = (int)(x % 1024); long y = x / 1024; const int col = (int)(y % 256), g = (int)(y / 256); const int d = col >> 7, nn = (col & 127) >> 1, ri = col & 1, sx = k >> 4, p2 = k & 15;
        const float* d4 = disc + (((size_t)d * 16 + g) * 64 + nn) * 4; float ar, ai, bbr, bbi; s5_apow(d4, (float)(d == 0 ? 63 - sx : sx), ar, ai);
        s5_bbar(d4, bre[((size_t)g * 64 + nn) * 16 + p2], bim[((size_t)g * 64 + nn) * 16 + p2], bbr, bbi);
        EB[x] = f2bf(ri == 0 ? (ar * bbr - ai * bbi) : (ar * bbi + ai * bbr)); } };
struct S5BuildU { long n; const bf16* p; bf16* uG;
    HD void operator()(long x) const { const int k = (int)(x % 1024); long y = x / 1024; const int rb = (int)(y % S5RB), g = (int)(y / S5RB); const int b = rb / NBLK, blk = rb % NBLK;
        uG[((size_t)g * S5RG + rb) * S5K_ + k] = p[((size_t)b * RPB + blk * 64 + (k >> 4)) * PS + SU + g * 16 + (k & 15)]; } };
struct S5Carry2 { long n; const float* disc; const float* est; bf16* uG;
    HD void operator()(long x) const { const int nn = (int)(x % 64); long y = x / 64; const int d = (int)(y % 2); y /= 2; const int g = (int)(y % 16), b = (int)(y / 16); float ar, ai; s5_apow(disc + (((size_t)d * 16 + g) * 64 + nn) * 4, 64.0f, ar, ai);
        float sr = 0.f, si = 0.f;
        for (int step = 0; step < NBLK; ++step) { const int blk = chain_blk(d, step); const size_t row = (size_t)g * S5RG + (size_t)b * NBLK + blk; const float tr = est[row * 256 + d * 128 + 2 * nn], ti = est[row * 256 + d * 128 + 2 * nn + 1];
            uG[row * S5K_ + 1024 + d * 128 + 2 * nn] = f2bf(sr); uG[row * S5K_ + 1024 + d * 128 + 2 * nn + 1] = f2bf(si);
            const float nr = ar * sr - ai * si + tr, ni = ar * si + ai * sr + ti; sr = nr; si = ni; } } };
struct EpiStoreF32 { float* out; int ld; int pad;
    HD void apply8(int row, int col0, const float* v) const { float* o = out + (size_t)row * ld + col0; for (int i = 0; i < 8; ++i) o[i] = v[i]; } };
struct EpiS5Z { const bf16* p; const float* dskip; bf16* zbuf;
    HD void apply8(int row, int col0, const float* v) const { const int g = row / S5RG, rb = row % S5RG; if (rb >= S5RB) return; const int b = rb / NBLK, blk = rb % NBLK, t = col0 >> 4, p0 = col0 & 15;
        const size_t r = (size_t)b * RPB + blk * 64 + t; const int c = g * 16 + p0;
        for (int i = 0; i < 8; ++i) zbuf[r * 256 + c + i] = f2bf(gelu_tanhf(v[i] + dskip[c + i] * bf2f(p[r * PS + SU + c + i]))); } };
struct EpiGlu { const bf16* zbuf; const float* gb; bf16* mix;
    HD void apply8(int row, int col0, const float* v) const { for (int i = 0; i < 8; ++i) mix[(size_t)row * D + 384 + col0 + i] = f2bf(bf2f(zbuf[(size_t)row * 256 + col0 + i]) * sigmoidf_(v[i] + gb[col0 + i])); } };

#ifndef HOST_EMU
namespace pg8 {
#define PG8_LAS __attribute__((address_space(3)))
typedef short bf16x8 __attribute__((ext_vector_type(8)));
typedef float f32x4 __attribute__((ext_vector_type(4)));
constexpr int BM = 256, BK = 64, HALF = 128, HTB = HALF * BK * 2, STAGE_BYTES = 8 * HTB, NXCD = 8, WGM = 8;
__device__ __forceinline__ int lds_byte(int r, int c) { const int st = (r >> 4) * 2 + (c >> 5), rr = r & 15, cc = c & 31, ob = rr * 64 + cc * 2; return st * 1024 + (ob ^ (((ob >> 9) & 1) << 5)); }
__device__ __forceinline__ void stage_rc(int b, int& R, int& C) { const int st = b / 1024, sb = b % 1024, swz = sb ^ (((sb >> 9) & 1) << 5); R = (st >> 1) * 16 + swz / 64; C = (st & 1) * 32 + (swz % 64) / 2; }
__device__ __forceinline__ int perm32(int rho) { const int n = rho >> 4, i = rho & 15; return 8 * (i >> 2) + 4 * n + (i & 3); }
struct Unit { int pm, pn; };
struct StaticOrder {
    int nM, nN, nwg, G, c;
    __device__ void init(int M, int N, int G_, int c_) { nM = M / BM; nN = N / BM; nwg = nM * nN; G = G_; c = c_; }
    __device__ bool next(int i, Unit& u) const {
        const long L = (long)i * G + c; if (L >= nwg) return false;
        int wgid = (int)L; { const int q = nwg / NXCD, r = nwg % NXCD, xcd = wgid % NXCD, off = wgid / NXCD; wgid = (xcd < r ? xcd * (q + 1) : r * (q + 1) + (xcd - r) * q) + off; }
        const int nig = WGM * nN, gid = wgid / nig, fm = gid * WGM, gsz = (nM - fm) < WGM ? (nM - fm) : WGM;
        u.pm = fm + ((wgid % nig) % gsz); u.pn = (wgid % nig) / gsz; return true;
    }
};
template <class F> __device__ __forceinline__ void epi_apply(const F& f, const f32x4 (&acc)[2][2][4][2], const Unit& u, int wr, int wc, int fr, int fq) {
    const int row0 = u.pm * BM + wr * 64 + fr, col0 = u.pn * BM + wc * 32 + 8 * fq;
#pragma unroll
    for (int ai = 0; ai < 2; ++ai)
#pragma unroll
        for (int m = 0; m < 4; ++m)
#pragma unroll
            for (int bj = 0; bj < 2; ++bj) { const f32x4 v0 = acc[ai][bj][m][0], v1 = acc[ai][bj][m][1];
                const float v[8] = {v0[0], v0[1], v0[2], v0[3], v1[0], v1[1], v1[2], v1[3]};
                f.apply8(row0 + ai * HALF + m * 16, col0 + bj * HALF, v); }
}
template <class F>
__device__ __forceinline__ void gemm_phase(PG8_LAS unsigned char* lds, const GemmDesc g, const F& E, int G_, int c_) {
    int tid_ = threadIdx.x; asm volatile("" : "+v"(tid_));
    const int tid = tid_, wid = __builtin_amdgcn_readfirstlane(tid >> 6), lane = tid & 63, wr = wid >> 2, wc = wid & 3, fr = lane & 15, fq = lane >> 4;
    const int K = g.K, nt = K / BK;
    int M = g.M; if (g.ntile) { int ntl = g.ntile[0] - g.tile0; ntl = ntl < 0 ? 0 : ntl; if (ntl * BM < M) M = ntl * BM; }
    StaticOrder S; S.init(M, g.N, G_, c_);
    unsigned voffA[2], voffB[2];
#pragma unroll
    for (int i = 0; i < 2; ++i) { int R, C; stage_rc(tid * 16 + i * 8192, R, C); const int Rb = (R & ~31) + perm32(R & 31);
        voffA[i] = (unsigned)(R * g.lda + C) * 2u; voffB[i] = (unsigned)(Rb * g.ldb + C) * 2u; }
    const size_t kstep = (size_t)(BK * 2);
    const size_t hstepA = (size_t)HALF * g.lda * 2, hstepB = (size_t)HALF * g.ldb * 2;
    const size_t tstepA = 2 * hstepA, tstepB = 2 * hstepB;
    const unsigned ldsw = (unsigned)wid * 1024u;
    const int aoff = lds_byte(wr * 64 + fr, fq * 8), boff = lds_byte(wc * 32 + fr, fq * 8);
#define PG8_SA(b, h) (((b) * 2 + (h)) * HTB)
#define PG8_SB(b, h) ((4 + (b) * 2 + (h)) * HTB)
#define PG8_STAGE(bufoff, gbase, voff) do { _Pragma("unroll") for (int _i = 0; _i < 2; ++_i) \
        __builtin_amdgcn_global_load_lds((const unsigned*)((const char*)(gbase) + (voff)[_i]), (PG8_LAS unsigned*)(lds + (bufoff) + ldsw + _i * 8192), 16, 0, 0); } while (0)
#define PG8_LDA(dst, b, h) do { _Pragma("unroll") for (int m = 0; m < 4; ++m) _Pragma("unroll") for (int k = 0; k < 2; ++k) dst[m][k] = *(const PG8_LAS bf16x8*)(lds + PG8_SA(b, h) + aoff + m * 2048 + k * 1024); } while (0)
#define PG8_LDB(dst, b, h) do { _Pragma("unroll") for (int n = 0; n < 2; ++n) _Pragma("unroll") for (int k = 0; k < 2; ++k) dst[n][k] = *(const PG8_LAS bf16x8*)(lds + PG8_SB(b, h) + boff + n * 2048 + k * 1024); } while (0)
#define PG8_MMA(ai, bj, At, Bt) do { __builtin_amdgcn_s_setprio(1); _Pragma("unroll") for (int m = 0; m < 4; ++m) _Pragma("unroll") for (int n = 0; n < 2; ++n) _Pragma("unroll") for (int k = 0; k < 2; ++k) \
        acc[ai][bj][m][n] = __builtin_amdgcn_mfma_f32_16x16x32_bf16(Bt[n][k], At[m][k], acc[ai][bj][m][n], 0, 0, 0); __builtin_amdgcn_s_setprio(0); } while (0)
#define PG8_WAIT_V(n) asm volatile("s_waitcnt vmcnt(" #n ")" ::: "memory")
#define PG8_WAIT_L(n) asm volatile("s_waitcnt lgkmcnt(" #n ")" ::: "memory")
#define PG8_BAR __builtin_amdgcn_s_barrier()
#define PG8_SCHED __builtin_amdgcn_sched_barrier(0)
#define PG8_BBASE(u) ((const char*)g.Bt + (g.tile_e ? (size_t)g.tile_e[g.tile0 + (u).pm] * g.e_stride * 2 : (g.tdiv ? (size_t)((u).pm / g.tdiv) * g.e_stride * 2 : (size_t)0)) + (size_t)(u).pn * tstepB)
    Unit cur, nxt; int ui = 0;
    if (!S.next(0, cur)) return;
    f32x4 acc[2][2][4][2];
#pragma unroll
    for (int a = 0; a < 2; ++a)
#pragma unroll
        for (int b = 0; b < 2; ++b)
#pragma unroll
            for (int m = 0; m < 4; ++m)
#pragma unroll
                for (int n = 0; n < 2; ++n) acc[a][b][m][n] = (f32x4){0.f, 0.f, 0.f, 0.f};
    bf16x8 At[4][2], B0[2][2], B1[2][2];
    const char* cA = (const char*)g.A + (size_t)cur.pm * tstepA; const char* cB = PG8_BBASE(cur);
    PG8_STAGE(PG8_SB(0, 0), cB, voffB); PG8_STAGE(PG8_SA(0, 0), cA, voffA); PG8_STAGE(PG8_SB(0, 1), cB + hstepB, voffB); PG8_STAGE(PG8_SA(0, 1), cA + hstepA, voffA);
    if (wr == 1) PG8_BAR;
    PG8_WAIT_V(4); PG8_BAR;
    PG8_STAGE(PG8_SB(1, 0), cB + kstep, voffB); PG8_STAGE(PG8_SA(1, 0), cA + kstep, voffA); PG8_STAGE(PG8_SB(1, 1), cB + hstepB + kstep, voffB);
    PG8_WAIT_V(6); PG8_BAR;
    for (;;) {
        const bool has_next = S.next(ui + 1, nxt);
        const char* nA = has_next ? (const char*)g.A + (size_t)nxt.pm * tstepA : cA; const char* nB = has_next ? PG8_BBASE(nxt) : cB;
        for (int t = 0; t < nt; t += 2) {
            const bool last = (t == nt - 2);
            const char* a1 = cA + (size_t)(t + 1) * kstep;
            const char* a2 = last ? nA : cA + (size_t)(t + 2) * kstep; const char* b2 = last ? nB : cB + (size_t)(t + 2) * kstep;
            const char* a3 = a2 + kstep; const char* b3 = b2 + kstep;
            PG8_LDB(B0, 0, 0); PG8_SCHED; PG8_LDA(At, 0, 0); PG8_STAGE(PG8_SA(1, 1), a1 + hstepA, voffA);
            PG8_WAIT_L(8); PG8_BAR; PG8_WAIT_L(0); PG8_MMA(0, 0, At, B0); PG8_BAR; PG8_SCHED;
            PG8_LDB(B1, 0, 1); PG8_STAGE(PG8_SB(0, 0), b2, voffB);
            PG8_BAR; PG8_WAIT_L(0); PG8_MMA(0, 1, At, B1); PG8_BAR;
            PG8_LDA(At, 0, 1); PG8_STAGE(PG8_SA(0, 0), a2, voffA);
            PG8_BAR; PG8_WAIT_L(0); PG8_MMA(1, 0, At, B0); PG8_BAR; PG8_SCHED;
            PG8_STAGE(PG8_SB(0, 1), b2 + hstepB, voffB);
            PG8_WAIT_V(6); PG8_BAR; PG8_MMA(1, 1, At, B1); PG8_BAR;
            PG8_LDB(B0, 1, 0); PG8_SCHED; PG8_LDA(At, 1, 0); PG8_STAGE(PG8_SA(0, 1), a2 + hstepA, voffA);
            PG8_WAIT_L(8); PG8_BAR; PG8_WAIT_L(0); PG8_MMA(0, 0, At, B0); PG8_BAR; PG8_SCHED;
            PG8_LDB(B1, 1, 1); PG8_STAGE(PG8_SB(1, 0), b3, voffB);
            PG8_BAR; PG8_WAIT_L(0); PG8_MMA(0, 1, At, B1); PG8_BAR;
            PG8_LDA(At, 1, 1); PG8_STAGE(PG8_SA(1, 0), a3, voffA);
            PG8_BAR; PG8_WAIT_L(0); PG8_MMA(1, 0, At, B0); PG8_BAR; PG8_SCHED;
            PG8_STAGE(PG8_SB(1, 1), b3 + hstepB, voffB);
            PG8_WAIT_V(6); PG8_BAR; PG8_MMA(1, 1, At, B1); PG8_BAR;
        }
        epi_apply(E, acc, cur, wr, wc, fr, fq);
        if (!has_next) break;
#pragma unroll
        for (int a = 0; a < 2; ++a)
#pragma unroll
            for (int b = 0; b < 2; ++b)
#pragma unroll
                for (int m = 0; m < 4; ++m)
#pragma unroll
                    for (int n = 0; n < 2; ++n) acc[a][b][m][n] = (f32x4){0.f, 0.f, 0.f, 0.f};
        cur = nxt; cA = nA; cB = nB; ++ui;
    }
    PG8_WAIT_V(0);
    if (wr == 0) PG8_BAR;
    PG8_BAR;
#undef PG8_SA
#undef PG8_SB
#undef PG8_STAGE
#undef PG8_LDA
#undef PG8_LDB
#undef PG8_MMA
#undef PG8_WAIT_V
#undef PG8_WAIT_L
#undef PG8_BAR
#undef PG8_SCHED
#undef PG8_BBASE
}
}

#define XB_TMO      128
#define XB_XCNT(j)  (256  + 64 * (j))
#define XB_XSUB(j)  (1280 + 64 * (j))
#define XB_XGEN(j)  (2304 + 64 * (j))
#define XB_TOP      3328
#define XB_TOPGEN   3392
#define XCD_BAR_WORDS 3456
#define XB_SPIN_CAP (1u << 20)
#define LAS __attribute__((address_space(3)))
__device__ __forceinline__ unsigned xb_ld(unsigned* p)              { return __hip_atomic_load(p, __ATOMIC_RELAXED, __HIP_MEMORY_SCOPE_AGENT); }
__device__ __forceinline__ unsigned xb_add(unsigned* p, unsigned v) { return __hip_atomic_fetch_add(p, v, __ATOMIC_RELAXED, __HIP_MEMORY_SCOPE_AGENT); }
__device__ __forceinline__ unsigned xb_xcc_id() { return (unsigned)__builtin_amdgcn_s_getreg((3 << 11) | 20) & 0xFu; }
#define XB_SPIN(cond, bar) do { unsigned _sp = 0; while (cond) { __builtin_amdgcn_s_sleep(1); \
    if ((++_sp & 255u) == 0u) { if (xb_ld(&(bar)[XB_TMO])) break; if (_sp > XB_SPIN_CAP) { atomicAdd(&(bar)[XB_TMO], 1u); break; } } } } while (0)
struct XcdBarrier { unsigned* bar; unsigned x; volatile LAS unsigned* st; };
__device__ __forceinline__ XcdBarrier xcd_barrier_post(unsigned* bar, volatile LAS unsigned* st) {
    XcdBarrier b; b.bar = bar; b.x = xb_xcc_id(); b.st = st;
    if (threadIdx.x == 0) (void)xb_add(&bar[XB_XCNT(b.x)], 1u);
    return b;
}
__device__ __forceinline__ void xcd_barrier_complete(unsigned* bar, unsigned x, unsigned& nloc, unsigned& nx) {
    const unsigned G = gridDim.x * gridDim.y * gridDim.z;
    unsigned sum, cnt, mine, sp = 0u;
    for (;;) {
        sum = 0u; cnt = 0u; mine = 0u;
#pragma unroll
        for (unsigned j = 0; j < 16; ++j) { const unsigned c = xb_ld(&bar[XB_XCNT(j)]); sum += c; cnt += (c > 0u) ? 1u : 0u; mine = (j == x) ? c : mine; }
        if (sum == G) break;
        __builtin_amdgcn_s_sleep(1);
        if ((++sp & 255u) == 0u) { if (xb_ld(&bar[XB_TMO])) break; if (sp > XB_SPIN_CAP) { atomicAdd(&bar[XB_TMO], 1u); break; } }
    }
    nloc = mine > 0u ? mine : 1u; nx = cnt > 0u ? cnt : 1u;
}
__device__ __forceinline__ void xcd_barrier(const XcdBarrier& b) {
    asm volatile("s_waitcnt vmcnt(0)" ::: "memory");
    __syncthreads();
    if (threadIdx.x == 0) {
        unsigned* bar = b.bar; asm volatile("" : "+s"(bar));
        __builtin_amdgcn_s_waitcnt(0);
        unsigned nloc = b.st[0], nx = b.st[1];
        if (nloc == 0u) { xcd_barrier_complete(bar, b.x, nloc, nx); b.st[0] = nloc; b.st[1] = nx; }
        const unsigned old = xb_add(&bar[XB_XSUB(b.x)], 1u);
        const unsigned gen = old / nloc;
        if (old + 1u == (gen + 1u) * nloc) {
            __builtin_amdgcn_fence(__ATOMIC_RELEASE, "agent");
            asm volatile("s_waitcnt vmcnt(0)" ::: "memory");
            const unsigned og = xb_add(&bar[XB_TOP], 1u);
            const unsigned tg = og / nx;
            if (og + 1u == (tg + 1u) * nx) xb_add(&bar[XB_TOPGEN], 1u);
            else XB_SPIN(xb_ld(&bar[XB_TOPGEN]) == tg, bar);
            __builtin_amdgcn_fence(__ATOMIC_ACQUIRE, "agent");
            xb_add(&bar[XB_XGEN(b.x)], 1u);
            asm volatile("s_waitcnt vmcnt(0)" ::: "memory");
        } else {
            XB_SPIN(xb_ld(&bar[XB_XGEN(b.x)]) == gen, bar);
            __builtin_amdgcn_fence(__ATOMIC_ACQUIRE, "agent");
            asm volatile("s_waitcnt vmcnt(0)" ::: "memory");
        }
    }
    __syncthreads();
}

__device__ __forceinline__ float wave_sum(float v) {
#pragma unroll
    for (int o = 1; o < 64; o <<= 1) v += __shfl_xor(v, o);
    return v;
}
typedef float f32x4v __attribute__((ext_vector_type(4)));
__device__ __forceinline__ unsigned pk2bf(float lo, float hi) { return (unsigned)f2bf(lo) | ((unsigned)f2bf(hi) << 16); }
#define LDS_WAIT() asm volatile("s_waitcnt lgkmcnt(0)" ::: "memory")
struct NormModW { int n; int sh_off; int sc_off; int skip_ctx; const float* h; const float* g; const float* mod; bf16* out; const float* wr; int* rt_e; float* rt_w;
    __device__ __forceinline__ void wave(int r, int lane, PG8_LAS unsigned char*) const {
        const f32x4v* hr = (const f32x4v*)(h + (size_t)r * D) + lane; f32x4v v[4]; float ss = 0.f;
#pragma unroll
        for (int j = 0; j < 4; ++j) { v[j] = hr[64 * j]; ss += (v[j].x * v[j].x + v[j].y * v[j].y) + (v[j].z * v[j].z + v[j].w * v[j].w); }
        const float rstd = 1.0f / sqrtf(wave_sum(ss) * (1.0f / D) + EPS); const float* m = mod + (size_t)mod_index(r) * 6 * D;
        float lg[NE];
#pragma unroll
        for (int e = 0; e < NE; ++e) lg[e] = 0.f;
#pragma unroll
        for (int j = 0; j < 4; ++j) { const int k0 = 4 * (lane + 64 * j); const f32x4v g4 = *(const f32x4v*)(g + k0), sc4 = *(const f32x4v*)(m + sc_off + k0), sh4 = *(const f32x4v*)(m + sh_off + k0);
            const f32x4v o = v[j] * rstd * g4 * (sc4 + 1.0f) + sh4;
            *(uint2*)(out + (size_t)r * D + k0) = make_uint2(pk2bf(o.x, o.y), pk2bf(o.z, o.w));
            if (wr) {
#pragma unroll
                for (int i = 0; i < 4; ++i) { const f32x4v w0 = *(const f32x4v*)(wr + (size_t)(k0 + i) * NE), w1 = *(const f32x4v*)(wr + (size_t)(k0 + i) * NE + 4); const float ov = o[i];
                    lg[0] += ov * w0.x; lg[1] += ov * w0.y; lg[2] += ov * w0.z; lg[3] += ov * w0.w; lg[4] += ov * w1.x; lg[5] += ov * w1.y; lg[6] += ov * w1.z; lg[7] += ov * w1.w; } } }
        if (wr) {
#pragma unroll
            for (int e = 0; e < NE; ++e) lg[e] = wave_sum(lg[e]);
            int e0 = 0; float b0 = lg[0];
#pragma unroll
            for (int e = 1; e < NE; ++e) if (lg[e] > b0) { b0 = lg[e]; e0 = e; }
            int e1 = -1; float b1 = -3.0e38f;
#pragma unroll
            for (int e = 0; e < NE; ++e) if (e != e0 && lg[e] > b1) { b1 = lg[e]; e1 = e; }
            const float w1 = 1.0f / (1.0f + expf(b1 - b0)); const bool skip = skip_ctx && ((r % RPB) < CTX);
            if (lane == 0) { rt_e[2 * r] = skip ? -1 : e0; rt_e[2 * r + 1] = skip ? -1 : e1; rt_w[2 * r] = w1; rt_w[2 * r + 1] = 1.0f - w1; } }
    } };
struct FinalNormW { int n; int pad; const float* h; const float* g; float* out;
    __device__ __forceinline__ void wave(int x, int lane, PG8_LAS unsigned char*) const { const int b = x / SEQ, tl = x % SEQ;
        const f32x4v* hr = (const f32x4v*)(h + ((size_t)b * RPB + CTX + tl) * D) + lane; f32x4v v[4]; float ss = 0.f;
#pragma unroll
        for (int j = 0; j < 4; ++j) { v[j] = hr[64 * j]; ss += (v[j].x * v[j].x + v[j].y * v[j].y) + (v[j].z * v[j].z + v[j].w * v[j].w); }
        const float rstd = 1.0f / sqrtf(wave_sum(ss) * (1.0f / D) + EPS);
#pragma unroll
        for (int j = 0; j < 4; ++j) { const int k0 = 4 * (lane + 64 * j); *(f32x4v*)(out + (size_t)x * D + k0) = v[j] * rstd * *(const f32x4v*)(g + k0); } } };
struct TransW { int n; int K, N, rs, ro, pad; const float* src; bf16* dst; size_t sstride, dstride;
    __device__ __forceinline__ void wave(int item, int lane, PG8_LAS unsigned char* lw) const {
        PG8_LAS float* scr = (PG8_LAS float*)lw; const int nblk = N / 32, ipm = (K / 64) * nblk; const int mat = item / ipm, r = item % ipm, kb = r / nblk, nb = r % nblk, k0 = 64 * kb, n0 = 32 * nb;
        const float* W = src + (size_t)mat * sstride; bf16* WT = dst + (size_t)mat * dstride;
#pragma unroll 8
        for (int i = 0; i < 32; ++i) { const int kk = 2 * i + (lane >> 5); scr[kk * 33 + (lane & 31)] = W[(size_t)(k0 + kk) * N + n0 + (lane & 31)]; }
        LDS_WAIT();
        const int c = lane & 7;
#pragma unroll
        for (int j = 0; j < 4; ++j) { const int nn = (lane >> 3) + 8 * j; const PG8_LAS float* sp = scr + (8 * c) * 33 + nn;
            uint4 o; o.x = pk2bf(sp[0 * 33], sp[1 * 33]); o.y = pk2bf(sp[2 * 33], sp[3 * 33]); o.z = pk2bf(sp[4 * 33], sp[5 * 33]); o.w = pk2bf(sp[6 * 33], sp[7 * 33]);
            *(uint4*)(WT + ((size_t)(n0 + nn) * rs + ro) * K + k0 + 8 * c) = o; }
        LDS_WAIT();
    } };

template <int MT, int NT, int KS, class PA, class PB>
__device__ __forceinline__ void wave_mma(PA A, int lda, PB Bt, int ldb, pg8::f32x4 (&acc)[MT][NT], int lane) {
    const int r = lane & 15, q = lane >> 4;
#pragma unroll
    for (int ks = 0; ks < KS; ++ks) { pg8::bf16x8 a[MT], b[NT];
#pragma unroll
        for (int m = 0; m < MT; ++m) a[m] = *(const pg8::bf16x8*)(A + (size_t)(m * 16 + r) * lda + ks * 32 + q * 8);
#pragma unroll
        for (int n = 0; n < NT; ++n) b[n] = *(const pg8::bf16x8*)(Bt + (size_t)(n * 16 + r) * ldb + ks * 32 + q * 8);
#pragma unroll
        for (int m = 0; m < MT; ++m)
#pragma unroll
            for (int n = 0; n < NT; ++n) acc[m][n] = __builtin_amdgcn_mfma_f32_16x16x32_bf16(a[m], b[n], acc[m][n], 0, 0, 0); }
}
template <int MTC, int NT> __device__ __forceinline__ void states_chunk(const bf16* A, const bf16* Bt, bf16* out, int ldo, int lane) {
    pg8::f32x4 acc[MTC][NT]; const int r = lane & 15, q = lane >> 4;
#pragma unroll
    for (int m = 0; m < MTC; ++m)
#pragma unroll
        for (int nn = 0; nn < NT; ++nn) acc[m][nn] = (pg8::f32x4){0.f, 0.f, 0.f, 0.f};
    wave_mma<MTC, NT, 2>(A, 64, Bt, 64, acc, lane);
#pragma unroll
    for (int m = 0; m < MTC; ++m)
#pragma unroll
        for (int nn = 0; nn < NT; ++nn)
#pragma unroll
            for (int e = 0; e < 4; ++e) out[(size_t)(m * 16 + q * 4 + e) * ldo + nn * 16 + r] = f2bf(acc[m][nn][e]);
}
template <int DKP, int NV> struct StatesW { int n; int pad; bf16* lab;
    __device__ __forceinline__ void wave(int it, int lane, PG8_LAS unsigned char*) const { typedef LaLay<DKP, NV> L; const int d = it / (int)LA_NI; const size_t item = (size_t)(it % (int)LA_NI);
        const bf16* A = lab + L::vT + item * NV * 64; const bf16* Bt = lab + L::koutT + ((size_t)d * LA_NI + item) * DKP * 64; bf16* out = lab + L::sT + ((size_t)d * LA_NI + item) * NV * DKP;
        constexpr int NT = DKP / 16, MT = NV / 16, M1 = MT > 4 ? (MT + 1) / 2 : MT, M2 = MT - M1;
        states_chunk<M1, NT>(A, Bt, out, DKP, lane);
        if constexpr (M2 > 0) states_chunk<M2, NT>(A + (size_t)M1 * 16 * 64, Bt, out + (size_t)M1 * 16 * DKP, DKP, lane); } };
template <int DKP, int NV, bool ISML> struct OutW { int n; int pad; const bf16* lab; const bf16* p; const float* gain; bf16* mix;
    __device__ __forceinline__ void wave(int it, int lane, PG8_LAS unsigned char* lw) const { typedef LaLay<DKP, NV> L; constexpr int NT = NV / 16, KQ = DKP / 32;
        const size_t item = (size_t)(it >> 1); const int half = it & 1, hh = (int)(item % 4); const size_t bb = item / 4; const size_t r0 = (bb / NBLK) * RPB + (bb % NBLK) * 64; const int t0 = half * 32;
        const int r = lane & 15, q = lane >> 4; PG8_LAS bf16* latt = (PG8_LAS bf16*)lw;
        pg8::f32x4 acc[2][NT], hs[2][6];
#pragma unroll
        for (int m = 0; m < 2; ++m) {
#pragma unroll
            for (int nn = 0; nn < NT; ++nn) acc[m][nn] = (pg8::f32x4){0.f, 0.f, 0.f, 0.f};
#pragma unroll
            for (int nn = 0; nn < 6; ++nn) hs[m][nn] = (pg8::f32x4){0.f, 0.f, 0.f, 0.f}; }
#pragma unroll
        for (int d = 0; d < 2; ++d) {
            const bf16* qa = lab + L::qin + (((size_t)d * NR + r0 + t0) * 4 + hh) * DKP; const bf16* kb = lab + L::kin + (((size_t)d * NR + r0) * 4 + hh) * DKP;
            pg8::f32x4 at[2][4];
#pragma unroll
            for (int m = 0; m < 2; ++m)
#pragma unroll
                for (int nn = 0; nn < 4; ++nn) at[m][nn] = (pg8::f32x4){0.f, 0.f, 0.f, 0.f};
            wave_mma<2, 4, KQ>(qa, 4 * DKP, kb, 4 * DKP, at, lane);
#pragma unroll
            for (int m = 0; m < 2; ++m)
#pragma unroll
                for (int nn = 0; nn < 4; ++nn)
#pragma unroll
                    for (int e = 0; e < 4; ++e) { const int tl = m * 16 + q * 4 + e, tt = t0 + tl, sx = nn * 16 + r; const bool valid = d == 0 ? (sx <= tt) : (sx >= tt);
                        latt[tl * 72 + sx] = f2bf(valid ? at[m][nn][e] : 0.f); }
            LDS_WAIT();
            wave_mma<2, NT, 2>((const PG8_LAS bf16*)latt, 72, lab + L::vT + item * NV * 64, 64, acc, lane);
            wave_mma<2, NT, KQ>(qa, 4 * DKP, lab + L::sT + ((size_t)d * LA_NI + item) * NV * DKP, DKP, acc, lane);
            LDS_WAIT();
            if (ISML) {
#pragma unroll
                for (int m = 0; m < 2; ++m)
#pragma unroll
                    for (int e = 0; e < 4; ++e) { const float den = __shfl(acc[m][NT - 1][e], lane & 48); const float inv = 1.0f / fmaxf(fabsf(den), 1.0f);
#pragma unroll
                        for (int nn = 0; nn < 6; ++nn) { hs[m][nn][e] += acc[m][nn][e] * inv; acc[m][nn][e] = 0.f; }
                        acc[m][NT - 1][e] = 0.f; } } }
#pragma unroll
        for (int m = 0; m < 2; ++m)
#pragma unroll
            for (int e = 0; e < 4; ++e) { float ss = 0.f;
#pragma unroll
                for (int nn = 0; nn < 6; ++nn) { const float o = ISML ? hs[m][nn][e] : acc[m][nn][e]; ss += o * o; }
                ss += __shfl_xor(ss, 1); ss += __shfl_xor(ss, 2); ss += __shfl_xor(ss, 4); ss += __shfl_xor(ss, 8);
                const float rstd = 1.0f / sqrtf(ss * (1.0f / 96.0f) + EPS); const size_t row = r0 + t0 + m * 16 + q * 4 + e;
#pragma unroll
                for (int nn = 0; nn < 6; ++nn) { const int j = nn * 16 + r; const float o = ISML ? hs[m][nn][e] : acc[m][nn][e]; const float gv = bf2f(p[row * PS + (ISML ? MO : GG) + hh * 96 + j]);
                    const float gt = ISML ? sigmoidf_(gv) : siluf(gv); mix[row * D + (ISML ? 640 : 0) + hh * 96 + j] = f2bf(o * rstd * gain[j] * gt); } } } };

#ifdef MULTI_LAUNCH
template <class F> __global__ void __launch_bounds__(256) k_run(F f) {
    for (long i = (long)blockIdx.x * blockDim.x + threadIdx.x; i < f.n; i += (long)gridDim.x * blockDim.x) f(i);
}
template <class F> __global__ void __launch_bounds__(512, 2) k_wrun(F f) {
    extern __shared__ __attribute__((aligned(16))) unsigned char shm[];
    const int wid = threadIdx.x >> 6, lane = threadIdx.x & 63;
    for (int it = blockIdx.x * 8 + wid; it < f.n; it += gridDim.x * 8) f.wave(it, lane, (PG8_LAS unsigned char*)shm + wid * 16384);
}
template <class F> __global__ void __launch_bounds__(512, 2) k_gemm(GemmDesc g, F e) {
    extern __shared__ __attribute__((aligned(16))) unsigned char shm[];
    pg8::gemm_phase<F>((PG8_LAS unsigned char*)shm, g, e, (int)gridDim.x, (int)blockIdx.x);
}
struct Ctx { hipStream_t stream; int ncu; const void* const* tbl;
    template <int I> const float* inp() const { return (const float*)tbl[I]; }
    template <class F> void run(const F& f, bool sync = true) {
        if (f.n <= 0) return; long nb = (f.n + 255) / 256; if (nb > 256L * 32) nb = 256L * 32;
        hipLaunchKernelGGL(k_run<F>, dim3((unsigned)nb), dim3(256), 0, stream, f); }
    template <class F> void wrun(const F& f, bool sync = true) {
        static bool attr_set = false;
        if (!attr_set) { (void)hipFuncSetAttribute((const void*)k_wrun<F>, hipFuncAttributeMaxDynamicSharedMemorySize, pg8::STAGE_BYTES); attr_set = true; }
        hipLaunchKernelGGL(k_wrun<F>, dim3(ncu), dim3(512), pg8::STAGE_BYTES, stream, f); }
    template <class F> void gemm(const GemmDesc& g, const F& e) {
        static bool attr_set = false;
        if (!attr_set) { (void)hipFuncSetAttribute((const void*)k_gemm<F>, hipFuncAttributeMaxDynamicSharedMemorySize, pg8::STAGE_BYTES); attr_set = true; }
        hipLaunchKernelGGL(k_gemm<F>, dim3(ncu), dim3(512), pg8::STAGE_BYTES, stream, g, e); }
};
#else
struct Ctx { XcdBarrier bar; PG8_LAS unsigned char* lds; long gtid, nthr;
    template <int I> __device__ __forceinline__ const float* inp() const { unsigned off = pg8::STAGE_BYTES + 64 + 8 * I; asm volatile("" : "+v"(off));
        const PG8_LAS unsigned* t = (const PG8_LAS unsigned*)(lds + off);
        const unsigned lo = __builtin_amdgcn_readfirstlane(t[0]), hi = __builtin_amdgcn_readfirstlane(t[1]); return (const float*)(((unsigned long long)hi << 32) | lo); }
    template <class F> __device__ __forceinline__ void run(const F& f, bool sync = true) {
        int i0 = (int)gtid; asm volatile("" : "+v"(i0));
        const int n = (int)f.n, st = (int)nthr;
        for (int i = i0; i < n; i += st) f((long)i);
        if (sync) xcd_barrier(bar); }
    template <class F> __device__ __forceinline__ void wrun(const F& f, bool sync = true) {
        int t0 = threadIdx.x; asm volatile("" : "+v"(t0));
        const int wid = __builtin_amdgcn_readfirstlane(t0 >> 6), lane = t0 & 63; const int nw = (int)gridDim.x * 8;
        for (int it = (int)blockIdx.x * 8 + wid; it < f.n; it += nw) { int ln = lane; asm volatile("" : "+v"(ln));
            f.wave(it, ln, lds + wid * 16384); }
        if (sync) xcd_barrier(bar); }
    template <class F> __device__ __forceinline__ void gemm(const GemmDesc& g, const F& e) {
        pg8::gemm_phase<F>(lds, g, e, (int)gridDim.x, (int)blockIdx.x);
        xcd_barrier(bar); }
};
#endif
#else
struct Ctx { const void* const* tbl;
template <int I> const float* inp() const { return (const float*)tbl[I]; }
template <class F> void run(const F& f, bool sync = true) {
#pragma omp parallel for schedule(static)
    for (long i = 0; i < f.n; ++i) f(i);
}
template <class F> void gemm(const GemmDesc& g, const F& e) {
    int M = g.M; if (g.ntile) { int nt = g.ntile[0] - g.tile0; if (nt < 0) nt = 0; if (nt * 256 < M) M = nt * 256; }
#pragma omp parallel for schedule(dynamic, 4)
    for (int r = 0; r < M; ++r) {
        const bf16* a = g.A + (size_t)r * g.lda; const bf16* B = g.Bt + (g.tile_e ? (size_t)g.tile_e[g.tile0 + r / 256] * g.e_stride : (g.tdiv ? (size_t)((r / 256) / g.tdiv) * g.e_stride : 0));
        static thread_local float af[4096]; for (int k = 0; k < g.K; ++k) af[k] = bf2f(a[k]);
        for (int c0 = 0; c0 < g.N; c0 += 8) { float v[8];
            for (int j = 0; j < 8; ++j) { const bf16* bt = B + (size_t)(c0 + j) * g.ldb; float s = 0.f; for (int k = 0; k < g.K; ++k) s += af[k] * bf2f(bt[k]); v[j] = s; }
            e.apply8(r, c0, v); }
    }
}
};
#endif

struct Inputs { const float *x, *c, *ctx, *c_ctx, *w_ada, *b_ada, *norm1, *norm2, *w_in, *w_out, *gla_wa2, *gla_ba, *gla_norm, *s5_lam_re, *s5_lam_im, *s5_log_dt, *s5_b_re, *s5_b_im,
    *s5_c_re, *s5_c_im, *s5_d, *s5_glu_w, *s5_glu_b, *ml_conv_w, *ml_conv_b, *ml_gate_b, *ml_norm, *ffn_w1, *ffn_w3, *ffn_w2, *moe_router, *moe_w1, *moe_w3, *moe_w2, *norm_f; };

#define INP(name) (cx.template inp<offsetof(Inputs, name) / 8>())
#define WSB ((unsigned char*)cx.template inp<36>())
#define out ((float*)cx.template inp<35>())
#define mod ((float*)(WSB + WS.mod))
#define h ((float*)(WSB + WS.h))
#define abuf ((bf16*)(WSB + WS.abuf))
#define winT ((bf16*)(WSB + WS.winT))
#define woutT ((bf16*)(WSB + WS.woutT))
#define w13T ((bf16*)(WSB + WS.w13T))
#define w2T ((bf16*)(WSB + WS.w2T))
#define pbuf ((bf16*)(WSB + WS.pbuf))
#define obuf ((float*)(WSB + WS.obuf))
#define lab ((bf16*)(WSB + WS.lab))
#define qkc ((bf16*)(WSB + WS.qkc))
#define mlF ((float*)(WSB + WS.mlF))
#define mlI ((float*)(WSB + WS.mlI))
#define s5disc ((float*)(WSB + WS.s5disc))
#define s5K ((float*)(WSB + WS.s5K))
#define s5TB ((bf16*)(WSB + WS.s5TB))
#define s5EB ((bf16*)(WSB + WS.s5EB))
#define s5uG ((bf16*)(WSB + WS.s5uG))
#define s5est ((float*)(WSB + WS.s5est))
#define zbuf ((bf16*)(WSB + WS.zbuf))
#define gluT ((bf16*)(WSB + WS.gluT))
#define act ((bf16*)(WSB + WS.act))
#define mw13T ((bf16*)(WSB + WS.mw13T))
#define mw2T ((bf16*)(WSB + WS.mw2T))
#define xs ((bf16*)(WSB + WS.xs))
#define mact ((bf16*)(WSB + WS.mact))
#define yrow ((bf16*)(WSB + WS.yrow))
#define rt_e ((int*)(WSB + WS.rt_e))
#define rt_w ((float*)(WSB + WS.rt_w))
#define rt_dest ((int*)(WSB + WS.rt_dest))
#define segcnt ((int*)(WSB + WS.segcnt))
#define ecnt ((int*)(WSB + WS.ecnt))
#define row_token ((int*)(WSB + WS.row_token))
#define tile_e ((int*)(WSB + WS.tile_e))
#define ntile ((int*)(WSB + WS.ntile))
#define modl (mod + (size_t)l * NMOD * 6 * D)
#define silc ((float*)(WSB + WS.silc))
#define modpart ((float*)(WSB + WS.uni))
template <int l, class X> HD void layer_fwd(X& cx) {
    constexpr bool last = (l == DEPTH - 1);
#ifdef HOST_EMU
        cx.run(NormModK{(long)NR, h, INP(norm1) + (size_t)l * D, modl, 0, D, abuf, nullptr, nullptr, nullptr, 0});
#else
        cx.wrun(NormModW{NR, 0, D, 0, h, INP(norm1) + (size_t)l * D, modl, abuf, nullptr, nullptr, nullptr});
#endif
        cx.gemm(GemmDesc{abuf, winT + (size_t)l * PS * D, nullptr, nullptr, 0, NR, PS, D, 0, D, D, 0, 0}, EpiStoreBf16{pbuf, PS, 0});
        { typedef LaLay<64, 96> LG; float* la2 = (float*)(lab + LG::sT);
        cx.run(GlaLa{(long)NR * 192, pbuf, INP(gla_wa2) + (size_t)l * 2 * 16 * 192, INP(gla_ba) + (size_t)l * 2 * 192, la2, 0}, false);
        cx.run(GlaLa{(long)NR * 192, pbuf, INP(gla_wa2) + (size_t)l * 2 * 16 * 192, INP(gla_ba) + (size_t)l * 2 * 192, la2 + (size_t)NR * 192, 1}, false);
        cx.run(GlaVT{(long)LA_NI * 96 * 64, pbuf, lab + LG::vT});
        cx.run(GlaCum{(long)NB * NBLK * 192, la2, 0}, false);
        cx.run(GlaCum{(long)NB * NBLK * 192, la2 + (size_t)NR * 192, 1});
        cx.run(GlaPrep{(long)2 * NR * 4 * 64, pbuf, la2, lab});
#ifdef HOST_EMU
        cx.run(StatesRef<64, 96>{(long)2 * LA_NI * 96 * 64, lab});
#else
        cx.wrun(StatesW<64, 96>{2 * (int)LA_NI, 0, lab});
#endif
        cx.run(CarryT<64, 96>{(long)2 * NB * 4 * 96 * 64, lab});
#ifdef HOST_EMU
        cx.run(OutRef<64, 96, false>{(long)NR * 384, lab, obuf});
        cx.run(HeadFin{(long)NR * 4, pbuf, obuf, INP(gla_norm) + (size_t)l * 96, abuf, 0});
#else
        cx.wrun(OutW<64, 96, false>{2 * (int)LA_NI, 0, lab, pbuf, INP(gla_norm) + (size_t)l * 96, abuf});
#endif
        }
        { typedef LaLay<96, 112> LM;
        cx.run(MlConv{(long)NR * 768, pbuf, INP(ml_conv_w) + (size_t)l * 3 * 768, INP(ml_conv_b) + (size_t)l * 768, qkc}, false);
        cx.run(MlVT{(long)LA_NI * 112 * 64, pbuf, lab + LM::vT}, false);
        cx.run(MlGates{(long)2 * NB * NBLK * 4, pbuf, INP(ml_gate_b) + (size_t)l * 16, mlF, mlI});
        cx.run(MlPrep{(long)2 * NR * 4 * 96, qkc, mlF, mlI, lab});
#ifdef HOST_EMU
        cx.run(StatesRef<96, 112>{(long)2 * LA_NI * 112 * 96, lab});
#else
        cx.wrun(StatesW<96, 112>{2 * (int)LA_NI, 0, lab});
#endif
        cx.run(CarryT<96, 112>{(long)2 * NB * 4 * 112 * 96, lab});
#ifdef HOST_EMU
        cx.run(OutRef<96, 112, true>{(long)NR * 384, lab, obuf});
        cx.run(HeadFin{(long)NR * 4, pbuf, obuf, INP(ml_norm) + (size_t)l * 96, abuf, 1});
#else
        cx.wrun(OutW<96, 112, true>{2 * (int)LA_NI, 0, lab, pbuf, INP(ml_norm) + (size_t)l * 96, abuf});
#endif
        }
        cx.run(S5Disc{(long)2 * 16 * 64, INP(s5_lam_re) + (size_t)l * 2048, INP(s5_lam_im) + (size_t)l * 2048, INP(s5_log_dt) + (size_t)l * 32, s5disc}, false);
        cx.run(TransposeK{(long)256 * 256, INP(s5_glu_w) + (size_t)l * 65536, nullptr, gluT, 256, 256, 256}, false);
        cx.run(S5BuildU{(long)16 * S5RB * 1024, pbuf, s5uG});
        cx.run(S5K2{(long)2 * 16 * 64 * 256, s5disc, INP(s5_b_re) + (size_t)l * 16384, INP(s5_b_im) + (size_t)l * 16384, INP(s5_c_re) + (size_t)l * 16384, INP(s5_c_im) + (size_t)l * 16384, s5K}, false);
        cx.run(S5BuildEB{(long)16 * 256 * 1024, s5disc, INP(s5_b_re) + (size_t)l * 16384, INP(s5_b_im) + (size_t)l * 16384, s5EB});
        cx.run(S5BuildTB{(long)16 * 1024 * S5K_, s5disc, INP(s5_c_re) + (size_t)l * 16384, INP(s5_c_im) + (size_t)l * 16384, s5K, s5TB}, false);
        cx.gemm(GemmDesc{s5uG, s5EB, nullptr, nullptr, (size_t)256 * 1024, 16 * S5RG, 256, 1024, 0, S5K_, 1024, S5RG / 256, 0}, EpiStoreF32{s5est, 256, 0});
        cx.run(S5Carry2{(long)NB * 16 * 2 * 64, s5disc, s5est, s5uG});
        cx.gemm(GemmDesc{s5uG, s5TB, nullptr, nullptr, (size_t)1024 * S5K_, 16 * S5RG, 1024, S5K_, 0, S5K_, S5K_, S5RG / 256, 0}, EpiS5Z{pbuf, INP(s5_d) + (size_t)l * 256, zbuf});
        cx.gemm(mk_gemm(zbuf, 256, gluT, 256, NR, 256, 256), EpiGlu{zbuf, INP(s5_glu_b) + (size_t)l * 256, abuf});
        cx.gemm(GemmDesc{abuf, woutT + (size_t)l * D * D, nullptr, nullptr, 0, NR, D, D, 0, D, D, 0, 0}, EpiResid{h, modl, 2 * D});
        if constexpr (l % 2 == 0) { constexpr int j = l / 2;
#ifdef HOST_EMU
            cx.run(NormModK{(long)NR, h, INP(norm2) + (size_t)l * D, modl, 3 * D, 4 * D, abuf, nullptr, nullptr, nullptr, 0});
#else
            cx.wrun(NormModW{NR, 3 * D, 4 * D, 0, h, INP(norm2) + (size_t)l * D, modl, abuf, nullptr, nullptr, nullptr});
#endif
            cx.gemm(GemmDesc{abuf, w13T + (size_t)j * 2 * DFF * D, nullptr, nullptr, 0, NR, 2 * DFF, D, 0, D, D, 0, 0}, EpiSwiGLU{act, DFF, 0});
            cx.gemm(GemmDesc{act, w2T + (size_t)j * D * DFF, nullptr, nullptr, 0, NR, D, DFF, 0, DFF, DFF, 0, 0}, EpiResid{h, modl, 5 * D});
        } else { constexpr int j = l / 2; const int nseg = (NR + 63) / 64;
#ifdef HOST_EMU
            for (int e = 0; e < NE; ++e) { const size_t wo = ((size_t)j * NE + e) * D * DFF;
                cx.run(TransposeK{(long)2 * DFF * D, INP(moe_w1) + wo, INP(moe_w3) + wo, mw13T + (size_t)e * 2 * DFF * D, D, DFF, 2 * DFF});
                cx.run(TransposeK{(long)D * DFF, INP(moe_w2) + wo, nullptr, mw2T + (size_t)e * D * DFF, DFF, D, D}); }
#else
            cx.wrun(TransW{NE * (D / 64) * (DFF / 32), D, DFF, 2, 0, 0, INP(moe_w1) + (size_t)j * NE * D * DFF, mw13T, (size_t)D * DFF, (size_t)2 * DFF * D}, false);
            cx.wrun(TransW{NE * (D / 64) * (DFF / 32), D, DFF, 2, 1, 0, INP(moe_w3) + (size_t)j * NE * D * DFF, mw13T, (size_t)D * DFF, (size_t)2 * DFF * D}, false);
            cx.wrun(TransW{NE * (DFF / 64) * (D / 32), DFF, D, 1, 0, 0, INP(moe_w2) + (size_t)j * NE * DFF * D, mw2T, (size_t)DFF * D, (size_t)D * DFF}, false);
#endif
#ifdef HOST_EMU
            cx.run(NormModK{(long)NR, h, INP(norm2) + (size_t)l * D, modl, 3 * D, 4 * D, abuf, INP(moe_router) + (size_t)j * D * NE, rt_e, rt_w, last ? 1 : 0});
#else
            cx.wrun(NormModW{NR, 3 * D, 4 * D, last ? 1 : 0, h, INP(norm2) + (size_t)l * D, modl, abuf, INP(moe_router) + (size_t)j * D * NE, rt_e, rt_w});
#endif
            cx.run(MoeSegCount{(long)NE * nseg, rt_e, segcnt, nseg});
            cx.run(MoePrefix{(long)NE, segcnt, ecnt, nseg});
            cx.run(MoeFillNeg{(long)MOE_MAXT * 256, row_token});
            cx.run(MoeTiles{1, ecnt, tile_e, ntile, row_token});
            cx.run(MoeAssign{(long)NE * nseg, rt_e, segcnt, ecnt, rt_dest, row_token, nseg});
            for (int t0 = 0; t0 < MOE_MAXT; t0 += MOE_PASS_T) { const int nt = (MOE_MAXT - t0 < MOE_PASS_T) ? MOE_MAXT - t0 : MOE_PASS_T;
                cx.run(MoeGather{(long)nt * 256 * (D / 8), abuf, row_token, xs, t0 * 256});
                cx.gemm(GemmDesc{xs, mw13T, tile_e, ntile, (size_t)2 * DFF * D, nt * 256, 2 * DFF, D, t0, D, D, 0, 0}, EpiSwiGLU{mact, DFF, 0});
                cx.gemm(GemmDesc{mact, mw2T, tile_e, ntile, (size_t)D * DFF, nt * 256, D, DFF, t0, DFF, DFF, 0, 0}, EpiStoreBf16{yrow + (size_t)t0 * 256 * D, D, 0}); }
            cx.run(MoeCombine{(long)NR * D, h, yrow, rt_e, rt_w, rt_dest, modl, 5 * D});
        }
    }
template <class X> HD void forward(X& cx) {
    cx.run(InitH{(long)NR * D, INP(x), INP(ctx), h}, false);
    cx.run(SiluC{(long)NMOD * D, INP(c), INP(c_ctx), silc}, false);
#ifdef HOST_EMU
    for (int l = 0; l < DEPTH; ++l) {
        cx.run(TransposeK{(long)PS * D, INP(w_in) + (size_t)l * D * DPROJ, nullptr, winT + (size_t)l * PS * D, D, DPROJ, PS});
        cx.run(TransposeK{(long)D * D, INP(w_out) + (size_t)l * D * D, nullptr, woutT + (size_t)l * D * D, D, D, D});
        if (l % 2 == 0) { const int j = l / 2;
            cx.run(TransposeK{(long)2 * DFF * D, INP(ffn_w1) + (size_t)j * D * DFF, INP(ffn_w3) + (size_t)j * D * DFF, w13T + (size_t)j * 2 * DFF * D, D, DFF, 2 * DFF});
            cx.run(TransposeK{(long)D * DFF, INP(ffn_w2) + (size_t)j * DFF * D, nullptr, w2T + (size_t)j * D * DFF, DFF, D, D}); }
    }
#else
    cx.wrun(TransW{DEPTH * (D / 64) * (DPROJ / 32), D, DPROJ, 1, 0, 0, INP(w_in), winT, (size_t)D * DPROJ, (size_t)PS * D}, false);
    for (int l = 0; l < DEPTH; ++l) cx.run(ZeroBf16{(long)(PS - DPROJ) * D, winT + ((size_t)l * PS + DPROJ) * D}, false);
    cx.wrun(TransW{DEPTH * (D / 64) * (D / 32), D, D, 1, 0, 0, INP(w_out), woutT, (size_t)D * D, (size_t)D * D}, false);
    cx.wrun(TransW{((DEPTH + 1) / 2) * (D / 64) * (DFF / 32), D, DFF, 2, 0, 0, INP(ffn_w1), w13T, (size_t)D * DFF, (size_t)2 * DFF * D}, false);
    cx.wrun(TransW{((DEPTH + 1) / 2) * (D / 64) * (DFF / 32), D, DFF, 2, 1, 0, INP(ffn_w3), w13T, (size_t)D * DFF, (size_t)2 * DFF * D}, false);
    cx.wrun(TransW{((DEPTH + 1) / 2) * (DFF / 64) * (D / 32), DFF, D, 1, 0, 0, INP(ffn_w2), w2T, (size_t)DFF * D, (size_t)D * DFF}, true);
#endif
    cx.run(ModPart{(long)MODKC * DEPTH * 6 * D, silc, INP(w_ada), modpart});
    cx.run(ModReduce{(long)DEPTH * NMOD * 6 * D, modpart, INP(b_ada), mod});
    layer_fwd<0>(cx);
    if constexpr (DEPTH > 1) layer_fwd<1>(cx);
    if constexpr (DEPTH > 2) layer_fwd<2>(cx);
    if constexpr (DEPTH > 3) layer_fwd<3>(cx);
    static_assert(DEPTH <= 4, "unrolled for DEPTH <= 4");
#ifdef HOST_EMU
    cx.run(FinalNorm{(long)NB * SEQ, h, INP(norm_f), out});
#else
    cx.wrun(FinalNormW{NB * SEQ, 0, h, INP(norm_f), out});
#endif
}

#undef silc
#undef modpart
#undef mod
#undef h
#undef abuf
#undef winT
#undef woutT
#undef w13T
#undef w2T
#undef pbuf
#undef obuf
#undef lab
#undef qkc
#undef mlF
#undef mlI
#undef s5disc
#undef s5K
#undef s5TB
#undef s5EB
#undef s5uG
#undef s5est
#undef zbuf
#undef gluT
#undef act
#undef mw13T
#undef mw2T
#undef xs
#undef mact
#undef yrow
#undef rt_e
#undef rt_w
#undef rt_dest
#undef segcnt
#undef ecnt
#undef row_token
#undef tile_e
#undef ntile
#undef WSB
#undef out
#undef modl
#ifndef HOST_EMU
#ifndef MULTI_LAUNCH
constexpr int MEGA_LDS = pg8::STAGE_BYTES + 512;
struct MegaArgs { const void* p[37]; };
__global__ void __launch_bounds__(512, 2) mega_fwd(MegaArgs a) {
    extern __shared__ __attribute__((aligned(16))) unsigned char shm[];
    PG8_LAS unsigned char* lds = (PG8_LAS unsigned char*)shm;
    volatile LAS unsigned* xbw = (volatile LAS unsigned*)(lds + pg8::STAGE_BYTES);
    if (threadIdx.x < 4) xbw[threadIdx.x] = 0u;
    if (threadIdx.x < 37) ((PG8_LAS unsigned long long*)(lds + pg8::STAGE_BYTES + 64))[threadIdx.x] = (unsigned long long)a.p[threadIdx.x];
    __syncthreads();
    Ctx cx; cx.lds = lds;
    cx.bar = xcd_barrier_post((unsigned*)((unsigned char*)cx.inp<36>() + WS.ctl), xbw);
    cx.gtid = (long)blockIdx.x * blockDim.x + threadIdx.x; cx.nthr = (long)gridDim.x * blockDim.x;
    forward(cx);
}
#endif
extern "C" void kernel_launch(void* const* d_in, const int* in_sizes, int n_in, void* d_out, int out_size, void* d_ws, size_t ws_size, hipStream_t stream) {
    static int ncu = 0;
    if (ncu == 0) { int dev = 0; (void)hipGetDevice(&dev); (void)hipDeviceGetAttribute(&ncu, hipDeviceAttributeMultiprocessorCount, dev); if (ncu <= 0) ncu = 256;
#ifndef MULTI_LAUNCH
        if (hipFuncSetAttribute((const void*)mega_fwd, hipFuncAttributeMaxDynamicSharedMemorySize, MEGA_LDS) != hipSuccess) { fprintf(stderr, "kernel_launch: hipFuncSetAttribute failed\n"); }
#endif
    }
    if (n_in != 35 || ws_size < WS.end || out_size != NB * SEQ * D) { fprintf(stderr, "kernel_launch: unexpected sizes n_in %d ws %zu (need %zu) out %d\n", n_in, ws_size, (size_t)WS.end, out_size); return; }
#ifdef MULTI_LAUNCH
    const void* tbl[37]; for (int i = 0; i < 35; ++i) tbl[i] = d_in[i]; tbl[35] = d_out; tbl[36] = d_ws;
    Ctx cx{stream, ncu, tbl};
    forward(cx);
#else
    (void)hipMemsetAsync((unsigned char*)d_ws + WS.ctl, 0, 1 << 20, stream);
    MegaArgs a{}; for (int i = 0; i < 35; ++i) a.p[i] = d_in[i];
    a.p[35] = d_out; a.p[36] = d_ws;
    hipLaunchKernelGGL(mega_fwd, dim3(ncu), dim3(512), MEGA_LDS, stream, a);
#endif
}
#endif
```

```cpp
#ifndef HOST_EMU
#include <hip/hip_runtime.h>
#define HD __host__ __device__ __forceinline__
#define UNROLL _Pragma("unroll")
#else
#include <cmath>
#include <cstdio>
#include <cstdlib>
#include <cstring>
#include <cstdint>
#define HD inline
#define UNROLL
#endif
#include <math.h>
#include <stdint.h>
#include <stddef.h>
#include <stdio.h>

#ifndef CFG_NB
#define CFG_NB 8
#endif
#ifndef CFG_SEQ
#define CFG_SEQ 4096
#endif
#ifndef CFG_CTX
#define CFG_CTX 256
#endif
#ifndef CFG_DEPTH
#define CFG_DEPTH 4
#endif
constexpr int NB = CFG_NB, SEQ = CFG_SEQ, CTX = CFG_CTX, DEPTH = CFG_DEPTH;
constexpr int D = 1024, GRID_W = 64;
constexpr int RPB = CTX + SEQ;
constexpr int NR = NB * RPB;
constexpr int NBLK = RPB / 64, CB = CTX / 64;
constexpr int DPROJ = 2976, PS = 3072;
constexpr int GQ = 0, GK = 192, GV = 384, GLR = 768, GG = 784, SU = 1168, MQ = 1424, MK = 1808, MV = 2192, MO = 2576, MG = 2960;
constexpr int DFF = 2816, NE = 8;
constexpr int NMOD = NB + 1;
constexpr float EPS = 1e-6f;
constexpr int MOE_MAXT = (2 * NR + NE * 255) / 256 + 1;
#ifndef FP8_DOWN_DENSE
#define FP8_DOWN_DENSE 1
#endif
#ifndef FP8_DOWN_MOE
#define FP8_DOWN_MOE 1
#endif
constexpr int MOE_XT = MOE_MAXT;

typedef unsigned short bf16;
struct __attribute__((aligned(16))) U4 { uint32_t x, y, z, w; };
HD float bf2f(bf16 v) { uint32_t u = ((uint32_t)v) << 16; float f; memcpy(&f, &u, 4); return f; }
HD bf16 f2bf(float f) { uint32_t u; memcpy(&u, &f, 4); u += 0x7fffu + ((u >> 16) & 1u); return (bf16)(u >> 16); }
#if defined(HOST_EMU)
HD float siluf(float x) { return x / (1.0f + expf(-x)); }
HD float sigmoidf_(float x) { return 1.0f / (1.0f + expf(-x)); }
HD float logsigmoidf_(float x) { return x < 0.f ? x - log1pf(expf(x)) : -log1pf(expf(-x)); }
HD float fexp(float x) { return expf(x); }
#else
__host__ __device__ __forceinline__ float fexp(float x) { return __builtin_amdgcn_exp2f(x * 1.4426950408889634f); }
__host__ __device__ __forceinline__ float siluf(float x) { return x * __builtin_amdgcn_rcpf(1.0f + fexp(-x)); }
__host__ __device__ __forceinline__ float sigmoidf_(float x) { return __builtin_amdgcn_rcpf(1.0f + fexp(-x)); }
__host__ __device__ __forceinline__ float logsigmoidf_(float x) { return fminf(x, 0.f) - 0.6931471805599453f * __builtin_amdgcn_logf(1.0f + fexp(-fabsf(x))); }
#endif
HD float gelu_tanhf(float x) { return 0.5f * x * (1.0f + tanhf(0.7978845608028654f * (x + 0.044715f * x * x * x))); }
#ifndef HOST_EMU
typedef float f4_t __attribute__((ext_vector_type(4)));
__device__ __forceinline__ unsigned cvt_pk_bf16(float lo, float hi) { unsigned r; asm("v_cvt_pk_bf16_f32 %0, %1, %2" : "=v"(r) : "v"(lo), "v"(hi)); return r; }
__device__ __forceinline__ void store8_bf16(bf16* dst, const float* v) { uint4 w; w.x = cvt_pk_bf16(v[0], v[1]); w.y = cvt_pk_bf16(v[2], v[3]); w.z = cvt_pk_bf16(v[4], v[5]); w.w = cvt_pk_bf16(v[6], v[7]); *(uint4*)dst = w; }
__device__ __forceinline__ void load8_bf16(const bf16* src, float* v) { const uint4 w = *(const uint4*)src; const unsigned u[4] = {w.x, w.y, w.z, w.w};
#pragma unroll
    for (int i = 0; i < 4; ++i) { v[2 * i] = __uint_as_float(u[i] << 16); v[2 * i + 1] = __uint_as_float(u[i] & 0xffff0000u); } }
__device__ __forceinline__ float fast_silu(float x) { return x * __builtin_amdgcn_rcpf(1.0f + __expf(-x)); }
__device__ __forceinline__ float fast_sigmoid(float x) { return __builtin_amdgcn_rcpf(1.0f + __expf(-x)); }
#endif
HD int mod_index(int r) { const int b = r / RPB, t = r % RPB; return t < CTX ? NB : b; }
HD int chain_blk(int d, int step) { return d == 0 ? step : (step < CB ? CB - 1 - step : NBLK - 1 - (step - CB)); }
HD int blk_row(int b, int blk, int d, int pp) { return b * RPB + blk * 64 + (d == 0 ? pp : 63 - pp); }

constexpr size_t LA_NI = (size_t)NB * NBLK * 4;
HD size_t tile_off(int row, int col, int KT) { return ((size_t)((row >> 4) * KT + (col >> 5)) * 64 + (size_t)((((col & 31) >> 3) << 4) + (row & 15))) * 8 + (col & 7); }
template <int DKP, int NV> struct LaLay {
    static constexpr int KQ = DKP / 32;
    static constexpr size_t qin = 0;
    static constexpr size_t kin = qin + (size_t)2 * NR * 4 * DKP;
    static constexpr size_t koutT = kin + (size_t)2 * NR * 4 * DKP;
    static constexpr size_t vT = koutT + (size_t)2 * LA_NI * DKP * 64;
    static constexpr size_t sT = vT + LA_NI * NV * 64;
    static constexpr size_t dec = sT + (size_t)2 * LA_NI * NV * DKP;
    static constexpr size_t end = dec + (size_t)2 * 2 * LA_NI * DKP;
    HD static size_t q_at(int d, size_t item, int tok, int i) { return qin + ((size_t)d * LA_NI + item) * 64 * DKP + tile_off(tok, i, KQ); }
    HD static size_t k_at(int d, size_t item, int tok, int i) { return kin + ((size_t)d * LA_NI + item) * 64 * DKP + tile_off(tok, i, KQ); }
    HD static size_t kt_at(int d, size_t item, int i, int tok) { return koutT + ((size_t)d * LA_NI + item) * DKP * 64 + tile_off(i, tok, 2); }
    HD static size_t v_at(size_t item, int j, int tok) { return vT + item * NV * 64 + tile_off(j, tok, 2); }
    HD static size_t s_at(int d, size_t item, int j, int i) { return sT + ((size_t)d * LA_NI + item) * NV * DKP + tile_off(j, i, KQ); }
};
constexpr size_t al256(size_t x) { return (x + 255) & ~(size_t)255; }
struct WsMap {
    size_t ctl, mod, silc, postab, h, abuf, winT, woutT, w13T, w2T, uni, end_fixed;
    size_t pbuf, lab, labg, obuf, s5tab, s5uG, s5est, zbuf, end_mix;
    size_t act, end_ffn;
    size_t mw13T, mw2T, xs8, mact, yrow, rt_e, rt_w, rt_dest, segcnt, ecnt, row_token, tile_e, ntile, end_moe;
    size_t end;
};
constexpr WsMap make_map() {
    WsMap m{}; size_t o = 0;
    m.ctl = o; o += 1 << 20;
    m.mod = o; o += al256((size_t)DEPTH * NMOD * 6 * D * 4);
    m.silc = o; o += al256((size_t)NMOD * D * 4);
    m.postab = o; o += al256((size_t)2 * GRID_W * 512 * 4);
    m.h = o; o += al256((size_t)NR * D * 4);
    m.abuf = o;
    m.winT = o; o += al256((size_t)DEPTH * PS * D * 2);
    m.woutT = o; o += al256((size_t)DEPTH * D * D * 2);
    m.w13T = o; o += al256((size_t)((DEPTH + 1) / 2) * 2 * DFF * D * 2);
    m.w2T = o; o += al256((size_t)((DEPTH + 1) / 2) * D * DFF * 2);
    m.uni = o; m.end_fixed = o;
    o = m.uni;
    m.pbuf = o; o += al256((size_t)NR * PS * 2);
    m.lab = o;
    { size_t o2 = m.lab;
      m.s5uG = o2; o2 += al256((size_t)16 * ((NB * NBLK + 255) / 256 * 256) * 1280 * 2);
      m.s5est = o2; o2 += al256((size_t)16 * ((NB * NBLK + 255) / 256 * 256) * 256 * 4);
      m.zbuf = o2; o2 += al256((size_t)NR * 256 * 2);
      const size_t la_bytes = al256(LaLay<96, 112>::end * 2);
      o = m.lab + (la_bytes > o2 - m.lab ? la_bytes : o2 - m.lab); }
    m.labg = o; o += al256(LaLay<64, 96>::end * 2);
    m.obuf = o;
#ifdef HOST_EMU
    o += al256((size_t)NR * 384 * 4);
    m.s5tab = o; o += (size_t)64 << 20;
#endif
    m.end_mix = o;
    o = m.uni;
    m.act = o; o += al256((size_t)NR * DFF * 2);
    m.end_ffn = o;
    o = m.uni;
    m.mw13T = o; o += al256((size_t)NE * 2 * DFF * D);
#ifdef HOST_EMU
    o += al256((size_t)NE * 2 * DFF * D);
#endif
    m.mw2T = o; o += al256((size_t)NE * D * DFF * 2);
    m.xs8 = o; o += al256((size_t)MOE_XT * 256 * D);
#if FP8_DOWN_MOE && !defined(HOST_EMU)
    m.mact = o; o += al256((size_t)MOE_MAXT * 256 * DFF);
#else
    m.mact = o; o += al256((size_t)MOE_MAXT * 256 * DFF * 2);
#endif
    m.yrow = o; o += al256((size_t)MOE_MAXT * 256 * D * 2);
    m.rt_e = o; o += al256((size_t)NR * 2 * 4);
    m.rt_w = o; o += al256((size_t)NR * 2 * 4);
    m.rt_dest = o; o += al256((size_t)NR * 2 * 4);
    m.segcnt = o; o += al256((size_t)NE * (NR / 64 + 1) * 4);
    m.ecnt = o; o += al256((size_t)64 * 4);
    m.row_token = o; o += al256((size_t)MOE_MAXT * 256 * 4);
    m.tile_e = o; o += al256((size_t)MOE_MAXT * 4);
    m.ntile = o; o += 256;
    m.end_moe = o;
    m.end = m.end_mix > m.end_moe ? m.end_mix : m.end_moe; if (m.end_ffn > m.end) m.end = m.end_ffn;
    return m;
}
constexpr WsMap WS = make_map();
struct S5Tab { size_t disc, K, apow, bbar, TB, EB, gluT, end; };
constexpr S5Tab make_s5tab() { S5Tab t{}; size_t o = 0;
    t.disc = o; o += al256((size_t)2 * 16 * 64 * 4 * 4); t.K = o; o += al256((size_t)2 * 16 * 64 * 256 * 4); t.apow = o; o += al256((size_t)2 * 16 * 65 * 64 * 2 * 4); t.bbar = o; o += al256((size_t)2 * 16 * 64 * 16 * 2 * 4);
    t.TB = o; o += al256((size_t)16 * 1024 * 1280 * 2); t.EB = o; o += al256((size_t)16 * 256 * 1024 * 2); t.gluT = o; o += al256((size_t)256 * 256 * 2); t.end = o; return t; }
constexpr S5Tab S5T = make_s5tab();
constexpr size_t ABUF_BYTES = al256((size_t)NR * D * 2);
#ifndef HOST_EMU
static_assert(ABUF_BYTES + S5T.end <= (size_t)NB * SEQ * D * 4, "the bf16 row buffer and the S5 tables must fit in d_out");
#endif

struct PosTab { long n; float* tab;
    HD void operator()(long i) const { const int cc = (int)(i % 512); const int pos = (int)((i / 512) % GRID_W); const int j = cc & 255; const float omega = expf(-9.210340371976184f * (float)j / 256.0f); const float ang = (float)pos * omega;
        tab[i] = (cc & 256) ? cosf(ang) : sinf(ang); } };
struct __attribute__((aligned(16))) F4 { float x, y, z, w; };
struct InitH { long n; const float* x; const float* ctx; const float* tab; float* h;
    HD void operator()(long i) const { const int r = (int)(i / (D / 4)), c = (int)(i % (D / 4)) * 4; const int b = r / RPB, t = r % RPB; F4 v;
        if (t < CTX) v = *(const F4*)(ctx + ((size_t)b * CTX + t) * D + c);
        else { const int tl = t - CTX, row = tl / GRID_W, col = tl % GRID_W; const F4 xv = *(const F4*)(x + ((size_t)b * SEQ + tl) * D + c);
            const F4 pe = *(const F4*)(tab + (c < 512 ? (size_t)row * 512 + c : (size_t)(GRID_W + col) * 512 + (c - 512))); v.x = xv.x + pe.x; v.y = xv.y + pe.y; v.z = xv.z + pe.z; v.w = xv.w + pe.w; }
        *(F4*)(h + (size_t)r * D + c) = v; } };
struct ModK { long n; const float* c; const float* cctx; const float* w_ada; const float* b_ada; float* mod;
    HD void operator()(long i) const { const int l = (int)(i / (6 * D)), j = (int)(i % (6 * D));
        float acc[NMOD];
        for (int m = 0; m < NMOD; ++m) acc[m] = b_ada[(size_t)l * 6 * D + j];
        const float* w = w_ada + (size_t)l * D * 6 * D + j;
        for (int k = 0; k < D; ++k) { const float wv = w[(size_t)k * 6 * D];
            for (int m = 0; m < NMOD; ++m) { const float cv = (m < NB) ? c[m * D + k] : cctx[k]; acc[m] += siluf(cv) * wv; } }
        for (int m = 0; m < NMOD; ++m) mod[((size_t)l * NMOD + m) * 6 * D + j] = acc[m]; } };
struct TransposeK { long n; const float* a; const float* b; bf16* dst; int K, N, NP, pad;
    HD void operator()(long i) const { const int nn = (int)(i / K), k = (int)(i % K);
        float v = 0.f;
        if (b) { const int j = nn >> 1; v = (nn & 1) ? b[(size_t)k * N + j] : a[(size_t)k * N + j]; }
        else if (nn < N) v = a[(size_t)k * N + nn];
        dst[i] = f2bf(v); } };
struct NormModK { long n; const float* h; const float* g; const float* mod; int sh_off, sc_off; bf16* out; const float* wr; int* rt_e; float* rt_w; int skip_ctx, nseg; int* segcnt;
    HD void operator()(long r) const { const float* hr = h + (size_t)r * D; float ss = 0.f;
        for (int k = 0; k < D; ++k) ss += hr[k] * hr[k];
        const float rstd = 1.0f / sqrtf(ss / D + EPS); const float* m = mod + (size_t)mod_index((int)r) * 6 * D;
        float lg[NE]; for (int e = 0; e < NE; ++e) lg[e] = 0.f;
        for (int k = 0; k < D; ++k) { const float v = hr[k] * rstd * g[k] * (1.0f + m[sc_off + k]) + m[sh_off + k]; out[(size_t)r * D + k] = f2bf(v);
            if (wr) for (int e = 0; e < NE; ++e) lg[e] += v * wr[k * NE + e]; }
        if (wr) { int e0 = 0; float b0 = lg[0]; for (int e = 1; e < NE; ++e) if (lg[e] > b0) { b0 = lg[e]; e0 = e; }
            int e1 = -1; float b1 = -3.0e38f; for (int e = 0; e < NE; ++e) if (e != e0 && lg[e] > b1) { b1 = lg[e]; e1 = e; }
            const float w1 = 1.0f / (1.0f + expf(b1 - b0));
            const bool skip = skip_ctx && ((int)(r % RPB) < CTX);
            rt_e[2 * r] = skip ? -1 : e0; rt_e[2 * r + 1] = skip ? -1 : e1; rt_w[2 * r] = w1; rt_w[2 * r + 1] = 1.0f - w1;
            if (!skip) { __atomic_fetch_add(&segcnt[(size_t)e0 * nseg + r / 64], 1, __ATOMIC_RELAXED); __atomic_fetch_add(&segcnt[(size_t)e1 * nseg + r / 64], 1, __ATOMIC_RELAXED); } } } };

struct SiluC { long n; const float* c; const float* cctx; float* sc;
    HD void operator()(long i) const { const int m = (int)(i / D), k = (int)(i % D); sc[i] = siluf(m < NB ? c[m * D + k] : cctx[k]); } };
constexpr int A8S = 2;
constexpr int W8S = 6;
constexpr int MODKC = 8;
struct ModPart { long n; const float* sc; const float* w_ada; float* part;
    HD void operator()(long i) const { const int j = (int)(i % (6 * D)); long y = i / (6 * D); const int l = (int)(y % DEPTH), kc = (int)(y / DEPTH);
        float acc[NMOD]; for (int m = 0; m < NMOD; ++m) acc[m] = 0.f;
        const float* w = w_ada + ((size_t)l * D + (size_t)kc * (D / MODKC)) * 6 * D + j; const float* s0 = sc + kc * (D / MODKC);
        for (int k = 0; k < D / MODKC; ++k) { const float wv = w[(size_t)k * 6 * D];
            for (int m = 0; m < NMOD; ++m) acc[m] += s0[m * D + k] * wv; }
        for (int m = 0; m < NMOD; ++m) part[(((size_t)kc * DEPTH + l) * NMOD + m) * 6 * D + j] = acc[m]; } };
struct ModReduce { long n; const float* part; const float* b_ada; float* mod;
    HD void operator()(long i) const { const int j = (int)(i % (6 * D)); long y = i / (6 * D); const int m = (int)(y % NMOD), l = (int)(y / NMOD); float a = b_ada[(size_t)l * 6 * D + j];
        for (int kc = 0; kc < MODKC; ++kc) a += part[(((size_t)kc * DEPTH + l) * NMOD + m) * 6 * D + j];
        mod[i] = a; } };
struct ZeroBf16 { long n; bf16* p; HD void operator()(long i) const { p[i] = 0; } };
HD uint32_t pk2(float lo, float hi) { return (uint32_t)f2bf(lo) | ((uint32_t)f2bf(hi) << 16); }
struct GlaFused { long n; const bf16* p; const float* wa2; const float* ba; bf16* lab;
    struct Ld { U4 l0[4], l1[4]; bf16 q[4], k[4]; };
    HD void load4(Ld& L_, const bf16* pe, int pstep, int j) const { UNROLL for (int e = 0; e < 4; ++e) { const bf16* pt = pe + e * pstep; const U4* lr = (const U4*)(pt + GLR); L_.l0[e] = lr[0]; L_.l1[e] = lr[1]; L_.q[e] = pt[GQ + j]; L_.k[e] = pt[GK + j]; } }
    HD void operator()(long x) const { typedef LaLay<64, 96> L; const int xi = (int)x; const int j = xi % 192; int y = xi / 192; const int blk = y % NBLK; y /= NBLK; const int b = y % NB, d = y / NB;
        const int hh = j / 48, i = j % 48; const size_t item = (size_t)(b * NBLK + blk) * 4 + hh; float w[16]; UNROLL for (int q = 0; q < 16; ++q) w[q] = wa2[(d * 16 + q) * 192 + j];
        const float bj = ba[d * 192 + j]; float c = 0.f;
        const int s_first = d == 0 ? 0 : 63, dir = d == 0 ? 1 : -1; const int r_first = b * RPB + blk * 64 + s_first;
        const bf16* pr = p + (size_t)r_first * PS; const int pstep = dir * PS; Ld cur, nxt; load4(cur, pr, pstep, j); float ko[8];
        for (int g4 = 0; g4 < 16; ++g4) {
            if (g4 < 15) load4(nxt, pr + 4 * pstep, pstep, j);
            UNROLL for (int e = 0; e < 4; ++e) { const uint32_t u[8] = {cur.l0[e].x, cur.l0[e].y, cur.l0[e].z, cur.l0[e].w, cur.l1[e].x, cur.l1[e].y, cur.l1[e].z, cur.l1[e].w}; float z = bj;
                UNROLL for (int q = 0; q < 8; ++q) { z += bf2f((bf16)(u[q] & 0xffffu)) * w[2 * q]; z += bf2f((bf16)(u[q] >> 16)) * w[2 * q + 1]; }
                c += logsigmoidf_(z) * (1.0f / 16.0f); const float kk = bf2f(cur.k[e]) * fexp(-c); const int tok = s_first + dir * (g4 * 4 + e);
                lab[L::q_at(d, item, tok, i)] = f2bf(bf2f(cur.q[e]) * 0.14433756729740643f * fexp(c)); lab[L::k_at(d, item, tok, i)] = f2bf(kk); ko[(g4 & 1) * 4 + e] = kk;
                if (i < 16) { lab[L::q_at(d, item, tok, 48 + i)] = 0; lab[L::k_at(d, item, tok, 48 + i)] = 0; } }
            pr += 4 * pstep;
            if (g4 & 1) { U4 v; const int c8 = g4 >> 1; const int s0 = d == 0 ? c8 * 8 : 56 - c8 * 8;
                v.x = d == 0 ? pk2(ko[0], ko[1]) : pk2(ko[7], ko[6]); v.y = d == 0 ? pk2(ko[2], ko[3]) : pk2(ko[5], ko[4]); v.z = d == 0 ? pk2(ko[4], ko[5]) : pk2(ko[3], ko[2]); v.w = d == 0 ? pk2(ko[6], ko[7]) : pk2(ko[1], ko[0]);
                *(U4*)(lab + L::kt_at(d, item, i, s0)) = v; if (i < 16) { U4 zz; zz.x = zz.y = zz.z = zz.w = 0u; *(U4*)(lab + L::kt_at(d, item, 48 + i, s0)) = zz; } }
            cur = nxt; }
        float* dec = (float*)(lab + L::dec) + ((size_t)d * LA_NI + item) * 64; dec[i] = fexp(c); if (i < 16) dec[48 + i] = 0.f; } };
template <int NV, int VOFF> struct VTFused { long n; const bf16* p; bf16* vT;
    HD void operator()(long x) const { const int xi = (int)x; const int j = xi % NV; const int item = xi / NV; const int hh = item % 4; const int bb = item / 4; const int r0 = (bb / NBLK) * RPB + (bb % NBLK) * 64;
        const bf16* pc = p + (size_t)r0 * PS + VOFF + hh * 96 + (j < 96 ? j : 0); const uint32_t fill = j == 96 ? 0x3f803f80u : 0u; uint32_t t[32];
        UNROLL for (int q = 0; q < 32; ++q) t[q] = (uint32_t)pc[(2 * q) * PS] | ((uint32_t)pc[(2 * q + 1) * PS] << 16);
        UNROLL for (int c8 = 0; c8 < 8; ++c8) { U4 v; v.x = j < 96 ? t[4 * c8] : fill; v.y = j < 96 ? t[4 * c8 + 1] : fill; v.z = j < 96 ? t[4 * c8 + 2] : fill; v.w = j < 96 ? t[4 * c8 + 3] : fill;
            *(U4*)(vT + (size_t)item * NV * 64 + tile_off(j, 8 * c8, 2)) = v; } } };
struct MlFused { long n; const bf16* p; const float* cw; const float* cb; const float* gb; bf16* lab;
    struct Ld { bf16 q[4][3], k[4][3], gi[4], gf[4]; };
    HD void load4(Ld& L_, const bf16* pe, int pstep, int t0, int dir, int cq, int ck, int gi, int gf) const {
        UNROLL for (int e = 0; e < 4; ++e) { const int t = t0 + dir * e; const bool first = (t == 0 || t == CTX), last = (t == CTX - 1 || t == RPB - 1); const bf16* pt = pe + e * pstep;
            L_.q[e][1] = pt[cq]; L_.k[e][1] = pt[ck]; L_.q[e][0] = first ? (bf16)0 : pt[cq - PS]; L_.k[e][0] = first ? (bf16)0 : pt[ck - PS]; L_.q[e][2] = last ? (bf16)0 : pt[cq + PS]; L_.k[e][2] = last ? (bf16)0 : pt[ck + PS];
            L_.gi[e] = pt[gi]; L_.gf[e] = pt[gf]; } }
    HD void operator()(long x) const { typedef LaLay<96, 112> L; const int xi = (int)x; const int i = xi % 96; int y = xi / 96; const int hh = y % 4; y /= 4; const int blk = y % NBLK; y /= NBLK; const int b = y % NB, d = y / NB;
        const size_t item = (size_t)(b * NBLK + blk) * 4 + hh; const int cq = MQ + hh * 96 + i, ck = MQ + 384 + hh * 96 + i;
        const float q0 = cw[cq - MQ], q1 = cw[768 + cq - MQ], q2 = cw[1536 + cq - MQ], qb = cb[cq - MQ], k0 = cw[ck - MQ], k1 = cw[768 + ck - MQ], k2 = cw[1536 + ck - MQ], kb = cb[ck - MQ];
        const int gi = MG + (2 * d) * 4 + hh, gf = MG + (2 * d + 1) * 4 + hh; const float bi = gb[(2 * d) * 4 + hh], bf_ = gb[(2 * d + 1) * 4 + hh]; float Fc = 0.f;
        const int s_first = d == 0 ? 0 : 63, dir = d == 0 ? 1 : -1; const int t_first = blk * 64 + s_first; const int r_first = b * RPB + t_first;
        const bf16* pr = p + (size_t)r_first * PS; const int pstep = dir * PS; Ld cur, nxt; load4(cur, pr, pstep, t_first, dir, cq, ck, gi, gf); float ko[8];
        for (int g4 = 0; g4 < 16; ++g4) {
            if (g4 < 15) load4(nxt, pr + 4 * pstep, pstep, t_first + dir * (g4 * 4 + 4), dir, cq, ck, gi, gf);
            UNROLL for (int e = 0; e < 4; ++e) { const float yq = q0 * bf2f(cur.q[e][0]) + q1 * bf2f(cur.q[e][1]) + q2 * bf2f(cur.q[e][2]), yk = k0 * bf2f(cur.k[e][0]) + k1 * bf2f(cur.k[e][1]) + k2 * bf2f(cur.k[e][2]);
                const float qc = siluf(yq + qb), kc = siluf(yk + kb) * 0.10206207261596577f; Fc += logsigmoidf_(bf2f(cur.gf[e]) + bf_); const float kk = kc * fexp(bf2f(cur.gi[e]) + bi - Fc); const int tok = s_first + dir * (g4 * 4 + e);
                lab[L::q_at(d, item, tok, i)] = f2bf(qc * fexp(Fc)); lab[L::k_at(d, item, tok, i)] = f2bf(kk); ko[(g4 & 1) * 4 + e] = kk; }
            pr += 4 * pstep;
            if (g4 & 1) { U4 v; const int c8 = g4 >> 1; const int s0 = d == 0 ? c8 * 8 : 56 - c8 * 8;
                v.x = d == 0 ? pk2(ko[0], ko[1]) : pk2(ko[7], ko[6]); v.y = d == 0 ? pk2(ko[2], ko[3]) : pk2(ko[5], ko[4]); v.z = d == 0 ? pk2(ko[4], ko[5]) : pk2(ko[3], ko[2]); v.w = d == 0 ? pk2(ko[6], ko[7]) : pk2(ko[1], ko[0]);
                *(U4*)(lab + L::kt_at(d, item, i, s0)) = v; }
            cur = nxt; }
        ((float*)(lab + L::dec))[((size_t)d * LA_NI + item) * 96 + i] = fexp(Fc); } };
template <int DKP, int NV> struct StatesRef { long n; bf16* lab;
    HD void operator()(long x) const { typedef LaLay<DKP, NV> L; const int i = (int)(x % DKP); long y = x / DKP; const int j = (int)(y % NV); y /= NV; const size_t item = (size_t)(y % LA_NI); const int d = (int)(y / LA_NI); float acc = 0.f;
        for (int sx = 0; sx < 64; ++sx) acc += bf2f(lab[L::v_at(item, j, sx)]) * bf2f(lab[L::kt_at(d, item, i, sx)]);
        lab[L::s_at(d, item, j, i)] = f2bf(acc); } };
constexpr int CARRY_CH = (NBLK % 17 == 0) ? 17 : ((NBLK % 4 == 0) ? 4 : 1);
template <int DKP, int NV> struct CarryT { long n; bf16* lab;
    HD void operator()(long x) const { typedef LaLay<DKP, NV> L; const int xi = (int)x; const int i = xi % DKP; int y = xi / DKP; const int j = y % NV; y /= NV; const int hh = y % 4; y /= 4; const int b = y % NB, d = y / NB;
        const float* dec = (const float*)(lab + L::dec); float sv = 0.f;
        for (int step = 0; step < NBLK; ++step) { const size_t item = (size_t)(b * NBLK + chain_blk(d, step)) * 4 + hh; const size_t o = L::s_at(d, item, j, i);
            const float tv = bf2f(lab[o]), dv = dec[((size_t)d * LA_NI + item) * DKP + i]; lab[o] = f2bf(sv); sv = dv * (sv + tv); } } };
template <int DKP, int NV, bool ISML> struct OutRef { long n; const bf16* lab; float* obuf;
    HD void operator()(long x) const { typedef LaLay<DKP, NV> L; const int j = (int)(x % 96); long y = x / 96; const int hh = (int)(y % 4); const int r = (int)(y / 4); const int b = r / RPB, t = r % RPB, blk = t / 64, tt = t % 64;
        const size_t item = ((size_t)b * NBLK + blk) * 4 + hh; float hv = 0.f;
        for (int d = 0; d < 2; ++d) { float num = 0.f, den = 0.f;
            for (int sx = 0; sx < 64; ++sx) { const bool valid = d == 0 ? (sx <= tt) : (sx >= tt); if (!valid) continue;
                float a = 0.f; for (int i = 0; i < DKP; ++i) a += bf2f(lab[L::q_at(d, item, tt, i)]) * bf2f(lab[L::k_at(d, item, sx, i)]);
                a = bf2f(f2bf(a)); num += a * bf2f(lab[L::v_at(item, j, sx)]); if (ISML) den += a * bf2f(lab[L::v_at(item, 96, sx)]); }
            for (int i = 0; i < DKP; ++i) { const float qv = bf2f(lab[L::q_at(d, item, tt, i)]); num += qv * bf2f(lab[L::s_at(d, item, j, i)]); if (ISML) den += qv * bf2f(lab[L::s_at(d, item, 96, i)]); }
            hv += ISML ? num / fmaxf(fabsf(den), 1.0f) : num; }
        obuf[x] = hv; } };
struct HeadFin { long n; const bf16* p; const float* obuf; const float* gain; bf16* mix; int mode, pad;
    HD void operator()(long x) const { const int hh = (int)(x % 4), r = (int)(x / 4); const float* o = obuf + (size_t)r * 384 + hh * 96; float ss = 0.f;
        for (int j = 0; j < 96; ++j) ss += o[j] * o[j];
        const float rstd = 1.0f / sqrtf(ss / 96.0f + EPS);
        for (int j = 0; j < 96; ++j) { const float gv = bf2f(p[(size_t)r * PS + (mode ? MO : GG) + hh * 96 + j]); const float gt = mode ? sigmoidf_(gv) : siluf(gv);
            mix[(size_t)r * D + (mode ? 640 : 0) + hh * 96 + j] = f2bf(o[j] * rstd * gain[j] * gt); } } };

struct S5Disc { long n; const float* lre; const float* lim; const float* ldt; float* disc;
    HD void operator()(long x) const { const int nn = (int)(x % 64); const int dg = (int)(x / 64); const float dt = expf(ldt[dg]); const float lr = lre[x], li = lim[x];
        const float mag = expf(lr * dt), ar = mag * cosf(li * dt), ai = mag * sinf(li * dt), den = lr * lr + li * li, pr = ar - 1.0f, pi = ai;
        disc[x * 4 + 0] = lr * dt; disc[x * 4 + 1] = li * dt; disc[x * 4 + 2] = (pr * lr + pi * li) / den; disc[x * 4 + 3] = (pi * lr - pr * li) / den; (void)nn; } };
HD void s5_apow(const float* disc4, float tau, float& ar, float& ai) { const float mag = expf(disc4[0] * tau); ar = mag * cosf(disc4[1] * tau); ai = mag * sinf(disc4[1] * tau); }
struct ZeroInt { long n; int* p; HD void operator()(long i) const { p[i] = 0; } };
struct MoePrefix { long n; int* segcnt; int* ecnt; int nseg, pad;
    HD void operator()(long e) const { int c = 0; for (int sg = 0; sg < nseg; ++sg) { const int v = segcnt[(size_t)e * nseg + sg]; segcnt[(size_t)e * nseg + sg] = c; c += v; } ecnt[e] = c; } };
struct MoeTiles2 { long n; const int* ecnt; int* tile_e; int* ntile;
    HD void operator()(long t) const { int acc = 0, ef = 0; for (int e = 0; e < NE; ++e) { const int nt = (ecnt[e] + 255) / 256; if (t >= acc && t < acc + nt) ef = e; acc += nt; } tile_e[t] = ef; if (t == 0) ntile[0] = acc; } };
struct MoeFillNeg { long n; int* row_token; HD void operator()(long i) const { row_token[i] = -1; } };
struct MoeAssign { long n; const int* rt_e; const int* segcnt; const int* ecnt; int* rt_dest; int* row_token; int nseg, pad;
    HD void operator()(long x) const { const int seg = (int)(x % nseg), e = (int)(x / nseg); int pstart = 0; for (int q = 0; q < e; ++q) pstart += (ecnt[q] + 255) / 256 * 256;
        int pos = pstart + segcnt[(size_t)e * nseg + seg];
        for (int r = seg * 64; r < seg * 64 + 64 && r < NR; ++r) for (int k = 0; k < 2; ++k) if (rt_e[2 * r + k] == e) { rt_dest[2 * r + k] = pos; row_token[pos] = r; ++pos; } } };
struct MoeGather8 { long n; const unsigned char* f8; const int* row_token; unsigned char* xs; int row0, pad;
    HD void operator()(long i) const { const int lr = (int)(i / (D / 16)), c = (int)(i % (D / 16)) * 16; const int tok = row_token[row0 + lr];
        U4 v; v.x = v.y = v.z = v.w = 0u; if (tok >= 0) v = *(const U4*)(f8 + (size_t)tok * D + c); *(U4*)(xs + (size_t)lr * D + c) = v; } };
struct MoeCombine { long n; float* h; const bf16* yrow; const int* rt_e; const float* rt_w; const int* rt_dest; const float* mod; int g_off, pad;
    HD void operator()(long i) const { const int r = (int)(i / (D / 8)), c = (int)(i % (D / 8)) * 8; if (rt_e[2 * r] < 0) return;
        const U4 y0 = *(const U4*)(yrow + (size_t)rt_dest[2 * r] * D + c), y1 = *(const U4*)(yrow + (size_t)rt_dest[2 * r + 1] * D + c); const float w0 = rt_w[2 * r], w1 = rt_w[2 * r + 1];
        const float* g = mod + (size_t)mod_index(r) * 6 * D + g_off + c; float* hp = h + (size_t)r * D + c; const F4 g0 = *(const F4*)g, g1 = *(const F4*)(g + 4); F4 h0 = *(const F4*)hp, h1 = *(const F4*)(hp + 4);
        const uint32_t a[4] = {y0.x, y0.y, y0.z, y0.w}, bq[4] = {y1.x, y1.y, y1.z, y1.w}; float yv[8];
        UNROLL for (int q = 0; q < 4; ++q) { yv[2 * q] = w0 * bf2f((bf16)(a[q] & 0xffffu)) + w1 * bf2f((bf16)(bq[q] & 0xffffu)); yv[2 * q + 1] = w0 * bf2f((bf16)(a[q] >> 16)) + w1 * bf2f((bf16)(bq[q] >> 16)); }
        h0.x += g0.x * yv[0]; h0.y += g0.y * yv[1]; h0.z += g0.z * yv[2]; h0.w += g0.w * yv[3]; h1.x += g1.x * yv[4]; h1.y += g1.y * yv[5]; h1.z += g1.z * yv[6]; h1.w += g1.w * yv[7];
        *(F4*)hp = h0; *(F4*)(hp + 4) = h1; } };
struct FinalNorm { long n; const float* h; const float* g; float* out;
    HD void operator()(long x) const { const int b = (int)(x / SEQ), tl = (int)(x % SEQ); const float* hr = h + ((size_t)b * RPB + CTX + tl) * D; float ss = 0.f;
        for (int k = 0; k < D; ++k) ss += hr[k] * hr[k];
        const float rstd = 1.0f / sqrtf(ss / D + EPS); for (int k = 0; k < D; ++k) out[(size_t)x * D + k] = hr[k] * rstd * g[k]; } };

struct EpiStoreBf16 { bf16* out; int ld; int row_off;
    HD void apply8(int row, int col0, const float* v) const { bf16* o = out + (size_t)(row - row_off) * ld + col0;
#ifndef HOST_EMU
        store8_bf16(o, v);
#else
        for (int i = 0; i < 8; ++i) o[i] = f2bf(v[i]);
#endif
    } };
struct EpiSwiGLU { bf16* out; int ld; int row_off;
    HD void apply8(int row, int col0, const float* v) const { bf16* o = out + (size_t)(row - row_off) * ld + col0 / 2;
#ifndef HOST_EMU
        uint2 w; w.x = cvt_pk_bf16(fast_silu(v[0]) * v[1], fast_silu(v[2]) * v[3]); w.y = cvt_pk_bf16(fast_silu(v[4]) * v[5], fast_silu(v[6]) * v[7]); *(uint2*)o = w;
#else
        for (int i = 0; i < 4; ++i) o[i] = f2bf(siluf(v[2 * i]) * v[2 * i + 1]);
#endif
    } };
#ifndef HOST_EMU
struct EpiSwiGLU8 { unsigned char* out; int ld; int row_off;
    __device__ __forceinline__ void apply8(int row, int col0, const float* v) const { unsigned char* o = out + (size_t)(row - row_off) * ld + col0 / 2; const float sc = (float)(1 << A8S);
        float a0 = fast_silu(v[0]) * v[1] * sc, a1 = fast_silu(v[2]) * v[3] * sc, a2 = fast_silu(v[4]) * v[5] * sc, a3 = fast_silu(v[6]) * v[7] * sc;
        a0 = __builtin_amdgcn_fmed3f(a0, -440.f, 440.f); a1 = __builtin_amdgcn_fmed3f(a1, -440.f, 440.f); a2 = __builtin_amdgcn_fmed3f(a2, -440.f, 440.f); a3 = __builtin_amdgcn_fmed3f(a3, -440.f, 440.f);
        int w = 0; w = __builtin_amdgcn_cvt_pk_fp8_f32(a0, a1, w, false); w = __builtin_amdgcn_cvt_pk_fp8_f32(a2, a3, w, true); *(unsigned*)o = (unsigned)w; } };
#endif
struct EpiResid { float* h; const float* mod; int g_off, pad;
    HD void apply8(int row, int col0, const float* v) const { float* o = h + (size_t)row * D + col0; const float* g = mod + (size_t)mod_index(row) * 6 * D + g_off + col0;
#ifndef HOST_EMU
        const f4_t g0 = *(const f4_t*)g, g1 = *(const f4_t*)(g + 4); f4_t h0 = *(const f4_t*)o, h1 = *(const f4_t*)(o + 4);
        h0 += g0 * (f4_t){v[0], v[1], v[2], v[3]}; h1 += g1 * (f4_t){v[4], v[5], v[6], v[7]}; *(f4_t*)o = h0; *(f4_t*)(o + 4) = h1;
#else
        for (int i = 0; i < 8; ++i) o[i] += g[i] * v[i];
#endif
    } };

struct GemmDesc { const bf16* A; const bf16* Bt; const int* tile_e; const int* ntile; const int* arow; size_t e_stride; int M, N, K, tile0, lda, ldb, tdiv, pad; };
HD GemmDesc mk_gemm(const bf16* A, int lda, const bf16* Bt, int ldb, int M, int N, int K) { return GemmDesc{A, Bt, nullptr, nullptr, nullptr, 0, M, N, K, 0, lda, ldb, 0, 0}; }

constexpr int S5RB = NB * NBLK;
constexpr int S5RG = (S5RB + 255) / 256 * 256;
constexpr int S5K_ = 1280;
HD void s5_bbar(const float* d4, float br, float bi, float& bbr, float& bbi) { bbr = d4[2] * br - d4[3] * bi; bbi = d4[2] * bi + d4[3] * br; }
struct S5Apow { long n; const float* lre; const float* lim; const float* ldt; float* apow;
    HD void operator()(long x) const { const int nn = (int)(x % 64); long y = x / 64; const int tau = (int)(y % 65); const int dg = (int)(y / 65); const float dt = expf(ldt[dg]);
        const float lr = lre[(size_t)dg * 64 + nn] * dt, li = lim[(size_t)dg * 64 + nn] * dt; const float mag = expf(lr * (float)tau); apow[x * 2] = mag * cosf(li * (float)tau); apow[x * 2 + 1] = mag * sinf(li * (float)tau); } };
struct S5Bbar { long n; const float* disc; const float* bre; const float* bim; float* bbar;
    HD void operator()(long x) const { const int pp = (int)(x % 16); long y = x / 16; const int nn = (int)(y % 64); y /= 64; const int g = (int)(y % 16), d = (int)(y / 16); (void)d;
        const float* d4 = disc + (y * 64 + nn) * 4; float br, bi; s5_bbar(d4, bre[((size_t)g * 64 + nn) * 16 + pp], bim[((size_t)g * 64 + nn) * 16 + pp], br, bi); bbar[x * 2] = br; bbar[x * 2 + 1] = bi; } };
struct S5K2 { long n; const float* apow; const float* bbar; const float* cre; const float* cim; float* Kt;
    HD void operator()(long x) const { const int p2 = (int)(x % 16); long y = x / 16; const int p1 = (int)(y % 16); y /= 16; const int tau = (int)(y % 64); y /= 64; const int g = (int)(y % 16), d = (int)(y / 16); float acc = 0.f;
        const float* ap = apow + (((size_t)d * 16 + g) * 65 + tau) * 64 * 2; const float* bb = bbar + (((size_t)d * 16 + g) * 64) * 16 * 2;
        for (int nn = 0; nn < 64; ++nn) { const float ar = ap[nn * 2], ai = ap[nn * 2 + 1], bbr = bb[(nn * 16 + p2) * 2], bbi = bb[(nn * 16 + p2) * 2 + 1];
            acc += cre[((size_t)g * 16 + p1) * 64 + nn] * (ar * bbr - ai * bbi) - cim[((size_t)g * 16 + p1) * 64 + nn] * (ar * bbi + ai * bbr); }
        Kt[x] = acc; } };
struct S5BuildTB { long n; const float* apow; const float* cre; const float* cim; const float* Kt; bf16* TB;
    HD void operator()(long x) const { const int k0 = (int)(x % (S5K_ / 8)) * 8; long y = x / (S5K_ / 8); const int tp = (int)(y % 1024), g = (int)(y / 1024); const int t = tp >> 4, p1 = tp & 15; float v[8];
        if (k0 < 1024) { const int sx = k0 >> 4, p2 = k0 & 15; const float* kf = Kt + ((((size_t)0 * 16 + g) * 64 + (sx <= t ? t - sx : 0)) * 16 + p1) * 16 + p2; const float* kb = Kt + ((((size_t)1 * 16 + g) * 64 + (sx >= t ? sx - t : 0)) * 16 + p1) * 16 + p2;
            UNROLL for (int q = 0; q < 8; ++q) v[q] = (sx <= t ? kf[q] : 0.f) + (sx >= t ? kb[q] : 0.f);
        } else { const int kk = k0 - 1024, d = kk >> 7, n0 = (kk & 127) >> 1; const int pt = d == 0 ? t : 63 - t; const float* ap = apow + ((((size_t)d * 16 + g) * 65 + pt + 1) * 64 + n0) * 2;
            UNROLL for (int q = 0; q < 4; ++q) { const float ar = ap[2 * q], ai = ap[2 * q + 1], cr = cre[((size_t)g * 16 + p1) * 64 + n0 + q], ci = cim[((size_t)g * 16 + p1) * 64 + n0 + q]; v[2 * q] = cr * ar - ci * ai; v[2 * q + 1] = -(cr * ai + ci * ar); } }
        U4 o; o.x = pk2(v[0], v[1]); o.y = pk2(v[2], v[3]); o.z = pk2(v[4], v[5]); o.w = pk2(v[6], v[7]); *(U4*)(TB + x * 8) = o; } };
struct S5BuildEB { long n; const float* apow; const float* bbar; bf16* EB;
    HD void operator()(long x) const { const int k0 = (int)(x % 128) * 8; long y = x / 128; const int col = (int)(y % 256), g = (int)(y / 256); const int d = col >> 7, nn = (col & 127) >> 1, ri = col & 1, sx = k0 >> 4, p2 = k0 & 15;
        const float* ap = apow + ((((size_t)d * 16 + g) * 65 + (d == 0 ? 63 - sx : sx)) * 64 + nn) * 2; const float* bb = bbar + ((((size_t)d * 16 + g) * 64 + nn) * 16 + p2) * 2; const float ar = ap[0], ai = ap[1]; float v[8];
        UNROLL for (int q = 0; q < 8; ++q) { const float bbr = bb[2 * q], bbi = bb[2 * q + 1]; v[q] = ri == 0 ? (ar * bbr - ai * bbi) : (ar * bbi + ai * bbr); }
        U4 o; o.x = pk2(v[0], v[1]); o.y = pk2(v[2], v[3]); o.z = pk2(v[4], v[5]); o.w = pk2(v[6], v[7]); *(U4*)(EB + x * 8) = o; } };
struct S5BuildU { long n; const bf16* p; bf16* uG;
    HD void operator()(long x) const { const int k0 = (int)(x % 128) * 8; long y = x / 128; const int rb = (int)(y % S5RB), g = (int)(y / S5RB); const int b = rb / NBLK, blk = rb % NBLK;
        *(U4*)(uG + ((size_t)g * S5RG + rb) * S5K_ + k0) = *(const U4*)(p + ((size_t)b * RPB + blk * 64 + (k0 >> 4)) * PS + SU + g * 16 + (k0 & 15)); } };
struct S5Carry2 { long n; const float* apow; const float* est; bf16* uG;
    HD void operator()(long x) const { const int nn = (int)(x % 64); long y = x / 64; const int d = (int)(y % 2); y /= 2; const int g = (int)(y % 16), b = (int)(y / 16);
        const float* ap = apow + ((((size_t)d * 16 + g) * 65 + 64) * 64 + nn) * 2; const float ar = ap[0], ai = ap[1]; float sr = 0.f, si = 0.f;
        for (int s0 = 0; s0 < NBLK; s0 += CARRY_CH) { float tr[CARRY_CH], ti[CARRY_CH];
            UNROLL for (int e = 0; e < CARRY_CH; ++e) { const size_t row = (size_t)g * S5RG + (size_t)b * NBLK + chain_blk(d, s0 + e); tr[e] = est[row * 256 + d * 128 + 2 * nn]; ti[e] = est[row * 256 + d * 128 + 2 * nn + 1]; }
            UNROLL for (int e = 0; e < CARRY_CH; ++e) { const size_t row = (size_t)g * S5RG + (size_t)b * NBLK + chain_blk(d, s0 + e);
                uG[row * S5K_ + 1024 + d * 128 + 2 * nn] = f2bf(sr); uG[row * S5K_ + 1024 + d * 128 + 2 * nn + 1] = f2bf(si);
                const float nr = ar * sr - ai * si + tr[e], ni = ar * si + ai * sr + ti[e]; sr = nr; si = ni; } } } };
struct EpiStoreF32 { float* out; int ld; int pad;
    HD void apply8(int row, int col0, const float* v) const { float* o = out + (size_t)row * ld + col0;
#ifndef HOST_EMU
        *(f4_t*)o = (f4_t){v[0], v[1], v[2], v[3]}; *(f4_t*)(o + 4) = (f4_t){v[4], v[5], v[6], v[7]};
#else
        for (int i = 0; i < 8; ++i) o[i] = v[i];
#endif
    } };
struct EpiS5Z { const bf16* p; const float* dskip; bf16* zbuf;
    HD void apply8(int row, int col0, const float* v) const { const int g = row / S5RG, rb = row % S5RG; if (rb >= S5RB) return; const int b = rb / NBLK, blk = rb % NBLK, t = col0 >> 4, p0 = col0 & 15;
        const size_t r = (size_t)b * RPB + blk * 64 + t; const int c = g * 16 + p0;
#ifndef HOST_EMU
        float u[8], z[8]; load8_bf16(p + r * PS + SU + c, u); const f4_t d0 = *(const f4_t*)(dskip + c), d1 = *(const f4_t*)(dskip + c + 4); const float dd[8] = {d0.x, d0.y, d0.z, d0.w, d1.x, d1.y, d1.z, d1.w};
#pragma unroll
        for (int i = 0; i < 8; ++i) { const float x = v[i] + dd[i] * u[i]; const float y = 0.7978845608028654f * (x + 0.044715f * x * x * x); const float th = 1.0f - 2.0f * __builtin_amdgcn_rcpf(1.0f + __expf(2.0f * y)); z[i] = 0.5f * x * (1.0f + th); }
        store8_bf16(zbuf + r * 256 + c, z);
#else
        for (int i = 0; i < 8; ++i) zbuf[r * 256 + c + i] = f2bf(gelu_tanhf(v[i] + dskip[c + i] * bf2f(p[r * PS + SU + c + i])));
#endif
    } };
struct EpiGlu { const bf16* zbuf; const float* gb; bf16* mix;
    HD void apply8(int row, int col0, const float* v) const {
#ifndef HOST_EMU
        float z[8], o[8]; load8_bf16(zbuf + (size_t)row * 256 + col0, z); const f4_t b0 = *(const f4_t*)(gb + col0), b1 = *(const f4_t*)(gb + col0 + 4); const float bb[8] = {b0.x, b0.y, b0.z, b0.w, b1.x, b1.y, b1.z, b1.w};
#pragma unroll
        for (int i = 0; i < 8; ++i) o[i] = z[i] * fast_sigmoid(v[i] + bb[i]);
        store8_bf16(mix + (size_t)row * D + 384 + col0, o);
#else
        for (int i = 0; i < 8; ++i) mix[(size_t)row * D + 384 + col0 + i] = f2bf(bf2f(zbuf[(size_t)row * 256 + col0 + i]) * sigmoidf_(v[i] + gb[col0 + i]));
#endif
    } };

#ifndef HOST_EMU
namespace pg8 {
#define PG8_LAS __attribute__((address_space(3)))
typedef short bf16x8 __attribute__((ext_vector_type(8)));
typedef float f32x4 __attribute__((ext_vector_type(4)));
typedef int v4i_t __attribute__((ext_vector_type(4)));
typedef int v8i_t __attribute__((ext_vector_type(8)));
constexpr int BM = 256, BK = 64, HALF = 128, HTB = HALF * BK * 2, STAGE_BYTES = 8 * HTB, NXCD = 8, WGM = 8;
__device__ __forceinline__ int lds_byte(int r, int c) { const int st = (r >> 4) * 2 + (c >> 5), rr = r & 15, cc = c & 31, ob = rr * 64 + cc * 2; return st * 1024 + (ob ^ (((ob >> 9) & 1) << 5)); }
__device__ __forceinline__ void stage_rc(int b, int& R, int& C) { const int st = b / 1024, sb = b % 1024, swz = sb ^ (((sb >> 9) & 1) << 5); R = (st >> 1) * 16 + swz / 64; C = (st & 1) * 32 + (swz % 64) / 2; }
__device__ __forceinline__ int perm32(int rho) { const int n = rho >> 4, i = rho & 15; return 8 * (i >> 2) + 4 * n + (i & 3); }
struct Unit { int pm, pn; };
struct StaticOrder {
    int nM, nN, nwg, G, c;
    __device__ void init(int M, int N, int G_, int c_) { nM = M / BM; nN = N / BM; nwg = nM * nN; G = G_; c = c_; }
    __device__ bool next(int i, Unit& u) const {
        const long L = (long)i * G + c; if (L >= nwg) return false;
        int wgid = (int)L; { const int q = nwg / NXCD, r = nwg % NXCD, xcd = wgid % NXCD, off = wgid / NXCD; wgid = (xcd < r ? xcd * (q + 1) : r * (q + 1) + (xcd - r) * q) + off; }
        const int nig = WGM * nN, gid = wgid / nig, fm = gid * WGM, gsz = (nM - fm) < WGM ? (nM - fm) : WGM;
        u.pm = fm + ((wgid % nig) % gsz); u.pn = (wgid % nig) / gsz; return true;
    }
};
template <class F> __device__ __forceinline__ void epi_apply(const F& f, const f32x4 (&acc)[2][2][4][2], const Unit& u, int wr, int wc, int fr, int fq) {
    const int row0 = u.pm * BM + wr * 64 + fr, col0 = u.pn * BM + wc * 32 + 8 * fq;
#pragma unroll
    for (int ai = 0; ai < 2; ++ai)
#pragma unroll
        for (int m = 0; m < 4; ++m)
#pragma unroll
            for (int bj = 0; bj < 2; ++bj) { const f32x4 v0 = acc[ai][bj][m][0], v1 = acc[ai][bj][m][1];
                const float v[8] = {v0[0], v0[1], v0[2], v0[3], v1[0], v1[1], v1[2], v1[3]};
                f.apply8(row0 + ai * HALF + m * 16, col0 + bj * HALF, v); }
}
#ifndef PG8_SP2
#define PG8_SP2 true
#endif
#ifndef PG8_ALIGN
#define PG8_ALIGN true
#endif
template <class F, bool FP8 = false, bool GATHER = false, bool SP2 = PG8_SP2, bool ALIGN_EPI = PG8_ALIGN>
__device__ __forceinline__ void gemm_phase(PG8_LAS unsigned char* lds, const GemmDesc g, const F& E, int G_, int c_) {
    int tid_ = threadIdx.x; asm volatile("" : "+v"(tid_));
    const int tid = tid_, wid = __builtin_amdgcn_readfirstlane(tid >> 6), lane = tid & 63, wr = wid >> 2, wc = wid & 3, fr = lane & 15, fq = lane >> 4;
    const int K = g.K, nt = FP8 ? K / 128 : K / BK; constexpr unsigned EB = FP8 ? 1u : 2u;
    int M = g.M; if (g.ntile) { int ntl = g.ntile[0] - g.tile0; ntl = ntl < 0 ? 0 : ntl; if (ntl * BM < M) M = ntl * BM; }
    StaticOrder S; S.init(M, g.N, G_, c_);
    unsigned voffB[1]; int RA[2]; unsigned CA[2];
#pragma unroll
    for (int i = 0; i < 2; ++i) { int R, C; stage_rc(tid * 16 + i * 8192, R, C); const int Rb = (R & ~31) + perm32(R & 31);
        RA[i] = R; CA[i] = (unsigned)C * 2u; if (i == 0) voffB[0] = (unsigned)Rb * (unsigned)g.ldb * EB + (unsigned)C * 2u; }
    const size_t pieceB = (size_t)64 * g.ldb * EB;
    const unsigned lda2 = (unsigned)g.lda * EB;
    const size_t kstep = (size_t)(BK * 2);
    const size_t hstepA = (size_t)HALF * g.lda * EB, hstepB = (size_t)HALF * g.ldb * EB;
    const size_t tstepA = 2 * hstepA, tstepB = 2 * hstepB;
    const unsigned ldsw = (unsigned)wid * 1024u; int sc8v = (127 + g.pad / 2) * 0x01010101;
    if constexpr (FP8) asm volatile("" : "+v"(sc8v));
    const int aoff = lds_byte(wr * 64 + fr, fq * 8), boff = lds_byte(wc * 32 + fr, fq * 8);
#define PG8_SA(b, h) (((b) * 2 + (h)) * HTB)
#define PG8_SB(b, h) ((4 + (b) * 2 + (h)) * HTB)
#define PG8_STAGE(bufoff, gbase, voff) do { _Pragma("unroll") for (int _i = 0; _i < 2; ++_i) \
        __builtin_amdgcn_global_load_lds((const unsigned*)((const char*)(gbase) + (voff)[_i]), (PG8_LAS unsigned*)(lds + (bufoff) + ldsw + _i * 8192), 16, 0, 0); } while (0)
#define PG8_STAGEB(bufoff, gbase) do { _Pragma("unroll") for (int _i = 0; _i < 2; ++_i) \
        __builtin_amdgcn_global_load_lds((const unsigned*)((const char*)(gbase) + _i * pieceB + voffB[0]), (PG8_LAS unsigned*)(lds + (bufoff) + ldsw + _i * 8192), 16, 0, 0); } while (0)
#define PG8_RD(off) (*(const PG8_LAS bf16x8*)(lds + (off)))
#define PG8_LDA(dst, b, h) do { if constexpr (FP8) { _Pragma("unroll") for (int m = 0; m < 4; ++m) { dst##8[m].lo = __builtin_bit_cast(v4i_t, PG8_RD(PG8_SA(b, h) + aoff + m * 2048)); dst##8[m].hi = __builtin_bit_cast(v4i_t, PG8_RD(PG8_SA(b, h) + aoff + m * 2048 + 1024)); } } else { \
        _Pragma("unroll") for (int m = 0; m < 4; ++m) _Pragma("unroll") for (int k = 0; k < 2; ++k) dst[m][k] = PG8_RD(PG8_SA(b, h) + aoff + m * 2048 + k * 1024); } } while (0)
#define PG8_LDB(dst, b, h) do { if constexpr (FP8) { _Pragma("unroll") for (int n = 0; n < 2; ++n) { dst##8[n].lo = __builtin_bit_cast(v4i_t, PG8_RD(PG8_SB(b, h) + boff + n * 2048)); dst##8[n].hi = __builtin_bit_cast(v4i_t, PG8_RD(PG8_SB(b, h) + boff + n * 2048 + 1024)); } } else { \
        _Pragma("unroll") for (int n = 0; n < 2; ++n) _Pragma("unroll") for (int k = 0; k < 2; ++k) dst[n][k] = PG8_RD(PG8_SB(b, h) + boff + n * 2048 + k * 1024); } } while (0)
#define PG8_CAT(x0, x1) __builtin_shufflevector(__builtin_bit_cast(v4i_t, x0), __builtin_bit_cast(v4i_t, x1), 0, 1, 2, 3, 4, 5, 6, 7)
#define PG8_MMA(ai, bj, At, Bt) do { __builtin_amdgcn_s_setprio(1); if constexpr (FP8) { _Pragma("unroll") for (int m = 0; m < 4; ++m) _Pragma("unroll") for (int n = 0; n < 2; ++n) \
        asm volatile("v_mfma_scale_f32_16x16x128_f8f6f4 %0, %1, %2, %0, %3, %4 op_sel_hi:[0,0,0]" : "+v"(acc[ai][bj][m][n]) : "v"(Bt##8[n]), "v"(At##8[m]), "v"(sc8v), "v"(sc8v)); } else { \
        _Pragma("unroll") for (int m = 0; m < 4; ++m) _Pragma("unroll") for (int n = 0; n < 2; ++n) _Pragma("unroll") for (int k = 0; k < 2; ++k) \
        acc[ai][bj][m][n] = __builtin_amdgcn_mfma_f32_16x16x32_bf16(Bt[n][k], At[m][k], acc[ai][bj][m][n], 0, 0, 0); } __builtin_amdgcn_s_setprio(0); } while (0)
#define PG8_WAIT_V(n) asm volatile("s_waitcnt vmcnt(" #n ")" ::: "memory")
#define PG8_WAIT_L(n) asm volatile("s_waitcnt lgkmcnt(" #n ")" ::: "memory")
#define PG8_BAR __builtin_amdgcn_s_barrier()
#define PG8_SCHED __builtin_amdgcn_sched_barrier(0)
#define PG8_MKVO(u, vo, base) do { if constexpr (GATHER) { base = (const char*)g.A; int _t = tid; asm volatile("" : "+v"(_t));     \
            _Pragma("unroll") for (int _i = 0; _i < 2; ++_i) { int _R, _C; stage_rc(_t * 16 + _i * 8192, _R, _C); _Pragma("unroll") for (int _h = 0; _h < 2; ++_h) { \
            int _row = g.arow[(size_t)(g.tile0 + (u).pm) * BM + _h * HALF + _R]; _row = _row < 0 ? 0 : _row; vo[_h][_i] = (unsigned)_row * lda2 + (unsigned)_C * 2u; } } } \
        else { base = (const char*)g.A + (size_t)(u).pm * tstepA; _Pragma("unroll") for (int _h = 0; _h < 2; ++_h) _Pragma("unroll") for (int _i = 0; _i < 2; ++_i) vo[_h][_i] = (unsigned)(_h * HALF + RA[_i]) * lda2 + CA[_i]; } } while (0)
#define PG8_BBASE(u) ((const char*)g.Bt + (g.tile_e ? (size_t)g.tile_e[g.tile0 + (u).pm] * g.e_stride * 2 : (g.tdiv ? (size_t)((u).pm / g.tdiv) * g.e_stride * 2 : (size_t)0)) + (size_t)(u).pn * tstepB)
    Unit cur, nxt; int ui = 0;
    if (!S.next(0, cur)) return;
    f32x4 acc[2][2][4][2];
#pragma unroll
    for (int a = 0; a < 2; ++a)
#pragma unroll
        for (int b = 0; b < 2; ++b)
#pragma unroll
            for (int m = 0; m < 4; ++m)
#pragma unroll
                for (int n = 0; n < 2; ++n) acc[a][b][m][n] = (f32x4){0.f, 0.f, 0.f, 0.f};
    bf16x8 At[4][2], B0[2][2], B1[2][2]; v8i_t At8[4], B08[2], B18[2];
    const char* cA; unsigned voC[2][2], voN[2][2]; PG8_MKVO(cur, voC, cA); const char* cB = PG8_BBASE(cur);
    if constexpr (SP2) {
        PG8_STAGEB(PG8_SB(0, 0), cB); PG8_STAGEB(PG8_SB(0, 1), cB + hstepB); PG8_STAGE(PG8_SA(0, 0), cA, voC[0]); PG8_STAGE(PG8_SA(0, 1), cA, voC[1]);
        if (wr == 1) PG8_BAR;
        PG8_WAIT_V(2); PG8_BAR;
        PG8_STAGEB(PG8_SB(1, 0), cB + kstep); PG8_STAGE(PG8_SA(1, 0), cA + kstep, voC[0]); PG8_STAGEB(PG8_SB(1, 1), cB + hstepB + kstep);
        PG8_WAIT_V(6); PG8_BAR;
    } else {
    PG8_STAGEB(PG8_SB(0, 0), cB); PG8_STAGE(PG8_SA(0, 0), cA, voC[0]); PG8_STAGEB(PG8_SB(0, 1), cB + hstepB); PG8_STAGE(PG8_SA(0, 1), cA, voC[1]);
    if (wr == 1) PG8_BAR;
    PG8_WAIT_V(4); PG8_BAR;
    PG8_STAGEB(PG8_SB(1, 0), cB + kstep); PG8_STAGE(PG8_SA(1, 0), cA + kstep, voC[0]); PG8_STAGEB(PG8_SB(1, 1), cB + hstepB + kstep);
    PG8_WAIT_V(6); PG8_BAR;
    }
    for (;;) {
        const bool has_next = S.next(ui + 1, nxt);
        const char* nA = cA; if constexpr (!GATHER) { if (has_next) nA = (const char*)g.A + (size_t)nxt.pm * tstepA; } else if (has_next) PG8_MKVO(nxt, voN, nA); else { _Pragma("unroll") for (int _h = 0; _h < 2; ++_h) _Pragma("unroll") for (int _i = 0; _i < 2; ++_i) voN[_h][_i] = voC[_h][_i]; }
        const char* nB = has_next ? PG8_BBASE(nxt) : cB;
        for (int t = 0; t < nt; t += 2) {
            const bool last = (t == nt - 2);
            const char* a1 = cA + (size_t)(t + 1) * kstep;
            const char* a2 = last ? nA : cA + (size_t)(t + 2) * kstep; const char* b2 = last ? nB : cB + (size_t)(t + 2) * kstep;
            const char* a3 = a2 + kstep; const char* b3 = b2 + kstep;
            if constexpr (SP2) {
            PG8_LDB(B0, 0, 0); PG8_LDB(B1, 0, 1); PG8_SCHED; PG8_LDA(At, 0, 0); PG8_STAGE(PG8_SA(1, 1), a1, voC[1]);
            if constexpr (GATHER) if (last) { _Pragma("unroll") for (int _h = 0; _h < 2; ++_h) _Pragma("unroll") for (int _i = 0; _i < 2; ++_i) voC[_h][_i] = voN[_h][_i]; }
            PG8_WAIT_V(8); PG8_WAIT_L(0); PG8_BAR; PG8_MMA(0, 0, At, B0); PG8_MMA(0, 1, At, B1); PG8_BAR; PG8_SCHED;
            PG8_LDA(At, 0, 1); PG8_STAGEB(PG8_SB(0, 0), b2); PG8_STAGEB(PG8_SB(0, 1), b2 + hstepB); PG8_STAGE(PG8_SA(0, 0), a2, voC[0]);
            PG8_WAIT_V(8); PG8_WAIT_L(0); PG8_BAR; PG8_MMA(1, 0, At, B0); PG8_MMA(1, 1, At, B1); PG8_BAR; PG8_SCHED;
            PG8_LDB(B0, 1, 0); PG8_LDB(B1, 1, 1); PG8_SCHED; PG8_LDA(At, 1, 0); PG8_STAGE(PG8_SA(0, 1), a2, voC[1]);
            PG8_WAIT_V(8); PG8_WAIT_L(0); PG8_BAR; PG8_MMA(0, 0, At, B0); PG8_MMA(0, 1, At, B1); PG8_BAR; PG8_SCHED;
            PG8_LDA(At, 1, 1); PG8_STAGEB(PG8_SB(1, 0), b3); PG8_STAGEB(PG8_SB(1, 1), b3 + hstepB); PG8_STAGE(PG8_SA(1, 0), a3, voC[0]);
            PG8_WAIT_V(8); PG8_WAIT_L(0); PG8_BAR; PG8_MMA(1, 0, At, B0); PG8_MMA(1, 1, At, B1); PG8_BAR; PG8_SCHED;
            } else {
            PG8_LDB(B0, 0, 0); PG8_SCHED; PG8_LDA(At, 0, 0); PG8_STAGE(PG8_SA(1, 1), a1, voC[1]);
            if constexpr (GATHER) if (last) { _Pragma("unroll") for (int _h = 0; _h < 2; ++_h) _Pragma("unroll") for (int _i = 0; _i < 2; ++_i) voC[_h][_i] = voN[_h][_i]; }
            PG8_WAIT_L(8); PG8_BAR; PG8_WAIT_L(0); PG8_MMA(0, 0, At, B0); PG8_BAR; PG8_SCHED;
            PG8_LDB(B1, 0, 1); PG8_STAGEB(PG8_SB(0, 0), b2);
            PG8_BAR; PG8_WAIT_L(0); PG8_MMA(0, 1, At, B1); PG8_BAR;
            PG8_LDA(At, 0, 1); PG8_STAGE(PG8_SA(0, 0), a2, voC[0]);
            PG8_BAR; PG8_WAIT_L(0); PG8_MMA(1, 0, At, B0); PG8_BAR; PG8_SCHED;
            PG8_STAGEB(PG8_SB(0, 1), b2 + hstepB);
            PG8_WAIT_V(6); PG8_BAR; PG8_MMA(1, 1, At, B1); PG8_BAR;
            PG8_LDB(B0, 1, 0); PG8_SCHED; PG8_LDA(At, 1, 0); PG8_STAGE(PG8_SA(0, 1), a2, voC[1]);
            PG8_WAIT_L(8); PG8_BAR; PG8_WAIT_L(0); PG8_MMA(0, 0, At, B0); PG8_BAR; PG8_SCHED;
            PG8_LDB(B1, 1, 1); PG8_STAGEB(PG8_SB(1, 0), b3);
            PG8_BAR; PG8_WAIT_L(0); PG8_MMA(0, 1, At, B1); PG8_BAR;
            PG8_LDA(At, 1, 1); PG8_STAGE(PG8_SA(1, 0), a3, voC[0]);
            PG8_BAR; PG8_WAIT_L(0); PG8_MMA(1, 0, At, B0); PG8_BAR; PG8_SCHED;
            PG8_STAGEB(PG8_SB(1, 1), b3 + hstepB);
            PG8_WAIT_V(6); PG8_BAR; PG8_MMA(1, 1, At, B1); PG8_BAR;
            }
        }
        if constexpr (ALIGN_EPI) { if (wr == 0) PG8_BAR; }
        if constexpr (FP8) asm volatile("s_nop 15\n\ts_nop 15" ::: "memory");
        epi_apply(E, acc, cur, wr, wc, fr, fq);
        if (!has_next) break;
#pragma unroll
        for (int a = 0; a < 2; ++a)
#pragma unroll
            for (int b = 0; b < 2; ++b)
#pragma unroll
                for (int m = 0; m < 4; ++m)
#pragma unroll
                    for (int n = 0; n < 2; ++n) acc[a][b][m][n] = (f32x4){0.f, 0.f, 0.f, 0.f};
        cur = nxt; cA = nA; cB = nB; ++ui;
        if constexpr (ALIGN_EPI) { if (wr == 1) PG8_BAR; }
    }
    PG8_WAIT_V(0);
    if constexpr (!ALIGN_EPI) { if (wr == 0) PG8_BAR; }
    PG8_BAR;
#undef PG8_SA
#undef PG8_SB
#undef PG8_STAGE
#undef PG8_STAGEB
#undef PG8_LDA
#undef PG8_LDB
#undef PG8_MMA
#undef PG8_CAT
#undef PG8_RD
#undef PG8_WAIT_V
#undef PG8_WAIT_L
#undef PG8_BAR
#undef PG8_SCHED
#undef PG8_BBASE
#undef PG8_MKVO
}
}

#define XB_TMO      128
#define XB_XCNT(j)  (256  + 64 * (j))
#define XB_XSUB(j)  (1280 + 64 * (j))
#define XB_XGEN(j)  (2304 + 64 * (j))
#define XB_TOP      3328
#define XB_TOPGEN   3392
#define XCD_BAR_WORDS 3456
#define XB_SPIN_CAP (1u << 20)
#define LAS __attribute__((address_space(3)))
__device__ __forceinline__ unsigned xb_ld(unsigned* p)              { return __hip_atomic_load(p, __ATOMIC_RELAXED, __HIP_MEMORY_SCOPE_AGENT); }
__device__ __forceinline__ unsigned xb_add(unsigned* p, unsigned v) { return __hip_atomic_fetch_add(p, v, __ATOMIC_RELAXED, __HIP_MEMORY_SCOPE_AGENT); }
__device__ __forceinline__ unsigned xb_xcc_id() { return (unsigned)__builtin_amdgcn_s_getreg((3 << 11) | 20) & 0xFu; }
#define XB_SPIN(cond, bar) do { unsigned _sp = 0; while (cond) { __builtin_amdgcn_s_sleep(1); \
    if ((++_sp & 255u) == 0u) { if (xb_ld(&(bar)[XB_TMO])) break; if (_sp > XB_SPIN_CAP) { atomicAdd(&(bar)[XB_TMO], 1u); break; } } } } while (0)
struct XcdBarrier { unsigned* bar; unsigned x; volatile LAS unsigned* st; };
__device__ __forceinline__ XcdBarrier xcd_barrier_post(unsigned* bar, volatile LAS unsigned* st) {
    XcdBarrier b; b.bar = bar; b.x = xb_xcc_id(); b.st = st;
    if (threadIdx.x == 0) (void)xb_add(&bar[XB_XCNT(b.x)], 1u);
    return b;
}
__device__ __forceinline__ void xcd_barrier_complete(unsigned* bar, unsigned x, unsigned& nloc, unsigned& nx) {
    const unsigned G = gridDim.x * gridDim.y * gridDim.z;
    unsigned sum, cnt, mine, sp = 0u;
    for (;;) {
        sum = 0u; cnt = 0u; mine = 0u;
#pragma unroll
        for (unsigned j = 0; j < 16; ++j) { const unsigned c = xb_ld(&bar[XB_XCNT(j)]); sum += c; cnt += (c > 0u) ? 1u : 0u; mine = (j == x) ? c : mine; }
        if (sum == G) break;
        __builtin_amdgcn_s_sleep(1);
        if ((++sp & 255u) == 0u) { if (xb_ld(&bar[XB_TMO])) break; if (sp > XB_SPIN_CAP) { atomicAdd(&bar[XB_TMO], 1u); break; } }
    }
    nloc = mine > 0u ? mine : 1u; nx = cnt > 0u ? cnt : 1u;
}
__device__ __forceinline__ void xcd_barrier(const XcdBarrier& b) {
    asm volatile("s_waitcnt vmcnt(0)" ::: "memory");
    __syncthreads();
    if (threadIdx.x == 0) {
        unsigned* bar = b.bar; asm volatile("" : "+s"(bar));
        __builtin_amdgcn_s_waitcnt(0);
        unsigned nloc = b.st[0], nx = b.st[1];
        if (nloc == 0u) { xcd_barrier_complete(bar, b.x, nloc, nx); b.st[0] = nloc; b.st[1] = nx; }
        const unsigned old = xb_add(&bar[XB_XSUB(b.x)], 1u);
        const unsigned gen = old / nloc;
        if (old + 1u == (gen + 1u) * nloc) {
            __builtin_amdgcn_fence(__ATOMIC_RELEASE, "agent");
            asm volatile("s_waitcnt vmcnt(0)" ::: "memory");
            const unsigned og = xb_add(&bar[XB_TOP], 1u);
            const unsigned tg = og / nx;
            if (og + 1u == (tg + 1u) * nx) xb_add(&bar[XB_TOPGEN], 1u);
            else XB_SPIN(xb_ld(&bar[XB_TOPGEN]) == tg, bar);
            __builtin_amdgcn_fence(__ATOMIC_ACQUIRE, "agent");
            xb_add(&bar[XB_XGEN(b.x)], 1u);
            asm volatile("s_waitcnt vmcnt(0)" ::: "memory");
        } else {
            XB_SPIN(xb_ld(&bar[XB_XGEN(b.x)]) == gen, bar);
            __builtin_amdgcn_fence(__ATOMIC_ACQUIRE, "agent");
            asm volatile("s_waitcnt vmcnt(0)" ::: "memory");
        }
    }
    __syncthreads();
}

__device__ __forceinline__ float wave_sum(float v) {
#pragma unroll
    for (int o = 1; o < 64; o <<= 1) v += __shfl_xor(v, o);
    return v;
}
typedef float f32x4v __attribute__((ext_vector_type(4)));
__device__ __forceinline__ unsigned pk2bf(float lo, float hi) { return (unsigned)f2bf(lo) | ((unsigned)f2bf(hi) << 16); }
#define LDS_WAIT() asm volatile("s_waitcnt lgkmcnt(0)" ::: "memory")
struct NormModW { int n; int sh_off; int sc_off; int skip_ctx; const float* h; const float* g; const float* mod; bf16* out; const float* wr; int* rt_e; float* rt_w; int* segcnt; int nseg, f8;
    __device__ __forceinline__ void wave(int it, int lane, PG8_LAS unsigned char*) const {
        f32x4v v[2][4]; float ss[2] = {0.f, 0.f};
#pragma unroll
        for (int q = 0; q < 2; ++q) { const f32x4v* hr = (const f32x4v*)(h + (size_t)(2 * it + q) * D) + lane;
#pragma unroll
            for (int j = 0; j < 4; ++j) v[q][j] = hr[64 * j]; }
#pragma unroll
        for (int q = 0; q < 2; ++q) {
#pragma unroll
            for (int j = 0; j < 4; ++j) ss[q] += (v[q][j].x * v[q][j].x + v[q][j].y * v[q][j].y) + (v[q][j].z * v[q][j].z + v[q][j].w * v[q][j].w); }
#pragma unroll
        for (int q = 0; q < 2; ++q) { const int r = 2 * it + q;
        const float rstd = 1.0f / sqrtf(wave_sum(ss[q]) * (1.0f / D) + EPS); const float* m = mod + (size_t)mod_index(r) * 6 * D;
        float lg[NE];
#pragma unroll
        for (int e = 0; e < NE; ++e) lg[e] = 0.f;
#pragma unroll
        for (int j = 0; j < 4; ++j) { const int k0 = 4 * (lane + 64 * j); const f32x4v g4 = *(const f32x4v*)(g + k0), sc4 = *(const f32x4v*)(m + sc_off + k0), sh4 = *(const f32x4v*)(m + sh_off + k0);
            const f32x4v o = v[q][j] * rstd * g4 * (sc4 + 1.0f) + sh4;
            if (f8) { int w8 = 0; w8 = __builtin_amdgcn_cvt_pk_fp8_f32(o.x, o.y, w8, false); w8 = __builtin_amdgcn_cvt_pk_fp8_f32(o.z, o.w, w8, true); *(int*)((unsigned char*)out + (size_t)r * D + k0) = w8; }
            else *(uint2*)(out + (size_t)r * D + k0) = make_uint2(cvt_pk_bf16(o.x, o.y), cvt_pk_bf16(o.z, o.w));
            if (wr) {
#pragma unroll
                for (int i = 0; i < 4; ++i) { const f32x4v w0 = *(const f32x4v*)(wr + (size_t)(k0 + i) * NE), w1 = *(const f32x4v*)(wr + (size_t)(k0 + i) * NE + 4); const float ov = o[i];
                    lg[0] += ov * w0.x; lg[1] += ov * w0.y; lg[2] += ov * w0.z; lg[3] += ov * w0.w; lg[4] += ov * w1.x; lg[5] += ov * w1.y; lg[6] += ov * w1.z; lg[7] += ov * w1.w; } } }
        if (wr) {
#pragma unroll
            for (int e = 0; e < NE; ++e) lg[e] = wave_sum(lg[e]);
            int e0 = 0; float b0 = lg[0];
#pragma unroll
            for (int e = 1; e < NE; ++e) if (lg[e] > b0) { b0 = lg[e]; e0 = e; }
            int e1 = -1; float b1 = -3.0e38f;
#pragma unroll
            for (int e = 0; e < NE; ++e) if (e != e0 && lg[e] > b1) { b1 = lg[e]; e1 = e; }
            const float w1 = 1.0f / (1.0f + expf(b1 - b0)); const bool skip = skip_ctx && ((r % RPB) < CTX);
            if (lane == 0) { rt_e[2 * r] = skip ? -1 : e0; rt_e[2 * r + 1] = skip ? -1 : e1; rt_w[2 * r] = w1; rt_w[2 * r + 1] = 1.0f - w1;
                if (!skip) { atomicAdd(&segcnt[(size_t)e0 * nseg + r / 64], 1); atomicAdd(&segcnt[(size_t)e1 * nseg + r / 64], 1); } } }
        }
    } };
struct MoePrefixW { int n; int nseg; int* segcnt; int* ecnt;
    __device__ __forceinline__ void wave(int e, int lane, PG8_LAS unsigned char*) const { constexpr int PER = ((NR + 63) / 64 + 63) / 64; int v[PER]; int tot = 0;
#pragma unroll
        for (int k = 0; k < PER; ++k) { const int sg = lane * PER + k; v[k] = sg < nseg ? segcnt[(size_t)e * nseg + sg] : 0; tot += v[k]; }
        int incl = tot;
#pragma unroll
        for (int o = 1; o < 64; o <<= 1) { const int t = __shfl_up(incl, o); if (lane >= o) incl += t; }
        int run = incl - tot;
#pragma unroll
        for (int k = 0; k < PER; ++k) { const int sg = lane * PER + k; if (sg < nseg) segcnt[(size_t)e * nseg + sg] = run; run += v[k]; }
        if (lane == 63) ecnt[e] = incl; } };
struct CombineNormW { int n; int mode; int g_off; int pad; float* h; const bf16* yrow; const int* rt_e; const float* rt_w; const int* rt_dest; const float* modc; const float* gn; const float* modn; bf16* outb; float* outf;
    __device__ __forceinline__ void wave(int r, int lane, PG8_LAS unsigned char*) const {
        const int t = r % RPB; if (mode == 1 && t < CTX) return;
        f32x4v* hr = (f32x4v*)(h + (size_t)r * D) + lane; f32x4v v[4];
#pragma unroll
        for (int j = 0; j < 4; ++j) v[j] = hr[64 * j];
        const int e0 = rt_e[2 * r];
        if (e0 >= 0) { const size_t d0 = (size_t)rt_dest[2 * r], d1 = (size_t)rt_dest[2 * r + 1]; const float w0 = rt_w[2 * r], w1 = rt_w[2 * r + 1]; const float* gt = modc + (size_t)mod_index(r) * 6 * D + g_off;
            uint2 y0[4], y1[4]; f32x4v g4[4];
#pragma unroll
            for (int j = 0; j < 4; ++j) { const int k0 = 4 * (lane + 64 * j); y0[j] = *(const uint2*)(yrow + d0 * D + k0); y1[j] = *(const uint2*)(yrow + d1 * D + k0); g4[j] = *(const f32x4v*)(gt + k0); }
#pragma unroll
            for (int j = 0; j < 4; ++j) { f32x4v y;
                y.x = w0 * __uint_as_float(y0[j].x << 16) + w1 * __uint_as_float(y1[j].x << 16); y.y = w0 * __uint_as_float(y0[j].x & 0xffff0000u) + w1 * __uint_as_float(y1[j].x & 0xffff0000u);
                y.z = w0 * __uint_as_float(y0[j].y << 16) + w1 * __uint_as_float(y1[j].y << 16); y.w = w0 * __uint_as_float(y0[j].y & 0xffff0000u) + w1 * __uint_as_float(y1[j].y & 0xffff0000u);
                v[j] += g4[j] * y; }
            if (mode == 0) {
#pragma unroll
                for (int j = 0; j < 4; ++j) hr[64 * j] = v[j]; } }
        float ss = 0.f;
#pragma unroll
        for (int j = 0; j < 4; ++j) ss += (v[j].x * v[j].x + v[j].y * v[j].y) + (v[j].z * v[j].z + v[j].w * v[j].w);
        const float rstd = 1.0f / sqrtf(wave_sum(ss) * (1.0f / D) + EPS);
        if (mode == 0) { const float* m = modn + (size_t)mod_index(r) * 6 * D;
#pragma unroll
            for (int j = 0; j < 4; ++j) { const int k0 = 4 * (lane + 64 * j); const f32x4v g4 = *(const f32x4v*)(gn + k0), sc4 = *(const f32x4v*)(m + D + k0), sh4 = *(const f32x4v*)(m + k0);
                const f32x4v o = v[j] * rstd * g4 * (sc4 + 1.0f) + sh4; *(uint2*)(outb + (size_t)r * D + k0) = make_uint2(cvt_pk_bf16(o.x, o.y), cvt_pk_bf16(o.z, o.w)); }
        } else { const int b = r / RPB, tl = t - CTX;
#pragma unroll
            for (int j = 0; j < 4; ++j) { const int k0 = 4 * (lane + 64 * j); *(f32x4v*)(outf + ((size_t)b * SEQ + tl) * D + k0) = v[j] * rstd * *(const f32x4v*)(gn + k0); } } } };
struct FinalNormW { int n; int pad; const float* h; const float* g; float* out;
    __device__ __forceinline__ void wave(int x, int lane, PG8_LAS unsigned char*) const { const int b = x / SEQ, tl = x % SEQ;
        const f32x4v* hr = (const f32x4v*)(h + ((size_t)b * RPB + CTX + tl) * D) + lane; f32x4v v[4]; float ss = 0.f;
#pragma unroll
        for (int j = 0; j < 4; ++j) { v[j] = hr[64 * j]; ss += (v[j].x * v[j].x + v[j].y * v[j].y) + (v[j].z * v[j].z + v[j].w * v[j].w); }
        const float rstd = 1.0f / sqrtf(wave_sum(ss) * (1.0f / D) + EPS);
#pragma unroll
        for (int j = 0; j < 4; ++j) { const int k0 = 4 * (lane + 64 * j); *(f32x4v*)(out + (size_t)x * D + k0) = v[j] * rstd * *(const f32x4v*)(g + k0); } } };
struct TransW { int n; int K, N, rs, ro, f8; const float* src; bf16* dst; size_t sstride, dstride;
    __device__ __forceinline__ void loadt(f32x4v (&v)[8], int tile, int lane) const { const int nblk = N / 32, ipm = (K / 64) * nblk; const int mat = tile / ipm, r = tile % ipm, kb = r / nblk, nb = r % nblk;
        const float* W = src + (size_t)mat * sstride + (size_t)(64 * kb + (lane >> 3)) * N + 32 * nb + 4 * (lane & 7);
#pragma unroll
        for (int i = 0; i < 8; ++i) v[i] = *(const f32x4v*)(W + (size_t)(8 * i) * N); }
    __device__ __forceinline__ void emit(const f32x4v (&v)[8], int tile, int lane, PG8_LAS float* scr) const { const int nblk = N / 32, ipm = (K / 64) * nblk; const int mat = tile / ipm, r = tile % ipm, kb = r / nblk, nb = r % nblk, k0 = 64 * kb, n0 = 32 * nb;
        const int kr = lane >> 3, nq = lane & 7;
#pragma unroll
        for (int i = 0; i < 8; ++i) { PG8_LAS float* sp = scr + (8 * i + kr) * 33 + 4 * nq; sp[0] = v[i].x; sp[1] = v[i].y; sp[2] = v[i].z; sp[3] = v[i].w; }
        LDS_WAIT();
        const int c = lane & 7;
        if (f8) { unsigned char* WT8 = (unsigned char*)dst + (size_t)mat * dstride; const float sc = __builtin_amdgcn_ldexpf(1.0f, f8);
#pragma unroll
            for (int j = 0; j < 4; ++j) { const int nn = (lane >> 3) + 8 * j; const PG8_LAS float* sp = scr + (8 * c) * 33 + nn; int w0 = 0, w1 = 0;
                w0 = __builtin_amdgcn_cvt_pk_fp8_f32(sp[0 * 33] * sc, sp[1 * 33] * sc, w0, false); w0 = __builtin_amdgcn_cvt_pk_fp8_f32(sp[2 * 33] * sc, sp[3 * 33] * sc, w0, true);
                w1 = __builtin_amdgcn_cvt_pk_fp8_f32(sp[4 * 33] * sc, sp[5 * 33] * sc, w1, false); w1 = __builtin_amdgcn_cvt_pk_fp8_f32(sp[6 * 33] * sc, sp[7 * 33] * sc, w1, true);
                *(uint2*)(WT8 + ((size_t)(n0 + nn) * rs + ro) * K + k0 + 8 * c) = make_uint2((unsigned)w0, (unsigned)w1); }
        } else { bf16* WT = dst + (size_t)mat * dstride;
#pragma unroll
            for (int j = 0; j < 4; ++j) { const int nn = (lane >> 3) + 8 * j; const PG8_LAS float* sp = scr + (8 * c) * 33 + nn;
                uint4 o; o.x = cvt_pk_bf16(sp[0 * 33], sp[1 * 33]); o.y = cvt_pk_bf16(sp[2 * 33], sp[3 * 33]); o.z = cvt_pk_bf16(sp[4 * 33], sp[5 * 33]); o.w = cvt_pk_bf16(sp[6 * 33], sp[7 * 33]);
                *(uint4*)(WT + ((size_t)(n0 + nn) * rs + ro) * K + k0 + 8 * c) = o; } }
        LDS_WAIT(); }
    __device__ __forceinline__ void wave(int item, int lane, PG8_LAS unsigned char* lw) const {
        PG8_LAS float* scr = (PG8_LAS float*)lw;
        const int t0 = 2 * item, t1 = 2 * item + 1; const bool two = t1 < tiles; f32x4v va[8], vb[8];
        loadt(va, t0, lane); if (two) loadt(vb, t1, lane);
        emit(va, t0, lane, scr); if (two) emit(vb, t1, lane, scr);
    } int tiles, pad2; };

template <int MT, int NT, int KS, class PA, class PB>
__device__ __forceinline__ void wave_mma(PA A, int lda, PB Bt, int ldb, pg8::f32x4 (&acc)[MT][NT], int lane) {
    const int r = lane & 15, q = lane >> 4;
#pragma unroll
    for (int ks = 0; ks < KS; ++ks) { pg8::bf16x8 a[MT], b[NT];
#pragma unroll
        for (int m = 0; m < MT; ++m) a[m] = *(const pg8::bf16x8*)(A + (size_t)(m * 16 + r) * lda + ks * 32 + q * 8);
#pragma unroll
        for (int n = 0; n < NT; ++n) b[n] = *(const pg8::bf16x8*)(Bt + (size_t)(n * 16 + r) * ldb + ks * 32 + q * 8);
#pragma unroll
        for (int m = 0; m < MT; ++m)
#pragma unroll
            for (int n = 0; n < NT; ++n) acc[m][n] = __builtin_amdgcn_mfma_f32_16x16x32_bf16(a[m], b[n], acc[m][n], 0, 0, 0); }
}
__device__ __forceinline__ float chunk_cumsum(float x, int d, int lane, float& tot) { float pre = x;
#pragma unroll
    for (int o = 1; o < 64; o <<= 1) { const float t = __shfl_up(pre, o); if (lane >= o) pre += t; }
    tot = __shfl(pre, 63); return d == 0 ? pre : tot - pre + x; }
struct MlPrepW2 { int n; int pad; const bf16* p; const float* cw; const float* cb; const float* gb; bf16* lab;
    __device__ __forceinline__ void wave(int it, int lane, PG8_LAS unsigned char* lw) const { typedef LaLay<96, 112> L;
        const int hh = it & 3; int y = it >> 2; const int blk = y % NBLK; y /= NBLK; const int b = y % NB, d = y / NB; const size_t item = ((size_t)b * NBLK + blk) * 4 + hh;
        const int tb = blk * 64; const size_t rb = (size_t)b * RPB + tb; const bool first_blk = (tb == 0 || tb == CTX), last_blk = (tb + 63 == CTX - 1 || tb + 63 == RPB - 1);
        PG8_LAS bf16* X = (PG8_LAS bf16*)lw; PG8_LAS float* SQ = (PG8_LAS float*)(lw + 14336); PG8_LAS float* SK = SQ + 64;
        { const bf16* pr = p + (rb + lane) * PS; const float gI = bf2f(pr[MG + (2 * d) * 4 + hh]) + gb[(2 * d) * 4 + hh], gF = bf2f(pr[MG + (2 * d + 1) * 4 + hh]) + gb[(2 * d + 1) * 4 + hh];
          float tot; const float Fc = chunk_cumsum(logsigmoidf_(gF), d, lane, tot); SQ[lane] = fexp(Fc); SK[lane] = fexp(gI - Fc) * 0.10206207261596577f;
          float* dec = (float*)(lab + L::dec) + ((size_t)d * LA_NI + item) * 96; const float dv = fexp(tot); dec[lane] = dv; if (lane < 32) dec[64 + lane] = dv; }
#pragma unroll 1
        for (int mat = 0; mat < 2; ++mat) { const int col0 = MQ + mat * 384 + hh * 96;
            pg8::v4i_t v[13];
#pragma unroll
            for (int k = 0; k < 13; ++k) { const int pi = lane + 64 * k, rw = pi / 12, c = pi % 12; const bool zero = (pi >= 792) || (rw == 0 && first_blk) || (rw == 65 && last_blk);
                v[k] = (pg8::v4i_t){0, 0, 0, 0}; if (!zero) v[k] = *(const pg8::v4i_t*)(p + (rb + rw - 1) * PS + col0 + c * 8); }
#pragma unroll
            for (int k = 0; k < 13; ++k) { const int pi = lane + 64 * k, rw = pi / 12, c = pi % 12; if (pi < 792) *(PG8_LAS pg8::v4i_t*)(X + rw * 104 + c * 8) = v[k]; }
            LDS_WAIT();
            unsigned o0[32], o1[32];
            const PG8_LAS float* SC = mat ? SK : SQ;
#pragma unroll
            for (int ps = 0; ps < 2; ++ps) { const int i = lane + 64 * ps; const bool act = i < 96; const int ci = mat * 384 + hh * 96 + (act ? i : 0);
                const float w0 = cw[ci], w1 = cw[768 + ci], w2 = cw[1536 + ci], bs = cb[ci]; const PG8_LAS bf16* xc = X + (act ? i : 0);
                float xa = bf2f(xc[0]), xb = bf2f(xc[104]);
#pragma unroll
                for (int s2 = 0; s2 < 32; ++s2) { const float x2 = bf2f(xc[(2 * s2 + 2) * 104]), x3 = bf2f(xc[(2 * s2 + 3) * 104]);
                    const float va = siluf(w0 * xa + w1 * xb + w2 * x2 + bs) * SC[2 * s2], vb = siluf(w0 * xb + w1 * x2 + w2 * x3 + bs) * SC[2 * s2 + 1];
                    const unsigned pk = cvt_pk_bf16(va, vb); if (ps == 0) o0[s2] = pk; else o1[s2] = pk; xa = x2; xb = x3; } }
            LDS_WAIT();
#pragma unroll
            for (int s2 = 0; s2 < 32; ++s2) { const int c0 = lane, t0 = 2 * s2;
                X[((t0 >> 4) * 3 + (c0 >> 5)) * 512 + ((((c0 & 31) >> 3) << 4) + (t0 & 15)) * 8 + (c0 & 7)] = (bf16)(o0[s2] & 0xffffu); X[((t0 >> 4) * 3 + (c0 >> 5)) * 512 + ((((c0 & 31) >> 3) << 4) + ((t0 + 1) & 15)) * 8 + (c0 & 7)] = (bf16)(o0[s2] >> 16);
                if (lane < 32) { const int c1 = 64 + lane; X[((t0 >> 4) * 3 + (c1 >> 5)) * 512 + ((((c1 & 31) >> 3) << 4) + (t0 & 15)) * 8 + (c1 & 7)] = (bf16)(o1[s2] & 0xffffu); X[((t0 >> 4) * 3 + (c1 >> 5)) * 512 + ((((c1 & 31) >> 3) << 4) + ((t0 + 1) & 15)) * 8 + (c1 & 7)] = (bf16)(o1[s2] >> 16); } }
            LDS_WAIT();
            { bf16* dst = lab + (mat ? L::kin : L::qin) + ((size_t)d * LA_NI + item) * 64 * 96;
#pragma unroll
              for (int k = 0; k < 12; ++k) { const int pi = lane + 64 * k; const pg8::v4i_t w = *(const PG8_LAS pg8::v4i_t*)(X + pi * 8); *(pg8::v4i_t*)(dst + (size_t)pi * 8) = w; } }
            LDS_WAIT();
            if (mat == 1) {
#pragma unroll
                for (int s2 = 0; s2 < 32; ++s2) { const int c0 = lane, t0 = 2 * s2;
                    *(PG8_LAS unsigned*)(X + ((c0 >> 4) * 2 + (t0 >> 5)) * 512 + ((((t0 & 31) >> 3) << 4) + (c0 & 15)) * 8 + (t0 & 7)) = o0[s2];
                    if (lane < 32) { const int c1 = 64 + lane; *(PG8_LAS unsigned*)(X + ((c1 >> 4) * 2 + (t0 >> 5)) * 512 + ((((t0 & 31) >> 3) << 4) + (c1 & 15)) * 8 + (t0 & 7)) = o1[s2]; } }
                LDS_WAIT();
                bf16* dst = lab + L::koutT + ((size_t)d * LA_NI + item) * 96 * 64;
#pragma unroll
                for (int k = 0; k < 12; ++k) { const int pi = lane + 64 * k; const pg8::v4i_t w = *(const PG8_LAS pg8::v4i_t*)(X + pi * 8); *(pg8::v4i_t*)(dst + (size_t)pi * 8) = w; }
                LDS_WAIT(); } } } };

struct GlaPrepW2 { int n; int pad; const bf16* p; const float* wa2; const float* ba; bf16* lab;
    __device__ __forceinline__ void wave(int it, int lane, PG8_LAS unsigned char* lw) const { typedef LaLay<64, 96> L;
        const int hh = it & 3; int y = it >> 2; const int blk = y % NBLK; y /= NBLK; const int b = y % NB, d = y / NB; const size_t item = ((size_t)b * NBLK + blk) * 4 + hh; const size_t rb = (size_t)b * RPB + blk * 64;
        PG8_LAS bf16* LR = (PG8_LAS bf16*)lw; PG8_LAS bf16* Q = LR + 64 * 16; PG8_LAS bf16* K = Q + 64 * 48; PG8_LAS bf16* X = (PG8_LAS bf16*)lw;
        pg8::v4i_t v[14];
#pragma unroll
        for (int k = 0; k < 2; ++k) { const int pi = lane + 64 * k; v[k] = *(const pg8::v4i_t*)(p + (rb + (pi >> 1)) * PS + GLR + (pi & 1) * 8); }
#pragma unroll
        for (int k = 0; k < 6; ++k) { const int pi = lane + 64 * k, rw = pi / 6, c = pi % 6; v[2 + k] = *(const pg8::v4i_t*)(p + (rb + rw) * PS + GQ + hh * 48 + c * 8); v[8 + k] = *(const pg8::v4i_t*)(p + (rb + rw) * PS + GK + hh * 48 + c * 8); }
#pragma unroll
        for (int k = 0; k < 2; ++k) { const int pi = lane + 64 * k; *(PG8_LAS pg8::v4i_t*)(LR + pi * 8) = v[k]; }
#pragma unroll
        for (int k = 0; k < 6; ++k) { const int pi = lane + 64 * k; *(PG8_LAS pg8::v4i_t*)(Q + pi * 8) = v[2 + k]; *(PG8_LAS pg8::v4i_t*)(K + pi * 8) = v[8 + k]; }
        LDS_WAIT();
        const bool act = lane < 48; const int i = act ? lane : 0; const int j = hh * 48 + i; float w[16];
#pragma unroll
        for (int q = 0; q < 16; ++q) w[q] = wa2[((size_t)d * 16 + q) * 192 + j];
        const float bj = ba[d * 192 + j]; float c = 0.f; unsigned oq[32], ok[32];
#pragma unroll
        for (int p2 = 0; p2 < 32; ++p2) { float qv[2], kv[2];
#pragma unroll
            for (int h2 = 0; h2 < 2; ++h2) { const int pp = 2 * p2 + h2; const int tok = d == 0 ? pp : 63 - pp; const pg8::v4i_t l0 = *(const PG8_LAS pg8::v4i_t*)(LR + tok * 16), l1 = *(const PG8_LAS pg8::v4i_t*)(LR + tok * 16 + 8);
                const unsigned u[8] = {(unsigned)l0.x, (unsigned)l0.y, (unsigned)l0.z, (unsigned)l0.w, (unsigned)l1.x, (unsigned)l1.y, (unsigned)l1.z, (unsigned)l1.w}; float z = bj;
#pragma unroll
                for (int q = 0; q < 8; ++q) { z += __uint_as_float(u[q] << 16) * w[2 * q]; z += __uint_as_float(u[q] & 0xffff0000u) * w[2 * q + 1]; }
                c += logsigmoidf_(z) * (1.0f / 16.0f); qv[h2] = bf2f(Q[tok * 48 + i]) * 0.14433756729740643f * fexp(c); kv[h2] = bf2f(K[tok * 48 + i]) * fexp(-c); }
            oq[p2] = act ? cvt_pk_bf16(qv[0], qv[1]) : 0u; ok[p2] = act ? cvt_pk_bf16(kv[0], kv[1]) : 0u; }
        { float* dec = (float*)(lab + L::dec) + ((size_t)d * LA_NI + item) * 64; dec[lane] = act ? fexp(c) : 0.f; }
        LDS_WAIT();
#pragma unroll 1
        for (int im = 0; im < 2; ++im) {
#pragma unroll
            for (int p2 = 0; p2 < 32; ++p2) { const unsigned o = im ? ok[p2] : oq[p2]; const int ta = d == 0 ? 2 * p2 : 63 - 2 * p2, tb2 = d == 0 ? 2 * p2 + 1 : 62 - 2 * p2; const int cb = (lane >> 5) * 512 + (((lane & 31) >> 3) << 4) * 8 + (lane & 7);
                X[(ta >> 4) * 1024 + cb + (ta & 15) * 8] = (bf16)(o & 0xffffu); X[(tb2 >> 4) * 1024 + cb + (tb2 & 15) * 8] = (bf16)(o >> 16); }
            LDS_WAIT();
            bf16* dst = lab + (im ? L::kin : L::qin) + ((size_t)d * LA_NI + item) * 64 * 64;
#pragma unroll
            for (int k = 0; k < 8; ++k) { const int pi = lane + 64 * k; const pg8::v4i_t wv = *(const PG8_LAS pg8::v4i_t*)(X + pi * 8); *(pg8::v4i_t*)(dst + (size_t)pi * 8) = wv; }
            LDS_WAIT(); }
#pragma unroll
        for (int p2 = 0; p2 < 32; ++p2) { const unsigned o = ok[p2]; const int tl = d == 0 ? 2 * p2 : 62 - 2 * p2; const unsigned ov = d == 0 ? o : ((o >> 16) | (o << 16));
            *(PG8_LAS unsigned*)(X + ((lane >> 4) * 2 + (tl >> 5)) * 512 + ((((tl & 31) >> 3) << 4) + (lane & 15)) * 8 + (tl & 7)) = ov; }
        LDS_WAIT();
        { bf16* dst = lab + L::koutT + ((size_t)d * LA_NI + item) * 64 * 64;
#pragma unroll
          for (int k = 0; k < 8; ++k) { const int pi = lane + 64 * k; const pg8::v4i_t wv = *(const PG8_LAS pg8::v4i_t*)(X + pi * 8); *(pg8::v4i_t*)(dst + (size_t)pi * 8) = wv; } }
        LDS_WAIT(); } };

template <int NV, int VOFF> struct VTW { int n; int pad; const bf16* p; bf16* vT;
    __device__ __forceinline__ void wave(int it, int lane, PG8_LAS unsigned char* lw) const { const int hh = it & 3; const int bb = it >> 2; const size_t r0 = (size_t)(bb / NBLK) * RPB + (bb % NBLK) * 64;
        PG8_LAS bf16* t = (PG8_LAS bf16*)lw; pg8::v4i_t v[12];
#pragma unroll
        for (int k = 0; k < 12; ++k) { const int pi = lane + 64 * k, rw = pi / 12, c = pi % 12; v[k] = *(const pg8::v4i_t*)(p + (r0 + rw) * PS + VOFF + hh * 96 + c * 8); }
#pragma unroll
        for (int k = 0; k < 12; ++k) { const int pi = lane + 64 * k, rw = pi / 12, c = pi % 12; *(PG8_LAS pg8::v4i_t*)(t + rw * 104 + c * 8) = v[k]; }
        LDS_WAIT();
        bf16* o = vT + (size_t)it * NV * 64 + (size_t)lane * 8; const int jr = lane & 15, sq = (lane >> 4) * 8;
#pragma unroll
        for (int jt = 0; jt < 6; ++jt)
#pragma unroll
            for (int ks = 0; ks < 2; ++ks) { const PG8_LAS bf16* c0 = t + (ks * 32 + sq) * 104 + jt * 16 + jr; pg8::v4i_t w;
                w.x = (int)((unsigned)c0[0] | ((unsigned)c0[104] << 16)); w.y = (int)((unsigned)c0[208] | ((unsigned)c0[312] << 16)); w.z = (int)((unsigned)c0[416] | ((unsigned)c0[520] << 16)); w.w = (int)((unsigned)c0[624] | ((unsigned)c0[728] << 16));
                *(pg8::v4i_t*)(o + (jt * 2 + ks) * 512) = w; }
        if (NV > 96) { const int f = jr == 0 ? 0x3f803f80 : 0; const pg8::v4i_t w = {f, f, f, f};
#pragma unroll
            for (int ks = 0; ks < 2; ++ks) *(pg8::v4i_t*)(o + (12 + ks) * 512) = w; }
        LDS_WAIT(); } };

template <int DKP, int NV, int NG> struct ChainW { int n; int pad; bf16* lab;
    static constexpr int CG = DKP / (16 * NG), MT = NV / 16;
    struct Fr { pg8::bf16x8 a[2]; pg8::bf16x8 b[NG][2]; float dc[NG]; };
    __device__ __forceinline__ void load(Fr& f, int d, int b, int hh, int jt, int cg, int step, int r, int q) const { typedef LaLay<DKP, NV> L; const int blk = chain_blk(d, step); const size_t item = ((size_t)b * NBLK + blk) * 4 + hh; const int ln = q * 16 + r;
        const bf16* A = lab + L::vT + item * NV * 64 + ((size_t)(jt * 2) * 64 + ln) * 8; const bf16* Bt = lab + L::koutT + ((size_t)d * LA_NI + item) * DKP * 64 + ((size_t)(cg * NG * 2) * 64 + ln) * 8;
        const float* dec = (const float*)(lab + L::dec) + ((size_t)d * LA_NI + item) * DKP + cg * (16 * NG) + r;
#pragma unroll
        for (int ks = 0; ks < 2; ++ks) f.a[ks] = *(const pg8::bf16x8*)(A + ks * 512);
#pragma unroll
        for (int nn = 0; nn < NG; ++nn) {
#pragma unroll
            for (int ks = 0; ks < 2; ++ks) f.b[nn][ks] = *(const pg8::bf16x8*)(Bt + (nn * 2 + ks) * 512);
            f.dc[nn] = dec[nn * 16]; } }
    __device__ __forceinline__ void process(const Fr& f, pg8::f32x4 (&S)[NG], int d, int b, int hh, int jt, int cg, int step, int r, int q, PG8_LAS unsigned char* lw) const { typedef LaLay<DKP, NV> L;
        pg8::f32x4 acc[NG];
#pragma unroll
        for (int nn = 0; nn < NG; ++nn) acc[nn] = (pg8::f32x4){0.f, 0.f, 0.f, 0.f};
#pragma unroll
        for (int ks = 0; ks < 2; ++ks)
#pragma unroll
            for (int nn = 0; nn < NG; ++nn) acc[nn] = __builtin_amdgcn_mfma_f32_16x16x32_bf16(f.a[ks], f.b[nn][ks], acc[nn], 0, 0, 0);
        const int blk = chain_blk(d, step); const size_t item = ((size_t)b * NBLK + blk) * 4 + hh; PG8_LAS bf16* lt = (PG8_LAS bf16*)lw;
#pragma unroll
        for (int nn = 0; nn < NG; ++nn)
#pragma unroll
            for (int e = 0; e < 4; ++e) { const int col = nn * 16 + r; lt[(col >> 5) * 512 + ((((col & 31) >> 3) << 4) + q * 4 + e) * 8 + (col & 7)] = f2bf(S[nn][e]); S[nn][e] = f.dc[nn] * (S[nn][e] + acc[nn][e]); }
        LDS_WAIT();
        bf16* out = lab + L::sT + ((size_t)d * LA_NI + item) * NV * DKP + ((size_t)(jt * (DKP / 32) + cg * (NG / 2)) * 64 + q * 16 + r) * 8;
#pragma unroll
        for (int tl = 0; tl < NG / 2; ++tl) { const pg8::v4i_t pv = *(const PG8_LAS pg8::v4i_t*)(lt + (tl * 64 + q * 16 + r) * 8); *(pg8::v4i_t*)(out + tl * 512) = pv; }
        LDS_WAIT(); }
    __device__ __forceinline__ void wave(int it, int lane, PG8_LAS unsigned char* lw) const {
        const int cg = it % CG; int c = it / CG; const int jt = c % MT; c /= MT; const int hh = c % 4; c /= 4; const int b = c % NB, d = c / NB; const int r = lane & 15, q = lane >> 4;
        pg8::f32x4 S[NG];
#pragma unroll
        for (int nn = 0; nn < NG; ++nn) S[nn] = (pg8::f32x4){0.f, 0.f, 0.f, 0.f};
        auto cl = [](int st) { return st < NBLK ? st : NBLK - 1; };
        Fr f0, f1, f2, f3; load(f0, d, b, hh, jt, cg, 0, r, q); load(f1, d, b, hh, jt, cg, cl(1), r, q); load(f2, d, b, hh, jt, cg, cl(2), r, q);
        static_assert(NBLK % 4 == 0 || NBLK < 4, "ChainW walks the chain four blocks per trip");
        for (int step = 0; step + 3 < NBLK; step += 4) {
            load(f3, d, b, hh, jt, cg, step + 3, r, q);
            process(f0, S, d, b, hh, jt, cg, step, r, q, lw);
            load(f0, d, b, hh, jt, cg, cl(step + 4), r, q);
            process(f1, S, d, b, hh, jt, cg, step + 1, r, q, lw);
            load(f1, d, b, hh, jt, cg, cl(step + 5), r, q);
            process(f2, S, d, b, hh, jt, cg, step + 2, r, q, lw);
            load(f2, d, b, hh, jt, cg, cl(step + 6), r, q);
            process(f3, S, d, b, hh, jt, cg, step + 3, r, q, lw); }
        if (NBLK < 4) { process(f0, S, d, b, hh, jt, cg, 0, r, q, lw); if (NBLK > 1) process(f1, S, d, b, hh, jt, cg, 1, r, q, lw); if (NBLK > 2) process(f2, S, d, b, hh, jt, cg, 2, r, q, lw); } } };
template <int DKP, int NV, bool ISML> struct OutW { int n; int pad; const bf16* lab; const bf16* p; const float* gain; bf16* mix;
    __device__ __forceinline__ void wave(int it, int lane, PG8_LAS unsigned char* lw) const { typedef LaLay<DKP, NV> L; constexpr int NT = NV / 16, KQ = DKP / 32; typedef pg8::bf16x8 frag;
        const size_t item = (size_t)(it >> 1); const int half = it & 1, hh = (int)(item % 4); const size_t bb = item / 4; const size_t r0 = (bb / NBLK) * RPB + (bb % NBLK) * 64; const int t0 = half * 32;
        const int r = lane & 15, q = lane >> 4; PG8_LAS bf16* latt = (PG8_LAS bf16*)lw;
        pg8::f32x4 acc[2][NT], hs[2][6];
#pragma unroll
        for (int m = 0; m < 2; ++m) {
#pragma unroll
            for (int nn = 0; nn < NT; ++nn) acc[m][nn] = (pg8::f32x4){0.f, 0.f, 0.f, 0.f};
#pragma unroll
            for (int nn = 0; nn < 6; ++nn) hs[m][nn] = (pg8::f32x4){0.f, 0.f, 0.f, 0.f}; }
        const bf16* vp = lab + L::vT + item * NV * 64 + (size_t)lane * 8;
#pragma unroll
        for (int d = 0; d < 2; ++d) {
            const bf16* qp = lab + L::qin + ((size_t)d * LA_NI + item) * 64 * DKP + ((size_t)(t0 / 16) * KQ * 64 + lane) * 8; const bf16* kp = lab + L::kin + ((size_t)d * LA_NI + item) * 64 * DKP + (size_t)lane * 8;
            const bf16* sp = lab + L::sT + ((size_t)d * LA_NI + item) * NV * DKP + (size_t)lane * 8;
            frag qa[2][KQ], sf[NT][KQ];
#pragma unroll
            for (int m = 0; m < 2; ++m)
#pragma unroll
                for (int ks = 0; ks < KQ; ++ks) qa[m][ks] = *(const frag*)(qp + (m * KQ + ks) * 512);
#pragma unroll
            for (int nn = 0; nn < NT; ++nn)
#pragma unroll
                for (int ks = 0; ks < KQ; ++ks) sf[nn][ks] = *(const frag*)(sp + (nn * KQ + ks) * 512);
            frag kf[4][KQ], vf[NT][2];
            if constexpr (!ISML) {
#pragma unroll
                for (int nn = 0; nn < 4; ++nn)
#pragma unroll
                    for (int ks = 0; ks < KQ; ++ks) kf[nn][ks] = *(const frag*)(kp + (nn * KQ + ks) * 512);
#pragma unroll
                for (int nn = 0; nn < NT; ++nn)
#pragma unroll
                    for (int ks = 0; ks < 2; ++ks) vf[nn][ks] = *(const frag*)(vp + (nn * 2 + ks) * 512); }
#pragma unroll
            for (int ks = 0; ks < KQ; ++ks)
#pragma unroll
                for (int m = 0; m < 2; ++m)
#pragma unroll
                    for (int nn = 0; nn < NT; ++nn) acc[m][nn] = __builtin_amdgcn_mfma_f32_16x16x32_bf16(qa[m][ks], sf[nn][ks], acc[m][nn], 0, 0, 0);
            if constexpr (ISML) {
#pragma unroll
            for (int nn = 0; nn < 4; ++nn)
#pragma unroll
                for (int ks = 0; ks < KQ; ++ks) kf[nn][ks] = *(const frag*)(kp + (nn * KQ + ks) * 512); }
            pg8::f32x4 at[2][4];
#pragma unroll
            for (int m = 0; m < 2; ++m)
#pragma unroll
                for (int nn = 0; nn < 4; ++nn) at[m][nn] = (pg8::f32x4){0.f, 0.f, 0.f, 0.f};
#pragma unroll
            for (int ks = 0; ks < KQ; ++ks)
#pragma unroll
                for (int m = 0; m < 2; ++m)
#pragma unroll
                    for (int nn = 0; nn < 4; ++nn) at[m][nn] = __builtin_amdgcn_mfma_f32_16x16x32_bf16(qa[m][ks], kf[nn][ks], at[m][nn], 0, 0, 0);
            if constexpr (ISML) {
#pragma unroll
            for (int nn = 0; nn < NT; ++nn)
#pragma unroll
                for (int ks = 0; ks < 2; ++ks) vf[nn][ks] = *(const frag*)(vp + (nn * 2 + ks) * 512); }
#pragma unroll
            for (int m = 0; m < 2; ++m)
#pragma unroll
                for (int nn = 0; nn < 4; ++nn)
#pragma unroll
                    for (int e = 0; e < 4; ++e) { const int tl = m * 16 + q * 4 + e, tt = t0 + tl, sx = nn * 16 + r; const bool valid = d == 0 ? (sx <= tt) : (sx >= tt);
                        latt[tl * 72 + sx] = f2bf(valid ? at[m][nn][e] : 0.f); }
            LDS_WAIT();
            frag af[2][2];
#pragma unroll
            for (int m = 0; m < 2; ++m)
#pragma unroll
                for (int ks = 0; ks < 2; ++ks) af[m][ks] = *(const PG8_LAS frag*)(latt + (m * 16 + r) * 72 + ks * 32 + q * 8);
#pragma unroll
            for (int ks = 0; ks < 2; ++ks)
#pragma unroll
                for (int m = 0; m < 2; ++m)
#pragma unroll
                    for (int nn = 0; nn < NT; ++nn) acc[m][nn] = __builtin_amdgcn_mfma_f32_16x16x32_bf16(af[m][ks], vf[nn][ks], acc[m][nn], 0, 0, 0);
            LDS_WAIT();
            if (ISML) {
#pragma unroll
                for (int m = 0; m < 2; ++m)
#pragma unroll
                    for (int e = 0; e < 4; ++e) { const float den = __shfl(acc[m][NT - 1][e], lane & 48); const float inv = 1.0f / fmaxf(fabsf(den), 1.0f);
#pragma unroll
                        for (int nn = 0; nn < 6; ++nn) { hs[m][nn][e] += acc[m][nn][e] * inv; acc[m][nn][e] = 0.f; }
                        acc[m][NT - 1][e] = 0.f; } } }
#pragma unroll
        for (int m = 0; m < 2; ++m)
#pragma unroll
            for (int e = 0; e < 4; ++e) { float ss = 0.f;
#pragma unroll
                for (int nn = 0; nn < 6; ++nn) { const float o = ISML ? hs[m][nn][e] : acc[m][nn][e]; ss += o * o; }
                ss += __shfl_xor(ss, 1); ss += __shfl_xor(ss, 2); ss += __shfl_xor(ss, 4); ss += __shfl_xor(ss, 8);
                const float rstd = 1.0f / sqrtf(ss * (1.0f / 96.0f) + EPS); PG8_LAS float* fo = (PG8_LAS float*)lw + (m * 16 + q * 4 + e) * 100;
#pragma unroll
                for (int nn = 0; nn < 6; ++nn) { const int j = nn * 16 + r; const float o = ISML ? hs[m][nn][e] : acc[m][nn][e]; fo[j] = o * rstd * gain[j]; } }
        LDS_WAIT();
        uint4 gv[6];
#pragma unroll
        for (int k = 0; k < 6; ++k) { const int pi = lane + 64 * k, rw = pi / 12, c8 = pi % 12; gv[k] = *(const uint4*)(p + (r0 + t0 + rw) * PS + (ISML ? MO : GG) + hh * 96 + c8 * 8); }
#pragma unroll
        for (int k = 0; k < 6; ++k) { const int pi = lane + 64 * k, rw = pi / 12, c8 = pi % 12; const PG8_LAS float* fr = (const PG8_LAS float*)lw + rw * 100 + c8 * 8;
            const pg8::f32x4 a0 = *(const PG8_LAS pg8::f32x4*)fr, a1 = *(const PG8_LAS pg8::f32x4*)(fr + 4); const unsigned gw[4] = {gv[k].x, gv[k].y, gv[k].z, gv[k].w}; float gt[8];
#pragma unroll
            for (int e = 0; e < 4; ++e) { const float g0 = __uint_as_float(gw[e] << 16), g1 = __uint_as_float(gw[e] & 0xffff0000u); gt[2 * e] = ISML ? fast_sigmoid(g0) : fast_silu(g0); gt[2 * e + 1] = ISML ? fast_sigmoid(g1) : fast_silu(g1); }
            uint4 ov; ov.x = cvt_pk_bf16(a0[0] * gt[0], a0[1] * gt[1]); ov.y = cvt_pk_bf16(a0[2] * gt[2], a0[3] * gt[3]); ov.z = cvt_pk_bf16(a1[0] * gt[4], a1[1] * gt[5]); ov.w = cvt_pk_bf16(a1[2] * gt[6], a1[3] * gt[7]);
            *(uint4*)(mix + (r0 + t0 + rw) * D + (ISML ? 640 : 0) + hh * 96 + c8 * 8) = ov; }
        LDS_WAIT(); } };

#ifdef MULTI_LAUNCH
template <class F> __global__ void __launch_bounds__(256) k_run(F f) {
    for (long i = (long)blockIdx.x * blockDim.x + threadIdx.x; i < f.n; i += (long)gridDim.x * blockDim.x) f(i);
}
template <class F> __global__ void __launch_bounds__(512, 2) k_wrun(F f) {
    extern __shared__ __attribute__((aligned(16))) unsigned char shm[];
    const int wid = threadIdx.x >> 6, lane = threadIdx.x & 63;
    for (int it = blockIdx.x * 8 + wid; it < f.n; it += gridDim.x * 8) f.wave(it, lane, (PG8_LAS unsigned char*)shm + wid * 16384);
}
template <class F> __global__ void __launch_bounds__(512, 2) k_gemm(GemmDesc g, F e) {
    extern __shared__ __attribute__((aligned(16))) unsigned char shm[];
    pg8::gemm_phase<F>((PG8_LAS unsigned char*)shm, g, e, (int)gridDim.x, (int)blockIdx.x);
}
struct Ctx { hipStream_t stream; int ncu; const void* const* tbl;
    void mark(int) const {} void probe_out(float*) const {}
    template <int I> const float* inp() const { return (const float*)tbl[I]; }
    template <class F> void run(const F& f, bool sync = true, int ioff = 0) {
        if (f.n <= 0) return; long nb = (f.n + 255) / 256; if (nb > 256L * 32) nb = 256L * 32;
        hipLaunchKernelGGL(k_run<F>, dim3((unsigned)nb), dim3(256), 0, stream, f); }
    template <class F> void wrun(const F& f, bool sync = true, int woff = 0) {
        static bool attr_set = false;
        if (!attr_set) { (void)hipFuncSetAttribute((const void*)k_wrun<F>, hipFuncAttributeMaxDynamicSharedMemorySize, pg8::STAGE_BYTES); attr_set = true; }
        hipLaunchKernelGGL(k_wrun<F>, dim3(ncu), dim3(512), pg8::STAGE_BYTES, stream, f); }
    template <class F> void gemm(const GemmDesc& g, const F& e) {
        static bool attr_set = false;
        if (!attr_set) { (void)hipFuncSetAttribute((const void*)k_gemm<F>, hipFuncAttributeMaxDynamicSharedMemorySize, pg8::STAGE_BYTES); attr_set = true; }
        hipLaunchKernelGGL(k_gemm<F>, dim3(ncu), dim3(512), pg8::STAGE_BYTES, stream, g, e); }
};
#else
#ifndef PROBE_A
#define PROBE_A -1
#endif
#ifndef PROBE_B
#define PROBE_B -1
#endif
struct Ctx { XcdBarrier bar; PG8_LAS unsigned char* lds; int gtid, nthr;
    __device__ __forceinline__ void mark(int id) const { if (PROBE_A >= 0 && blockIdx.x == 0 && threadIdx.x == 0) { volatile PG8_LAS unsigned long long* t = (volatile PG8_LAS unsigned long long*)(lds + pg8::STAGE_BYTES + 400);
            if (id == PROBE_A) t[0] = __builtin_amdgcn_s_memrealtime(); if (id == PROBE_B) t[1] = __builtin_amdgcn_s_memrealtime(); } }
    __device__ __forceinline__ void probe_out(float* o) const { if (PROBE_A >= 0 && blockIdx.x == 0 && threadIdx.x == 0) { volatile PG8_LAS unsigned long long* t = (volatile PG8_LAS unsigned long long*)(lds + pg8::STAGE_BYTES + 400);
            o[0] += (float)(t[1] - t[0]) * 0.1f; } }
    template <int I> __device__ __forceinline__ const float* inp() const { unsigned off = pg8::STAGE_BYTES + 64 + 8 * I; asm volatile("" : "+v"(off));
        const PG8_LAS unsigned* t = (const PG8_LAS unsigned*)(lds + off);
        const unsigned lo = __builtin_amdgcn_readfirstlane(t[0]), hi = __builtin_amdgcn_readfirstlane(t[1]);
        return (const float*)(const __attribute__((address_space(1))) float*)(((unsigned long long)hi << 32) | lo); }
    template <class F> __device__ __forceinline__ void run(const F& f, bool sync = true, int ioff = 0) {
        int i0 = gtid - ioff; asm volatile("" : "+v"(i0)); if (i0 < 0) i0 += nthr;
        const int n = (int)f.n; int st = (int)nthr; asm volatile("" : "+s"(st));
        for (int i = i0; i < n; i += st) f((long)i);
        if (sync) xcd_barrier(bar); }
    template <class F> __device__ __forceinline__ void wrun(const F& f, bool sync = true, int woff = 0) {
        int t0 = threadIdx.x; asm volatile("" : "+v"(t0));
        const int wid = __builtin_amdgcn_readfirstlane(t0 >> 6), lane = t0 & 63; const int nw = (int)gridDim.x * 8; int w0 = (int)blockIdx.x * 8 + wid - woff; if (w0 < 0) w0 += nw;
        for (int it = w0; it < f.n; it += nw) { int ln = lane; asm volatile("" : "+v"(ln));
            f.wave(it, ln, lds + wid * 16384); }
        if (sync) xcd_barrier(bar); }
    template <class F> __device__ __forceinline__ void gemm(const GemmDesc& g, const F& e) {
        pg8::gemm_phase<F>(lds, g, e, (int)gridDim.x, (int)blockIdx.x);
        xcd_barrier(bar); }
    template <class F> __device__ __forceinline__ void gemm8(const GemmDesc& g, const F& e) {
        pg8::gemm_phase<F, true, false, false, PG8_ALIGN>(lds, g, e, (int)gridDim.x, (int)blockIdx.x);
        xcd_barrier(bar); }
};
#endif
#else
struct Ctx { const void* const* tbl;
void mark(int) const {} void probe_out(float*) const {}
template <int I> const float* inp() const { return (const float*)tbl[I]; }
template <class F> void run(const F& f, bool sync = true, int ioff = 0) {
#pragma omp parallel for schedule(static)
    for (long i = 0; i < f.n; ++i) f(i);
}
template <class F> void gemm(const GemmDesc& g, const F& e) {
    int M = g.M; if (g.ntile) { int nt = g.ntile[0] - g.tile0; if (nt < 0) nt = 0; if (nt * 256 < M) M = nt * 256; }
#pragma omp parallel for schedule(dynamic, 4)
    for (int r = 0; r < M; ++r) {
        int ar = r; if (g.arow) { ar = g.arow[(size_t)g.tile0 * 256 + r]; if (ar < 0) ar = 0; }
        const bf16* a = g.A + (size_t)ar * g.lda; const bf16* B = g.Bt + (g.tile_e ? (size_t)g.tile_e[g.tile0 + r / 256] * g.e_stride : (g.tdiv ? (size_t)((r / 256) / g.tdiv) * g.e_stride : 0));
        static thread_local float af[4096]; for (int k = 0; k < g.K; ++k) af[k] = bf2f(a[k]);
        for (int c0 = 0; c0 < g.N; c0 += 8) { float v[8];
            for (int j = 0; j < 8; ++j) { const bf16* bt = B + (size_t)(c0 + j) * g.ldb; float s = 0.f; for (int k = 0; k < g.K; ++k) s += af[k] * bf2f(bt[k]); v[j] = s; }
            e.apply8(r, c0, v); }
    }
}
};
#endif

struct Inputs { const float *x, *c, *ctx, *c_ctx, *w_ada, *b_ada, *norm1, *norm2, *w_in, *w_out, *gla_wa2, *gla_ba, *gla_norm, *s5_lam_re, *s5_lam_im, *s5_log_dt, *s5_b_re, *s5_b_im,
    *s5_c_re, *s5_c_im, *s5_d, *s5_glu_w, *s5_glu_b, *ml_conv_w, *ml_conv_b, *ml_gate_b, *ml_norm, *ffn_w1, *ffn_w3, *ffn_w2, *moe_router, *moe_w1, *moe_w3, *moe_w2, *norm_f; };

#define INP(name) (cx.template inp<offsetof(Inputs, name) / 8>())
#ifndef PROBE_REP
#define PROBE_REP -1
#endif
#ifndef PROBE_L
#define PROBE_L -1
#endif
#define REPEAT(k) if constexpr (false) {} else for (int rep_ = 0; rep_ < 1; ++rep_)
#define SEC_BEGIN(k) { auto sec_ = [&]() __attribute__((always_inline)) {
#define SEC_END(k) }; sec_(); if constexpr (PROBE_REP == (k) && (PROBE_L == l || PROBE_L < 0)) sec_(); }
#define WSB ((unsigned char*)cx.template inp<36>())
#ifdef HOST_EMU
#define S5TABBASE (WSB + WS.s5tab)
#else
#define S5TABBASE ((unsigned char*)cx.template inp<35>() + ABUF_BYTES)
#endif
#define out ((float*)cx.template inp<35>())
#define mod ((float*)(WSB + WS.mod))
#define h ((float*)(WSB + WS.h))
#define abuf ((bf16*)cx.template inp<35>())
#define winT ((bf16*)(WSB + WS.winT))
#define woutT ((bf16*)(WSB + WS.woutT))
#define w13T ((bf16*)(WSB + WS.w13T))
#define w2T ((bf16*)(WSB + WS.w2T))
#define pbuf ((bf16*)(WSB + WS.pbuf))
#define obuf ((float*)(WSB + WS.obuf))
#define lab ((bf16*)(WSB + WS.lab))
#define labg ((bf16*)(WSB + WS.labg))
#define s5disc ((float*)(S5TABBASE + S5T.disc))
#define s5K ((float*)(S5TABBASE + S5T.K))
#define s5apow ((float*)(S5TABBASE + S5T.apow))
#define s5bbar ((float*)(S5TABBASE + S5T.bbar))
#define s5TB ((bf16*)(S5TABBASE + S5T.TB))
#define s5EB ((bf16*)(S5TABBASE + S5T.EB))
#define s5uG ((bf16*)(WSB + WS.s5uG))
#define s5est ((float*)(WSB + WS.s5est))
#define zbuf ((bf16*)(WSB + WS.zbuf))
#define gluT ((bf16*)(S5TABBASE + S5T.gluT))
#define act ((bf16*)(WSB + WS.act))
#define mw13T ((bf16*)(WSB + WS.mw13T))
#define mw2T ((bf16*)(WSB + WS.mw2T))
#define mact ((bf16*)(WSB + WS.mact))
#define xs8 ((unsigned char*)(WSB + WS.xs8))
#define yrow ((bf16*)(WSB + WS.yrow))
#define rt_e ((int*)(WSB + WS.rt_e))
#define rt_w ((float*)(WSB + WS.rt_w))
#define rt_dest ((int*)(WSB + WS.rt_dest))
#define segcnt ((int*)(WSB + WS.segcnt))
#define ecnt ((int*)(WSB + WS.ecnt))
#define row_token ((int*)(WSB + WS.row_token))
#define tile_e ((int*)(WSB + WS.tile_e))
#define ntile ((int*)(WSB + WS.ntile))
#define modl (mod + (size_t)l * NMOD * 6 * D)
#define silc ((float*)(WSB + WS.silc))
#define postab ((float*)(WSB + WS.postab))
#define modpart ((float*)(WSB + WS.uni))
template <int l, class X> HD void layer_fwd(X& cx) {
    constexpr bool last = (l == DEPTH - 1);
    cx.mark(10 * (l + 1));
        REPEAT(1) {
#ifdef HOST_EMU
        cx.run(NormModK{(long)NR, h, INP(norm1) + (size_t)l * D, modl, 0, D, abuf, nullptr, nullptr, nullptr, 0, 0, nullptr});
#else
        if constexpr (!(l > 0 && (l - 1) % 2 == 1)) cx.wrun(NormModW{NR / 2, 0, D, 0, h, INP(norm1) + (size_t)l * D, modl, abuf, nullptr, nullptr, nullptr, nullptr, 0, 0});
#endif
        }
        cx.mark(10 * (l + 1) + 1);
        SEC_BEGIN(2) cx.gemm(GemmDesc{abuf, winT + (size_t)l * PS * D, nullptr, nullptr, nullptr, 0, NR, PS, D, 0, D, D, 0, 0}, EpiStoreBf16{pbuf, PS, 0}); SEC_END(2)
        cx.mark(10 * (l + 1) + 2);
        SEC_BEGIN(3) { typedef LaLay<64, 96> LG; typedef LaLay<96, 112> LM;
#ifdef HOST_EMU
        cx.run(GlaFused{(long)2 * NB * NBLK * 192, pbuf, INP(gla_wa2) + (size_t)l * 2 * 16 * 192, INP(gla_ba) + (size_t)l * 2 * 192, labg}, false);
#else
        cx.wrun(GlaPrepW2{2 * NB * NBLK * 4, 0, pbuf, INP(gla_wa2) + (size_t)l * 2 * 16 * 192, INP(gla_ba) + (size_t)l * 2 * 192, labg}, false);
#endif
#ifdef HOST_EMU
        cx.run(MlFused{(long)2 * NB * NBLK * 384, pbuf, INP(ml_conv_w) + (size_t)l * 3 * 768, INP(ml_conv_b) + (size_t)l * 768, INP(ml_gate_b) + (size_t)l * 16, lab}, false, 77824);
#else
        cx.wrun(MlPrepW2{2 * NB * NBLK * 4, 0, pbuf, INP(ml_conv_w) + (size_t)l * 3 * 768, INP(ml_conv_b) + (size_t)l * 768, INP(ml_gate_b) + (size_t)l * 16, lab}, false, (2 * NB * NBLK * 4) % 2048);
#endif
#ifdef HOST_EMU
        cx.run(VTFused<96, GV>{(long)LA_NI * 96, pbuf, labg + LG::vT}, false, 102400);
#else
        cx.wrun(VTW<96, GV>{(int)LA_NI, 0, pbuf, labg + LG::vT}, false, (4 * NB * NBLK * 4) % 2048);
#endif
        cx.run(S5Disc{(long)2 * 16 * 64, INP(s5_lam_re) + (size_t)l * 2048, INP(s5_lam_im) + (size_t)l * 2048, INP(s5_log_dt) + (size_t)l * 32, s5disc}, false);
        cx.run(S5Apow{(long)2 * 16 * 65 * 64, INP(s5_lam_re) + (size_t)l * 2048, INP(s5_lam_im) + (size_t)l * 2048, INP(s5_log_dt) + (size_t)l * 32, s5apow}, false);
        cx.run(TransposeK{(long)256 * 256, INP(s5_glu_w) + (size_t)l * 65536, nullptr, gluT, 256, 256, 256}, false);
#ifdef HOST_EMU
        cx.run(VTFused<112, MV>{(long)LA_NI * 112, pbuf, lab + LM::vT}, true, 49152);
#else
        cx.wrun(VTW<112, MV>{(int)LA_NI, 0, pbuf, lab + LM::vT}, true, (4 * NB * NBLK * 4 + (int)LA_NI) % 2048);
#endif
#ifdef HOST_EMU
        cx.run(S5Bbar{(long)2 * 16 * 64 * 16, s5disc, INP(s5_b_re) + (size_t)l * 16384, INP(s5_b_im) + (size_t)l * 16384, s5bbar}, false);
        cx.run(StatesRef<64, 96>{(long)2 * LA_NI * 96 * 64, labg});
        cx.run(StatesRef<96, 112>{(long)2 * LA_NI * 112 * 96, lab});
        cx.run(CarryT<96, 112>{(long)2 * NB * 4 * 112 * 96, lab}, false);
        cx.run(CarryT<64, 96>{(long)2 * NB * 4 * 96 * 64, labg});
#else
        cx.run(S5Bbar{(long)2 * 16 * 64 * 16, s5disc, INP(s5_b_re) + (size_t)l * 16384, INP(s5_b_im) + (size_t)l * 16384, s5bbar}, false);
        cx.wrun(ChainW<96, 112, 2>{2 * NB * 4 * 7 * 3, 0, lab}, false);
        cx.wrun(ChainW<64, 96, 4>{2 * NB * 4 * 6, 0, labg}, true, (2 * NB * 4 * 7 * 3) % 2048);
#endif
        cx.run(S5K2{(long)2 * 16 * 64 * 256, s5apow, s5bbar, INP(s5_c_re) + (size_t)l * 16384, INP(s5_c_im) + (size_t)l * 16384, s5K}, false);
        cx.run(S5BuildEB{(long)16 * 256 * 128, s5apow, s5bbar, s5EB}, false);
#ifdef HOST_EMU
        cx.run(OutRef<64, 96, false>{(long)NR * 384, labg, obuf});
        cx.run(HeadFin{(long)NR * 4, pbuf, obuf, INP(gla_norm) + (size_t)l * 96, abuf, 0});
        cx.run(OutRef<96, 112, true>{(long)NR * 384, lab, obuf});
        cx.run(HeadFin{(long)NR * 4, pbuf, obuf, INP(ml_norm) + (size_t)l * 96, abuf, 1});
#else
        cx.wrun(OutW<96, 112, true>{2 * (int)LA_NI, 0, lab, pbuf, INP(ml_norm) + (size_t)l * 96, abuf}, false);
        cx.wrun(OutW<64, 96, false>{2 * (int)LA_NI, 0, labg, pbuf, INP(gla_norm) + (size_t)l * 96, abuf});
#endif
        } SEC_END(3)
        cx.mark(10 * (l + 1) + 3);
        cx.mark(10 * (l + 1) + 4);
        SEC_BEGIN(5) {
        cx.run(S5BuildTB{(long)16 * 1024 * (S5K_ / 8), s5apow, INP(s5_c_re) + (size_t)l * 16384, INP(s5_c_im) + (size_t)l * 16384, s5K, s5TB}, false);
        cx.run(S5BuildU{(long)16 * S5RB * 128, pbuf, s5uG});
        cx.gemm(GemmDesc{s5uG, s5EB, nullptr, nullptr, nullptr, (size_t)256 * 1024, 16 * S5RG, 256, 1024, 0, S5K_, 1024, S5RG / 256, 0}, EpiStoreF32{s5est, 256, 0});
        cx.run(S5Carry2{(long)NB * 16 * 2 * 64, s5apow, s5est, s5uG});
        cx.gemm(GemmDesc{s5uG, s5TB, nullptr, nullptr, nullptr, (size_t)1024 * S5K_, 16 * S5RG, 1024, S5K_, 0, S5K_, S5K_, S5RG / 256, 0}, EpiS5Z{pbuf, INP(s5_d) + (size_t)l * 256, zbuf});
        cx.gemm(mk_gemm(zbuf, 256, gluT, 256, NR, 256, 256), EpiGlu{zbuf, INP(s5_glu_b) + (size_t)l * 256, abuf});
        } SEC_END(5)
        cx.mark(10 * (l + 1) + 5);
        cx.gemm(GemmDesc{abuf, woutT + (size_t)l * D * D, nullptr, nullptr, nullptr, 0, NR, D, D, 0, D, D, 0, 0}, EpiResid{h, modl, 2 * D});
        cx.mark(10 * (l + 1) + 6);
        if constexpr (l % 2 == 0) { constexpr int j = l / 2;
            SEC_BEGIN(6) {
#ifdef HOST_EMU
            cx.run(NormModK{(long)NR, h, INP(norm2) + (size_t)l * D, modl, 3 * D, 4 * D, abuf, nullptr, nullptr, nullptr, 0, 0, nullptr});
#else
            cx.wrun(NormModW{NR / 2, 3 * D, 4 * D, 0, h, INP(norm2) + (size_t)l * D, modl, abuf, nullptr, nullptr, nullptr, nullptr, 0, 1});
#endif
#ifdef HOST_EMU
            cx.gemm(GemmDesc{abuf, w13T + (size_t)j * 2 * DFF * D, nullptr, nullptr, nullptr, 0, NR, 2 * DFF, D, 0, D, D, 0, 0}, EpiSwiGLU{act, DFF, 0});
#else
            cx.gemm8(GemmDesc{abuf, (const bf16*)((const unsigned char*)w13T + (size_t)j * 2 * DFF * D), nullptr, nullptr, nullptr, 0, NR, 2 * DFF, D, 0, D, D, 0, -W8S},
#if FP8_DOWN_DENSE
                EpiSwiGLU8{(unsigned char*)act, DFF, 0});
#else
                EpiSwiGLU{act, DFF, 0});
#endif
#endif
            } SEC_END(6)
#if FP8_DOWN_DENSE && !defined(HOST_EMU)
            cx.gemm8(GemmDesc{act, (const bf16*)((const unsigned char*)w2T + (size_t)j * D * DFF), nullptr, nullptr, nullptr, 0, NR, D, DFF, 0, DFF, DFF, 0, -(W8S + A8S)}, EpiResid{h, modl, 5 * D});
#else
            cx.gemm(GemmDesc{act, w2T + (size_t)j * D * DFF, nullptr, nullptr, nullptr, 0, NR, D, DFF, 0, DFF, DFF, 0, 0}, EpiResid{h, modl, 5 * D});
#endif
        } else { constexpr int j = l / 2; const int nseg = (NR + 63) / 64;
            SEC_BEGIN(7) {
#ifdef HOST_EMU
            for (int e = 0; e < NE; ++e) { const size_t wo = ((size_t)j * NE + e) * D * DFF;
                cx.run(TransposeK{(long)2 * DFF * D, INP(moe_w1) + wo, INP(moe_w3) + wo, mw13T + (size_t)e * 2 * DFF * D, D, DFF, 2 * DFF});
                cx.run(TransposeK{(long)D * DFF, INP(moe_w2) + wo, nullptr, mw2T + (size_t)e * D * DFF, DFF, D, D}); }
            cx.run(ZeroInt{(long)NE * nseg, segcnt});
            cx.run(MoeFillNeg{(long)MOE_MAXT * 256, row_token});
            cx.run(NormModK{(long)NR, h, INP(norm2) + (size_t)l * D, modl, 3 * D, 4 * D, abuf, INP(moe_router) + (size_t)j * D * NE, rt_e, rt_w, last ? 1 : 0, nseg, segcnt});
            cx.run(MoePrefix{(long)NE, segcnt, ecnt, nseg});
#else
            cx.wrun(TransW{((NE * (D / 64) * (DFF / 32)) + 1) / 2, D, DFF, 2, 0, W8S, INP(moe_w1) + (size_t)j * NE * D * DFF, mw13T, (size_t)D * DFF, (size_t)2 * DFF * D, (NE * (D / 64) * (DFF / 32)), 0}, false);
            cx.wrun(TransW{((NE * (D / 64) * (DFF / 32)) + 1) / 2, D, DFF, 2, 1, W8S, INP(moe_w3) + (size_t)j * NE * D * DFF, mw13T, (size_t)D * DFF, (size_t)2 * DFF * D, (NE * (D / 64) * (DFF / 32)), 0}, false);
            cx.wrun(TransW{((NE * (DFF / 64) * (D / 32)) + 1) / 2, DFF, D, 1, 0, FP8_DOWN_MOE ? W8S : 0, INP(moe_w2) + (size_t)j * NE * DFF * D, mw2T, (size_t)DFF * D, (size_t)D * DFF, (NE * (DFF / 64) * (D / 32)), 0}, false);
            cx.run(MoeFillNeg{(long)MOE_MAXT * 256, row_token}, false);
            cx.run(ZeroInt{(long)NE * nseg, segcnt});
            cx.wrun(NormModW{NR / 2, 3 * D, 4 * D, last ? 1 : 0, h, INP(norm2) + (size_t)l * D, modl, abuf, INP(moe_router) + (size_t)j * D * NE, rt_e, rt_w, segcnt, nseg, 1});
            cx.wrun(MoePrefixW{NE, nseg, segcnt, ecnt});
#endif
            cx.run(MoeTiles2{(long)MOE_MAXT, ecnt, tile_e, ntile}, false);
            cx.run(MoeAssign{(long)NE * nseg, rt_e, segcnt, ecnt, rt_dest, row_token, nseg});
#ifdef HOST_EMU
            cx.gemm(GemmDesc{abuf, mw13T, tile_e, ntile, row_token, (size_t)2 * DFF * D, MOE_MAXT * 256, 2 * DFF, D, 0, D, D, 0, 0}, EpiSwiGLU{mact, DFF, 0});
#else
            for (int t0 = 0; t0 < MOE_MAXT; t0 += MOE_XT) { const int nt = (MOE_MAXT - t0 < MOE_XT) ? MOE_MAXT - t0 : MOE_XT;
                cx.run(MoeGather8{(long)nt * 256 * (D / 16), (const unsigned char*)abuf, row_token, xs8, t0 * 256, 0});
                cx.gemm8(GemmDesc{(const bf16*)xs8, mw13T, tile_e, ntile, nullptr, (size_t)2 * DFF * D / 2, nt * 256, 2 * DFF, D, t0, D, D, 0, -W8S},
#if FP8_DOWN_MOE
                    EpiSwiGLU8{(unsigned char*)mact + (size_t)t0 * 256 * DFF, DFF, 0}); }
#else
                    EpiSwiGLU{mact + (size_t)t0 * 256 * DFF, DFF, 0}); }
#endif
#endif
#if FP8_DOWN_MOE && !defined(HOST_EMU)
            cx.gemm8(GemmDesc{mact, mw2T, tile_e, ntile, nullptr, (size_t)D * DFF / 2, MOE_MAXT * 256, D, DFF, 0, DFF, DFF, 0, -(W8S + A8S)}, EpiStoreBf16{yrow, D, 0});
#else
            cx.gemm(GemmDesc{mact, mw2T, tile_e, ntile, nullptr, (size_t)D * DFF, MOE_MAXT * 256, D, DFF, 0, DFF, DFF, 0, 0}, EpiStoreBf16{yrow, D, 0});
#endif
            } SEC_END(7)
#ifdef HOST_EMU
            cx.run(MoeCombine{(long)NR * D / 8, h, yrow, rt_e, rt_w, rt_dest, modl, 5 * D});
#else
            if constexpr (last) cx.wrun(CombineNormW{NR, 1, 5 * D, 0, h, yrow, rt_e, rt_w, rt_dest, modl, INP(norm_f), modl, abuf, out});
            else cx.wrun(CombineNormW{NR, 0, 5 * D, 0, h, yrow, rt_e, rt_w, rt_dest, modl, INP(norm1) + (size_t)(l + 1) * D, mod + (size_t)(l + 1) * NMOD * 6 * D, abuf, out});
#endif
        }
        cx.mark(10 * (l + 1) + 7);
    }
template <class X> HD void forward(X& cx) {
    cx.mark(0);
    constexpr int l = 0; (void)l;
    cx.run(PosTab{(long)2 * GRID_W * 512, postab}, false);
    cx.run(SiluC{(long)NMOD * D, INP(c), INP(c_ctx), silc});
    cx.run(InitH{(long)NR * D / 4, INP(x), INP(ctx), postab, h}, false);
#ifdef HOST_EMU
    for (int l = 0; l < DEPTH; ++l) {
        cx.run(TransposeK{(long)PS * D, INP(w_in) + (size_t)l * D * DPROJ, nullptr, winT + (size_t)l * PS * D, D, DPROJ, PS});
        cx.run(TransposeK{(long)D * D, INP(w_out) + (size_t)l * D * D, nullptr, woutT + (size_t)l * D * D, D, D, D});
        if (l % 2 == 0) { const int j = l / 2;
            cx.run(TransposeK{(long)2 * DFF * D, INP(ffn_w1) + (size_t)j * D * DFF, INP(ffn_w3) + (size_t)j * D * DFF, w13T + (size_t)j * 2 * DFF * D, D, DFF, 2 * DFF});
            cx.run(TransposeK{(long)D * DFF, INP(ffn_w2) + (size_t)j * DFF * D, nullptr, w2T + (size_t)j * D * DFF, DFF, D, D}); }
    }
#else
    cx.wrun(TransW{((DEPTH * (D / 64) * (DPROJ / 32)) + 1) / 2, D, DPROJ, 1, 0, 0, INP(w_in), winT, (size_t)D * DPROJ, (size_t)PS * D, (DEPTH * (D / 64) * (DPROJ / 32)), 0}, false);
    for (int l = 0; l < DEPTH; ++l) cx.run(ZeroBf16{(long)(PS - DPROJ) * D, winT + ((size_t)l * PS + DPROJ) * D}, false);
    cx.wrun(TransW{((DEPTH * (D / 64) * (D / 32)) + 1) / 2, D, D, 1, 0, 0, INP(w_out), woutT, (size_t)D * D, (size_t)D * D, (DEPTH * (D / 64) * (D / 32)), 0}, false);
    cx.wrun(TransW{((((DEPTH + 1) / 2) * (D / 64) * (DFF / 32)) + 1) / 2, D, DFF, 2, 0, W8S, INP(ffn_w1), w13T, (size_t)D * DFF, (size_t)2 * DFF * D, (((DEPTH + 1) / 2) * (D / 64) * (DFF / 32)), 0}, false);
    cx.wrun(TransW{((((DEPTH + 1) / 2) * (D / 64) * (DFF / 32)) + 1) / 2, D, DFF, 2, 1, W8S, INP(ffn_w3), w13T, (size_t)D * DFF, (size_t)2 * DFF * D, (((DEPTH + 1) / 2) * (D / 64) * (DFF / 32)), 0}, false);
    cx.wrun(TransW{((((DEPTH + 1) / 2) * (DFF / 64) * (D / 32)) + 1) / 2, DFF, D, 1, 0, FP8_DOWN_DENSE ? W8S : 0, INP(ffn_w2), w2T, (size_t)DFF * D, (size_t)D * DFF, (((DEPTH + 1) / 2) * (DFF / 64) * (D / 32)), 0}, false);
#endif
    cx.run(ModPart{(long)MODKC * DEPTH * 6 * D, silc, INP(w_ada), modpart});
    cx.run(ModReduce{(long)DEPTH * NMOD * 6 * D, modpart, INP(b_ada), mod});
    cx.mark(1);
    layer_fwd<0>(cx);
    if constexpr (DEPTH > 1) layer_fwd<1>(cx);
    if constexpr (DEPTH > 2) layer_fwd<2>(cx);
    if constexpr (DEPTH > 3) layer_fwd<3>(cx);
    static_assert(DEPTH <= 4, "unrolled for DEPTH <= 4");
#ifdef HOST_EMU
    cx.run(FinalNorm{(long)NB * SEQ, h, INP(norm_f), out});
#else
    if constexpr ((DEPTH - 1) % 2 == 0) cx.wrun(FinalNormW{NB * SEQ, 0, h, INP(norm_f), out});
#endif
    cx.mark(99);
    cx.probe_out(out);
}

#undef silc
#undef postab
#undef modpart
#undef mod
#undef h
#undef abuf
#undef winT
#undef woutT
#undef w13T
#undef w2T
#undef pbuf
#undef obuf
#undef lab
#undef labg
#undef s5disc
#undef s5K
#undef s5apow
#undef s5bbar
#undef s5TB
#undef s5EB
#undef s5uG
#undef s5est
#undef zbuf
#undef gluT
#undef act
#undef mw13T
#undef mw2T
#undef mact
#undef xs8
#undef yrow
#undef rt_e
#undef rt_w
#undef rt_dest
#undef segcnt
#undef ecnt
#undef row_token
#undef tile_e
#undef ntile
#undef WSB
#undef S5TABBASE
#undef out
#undef modl
#ifndef HOST_EMU
#ifndef MULTI_LAUNCH
constexpr int MEGA_LDS = pg8::STAGE_BYTES + 512;
struct MegaArgs { const void* p[37]; };
__global__ void __launch_bounds__(512, 2) mega_fwd(MegaArgs a) {
    extern __shared__ __attribute__((aligned(16))) unsigned char shm[];
    PG8_LAS unsigned char* lds = (PG8_LAS unsigned char*)shm;
    volatile LAS unsigned* xbw = (volatile LAS unsigned*)(lds + pg8::STAGE_BYTES);
    if (threadIdx.x < 4) xbw[threadIdx.x] = 0u;
    if (threadIdx.x < 37) ((PG8_LAS unsigned long long*)(lds + pg8::STAGE_BYTES + 64))[threadIdx.x] = (unsigned long long)a.p[threadIdx.x];
    __syncthreads();
    Ctx cx; cx.lds = lds;
    cx.bar = xcd_barrier_post((unsigned*)((unsigned char*)cx.inp<36>() + WS.ctl), xbw);
    cx.gtid = (int)(blockIdx.x * blockDim.x + threadIdx.x); cx.nthr = (int)(gridDim.x * blockDim.x);
    forward(cx);
}
#endif
extern "C" void kernel_launch(void* const* d_in, const int* in_sizes, int n_in, void* d_out, int out_size, void* d_ws, size_t ws_size, hipStream_t stream) {
    static int ncu = 0;
    if (ncu == 0) { int dev = 0; (void)hipGetDevice(&dev); (void)hipDeviceGetAttribute(&ncu, hipDeviceAttributeMultiprocessorCount, dev); if (ncu <= 0) ncu = 256;
#ifndef MULTI_LAUNCH
        if (hipFuncSetAttribute((const void*)mega_fwd, hipFuncAttributeMaxDynamicSharedMemorySize, MEGA_LDS) != hipSuccess) { fprintf(stderr, "kernel_launch: hipFuncSetAttribute failed\n"); }
#endif
    }
    if (n_in != 35 || ws_size < WS.end || out_size != NB * SEQ * D) { fprintf(stderr, "kernel_launch: unexpected sizes n_in %d ws %zu (need %zu) out %d\n", n_in, ws_size, (size_t)WS.end, out_size); return; }
#ifdef MULTI_LAUNCH
    const void* tbl[37]; for (int i = 0; i < 35; ++i) tbl[i] = d_in[i]; tbl[35] = d_out; tbl[36] = d_ws;
    Ctx cx{stream, ncu, tbl};
    forward(cx);
#else
    (void)hipMemsetAsync((unsigned char*)d_ws + WS.ctl, 0, 1 << 20, stream);
    MegaArgs a{}; for (int i = 0; i < 35; ++i) a.p[i] = d_in[i];
    a.p[35] = d_out; a.p[36] = d_ws;
    hipLaunchKernelGGL(mega_fwd, dim3(ncu), dim3(512), MEGA_LDS, stream, a);
#endif
}
#endif
```

```cpp
#ifndef HOST_EMU
#include <hip/hip_runtime.h>
#define HD __host__ __device__ __forceinline__
#define UNROLL _Pragma("unroll")
#else
#include <cmath>
#include <cstdio>
#include <cstdlib>
#include <cstring>
#include <cstdint>
#define HD inline
#define UNROLL
#endif
#include <math.h>
#include <stdint.h>
#include <stddef.h>
#include <stdio.h>

#ifndef CFG_NB
#define CFG_NB 8
#endif
#ifndef CFG_SEQ
#define CFG_SEQ 4096
#endif
#ifndef CFG_CTX
#define CFG_CTX 256
#endif
#ifndef CFG_DEPTH
#define CFG_DEPTH 4
#endif
constexpr int NB = CFG_NB, SEQ = CFG_SEQ, CTX = CFG_CTX, DEPTH = CFG_DEPTH;
constexpr int D = 1024, GRID_W = 64;
constexpr int RPB = CTX + SEQ;
constexpr int NR = NB * RPB;
constexpr int NBLK = RPB / 64, CB = CTX / 64;
constexpr int DPROJ = 2976, PS = 3072;
constexpr int GQ = 0, GK = 192, GV = 384, GLR = 768, GG = 784, SU = 1168, MQ = 1424, MK = 1808, MV = 2192, MO = 2576, MG = 2960;
constexpr int DFF = 2816, NE = 8;
constexpr int NMOD = NB + 1;
constexpr float EPS = 1e-6f;
constexpr int MOE_MAXT = (2 * NR + NE * 255) / 256 + 1;
#ifndef FP8_DOWN_DENSE
#define FP8_DOWN_DENSE 1
#endif
#ifndef FP8_DOWN_MOE
#define FP8_DOWN_MOE 1
#endif
constexpr int MOE_XT = MOE_MAXT;

typedef unsigned short bf16;
struct __attribute__((aligned(16))) U4 { uint32_t x, y, z, w; };
HD float bf2f(bf16 v) { uint32_t u = ((uint32_t)v) << 16; float f; memcpy(&f, &u, 4); return f; }
HD bf16 f2bf(float f) { uint32_t u; memcpy(&u, &f, 4); u += 0x7fffu + ((u >> 16) & 1u); return (bf16)(u >> 16); }
#if defined(HOST_EMU)
HD float siluf(float x) { return x / (1.0f + expf(-x)); }
HD float sigmoidf_(float x) { return 1.0f / (1.0f + expf(-x)); }
HD float logsigmoidf_(float x) { return x < 0.f ? x - log1pf(expf(x)) : -log1pf(expf(-x)); }
HD float fexp(float x) { return expf(x); }
#else
__host__ __device__ __forceinline__ float fexp(float x) { return __builtin_amdgcn_exp2f(x * 1.4426950408889634f); }
__host__ __device__ __forceinline__ float siluf(float x) { return x * __builtin_amdgcn_rcpf(1.0f + fexp(-x)); }
__host__ __device__ __forceinline__ float sigmoidf_(float x) { return __builtin_amdgcn_rcpf(1.0f + fexp(-x)); }
__host__ __device__ __forceinline__ float logsigmoidf_(float x) { return fminf(x, 0.f) - 0.6931471805599453f * __builtin_amdgcn_logf(1.0f + fexp(-fabsf(x))); }
#endif
HD float gelu_tanhf(float x) { return 0.5f * x * (1.0f + tanhf(0.7978845608028654f * (x + 0.044715f * x * x * x))); }
#ifndef HOST_EMU
typedef float f4_t __attribute__((ext_vector_type(4)));
__device__ __forceinline__ unsigned cvt_pk_bf16(float lo, float hi) { unsigned r; asm("v_cvt_pk_bf16_f32 %0, %1, %2" : "=v"(r) : "v"(lo), "v"(hi)); return r; }
__device__ __forceinline__ void store8_bf16(bf16* dst, const float* v) { uint4 w; w.x = cvt_pk_bf16(v[0], v[1]); w.y = cvt_pk_bf16(v[2], v[3]); w.z = cvt_pk_bf16(v[4], v[5]); w.w = cvt_pk_bf16(v[6], v[7]); *(uint4*)dst = w; }
__device__ __forceinline__ void load8_bf16(const bf16* src, float* v) { const uint4 w = *(const uint4*)src; const unsigned u[4] = {w.x, w.y, w.z, w.w};
#pragma unroll
    for (int i = 0; i < 4; ++i) { v[2 * i] = __uint_as_float(u[i] << 16); v[2 * i + 1] = __uint_as_float(u[i] & 0xffff0000u); } }
__device__ __forceinline__ float fast_silu(float x) { return x * __builtin_amdgcn_rcpf(1.0f + __expf(-x)); }
__device__ __forceinline__ float fast_sigmoid(float x) { return __builtin_amdgcn_rcpf(1.0f + __expf(-x)); }
#endif
HD int mod_index(int r) { const int b = r / RPB, t = r % RPB; return t < CTX ? NB : b; }
HD int chain_blk(int d, int step) { return d == 0 ? step : (step < CB ? CB - 1 - step : NBLK - 1 - (step - CB)); }
HD int blk_row(int b, int blk, int d, int pp) { return b * RPB + blk * 64 + (d == 0 ? pp : 63 - pp); }

constexpr size_t LA_NI = (size_t)NB * NBLK * 4;
HD size_t tile_off(int row, int col, int KT) { return ((size_t)((row >> 4) * KT + (col >> 5)) * 64 + (size_t)((((col & 31) >> 3) << 4) + (row & 15))) * 8 + (col & 7); }
template <int DKP, int NV> struct LaLay {
    static constexpr int KQ = DKP / 32;
    static constexpr size_t qin = 0;
    static constexpr size_t kin = qin + (size_t)2 * NR * 4 * DKP;
    static constexpr size_t koutT = kin + (size_t)2 * NR * 4 * DKP;
    static constexpr size_t vT = koutT + (size_t)2 * LA_NI * DKP * 64;
    static constexpr size_t sT = vT + LA_NI * NV * 64;
    static constexpr size_t dec = sT + (size_t)2 * LA_NI * NV * DKP;
    static constexpr size_t end = dec + (size_t)2 * 2 * LA_NI * DKP;
    HD static size_t q_at(int d, size_t item, int tok, int i) { return qin + ((size_t)d * LA_NI + item) * 64 * DKP + tile_off(tok, i, KQ); }
    HD static size_t k_at(int d, size_t item, int tok, int i) { return kin + ((size_t)d * LA_NI + item) * 64 * DKP + tile_off(tok, i, KQ); }
    HD static size_t kt_at(int d, size_t item, int i, int tok) { return koutT + ((size_t)d * LA_NI + item) * DKP * 64 + tile_off(i, tok, 2); }
    HD static size_t v_at(size_t item, int j, int tok) { return vT + item * NV * 64 + tile_off(j, tok, 2); }
    HD static size_t s_at(int d, size_t item, int j, int i) { return sT + ((size_t)d * LA_NI + item) * NV * DKP + tile_off(j, i, KQ); }
};
constexpr size_t al256(size_t x) { return (x + 255) & ~(size_t)255; }
struct WsMap {
    size_t ctl, mod, silc, postab, h, abuf, winT, woutT, w13T, w2T, uni, end_fixed;
    size_t pbuf, lab, labg, obuf, s5tab, s5uG, s5est, zbuf, end_mix;
    size_t act, end_ffn;
    size_t mw13T, mw2T, xs8, mact, yrow, rt_e, rt_w, rt_dest, segcnt, ecnt, row_token, tile_e, ntile, end_moe;
    size_t end;
};
constexpr WsMap make_map() {
    WsMap m{}; size_t o = 0;
    m.ctl = o; o += 1 << 20;
    m.mod = o; o += al256((size_t)DEPTH * NMOD * 6 * D * 4);
    m.silc = o; o += al256((size_t)NMOD * D * 4);
    m.postab = o; o += al256((size_t)2 * GRID_W * 512 * 4);
    m.h = o; o += al256((size_t)NR * D * 4);
    m.abuf = o;
    m.winT = o; o += al256((size_t)DEPTH * PS * D * 2);
    m.woutT = o; o += al256((size_t)DEPTH * D * D * 2);
    m.w13T = o; o += al256((size_t)((DEPTH + 1) / 2) * 2 * DFF * D * 2);
    m.w2T = o; o += al256((size_t)((DEPTH + 1) / 2) * D * DFF * 2);
    m.uni = o; m.end_fixed = o;
    o = m.uni;
    m.pbuf = o; o += al256((size_t)NR * PS * 2);
    m.lab = o;
    { size_t o2 = m.lab;
      m.s5uG = o2; o2 += al256((size_t)16 * ((NB * NBLK + 255) / 256 * 256) * 1280 * 2);
      m.s5est = o2; o2 += al256((size_t)16 * ((NB * NBLK + 255) / 256 * 256) * 256 * 4);
      m.zbuf = o2; o2 += al256((size_t)NR * 256 * 2);
      const size_t la_bytes = al256(LaLay<96, 112>::end * 2);
      o = m.lab + (la_bytes > o2 - m.lab ? la_bytes : o2 - m.lab); }
    m.labg = o; o += al256(LaLay<64, 96>::end * 2);
    m.obuf = o;
#ifdef HOST_EMU
    o += al256((size_t)NR * 384 * 4);
    m.s5tab = o; o += (size_t)64 << 20;
#endif
    m.end_mix = o;
    o = m.uni;
    m.act = o; o += al256((size_t)NR * DFF * 2);
    m.end_ffn = o;
    o = m.uni;
    m.mw13T = o; o += al256((size_t)NE * 2 * DFF * D);
#ifdef HOST_EMU
    o += al256((size_t)NE * 2 * DFF * D);
#endif
    m.mw2T = o; o += al256((size_t)NE * D * DFF * 2);
    m.xs8 = o; o += al256((size_t)MOE_XT * 256 * D);
#if FP8_DOWN_MOE && !defined(HOST_EMU)
    m.mact = o; o += al256((size_t)MOE_MAXT * 256 * DFF);
#else
    m.mact = o; o += al256((size_t)MOE_MAXT * 256 * DFF * 2);
#endif
    m.yrow = o; o += al256((size_t)MOE_MAXT * 256 * D * 2);
    m.rt_e = o; o += al256((size_t)NR * 2 * 4);
    m.rt_w = o; o += al256((size_t)NR * 2 * 4);
    m.rt_dest = o; o += al256((size_t)NR * 2 * 4);
    m.segcnt = o; o += al256((size_t)NE * (NR / 64 + 1) * 4);
    m.ecnt = o; o += al256((size_t)64 * 4);
    m.row_token = o; o += al256((size_t)MOE_MAXT * 256 * 4);
    m.tile_e = o; o += al256((size_t)MOE_MAXT * 4);
    m.ntile = o; o += 256;
    m.end_moe = o;
    m.end = m.end_mix > m.end_moe ? m.end_mix : m.end_moe; if (m.end_ffn > m.end) m.end = m.end_ffn;
    return m;
}
constexpr WsMap WS = make_map();
struct S5Tab { size_t disc, K, apow, bbar, TB, EB, gluT, end; };
constexpr S5Tab make_s5tab() { S5Tab t{}; size_t o = 0;
    t.disc = o; o += al256((size_t)2 * 16 * 64 * 4 * 4); t.K = o; o += al256((size_t)2 * 16 * 64 * 256 * 4); t.apow = o; o += al256((size_t)2 * 16 * 65 * 64 * 2 * 4); t.bbar = o; o += al256((size_t)2 * 16 * 64 * 16 * 2 * 4);
    t.TB = o; o += al256((size_t)16 * 1024 * 1280 * 2); t.EB = o; o += al256((size_t)16 * 256 * 1024 * 2); t.gluT = o; o += al256((size_t)256 * 256 * 2); t.end = o; return t; }
constexpr S5Tab S5T = make_s5tab();
constexpr size_t ABUF_BYTES = al256((size_t)NR * D * 2);
#ifndef HOST_EMU
static_assert(ABUF_BYTES + S5T.end <= (size_t)NB * SEQ * D * 4, "the bf16 row buffer and the S5 tables must fit in d_out");
#endif

struct PosTab { long n; float* tab;
    HD void operator()(long i) const { const int cc = (int)(i % 512); const int pos = (int)((i / 512) % GRID_W); const int j = cc & 255; const float omega = expf(-9.210340371976184f * (float)j / 256.0f); const float ang = (float)pos * omega;
        tab[i] = (cc & 256) ? cosf(ang) : sinf(ang); } };
struct __attribute__((aligned(16))) F4 { float x, y, z, w; };
struct InitH { long n; const float* x; const float* ctx; const float* tab; float* h;
    HD void operator()(long i) const { const int r = (int)(i / (D / 4)), c = (int)(i % (D / 4)) * 4; const int b = r / RPB, t = r % RPB; F4 v;
        if (t < CTX) v = *(const F4*)(ctx + ((size_t)b * CTX + t) * D + c);
        else { const int tl = t - CTX, row = tl / GRID_W, col = tl % GRID_W; const F4 xv = *(const F4*)(x + ((size_t)b * SEQ + tl) * D + c);
            const F4 pe = *(const F4*)(tab + (c < 512 ? (size_t)row * 512 + c : (size_t)(GRID_W + col) * 512 + (c - 512))); v.x = xv.x + pe.x; v.y = xv.y + pe.y; v.z = xv.z + pe.z; v.w = xv.w + pe.w; }
        *(F4*)(h + (size_t)r * D + c) = v; } };
struct ModK { long n; const float* c; const float* cctx; const float* w_ada; const float* b_ada; float* mod;
    HD void operator()(long i) const { const int l = (int)(i / (6 * D)), j = (int)(i % (6 * D));
        float acc[NMOD];
        for (int m = 0; m < NMOD; ++m) acc[m] = b_ada[(size_t)l * 6 * D + j];
        const float* w = w_ada + (size_t)l * D * 6 * D + j;
        for (int k = 0; k < D; ++k) { const float wv = w[(size_t)k * 6 * D];
            for (int m = 0; m < NMOD; ++m) { const float cv = (m < NB) ? c[m * D + k] : cctx[k]; acc[m] += siluf(cv) * wv; } }
        for (int m = 0; m < NMOD; ++m) mod[((size_t)l * NMOD + m) * 6 * D + j] = acc[m]; } };
struct TransposeK { long n; const float* a; const float* b; bf16* dst; int K, N, NP, pad;
    HD void operator()(long i) const { const int nn = (int)(i / K), k = (int)(i % K);
        float v = 0.f;
        if (b) { const int j = nn >> 1; v = (nn & 1) ? b[(size_t)k * N + j] : a[(size_t)k * N + j]; }
        else if (nn < N) v = a[(size_t)k * N + nn];
        dst[i] = f2bf(v); } };
struct NormModK { long n; const float* h; const float* g; const float* mod; int sh_off, sc_off; bf16* out; const float* wr; int* rt_e; float* rt_w; int skip_ctx, nseg; int* segcnt;
    HD void operator()(long r) const { const float* hr = h + (size_t)r * D; float ss = 0.f;
        for (int k = 0; k < D; ++k) ss += hr[k] * hr[k];
        const float rstd = 1.0f / sqrtf(ss / D + EPS); const float* m = mod + (size_t)mod_index((int)r) * 6 * D;
        float lg[NE]; for (int e = 0; e < NE; ++e) lg[e] = 0.f;
        for (int k = 0; k < D; ++k) { const float v = hr[k] * rstd * g[k] * (1.0f + m[sc_off + k]) + m[sh_off + k]; out[(size_t)r * D + k] = f2bf(v);
            if (wr) for (int e = 0; e < NE; ++e) lg[e] += v * wr[k * NE + e]; }
        if (wr) { int e0 = 0; float b0 = lg[0]; for (int e = 1; e < NE; ++e) if (lg[e] > b0) { b0 = lg[e]; e0 = e; }
            int e1 = -1; float b1 = -3.0e38f; for (int e = 0; e < NE; ++e) if (e != e0 && lg[e] > b1) { b1 = lg[e]; e1 = e; }
            const float w1 = 1.0f / (1.0f + expf(b1 - b0));
            const bool skip = skip_ctx && ((int)(r % RPB) < CTX);
            rt_e[2 * r] = skip ? -1 : e0; rt_e[2 * r + 1] = skip ? -1 : e1; rt_w[2 * r] = w1; rt_w[2 * r + 1] = 1.0f - w1;
            if (!skip) { __atomic_fetch_add(&segcnt[(size_t)e0 * nseg + r / 64], 1, __ATOMIC_RELAXED); __atomic_fetch_add(&segcnt[(size_t)e1 * nseg + r / 64], 1, __ATOMIC_RELAXED); } } } };

struct SiluC { long n; const float* c; const float* cctx; float* sc;
    HD void operator()(long i) const { const int m = (int)(i / D), k = (int)(i % D); sc[i] = siluf(m < NB ? c[m * D + k] : cctx[k]); } };
constexpr int A8S = 2;
constexpr int W8S = 6;
constexpr int MODKC = 8;
struct ModPart { long n; const float* sc; const float* w_ada; float* part;
    HD void operator()(long i) const { const int j = (int)(i % (6 * D)); long y = i / (6 * D); const int l = (int)(y % DEPTH), kc = (int)(y / DEPTH);
        float acc[NMOD]; for (int m = 0; m < NMOD; ++m) acc[m] = 0.f;
        const float* w = w_ada + ((size_t)l * D + (size_t)kc * (D / MODKC)) * 6 * D + j; const float* s0 = sc + kc * (D / MODKC);
        for (int k = 0; k < D / MODKC; ++k) { const float wv = w[(size_t)k * 6 * D];
            for (int m = 0; m < NMOD; ++m) acc[m] += s0[m * D + k] * wv; }
        for (int m = 0; m < NMOD; ++m) part[(((size_t)kc * DEPTH + l) * NMOD + m) * 6 * D + j] = acc[m]; } };
struct ModReduce { long n; const float* part; const float* b_ada; float* mod;
    HD void operator()(long i) const { const int j = (int)(i % (6 * D)); long y = i / (6 * D); const int m = (int)(y % NMOD), l = (int)(y / NMOD); float a = b_ada[(size_t)l * 6 * D + j];
        for (int kc = 0; kc < MODKC; ++kc) a += part[(((size_t)kc * DEPTH + l) * NMOD + m) * 6 * D + j];
        mod[i] = a; } };
struct ZeroBf16 { long n; bf16* p; HD void operator()(long i) const { p[i] = 0; } };
HD uint32_t pk2(float lo, float hi) { return (uint32_t)f2bf(lo) | ((uint32_t)f2bf(hi) << 16); }
struct GlaFused { long n; const bf16* p; const float* wa2; const float* ba; bf16* lab;
    struct Ld { U4 l0[4], l1[4]; bf16 q[4], k[4]; };
    HD void load4(Ld& L_, const bf16* pe, int pstep, int j) const { UNROLL for (int e = 0; e < 4; ++e) { const bf16* pt = pe + e * pstep; const U4* lr = (const U4*)(pt + GLR); L_.l0[e] = lr[0]; L_.l1[e] = lr[1]; L_.q[e] = pt[GQ + j]; L_.k[e] = pt[GK + j]; } }
    HD void operator()(long x) const { typedef LaLay<64, 96> L; const int xi = (int)x; const int j = xi % 192; int y = xi / 192; const int blk = y % NBLK; y /= NBLK; const int b = y % NB, d = y / NB;
        const int hh = j / 48, i = j % 48; const size_t item = (size_t)(b * NBLK + blk) * 4 + hh; float w[16]; UNROLL for (int q = 0; q < 16; ++q) w[q] = wa2[(d * 16 + q) * 192 + j];
        const float bj = ba[d * 192 + j]; float c = 0.f;
        const int s_first = d == 0 ? 0 : 63, dir = d == 0 ? 1 : -1; const int r_first = b * RPB + blk * 64 + s_first;
        const bf16* pr = p + (size_t)r_first * PS; const int pstep = dir * PS; Ld cur, nxt; load4(cur, pr, pstep, j); float ko[8];
        for (int g4 = 0; g4 < 16; ++g4) {
            if (g4 < 15) load4(nxt, pr + 4 * pstep, pstep, j);
            UNROLL for (int e = 0; e < 4; ++e) { const uint32_t u[8] = {cur.l0[e].x, cur.l0[e].y, cur.l0[e].z, cur.l0[e].w, cur.l1[e].x, cur.l1[e].y, cur.l1[e].z, cur.l1[e].w}; float z = bj;
                UNROLL for (int q = 0; q < 8; ++q) { z += bf2f((bf16)(u[q] & 0xffffu)) * w[2 * q]; z += bf2f((bf16)(u[q] >> 16)) * w[2 * q + 1]; }
                c += logsigmoidf_(z) * (1.0f / 16.0f); const float kk = bf2f(cur.k[e]) * fexp(-c); const int tok = s_first + dir * (g4 * 4 + e);
                lab[L::q_at(d, item, tok, i)] = f2bf(bf2f(cur.q[e]) * 0.14433756729740643f * fexp(c)); lab[L::k_at(d, item, tok, i)] = f2bf(kk); ko[(g4 & 1) * 4 + e] = kk;
                if (i < 16) { lab[L::q_at(d, item, tok, 48 + i)] = 0; lab[L::k_at(d, item, tok, 48 + i)] = 0; } }
            pr += 4 * pstep;
            if (g4 & 1) { U4 v; const int c8 = g4 >> 1; const int s0 = d == 0 ? c8 * 8 : 56 - c8 * 8;
                v.x = d == 0 ? pk2(ko[0], ko[1]) : pk2(ko[7], ko[6]); v.y = d == 0 ? pk2(ko[2], ko[3]) : pk2(ko[5], ko[4]); v.z = d == 0 ? pk2(ko[4], ko[5]) : pk2(ko[3], ko[2]); v.w = d == 0 ? pk2(ko[6], ko[7]) : pk2(ko[1], ko[0]);
                *(U4*)(lab + L::kt_at(d, item, i, s0)) = v; if (i < 16) { U4 zz; zz.x = zz.y = zz.z = zz.w = 0u; *(U4*)(lab + L::kt_at(d, item, 48 + i, s0)) = zz; } }
            cur = nxt; }
        float* dec = (float*)(lab + L::dec) + ((size_t)d * LA_NI + item) * 64; dec[i] = fexp(c); if (i < 16) dec[48 + i] = 0.f; } };
template <int NV, int VOFF> struct VTFused { long n; const bf16* p; bf16* vT;
    HD void operator()(long x) const { const int xi = (int)x; const int j = xi % NV; const int item = xi / NV; const int hh = item % 4; const int bb = item / 4; const int r0 = (bb / NBLK) * RPB + (bb % NBLK) * 64;
        const bf16* pc = p + (size_t)r0 * PS + VOFF + hh * 96 + (j < 96 ? j : 0); const uint32_t fill = j == 96 ? 0x3f803f80u : 0u; uint32_t t[32];
        UNROLL for (int q = 0; q < 32; ++q) t[q] = (uint32_t)pc[(2 * q) * PS] | ((uint32_t)pc[(2 * q + 1) * PS] << 16);
        UNROLL for (int c8 = 0; c8 < 8; ++c8) { U4 v; v.x = j < 96 ? t[4 * c8] : fill; v.y = j < 96 ? t[4 * c8 + 1] : fill; v.z = j < 96 ? t[4 * c8 + 2] : fill; v.w = j < 96 ? t[4 * c8 + 3] : fill;
            *(U4*)(vT + (size_t)item * NV * 64 + tile_off(j, 8 * c8, 2)) = v; } } };
struct MlFused { long n; const bf16* p; const float* cw; const float* cb; const float* gb; bf16* lab;
    struct Ld { bf16 q[4][3], k[4][3], gi[4], gf[4]; };
    HD void load4(Ld& L_, const bf16* pe, int pstep, int t0, int dir, int cq, int ck, int gi, int gf) const {
        UNROLL for (int e = 0; e < 4; ++e) { const int t = t0 + dir * e; const bool first = (t == 0 || t == CTX), last = (t == CTX - 1 || t == RPB - 1); const bf16* pt = pe + e * pstep;
            L_.q[e][1] = pt[cq]; L_.k[e][1] = pt[ck]; L_.q[e][0] = first ? (bf16)0 : pt[cq - PS]; L_.k[e][0] = first ? (bf16)0 : pt[ck - PS]; L_.q[e][2] = last ? (bf16)0 : pt[cq + PS]; L_.k[e][2] = last ? (bf16)0 : pt[ck + PS];
            L_.gi[e] = pt[gi]; L_.gf[e] = pt[gf]; } }
    HD void operator()(long x) const { typedef LaLay<96, 112> L; const int xi = (int)x; const int i = xi % 96; int y = xi / 96; const int hh = y % 4; y /= 4; const int blk = y % NBLK; y /= NBLK; const int b = y % NB, d = y / NB;
        const size_t item = (size_t)(b * NBLK + blk) * 4 + hh; const int cq = MQ + hh * 96 + i, ck = MQ + 384 + hh * 96 + i;
        const float q0 = cw[cq - MQ], q1 = cw[768 + cq - MQ], q2 = cw[1536 + cq - MQ], qb = cb[cq - MQ], k0 = cw[ck - MQ], k1 = cw[768 + ck - MQ], k2 = cw[1536 + ck - MQ], kb = cb[ck - MQ];
        const int gi = MG + (2 * d) * 4 + hh, gf = MG + (2 * d + 1) * 4 + hh; const float bi = gb[(2 * d) * 4 + hh], bf_ = gb[(2 * d + 1) * 4 + hh]; float Fc = 0.f;
        const int s_first = d == 0 ? 0 : 63, dir = d == 0 ? 1 : -1; const int t_first = blk * 64 + s_first; const int r_first = b * RPB + t_first;
        const bf16* pr = p + (size_t)r_first * PS; const int pstep = dir * PS; Ld cur, nxt; load4(cur, pr, pstep, t_first, dir, cq, ck, gi, gf); float ko[8];
        for (int g4 = 0; g4 < 16; ++g4) {
            if (g4 < 15) load4(nxt, pr + 4 * pstep, pstep, t_first + dir * (g4 * 4 + 4), dir, cq, ck, gi, gf);
            UNROLL for (int e = 0; e < 4; ++e) { const float yq = q0 * bf2f(cur.q[e][0]) + q1 * bf2f(cur.q[e][1]) + q2 * bf2f(cur.q[e][2]), yk = k0 * bf2f(cur.k[e][0]) + k1 * bf2f(cur.k[e][1]) + k2 * bf2f(cur.k[e][2]);
                const float qc = siluf(yq + qb), kc = siluf(yk + kb) * 0.10206207261596577f; Fc += logsigmoidf_(bf2f(cur.gf[e]) + bf_); const float kk = kc * fexp(bf2f(cur.gi[e]) + bi - Fc); const int tok = s_first + dir * (g4 * 4 + e);
                lab[L::q_at(d, item, tok, i)] = f2bf(qc * fexp(Fc)); lab[L::k_at(d, item, tok, i)] = f2bf(kk); ko[(g4 & 1) * 4 + e] = kk; }
            pr += 4 * pstep;
            if (g4 & 1) { U4 v; const int c8 = g4 >> 1; const int s0 = d == 0 ? c8 * 8 : 56 - c8 * 8;
                v.x = d == 0 ? pk2(ko[0], ko[1]) : pk2(ko[7], ko[6]); v.y = d == 0 ? pk2(ko[2], ko[3]) : pk2(ko[5], ko[4]); v.z = d == 0 ? pk2(ko[4], ko[5]) : pk2(ko[3], ko[2]); v.w = d == 0 ? pk2(ko[6], ko[7]) : pk2(ko[1], ko[0]);
                *(U4*)(lab + L::kt_at(d, item, i, s0)) = v; }
            cur = nxt; }
        ((float*)(lab + L::dec))[((size_t)d * LA_NI + item) * 96 + i] = fexp(Fc); } };
template <int DKP, int NV> struct StatesRef { long n; bf16* lab;
    HD void operator()(long x) const { typedef LaLay<DKP, NV> L; const int i = (int)(x % DKP); long y = x / DKP; const int j = (int)(y % NV); y /= NV; const size_t item = (size_t)(y % LA_NI); const int d = (int)(y / LA_NI); float acc = 0.f;
        for (int sx = 0; sx < 64; ++sx) acc += bf2f(lab[L::v_at(item, j, sx)]) * bf2f(lab[L::kt_at(d, item, i, sx)]);
        lab[L::s_at(d, item, j, i)] = f2bf(acc); } };
constexpr int CARRY_CH = (NBLK % 17 == 0) ? 17 : ((NBLK % 4 == 0) ? 4 : 1);
template <int DKP, int NV> struct CarryT { long n; bf16* lab;
    HD void operator()(long x) const { typedef LaLay<DKP, NV> L; const int xi = (int)x; const int i = xi % DKP; int y = xi / DKP; const int j = y % NV; y /= NV; const int hh = y % 4; y /= 4; const int b = y % NB, d = y / NB;
        const float* dec = (const float*)(lab + L::dec); float sv = 0.f;
        for (int step = 0; step < NBLK; ++step) { const size_t item = (size_t)(b * NBLK + chain_blk(d, step)) * 4 + hh; const size_t o = L::s_at(d, item, j, i);
            const float tv = bf2f(lab[o]), dv = dec[((size_t)d * LA_NI + item) * DKP + i]; lab[o] = f2bf(sv); sv = dv * (sv + tv); } } };
template <int DKP, int NV, bool ISML> struct OutRef { long n; const bf16* lab; float* obuf;
    HD void operator()(long x) const { typedef LaLay<DKP, NV> L; const int j = (int)(x % 96); long y = x / 96; const int hh = (int)(y % 4); const int r = (int)(y / 4); const int b = r / RPB, t = r % RPB, blk = t / 64, tt = t % 64;
        const size_t item = ((size_t)b * NBLK + blk) * 4 + hh; float hv = 0.f;
        for (int d = 0; d < 2; ++d) { float num = 0.f, den = 0.f;
            for (int sx = 0; sx < 64; ++sx) { const bool valid = d == 0 ? (sx <= tt) : (sx >= tt); if (!valid) continue;
                float a = 0.f; for (int i = 0; i < DKP; ++i) a += bf2f(lab[L::q_at(d, item, tt, i)]) * bf2f(lab[L::k_at(d, item, sx, i)]);
                a = bf2f(f2bf(a)); num += a * bf2f(lab[L::v_at(item, j, sx)]); if (ISML) den += a * bf2f(lab[L::v_at(item, 96, sx)]); }
            for (int i = 0; i < DKP; ++i) { const float qv = bf2f(lab[L::q_at(d, item, tt, i)]); num += qv * bf2f(lab[L::s_at(d, item, j, i)]); if (ISML) den += qv * bf2f(lab[L::s_at(d, item, 96, i)]); }
            hv += ISML ? num / fmaxf(fabsf(den), 1.0f) : num; }
        obuf[x] = hv; } };
struct HeadFin { long n; const bf16* p; const float* obuf; const float* gain; bf16* mix; int mode, pad;
    HD void operator()(long x) const { const int hh = (int)(x % 4), r = (int)(x / 4); const float* o = obuf + (size_t)r * 384 + hh * 96; float ss = 0.f;
        for (int j = 0; j < 96; ++j) ss += o[j] * o[j];
        const float rstd = 1.0f / sqrtf(ss / 96.0f + EPS);
        for (int j = 0; j < 96; ++j) { const float gv = bf2f(p[(size_t)r * PS + (mode ? MO : GG) + hh * 96 + j]); const float gt = mode ? sigmoidf_(gv) : siluf(gv);
            mix[(size_t)r * D + (mode ? 640 : 0) + hh * 96 + j] = f2bf(o[j] * rstd * gain[j] * gt); } } };

struct S5Disc { long n; const float* lre; const float* lim; const float* ldt; float* disc;
    HD void operator()(long x) const { const int nn = (int)(x % 64); const int dg = (int)(x / 64); const float dt = expf(ldt[dg]); const float lr = lre[x], li = lim[x];
        const float mag = expf(lr * dt), ar = mag * cosf(li * dt), ai = mag * sinf(li * dt), den = lr * lr + li * li, pr = ar - 1.0f, pi = ai;
        disc[x * 4 + 0] = lr * dt; disc[x * 4 + 1] = li * dt; disc[x * 4 + 2] = (pr * lr + pi * li) / den; disc[x * 4 + 3] = (pi * lr - pr * li) / den; (void)nn; } };
HD void s5_apow(const float* disc4, float tau, float& ar, float& ai) { const float mag = expf(disc4[0] * tau); ar = mag * cosf(disc4[1] * tau); ai = mag * sinf(disc4[1] * tau); }
struct ZeroInt { long n; int* p; HD void operator()(long i) const { p[i] = 0; } };
struct MoePrefix { long n; int* segcnt; int* ecnt; int nseg, pad;
    HD void operator()(long e) const { int c = 0; for (int sg = 0; sg < nseg; ++sg) { const int v = segcnt[(size_t)e * nseg + sg]; segcnt[(size_t)e * nseg + sg] = c; c += v; } ecnt[e] = c; } };
struct MoeTiles2 { long n; const int* ecnt; int* tile_e; int* ntile;
    HD void operator()(long t) const { int acc = 0, ef = 0; for (int e = 0; e < NE; ++e) { const int nt = (ecnt[e] + 255) / 256; if (t >= acc && t < acc + nt) ef = e; acc += nt; } tile_e[t] = ef; if (t == 0) ntile[0] = acc; } };
struct MoeFillNeg { long n; int* row_token; HD void operator()(long i) const { row_token[i] = -1; } };
struct MoeAssign { long n; const int* rt_e; const int* segcnt; const int* ecnt; int* rt_dest; int* row_token; int nseg, pad;
    HD void operator()(long x) const { const int seg = (int)(x % nseg), e = (int)(x / nseg); int pstart = 0; for (int q = 0; q < e; ++q) pstart += (ecnt[q] + 255) / 256 * 256;
        int pos = pstart + segcnt[(size_t)e * nseg + seg];
        for (int r = seg * 64; r < seg * 64 + 64 && r < NR; ++r) for (int k = 0; k < 2; ++k) if (rt_e[2 * r + k] == e) { rt_dest[2 * r + k] = pos; row_token[pos] = r; ++pos; } } };
struct MoeGather8 { long n; const unsigned char* f8; const int* row_token; unsigned char* xs; int row0, pad;
    HD void operator()(long i) const { const int lr = (int)(i / (D / 16)), c = (int)(i % (D / 16)) * 16; const int tok = row_token[row0 + lr];
        U4 v; v.x = v.y = v.z = v.w = 0u; if (tok >= 0) v = *(const U4*)(f8 + (size_t)tok * D + c); *(U4*)(xs + (size_t)lr * D + c) = v; } };
struct MoeCombine { long n; float* h; const bf16* yrow; const int* rt_e; const float* rt_w; const int* rt_dest; const float* mod; int g_off, pad;
    HD void operator()(long i) const { const int r = (int)(i / (D / 8)), c = (int)(i % (D / 8)) * 8; if (rt_e[2 * r] < 0) return;
        const U4 y0 = *(const U4*)(yrow + (size_t)rt_dest[2 * r] * D + c), y1 = *(const U4*)(yrow + (size_t)rt_dest[2 * r + 1] * D + c); const float w0 = rt_w[2 * r], w1 = rt_w[2 * r + 1];
        const float* g = mod + (size_t)mod_index(r) * 6 * D + g_off + c; float* hp = h + (size_t)r * D + c; const F4 g0 = *(const F4*)g, g1 = *(const F4*)(g + 4); F4 h0 = *(const F4*)hp, h1 = *(const F4*)(hp + 4);
        const uint32_t a[4] = {y0.x, y0.y, y0.z, y0.w}, bq[4] = {y1.x, y1.y, y1.z, y1.w}; float yv[8];
        UNROLL for (int q = 0; q < 4; ++q) { yv[2 * q] = w0 * bf2f((bf16)(a[q] & 0xffffu)) + w1 * bf2f((bf16)(bq[q] & 0xffffu)); yv[2 * q + 1] = w0 * bf2f((bf16)(a[q] >> 16)) + w1 * bf2f((bf16)(bq[q] >> 16)); }
        h0.x += g0.x * yv[0]; h0.y += g0.y * yv[1]; h0.z += g0.z * yv[2]; h0.w += g0.w * yv[3]; h1.x += g1.x * yv[4]; h1.y += g1.y * yv[5]; h1.z += g1.z * yv[6]; h1.w += g1.w * yv[7];
        *(F4*)hp = h0; *(F4*)(hp + 4) = h1; } };
struct FinalNorm { long n; const float* h; const float* g; float* out;
    HD void operator()(long x) const { const int b = (int)(x / SEQ), tl = (int)(x % SEQ); const float* hr = h + ((size_t)b * RPB + CTX + tl) * D; float ss = 0.f;
        for (int k = 0; k < D; ++k) ss += hr[k] * hr[k];
        const float rstd = 1.0f / sqrtf(ss / D + EPS); for (int k = 0; k < D; ++k) out[(size_t)x * D + k] = hr[k] * rstd * g[k]; } };

struct EpiStoreBf16 { bf16* out; int ld; int row_off;
    HD void apply8(int row, int col0, const float* v) const { bf16* o = out + (size_t)(row - row_off) * ld + col0;
#ifndef HOST_EMU
        store8_bf16(o, v);
#else
        for (int i = 0; i < 8; ++i) o[i] = f2bf(v[i]);
#endif
    } };
struct EpiSwiGLU { bf16* out; int ld; int row_off;
    HD void apply8(int row, int col0, const float* v) const { bf16* o = out + (size_t)(row - row_off) * ld + col0 / 2;
#ifndef HOST_EMU
        uint2 w; w.x = cvt_pk_bf16(fast_silu(v[0]) * v[1], fast_silu(v[2]) * v[3]); w.y = cvt_pk_bf16(fast_silu(v[4]) * v[5], fast_silu(v[6]) * v[7]); *(uint2*)o = w;
#else
        for (int i = 0; i < 4; ++i) o[i] = f2bf(siluf(v[2 * i]) * v[2 * i + 1]);
#endif
    } };
#ifndef HOST_EMU
struct EpiSwiGLU8 { unsigned char* out; int ld; int row_off;
    __device__ __forceinline__ void apply8(int row, int col0, const float* v) const { unsigned char* o = out + (size_t)(row - row_off) * ld + col0 / 2; const float sc = (float)(1 << A8S);
        float a0 = fast_silu(v[0]) * v[1] * sc, a1 = fast_silu(v[2]) * v[3] * sc, a2 = fast_silu(v[4]) * v[5] * sc, a3 = fast_silu(v[6]) * v[7] * sc;
        a0 = __builtin_amdgcn_fmed3f(a0, -440.f, 440.f); a1 = __builtin_amdgcn_fmed3f(a1, -440.f, 440.f); a2 = __builtin_amdgcn_fmed3f(a2, -440.f, 440.f); a3 = __builtin_amdgcn_fmed3f(a3, -440.f, 440.f);
        int w = 0; w = __builtin_amdgcn_cvt_pk_fp8_f32(a0, a1, w, false); w = __builtin_amdgcn_cvt_pk_fp8_f32(a2, a3, w, true); *(unsigned*)o = (unsigned)w; } };
#endif
struct EpiResid { float* h; const float* mod; int g_off, pad;
    HD void apply8(int row, int col0, const float* v) const { float* o = h + (size_t)row * D + col0; const float* g = mod + (size_t)mod_index(row) * 6 * D + g_off + col0;
#ifndef HOST_EMU
        const f4_t g0 = *(const f4_t*)g, g1 = *(const f4_t*)(g + 4); f4_t h0 = *(const f4_t*)o, h1 = *(const f4_t*)(o + 4);
        h0 += g0 * (f4_t){v[0], v[1], v[2], v[3]}; h1 += g1 * (f4_t){v[4], v[5], v[6], v[7]}; *(f4_t*)o = h0; *(f4_t*)(o + 4) = h1;
#else
        for (int i = 0; i < 8; ++i) o[i] += g[i] * v[i];
#endif
    } };

struct GemmDesc { const bf16* A; const bf16* Bt; const int* tile_e; const int* ntile; const int* arow; size_t e_stride; int M, N, K, tile0, lda, ldb, tdiv, pad; };
HD GemmDesc mk_gemm(const bf16* A, int lda, const bf16* Bt, int ldb, int M, int N, int K) { return GemmDesc{A, Bt, nullptr, nullptr, nullptr, 0, M, N, K, 0, lda, ldb, 0, 0}; }

constexpr int S5RB = NB * NBLK;
constexpr int S5RG = (S5RB + 255) / 256 * 256;
constexpr int S5K_ = 1280;
HD void s5_bbar(const float* d4, float br, float bi, float& bbr, float& bbi) { bbr = d4[2] * br - d4[3] * bi; bbi = d4[2] * bi + d4[3] * br; }
struct S5Apow { long n; const float* lre; const float* lim; const float* ldt; float* apow;
    HD void operator()(long x) const { const int nn = (int)(x % 64); long y = x / 64; const int tau = (int)(y % 65); const int dg = (int)(y / 65); const float dt = expf(ldt[dg]);
        const float lr = lre[(size_t)dg * 64 + nn] * dt, li = lim[(size_t)dg * 64 + nn] * dt; const float mag = expf(lr * (float)tau); apow[x * 2] = mag * cosf(li * (float)tau); apow[x * 2 + 1] = mag * sinf(li * (float)tau); } };
struct S5Bbar { long n; const float* disc; const float* bre; const float* bim; float* bbar;
    HD void operator()(long x) const { const int pp = (int)(x % 16); long y = x / 16; const int nn = (int)(y % 64); y /= 64; const int g = (int)(y % 16), d = (int)(y / 16); (void)d;
        const float* d4 = disc + (y * 64 + nn) * 4; float br, bi; s5_bbar(d4, bre[((size_t)g * 64 + nn) * 16 + pp], bim[((size_t)g * 64 + nn) * 16 + pp], br, bi); bbar[x * 2] = br; bbar[x * 2 + 1] = bi; } };
struct S5K2 { long n; const float* apow; const float* bbar; const float* cre; const float* cim; float* Kt;
    HD void operator()(long x) const { const int p2 = (int)(x % 16); long y = x / 16; const int p1 = (int)(y % 16); y /= 16; const int tau = (int)(y % 64); y /= 64; const int g = (int)(y % 16), d = (int)(y / 16); float acc = 0.f;
        const float* ap = apow + (((size_t)d * 16 + g) * 65 + tau) * 64 * 2; const float* bb = bbar + (((size_t)d * 16 + g) * 64) * 16 * 2;
        for (int nn = 0; nn < 64; ++nn) { const float ar = ap[nn * 2], ai = ap[nn * 2 + 1], bbr = bb[(nn * 16 + p2) * 2], bbi = bb[(nn * 16 + p2) * 2 + 1];
            acc += cre[((size_t)g * 16 + p1) * 64 + nn] * (ar * bbr - ai * bbi) - cim[((size_t)g * 16 + p1) * 64 + nn] * (ar * bbi + ai * bbr); }
        Kt[x] = acc; } };
struct S5BuildTB { long n; const float* apow; const float* cre; const float* cim; const float* Kt; bf16* TB;
    HD void operator()(long x) const { const int k0 = (int)(x % (S5K_ / 8)) * 8; long y = x / (S5K_ / 8); const int tp = (int)(y % 1024), g = (int)(y / 1024); const int t = tp >> 4, p1 = tp & 15; float v[8];
        if (k0 < 1024) { const int sx = k0 >> 4, p2 = k0 & 15; const float* kf = Kt + ((((size_t)0 * 16 + g) * 64 + (sx <= t ? t - sx : 0)) * 16 + p1) * 16 + p2; const float* kb = Kt + ((((size_t)1 * 16 + g) * 64 + (sx >= t ? sx - t : 0)) * 16 + p1) * 16 + p2;
            UNROLL for (int q = 0; q < 8; ++q) v[q] = (sx <= t ? kf[q] : 0.f) + (sx >= t ? kb[q] : 0.f);
        } else { const int kk = k0 - 1024, d = kk >> 7, n0 = (kk & 127) >> 1; const int pt = d == 0 ? t : 63 - t; const float* ap = apow + ((((size_t)d * 16 + g) * 65 + pt + 1) * 64 + n0) * 2;
            UNROLL for (int q = 0; q < 4; ++q) { const float ar = ap[2 * q], ai = ap[2 * q + 1], cr = cre[((size_t)g * 16 + p1) * 64 + n0 + q], ci = cim[((size_t)g * 16 + p1) * 64 + n0 + q]; v[2 * q] = cr * ar - ci * ai; v[2 * q + 1] = -(cr * ai + ci * ar); } }
        U4 o; o.x = pk2(v[0], v[1]); o.y = pk2(v[2], v[3]); o.z = pk2(v[4], v[5]); o.w = pk2(v[6], v[7]); *(U4*)(TB + x * 8) = o; } };
struct S5BuildEB { long n; const float* apow; const float* bbar; bf16* EB;
    HD void operator()(long x) const { const int k0 = (int)(x % 128) * 8; long y = x / 128; const int col = (int)(y % 256), g = (int)(y / 256); const int d = col >> 7, nn = (col & 127) >> 1, ri = col & 1, sx = k0 >> 4, p2 = k0 & 15;
        const float* ap = apow + ((((size_t)d * 16 + g) * 65 + (d == 0 ? 63 - sx : sx)) * 64 + nn) * 2; const float* bb = bbar + ((((size_t)d * 16 + g) * 64 + nn) * 16 + p2) * 2; const float ar = ap[0], ai = ap[1]; float v[8];
        UNROLL for (int q = 0; q < 8; ++q) { const float bbr = bb[2 * q], bbi = bb[2 * q + 1]; v[q] = ri == 0 ? (ar * bbr - ai * bbi) : (ar * bbi + ai * bbr); }
        U4 o; o.x = pk2(v[0], v[1]); o.y = pk2(v[2], v[3]); o.z = pk2(v[4], v[5]); o.w = pk2(v[6], v[7]); *(U4*)(EB + x * 8) = o; } };
struct S5BuildU { long n; const bf16* p; bf16* uG;
    HD void operator()(long x) const { const int k0 = (int)(x % 128) * 8; long y = x / 128; const int rb = (int)(y % S5RB), g = (int)(y / S5RB); const int b = rb / NBLK, blk = rb % NBLK;
        *(U4*)(uG + ((size_t)g * S5RG + rb) * S5K_ + k0) = *(const U4*)(p + ((size_t)b * RPB + blk * 64 + (k0 >> 4)) * PS + SU + g * 16 + (k0 & 15)); } };
struct S5Carry2 { long n; const float* apow; const float* est; bf16* uG;
    HD void operator()(long x) const { const int nn = (int)(x % 64); long y = x / 64; const int d = (int)(y % 2); y /= 2; const int g = (int)(y % 16), b = (int)(y / 16);
        const float* ap = apow + ((((size_t)d * 16 + g) * 65 + 64) * 64 + nn) * 2; const float ar = ap[0], ai = ap[1]; float sr = 0.f, si = 0.f;
        for (int s0 = 0; s0 < NBLK; s0 += CARRY_CH) { float tr[CARRY_CH], ti[CARRY_CH];
            UNROLL for (int e = 0; e < CARRY_CH; ++e) { const size_t row = (size_t)g * S5RG + (size_t)b * NBLK + chain_blk(d, s0 + e); tr[e] = est[row * 256 + d * 128 + 2 * nn]; ti[e] = est[row * 256 + d * 128 + 2 * nn + 1]; }
            UNROLL for (int e = 0; e < CARRY_CH; ++e) { const size_t row = (size_t)g * S5RG + (size_t)b * NBLK + chain_blk(d, s0 + e);
                uG[row * S5K_ + 1024 + d * 128 + 2 * nn] = f2bf(sr); uG[row * S5K_ + 1024 + d * 128 + 2 * nn + 1] = f2bf(si);
                const float nr = ar * sr - ai * si + tr[e], ni = ar * si + ai * sr + ti[e]; sr = nr; si = ni; } } } };
struct EpiStoreF32 { float* out; int ld; int pad;
    HD void apply8(int row, int col0, const float* v) const { float* o = out + (size_t)row * ld + col0;
#ifndef HOST_EMU
        *(f4_t*)o = (f4_t){v[0], v[1], v[2], v[3]}; *(f4_t*)(o + 4) = (f4_t){v[4], v[5], v[6], v[7]};
#else
        for (int i = 0; i < 8; ++i) o[i] = v[i];
#endif
    } };
struct EpiS5Z { const bf16* p; const float* dskip; bf16* zbuf;
    HD void apply8(int row, int col0, const float* v) const { const int g = row / S5RG, rb = row % S5RG; if (rb >= S5RB) return; const int b = rb / NBLK, blk = rb % NBLK, t = col0 >> 4, p0 = col0 & 15;
        const size_t r = (size_t)b * RPB + blk * 64 + t; const int c = g * 16 + p0;
#ifndef HOST_EMU
        float u[8], z[8]; load8_bf16(p + r * PS + SU + c, u); const f4_t d0 = *(const f4_t*)(dskip + c), d1 = *(const f4_t*)(dskip + c + 4); const float dd[8] = {d0.x, d0.y, d0.z, d0.w, d1.x, d1.y, d1.z, d1.w};
#pragma unroll
        for (int i = 0; i < 8; ++i) { const float x = v[i] + dd[i] * u[i]; const float y = 0.7978845608028654f * (x + 0.044715f * x * x * x); const float th = 1.0f - 2.0f * __builtin_amdgcn_rcpf(1.0f + __expf(2.0f * y)); z[i] = 0.5f * x * (1.0f + th); }
        store8_bf16(zbuf + r * 256 + c, z);
#else
        for (int i = 0; i < 8; ++i) zbuf[r * 256 + c + i] = f2bf(gelu_tanhf(v[i] + dskip[c + i] * bf2f(p[r * PS + SU + c + i])));
#endif
    } };
struct EpiGlu { const bf16* zbuf; const float* gb; bf16* mix;
    HD void apply8(int row, int col0, const float* v) const {
#ifndef HOST_EMU
        float z[8], o[8]; load8_bf16(zbuf + (size_t)row * 256 + col0, z); const f4_t b0 = *(const f4_t*)(gb + col0), b1 = *(const f4_t*)(gb + col0 + 4); const float bb[8] = {b0.x, b0.y, b0.z, b0.w, b1.x, b1.y, b1.z, b1.w};
#pragma unroll
        for (int i = 0; i < 8; ++i) o[i] = z[i] * fast_sigmoid(v[i] + bb[i]);
        store8_bf16(mix + (size_t)row * D + 384 + col0, o);
#else
        for (int i = 0; i < 8; ++i) mix[(size_t)row * D + 384 + col0 + i] = f2bf(bf2f(zbuf[(size_t)row * 256 + col0 + i]) * sigmoidf_(v[i] + gb[col0 + i]));
#endif
    } };

#ifndef HOST_EMU
namespace pg8 {
#define PG8_LAS __attribute__((address_space(3)))
typedef short bf16x8 __attribute__((ext_vector_type(8)));
typedef float f32x4 __attribute__((ext_vector_type(4)));
typedef int v4i_t __attribute__((ext_vector_type(4)));
typedef int v8i_t __attribute__((ext_vector_type(8)));
constexpr int BM = 256, BK = 64, HALF = 128, HTB = HALF * BK * 2, STAGE_BYTES = 8 * HTB, NXCD = 8, WGM = 8;
__device__ __forceinline__ int lds_byte(int r, int c) { const int st = (r >> 4) * 2 + (c >> 5), rr = r & 15, cc = c & 31, ob = rr * 64 + cc * 2; return st * 1024 + (ob ^ (((ob >> 9) & 1) << 5)); }
__device__ __forceinline__ void stage_rc(int b, int& R, int& C) { const int st = b / 1024, sb = b % 1024, swz = sb ^ (((sb >> 9) & 1) << 5); R = (st >> 1) * 16 + swz / 64; C = (st & 1) * 32 + (swz % 64) / 2; }
__device__ __forceinline__ int perm32(int rho) { const int n = rho >> 4, i = rho & 15; return 8 * (i >> 2) + 4 * n + (i & 3); }
struct Unit { int pm, pn; };
struct StaticOrder {
    int nM, nN, nwg, G, c;
    __device__ void init(int M, int N, int G_, int c_) { nM = M / BM; nN = N / BM; nwg = nM * nN; G = G_; c = c_; }
    __device__ bool next(int i, Unit& u) const {
        const long L = (long)i * G + c; if (L >= nwg) return false;
        int wgid = (int)L; { const int q = nwg / NXCD, r = nwg % NXCD, xcd = wgid % NXCD, off = wgid / NXCD; wgid = (xcd < r ? xcd * (q + 1) : r * (q + 1) + (xcd - r) * q) + off; }
        const int nig = WGM * nN, gid = wgid / nig, fm = gid * WGM, gsz = (nM - fm) < WGM ? (nM - fm) : WGM;
        u.pm = fm + ((wgid % nig) % gsz); u.pn = (wgid % nig) / gsz; return true;
    }
};
template <class F> __device__ __forceinline__ void epi_apply(const F& f, const f32x4 (&acc)[2][2][4][2], const Unit& u, int wr, int wc, int fr, int fq) {
    const int row0 = u.pm * BM + wr * 64 + fr, col0 = u.pn * BM + wc * 32 + 8 * fq;
#pragma unroll
    for (int ai = 0; ai < 2; ++ai)
#pragma unroll
        for (int m = 0; m < 4; ++m)
#pragma unroll
            for (int bj = 0; bj < 2; ++bj) { const f32x4 v0 = acc[ai][bj][m][0], v1 = acc[ai][bj][m][1];
                const float v[8] = {v0[0], v0[1], v0[2], v0[3], v1[0], v1[1], v1[2], v1[3]};
                f.apply8(row0 + ai * HALF + m * 16, col0 + bj * HALF, v); }
}
#ifndef PG8_SP2
#define PG8_SP2 true
#endif
#ifndef PG8_ALIGN
#define PG8_ALIGN true
#endif
template <class F, bool FP8 = false, bool GATHER = false, bool SP2 = PG8_SP2, bool ALIGN_EPI = PG8_ALIGN>
__device__ __forceinline__ void gemm_phase(PG8_LAS unsigned char* lds, const GemmDesc g, const F& E, int G_, int c_) {
    int tid_ = threadIdx.x; asm volatile("" : "+v"(tid_));
    const int tid = tid_, wid = __builtin_amdgcn_readfirstlane(tid >> 6), lane = tid & 63, wr = wid >> 2, wc = wid & 3, fr = lane & 15, fq = lane >> 4;
    const int K = g.K, nt = FP8 ? K / 128 : K / BK; constexpr unsigned EB = FP8 ? 1u : 2u;
    int M = g.M; if (g.ntile) { int ntl = g.ntile[0] - g.tile0; ntl = ntl < 0 ? 0 : ntl; if (ntl * BM < M) M = ntl * BM; }
    StaticOrder S; S.init(M, g.N, G_, c_);
    unsigned voffB[1]; int RA[2]; unsigned CA[2];
#pragma unroll
    for (int i = 0; i < 2; ++i) { int R, C; stage_rc(tid * 16 + i * 8192, R, C); const int Rb = (R & ~31) + perm32(R & 31);
        RA[i] = R; CA[i] = (unsigned)C * 2u; if (i == 0) voffB[0] = (unsigned)Rb * (unsigned)g.ldb * EB + (unsigned)C * 2u; }
    const size_t pieceB = (size_t)64 * g.ldb * EB;
    const unsigned lda2 = (unsigned)g.lda * EB;
    const size_t kstep = (size_t)(BK * 2);
    const size_t hstepA = (size_t)HALF * g.lda * EB, hstepB = (size_t)HALF * g.ldb * EB;
    const size_t tstepA = 2 * hstepA, tstepB = 2 * hstepB;
    const unsigned ldsw = (unsigned)wid * 1024u; int sc8v = (127 + g.pad / 2) * 0x01010101;
    if constexpr (FP8) asm volatile("" : "+v"(sc8v));
    const int aoff = lds_byte(wr * 64 + fr, fq * 8), boff = lds_byte(wc * 32 + fr, fq * 8);
#define PG8_SA(b, h) (((b) * 2 + (h)) * HTB)
#define PG8_SB(b, h) ((4 + (b) * 2 + (h)) * HTB)
#define PG8_STAGE(bufoff, gbase, voff) do { _Pragma("unroll") for (int _i = 0; _i < 2; ++_i) \
        __builtin_amdgcn_global_load_lds((const unsigned*)((const char*)(gbase) + (voff)[_i]), (PG8_LAS unsigned*)(lds + (bufoff) + ldsw + _i * 8192), 16, 0, 0); } while (0)
#define PG8_STAGEB(bufoff, gbase) do { _Pragma("unroll") for (int _i = 0; _i < 2; ++_i) \
        __builtin_amdgcn_global_load_lds((const unsigned*)((const char*)(gbase) + _i * pieceB + voffB[0]), (PG8_LAS unsigned*)(lds + (bufoff) + ldsw + _i * 8192), 16, 0, 0); } while (0)
#define PG8_RD(off) (*(const PG8_LAS bf16x8*)(lds + (off)))
#define PG8_LDA(dst, b, h) do { if constexpr (FP8) { _Pragma("unroll") for (int m = 0; m < 4; ++m) { dst##8[m].lo = __builtin_bit_cast(v4i_t, PG8_RD(PG8_SA(b, h) + aoff + m * 2048)); dst##8[m].hi = __builtin_bit_cast(v4i_t, PG8_RD(PG8_SA(b, h) + aoff + m * 2048 + 1024)); } } else { \
        _Pragma("unroll") for (int m = 0; m < 4; ++m) _Pragma("unroll") for (int k = 0; k < 2; ++k) dst[m][k] = PG8_RD(PG8_SA(b, h) + aoff + m * 2048 + k * 1024); } } while (0)
#define PG8_LDB(dst, b, h) do { if constexpr (FP8) { _Pragma("unroll") for (int n = 0; n < 2; ++n) { dst##8[n].lo = __builtin_bit_cast(v4i_t, PG8_RD(PG8_SB(b, h) + boff + n * 2048)); dst##8[n].hi = __builtin_bit_cast(v4i_t, PG8_RD(PG8_SB(b, h) + boff + n * 2048 + 1024)); } } else { \
        _Pragma("unroll") for (int n = 0; n < 2; ++n) _Pragma("unroll") for (int k = 0; k < 2; ++k) dst[n][k] = PG8_RD(PG8_SB(b, h) + boff + n * 2048 + k * 1024); } } while (0)
#define PG8_CAT(x0, x1) __builtin_shufflevector(__builtin_bit_cast(v4i_t, x0), __builtin_bit_cast(v4i_t, x1), 0, 1, 2, 3, 4, 5, 6, 7)
#define PG8_MMA(ai, bj, At, Bt) do { __builtin_amdgcn_s_setprio(1); if constexpr (FP8) { _Pragma("unroll") for (int m = 0; m < 4; ++m) _Pragma("unroll") for (int n = 0; n < 2; ++n) \
        asm volatile("v_mfma_scale_f32_16x16x128_f8f6f4 %0, %1, %2, %0, %3, %4 op_sel_hi:[0,0,0]" : "+v"(acc[ai][bj][m][n]) : "v"(Bt##8[n]), "v"(At##8[m]), "v"(sc8v), "v"(sc8v)); } else { \
        _Pragma("unroll") for (int m = 0; m < 4; ++m) _Pragma("unroll") for (int n = 0; n < 2; ++n) _Pragma("unroll") for (int k = 0; k < 2; ++k) \
        acc[ai][bj][m][n] = __builtin_amdgcn_mfma_f32_16x16x32_bf16(Bt[n][k], At[m][k], acc[ai][bj][m][n], 0, 0, 0); } __builtin_amdgcn_s_setprio(0); } while (0)
#define PG8_WAIT_V(n) asm volatile("s_waitcnt vmcnt(" #n ")" ::: "memory")
#define PG8_WAIT_L(n) asm volatile("s_waitcnt lgkmcnt(" #n ")" ::: "memory")
#define PG8_BAR __builtin_amdgcn_s_barrier()
#define PG8_SCHED __builtin_amdgcn_sched_barrier(0)
#define PG8_MKVO(u, vo, base) do { if constexpr (GATHER) { base = (const char*)g.A; int _t = tid; asm volatile("" : "+v"(_t));     \
            _Pragma("unroll") for (int _i = 0; _i < 2; ++_i) { int _R, _C; stage_rc(_t * 16 + _i * 8192, _R, _C); _Pragma("unroll") for (int _h = 0; _h < 2; ++_h) { \
            int _row = g.arow[(size_t)(g.tile0 + (u).pm) * BM + _h * HALF + _R]; _row = _row < 0 ? 0 : _row; vo[_h][_i] = (unsigned)_row * lda2 + (unsigned)_C * 2u; } } } \
        else { base = (const char*)g.A + (size_t)(u).pm * tstepA; _Pragma("unroll") for (int _h = 0; _h < 2; ++_h) _Pragma("unroll") for (int _i = 0; _i < 2; ++_i) vo[_h][_i] = (unsigned)(_h * HALF + RA[_i]) * lda2 + CA[_i]; } } while (0)
#define PG8_BBASE(u) ((const char*)g.Bt + (g.tile_e ? (size_t)g.tile_e[g.tile0 + (u).pm] * g.e_stride * 2 : (g.tdiv ? (size_t)((u).pm / g.tdiv) * g.e_stride * 2 : (size_t)0)) + (size_t)(u).pn * tstepB)
    Unit cur, nxt; int ui = 0;
    if (!S.next(0, cur)) return;
    f32x4 acc[2][2][4][2];
#pragma unroll
    for (int a = 0; a < 2; ++a)
#pragma unroll
        for (int b = 0; b < 2; ++b)
#pragma unroll
            for (int m = 0; m < 4; ++m)
#pragma unroll
                for (int n = 0; n < 2; ++n) acc[a][b][m][n] = (f32x4){0.f, 0.f, 0.f, 0.f};
    bf16x8 At[4][2], B0[2][2], B1[2][2]; v8i_t At8[4], B08[2], B18[2];
    const char* cA; unsigned voC[2][2], voN[2][2]; PG8_MKVO(cur, voC, cA); const char* cB = PG8_BBASE(cur);
    if constexpr (SP2) {
        PG8_STAGEB(PG8_SB(0, 0), cB); PG8_STAGEB(PG8_SB(0, 1), cB + hstepB); PG8_STAGE(PG8_SA(0, 0), cA, voC[0]); PG8_STAGE(PG8_SA(0, 1), cA, voC[1]);
        if (wr == 1) PG8_BAR;
        PG8_WAIT_V(2); PG8_BAR;
        PG8_STAGEB(PG8_SB(1, 0), cB + kstep); PG8_STAGE(PG8_SA(1, 0), cA + kstep, voC[0]); PG8_STAGEB(PG8_SB(1, 1), cB + hstepB + kstep);
        PG8_WAIT_V(6); PG8_BAR;
    } else {
    PG8_STAGEB(PG8_SB(0, 0), cB); PG8_STAGE(PG8_SA(0, 0), cA, voC[0]); PG8_STAGEB(PG8_SB(0, 1), cB + hstepB); PG8_STAGE(PG8_SA(0, 1), cA, voC[1]);
    if (wr == 1) PG8_BAR;
    PG8_WAIT_V(4); PG8_BAR;
    PG8_STAGEB(PG8_SB(1, 0), cB + kstep); PG8_STAGE(PG8_SA(1, 0), cA + kstep, voC[0]); PG8_STAGEB(PG8_SB(1, 1), cB + hstepB + kstep);
    PG8_WAIT_V(6); PG8_BAR;
    }
    for (;;) {
        const bool has_next = S.next(ui + 1, nxt);
        const char* nA = cA; if constexpr (!GATHER) { if (has_next) nA = (const char*)g.A + (size_t)nxt.pm * tstepA; } else if (has_next) PG8_MKVO(nxt, voN, nA); else { _Pragma("unroll") for (int _h = 0; _h < 2; ++_h) _Pragma("unroll") for (int _i = 0; _i < 2; ++_i) voN[_h][_i] = voC[_h][_i]; }
        const char* nB = has_next ? PG8_BBASE(nxt) : cB;
        for (int t = 0; t < nt; t += 2) {
            const bool last = (t == nt - 2);
            const char* a1 = cA + (size_t)(t + 1) * kstep;
            const char* a2 = last ? nA : cA + (size_t)(t + 2) * kstep; const char* b2 = last ? nB : cB + (size_t)(t + 2) * kstep;
            const char* a3 = a2 + kstep; const char* b3 = b2 + kstep;
            if constexpr (SP2) {
            PG8_LDB(B0, 0, 0); PG8_LDB(B1, 0, 1); PG8_SCHED; PG8_LDA(At, 0, 0); PG8_STAGE(PG8_SA(1, 1), a1, voC[1]);
            if constexpr (GATHER) if (last) { _Pragma("unroll") for (int _h = 0; _h < 2; ++_h) _Pragma("unroll") for (int _i = 0; _i < 2; ++_i) voC[_h][_i] = voN[_h][_i]; }
            PG8_WAIT_V(8); PG8_WAIT_L(0); PG8_BAR; PG8_MMA(0, 0, At, B0); PG8_MMA(0, 1, At, B1); PG8_BAR; PG8_SCHED;
            PG8_LDA(At, 0, 1); PG8_STAGEB(PG8_SB(0, 0), b2); PG8_STAGEB(PG8_SB(0, 1), b2 + hstepB); PG8_STAGE(PG8_SA(0, 0), a2, voC[0]);
            PG8_WAIT_V(8); PG8_WAIT_L(0); PG8_BAR; PG8_MMA(1, 0, At, B0); PG8_MMA(1, 1, At, B1); PG8_BAR; PG8_SCHED;
            PG8_LDB(B0, 1, 0); PG8_LDB(B1, 1, 1); PG8_SCHED; PG8_LDA(At, 1, 0); PG8_STAGE(PG8_SA(0, 1), a2, voC[1]);
            PG8_WAIT_V(8); PG8_WAIT_L(0); PG8_BAR; PG8_MMA(0, 0, At, B0); PG8_MMA(0, 1, At, B1); PG8_BAR; PG8_SCHED;
            PG8_LDA(At, 1, 1); PG8_STAGEB(PG8_SB(1, 0), b3); PG8_STAGEB(PG8_SB(1, 1), b3 + hstepB); PG8_STAGE(PG8_SA(1, 0), a3, voC[0]);
            PG8_WAIT_V(8); PG8_WAIT_L(0); PG8_BAR; PG8_MMA(1, 0, At, B0); PG8_MMA(1, 1, At, B1); PG8_BAR; PG8_SCHED;
            } else {
            PG8_LDB(B0, 0, 0); PG8_SCHED; PG8_LDA(At, 0, 0); PG8_STAGE(PG8_SA(1, 1), a1, voC[1]);
            if constexpr (GATHER) if (last) { _Pragma("unroll") for (int _h = 0; _h < 2; ++_h) _Pragma("unroll") for (int _i = 0; _i < 2; ++_i) voC[_h][_i] = voN[_h][_i]; }
            PG8_WAIT_L(8); PG8_BAR; PG8_WAIT_L(0); PG8_MMA(0, 0, At, B0); PG8_BAR; PG8_SCHED;
            PG8_LDB(B1, 0, 1); PG8_STAGEB(PG8_SB(0, 0), b2);
            PG8_BAR; PG8_WAIT_L(0); PG8_MMA(0, 1, At, B1); PG8_BAR;
            PG8_LDA(At, 0, 1); PG8_STAGE(PG8_SA(0, 0), a2, voC[0]);
            PG8_BAR; PG8_WAIT_L(0); PG8_MMA(1, 0, At, B0); PG8_BAR; PG8_SCHED;
            PG8_STAGEB(PG8_SB(0, 1), b2 + hstepB);
            PG8_WAIT_V(6); PG8_BAR; PG8_MMA(1, 1, At, B1); PG8_BAR;
            PG8_LDB(B0, 1, 0); PG8_SCHED; PG8_LDA(At, 1, 0); PG8_STAGE(PG8_SA(0, 1), a2, voC[1]);
            PG8_WAIT_L(8); PG8_BAR; PG8_WAIT_L(0); PG8_MMA(0, 0, At, B0); PG8_BAR; PG8_SCHED;
            PG8_LDB(B1, 1, 1); PG8_STAGEB(PG8_SB(1, 0), b3);
            PG8_BAR; PG8_WAIT_L(0); PG8_MMA(0, 1, At, B1); PG8_BAR;
            PG8_LDA(At, 1, 1); PG8_STAGE(PG8_SA(1, 0), a3, voC[0]);
            PG8_BAR; PG8_WAIT_L(0); PG8_MMA(1, 0, At, B0); PG8_BAR; PG8_SCHED;
            PG8_STAGEB(PG8_SB(1, 1), b3 + hstepB);
            PG8_WAIT_V(6); PG8_BAR; PG8_MMA(1, 1, At, B1); PG8_BAR;
            }
        }
        if constexpr (ALIGN_EPI) { if (wr == 0) PG8_BAR; }
        if constexpr (FP8) asm volatile("s_nop 15\n\ts_nop 15" ::: "memory");
        epi_apply(E, acc, cur, wr, wc, fr, fq);
        if (!has_next) break;
#pragma unroll
        for (int a = 0; a < 2; ++a)
#pragma unroll
            for (int b = 0; b < 2; ++b)
#pragma unroll
                for (int m = 0; m < 4; ++m)
#pragma unroll
                    for (int n = 0; n < 2; ++n) acc[a][b][m][n] = (f32x4){0.f, 0.f, 0.f, 0.f};
        cur = nxt; cA = nA; cB = nB; ++ui;
        if constexpr (ALIGN_EPI) { if (wr == 1) PG8_BAR; }
    }
    PG8_WAIT_V(0);
    if constexpr (!ALIGN_EPI) { if (wr == 0) PG8_BAR; }
    PG8_BAR;
#undef PG8_SA
#undef PG8_SB
#undef PG8_STAGE
#undef PG8_STAGEB
#undef PG8_LDA
#undef PG8_LDB
#undef PG8_MMA
#undef PG8_CAT
#undef PG8_RD
#undef PG8_WAIT_V
#undef PG8_WAIT_L
#undef PG8_BAR
#undef PG8_SCHED
#undef PG8_BBASE
#undef PG8_MKVO
}
}

#define XB_TMO      128
#define XB_XCNT(j)  (256  + 64 * (j))
#define XB_XSUB(j)  (1280 + 64 * (j))
#define XB_XGEN(j)  (2304 + 64 * (j))
#define XB_TOP      3328
#define XB_TOPGEN   3392
#define XCD_BAR_WORDS 3456
#define XB_SPIN_CAP (1u << 20)
#define LAS __attribute__((address_space(3)))
__device__ __forceinline__ unsigned xb_ld(unsigned* p)              { return __hip_atomic_load(p, __ATOMIC_RELAXED, __HIP_MEMORY_SCOPE_AGENT); }
__device__ __forceinline__ unsigned xb_add(unsigned* p, unsigned v) { return __hip_atomic_fetch_add(p, v, __ATOMIC_RELAXED, __HIP_MEMORY_SCOPE_AGENT); }
__device__ __forceinline__ unsigned xb_xcc_id() { return (unsigned)__builtin_amdgcn_s_getreg((3 << 11) | 20) & 0xFu; }
#define XB_SPIN(cond, bar) do { unsigned _sp = 0; while (cond) { __builtin_amdgcn_s_sleep(1); \
    if ((++_sp & 255u) == 0u) { if (xb_ld(&(bar)[XB_TMO])) break; if (_sp > XB_SPIN_CAP) { atomicAdd(&(bar)[XB_TMO], 1u); break; } } } } while (0)
struct XcdBarrier { unsigned* bar; unsigned x; volatile LAS unsigned* st; };
__device__ __forceinline__ XcdBarrier xcd_barrier_post(unsigned* bar, volatile LAS unsigned* st) {
    XcdBarrier b; b.bar = bar; b.x = xb_xcc_id(); b.st = st;
    if (threadIdx.x == 0) (void)xb_add(&bar[XB_XCNT(b.x)], 1u);
    return b;
}
__device__ __forceinline__ void xcd_barrier_complete(unsigned* bar, unsigned x, unsigned& nloc, unsigned& nx) {
    const unsigned G = gridDim.x * gridDim.y * gridDim.z;
    unsigned sum, cnt, mine, sp = 0u;
    for (;;) {
        sum = 0u; cnt = 0u; mine = 0u;
#pragma unroll
        for (unsigned j = 0; j < 16; ++j) { const unsigned c = xb_ld(&bar[XB_XCNT(j)]); sum += c; cnt += (c > 0u) ? 1u : 0u; mine = (j == x) ? c : mine; }
        if (sum == G) break;
        __builtin_amdgcn_s_sleep(1);
        if ((++sp & 255u) == 0u) { if (xb_ld(&bar[XB_TMO])) break; if (sp > XB_SPIN_CAP) { atomicAdd(&bar[XB_TMO], 1u); break; } }
    }
    nloc = mine > 0u ? mine : 1u; nx = cnt > 0u ? cnt : 1u;
}
__device__ __forceinline__ void xcd_barrier(const XcdBarrier& b) {
    asm volatile("s_waitcnt vmcnt(0)" ::: "memory");
    __syncthreads();
    if (threadIdx.x == 0) {
        unsigned* bar = b.bar; asm volatile("" : "+s"(bar));
        __builtin_amdgcn_s_waitcnt(0);
        unsigned nloc = b.st[0], nx = b.st[1];
        if (nloc == 0u) { xcd_barrier_complete(bar, b.x, nloc, nx); b.st[0] = nloc; b.st[1] = nx; }
        const unsigned old = xb_add(&bar[XB_XSUB(b.x)], 1u);
        const unsigned gen = old / nloc;
        if (old + 1u == (gen + 1u) * nloc) {
            __builtin_amdgcn_fence(__ATOMIC_RELEASE, "agent");
            asm volatile("s_waitcnt vmcnt(0)" ::: "memory");
            const unsigned og = xb_add(&bar[XB_TOP], 1u);
            const unsigned tg = og / nx;
            if (og + 1u == (tg + 1u) * nx) xb_add(&bar[XB_TOPGEN], 1u);
            else XB_SPIN(xb_ld(&bar[XB_TOPGEN]) == tg, bar);
            __builtin_amdgcn_fence(__ATOMIC_ACQUIRE, "agent");
            xb_add(&bar[XB_XGEN(b.x)], 1u);
            asm volatile("s_waitcnt vmcnt(0)" ::: "memory");
        } else {
            XB_SPIN(xb_ld(&bar[XB_XGEN(b.x)]) == gen, bar);
            __builtin_amdgcn_fence(__ATOMIC_ACQUIRE, "agent");
            asm volatile("s_waitcnt vmcnt(0)" ::: "memory");
        }
    }
    __syncthreads();
}

__device__ __forceinline__ float wave_sum(float v) {
#pragma unroll
    for (int o = 1; o < 64; o <<= 1) v += __shfl_xor(v, o);
    return v;
}
typedef float f32x4v __attribute__((ext_vector_type(4)));
__device__ __forceinline__ unsigned pk2bf(float lo, float hi) { return (unsigned)f2bf(lo) | ((unsigned)f2bf(hi) << 16); }
#define LDS_WAIT() asm volatile("s_waitcnt lgkmcnt(0)" ::: "memory")
struct NormModW { int n; int sh_off; int sc_off; int skip_ctx; const float* h; const float* g; const float* mod; bf16* out; const float* wr; int* rt_e; float* rt_w; int* segcnt; int nseg, f8;
    __device__ __forceinline__ void wave(int it, int lane, PG8_LAS unsigned char*) const {
        f32x4v v[2][4]; float ss[2] = {0.f, 0.f};
#pragma unroll
        for (int q = 0; q < 2; ++q) { const f32x4v* hr = (const f32x4v*)(h + (size_t)(2 * it + q) * D) + lane;
#pragma unroll
            for (int j = 0; j < 4; ++j) v[q][j] = hr[64 * j]; }
#pragma unroll
        for (int q = 0; q < 2; ++q) {
#pragma unroll
            for (int j = 0; j < 4; ++j) ss[q] += (v[q][j].x * v[q][j].x + v[q][j].y * v[q][j].y) + (v[q][j].z * v[q][j].z + v[q][j].w * v[q][j].w); }
#pragma unroll
        for (int q = 0; q < 2; ++q) { const int r = 2 * it + q;
        const float rstd = 1.0f / sqrtf(wave_sum(ss[q]) * (1.0f / D) + EPS); const float* m = mod + (size_t)mod_index(r) * 6 * D;
        float lg[NE];
#pragma unroll
        for (int e = 0; e < NE; ++e) lg[e] = 0.f;
#pragma unroll
        for (int j = 0; j < 4; ++j) { const int k0 = 4 * (lane + 64 * j); const f32x4v g4 = *(const f32x4v*)(g + k0), sc4 = *(const f32x4v*)(m + sc_off + k0), sh4 = *(const f32x4v*)(m + sh_off + k0);
            const f32x4v o = v[q][j] * rstd * g4 * (sc4 + 1.0f) + sh4;
            if (f8) { int w8 = 0; w8 = __builtin_amdgcn_cvt_pk_fp8_f32(o.x, o.y, w8, false); w8 = __builtin_amdgcn_cvt_pk_fp8_f32(o.z, o.w, w8, true); *(int*)((unsigned char*)out + (size_t)r * D + k0) = w8; }
            else *(uint2*)(out + (size_t)r * D + k0) = make_uint2(cvt_pk_bf16(o.x, o.y), cvt_pk_bf16(o.z, o.w));
            if (wr) {
#pragma unroll
                for (int i = 0; i < 4; ++i) { const f32x4v w0 = *(const f32x4v*)(wr + (size_t)(k0 + i) * NE), w1 = *(const f32x4v*)(wr + (size_t)(k0 + i) * NE + 4); const float ov = o[i];
                    lg[0] += ov * w0.x; lg[1] += ov * w0.y; lg[2] += ov * w0.z; lg[3] += ov * w0.w; lg[4] += ov * w1.x; lg[5] += ov * w1.y; lg[6] += ov * w1.z; lg[7] += ov * w1.w; } } }
        if (wr) {
#pragma unroll
            for (int e = 0; e < NE; ++e) lg[e] = wave_sum(lg[e]);
            int e0 = 0; float b0 = lg[0];
#pragma unroll
            for (int e = 1; e < NE; ++e) if (lg[e] > b0) { b0 = lg[e]; e0 = e; }
            int e1 = -1; float b1 = -3.0e38f;
#pragma unroll
            for (int e = 0; e < NE; ++e) if (e != e0 && lg[e] > b1) { b1 = lg[e]; e1 = e; }
            const float w1 = 1.0f / (1.0f + expf(b1 - b0)); const bool skip = skip_ctx && ((r % RPB) < CTX);
            if (lane == 0) { rt_e[2 * r] = skip ? -1 : e0; rt_e[2 * r + 1] = skip ? -1 : e1; rt_w[2 * r] = w1; rt_w[2 * r + 1] = 1.0f - w1;
                if (!skip) { atomicAdd(&segcnt[(size_t)e0 * nseg + r / 64], 1); atomicAdd(&segcnt[(size_t)e1 * nseg + r / 64], 1); } } }
        }
    } };
struct MoePrefixW { int n; int nseg; int* segcnt; int* ecnt;
    __device__ __forceinline__ void wave(int e, int lane, PG8_LAS unsigned char*) const { constexpr int PER = ((NR + 63) / 64 + 63) / 64; int v[PER]; int tot = 0;
#pragma unroll
        for (int k = 0; k < PER; ++k) { const int sg = lane * PER + k; v[k] = sg < nseg ? segcnt[(size_t)e * nseg + sg] : 0; tot += v[k]; }
        int incl = tot;
#pragma unroll
        for (int o = 1; o < 64; o <<= 1) { const int t = __shfl_up(incl, o); if (lane >= o) incl += t; }
        int run = incl - tot;
#pragma unroll
        for (int k = 0; k < PER; ++k) { const int sg = lane * PER + k; if (sg < nseg) segcnt[(size_t)e * nseg + sg] = run; run += v[k]; }
        if (lane == 63) ecnt[e] = incl; } };
struct CombineNormW { int n; int mode; int g_off; int pad; float* h; const bf16* yrow; const int* rt_e; const float* rt_w; const int* rt_dest; const float* modc; const float* gn; const float* modn; bf16* outb; float* outf;
    __device__ __forceinline__ void wave(int r, int lane, PG8_LAS unsigned char*) const {
        const int t = r % RPB; if (mode == 1 && t < CTX) return;
        f32x4v* hr = (f32x4v*)(h + (size_t)r * D) + lane; f32x4v v[4];
#pragma unroll
        for (int j = 0; j < 4; ++j) v[j] = hr[64 * j];
        const int e0 = rt_e[2 * r];
        if (e0 >= 0) { const size_t d0 = (size_t)rt_dest[2 * r], d1 = (size_t)rt_dest[2 * r + 1]; const float w0 = rt_w[2 * r], w1 = rt_w[2 * r + 1]; const float* gt = modc + (size_t)mod_index(r) * 6 * D + g_off;
            uint2 y0[4], y1[4]; f32x4v g4[4];
#pragma unroll
            for (int j = 0; j < 4; ++j) { const int k0 = 4 * (lane + 64 * j); y0[j] = *(const uint2*)(yrow + d0 * D + k0); y1[j] = *(const uint2*)(yrow + d1 * D + k0); g4[j] = *(const f32x4v*)(gt + k0); }
#pragma unroll
            for (int j = 0; j < 4; ++j) { f32x4v y;
                y.x = w0 * __uint_as_float(y0[j].x << 16) + w1 * __uint_as_float(y1[j].x << 16); y.y = w0 * __uint_as_float(y0[j].x & 0xffff0000u) + w1 * __uint_as_float(y1[j].x & 0xffff0000u);
                y.z = w0 * __uint_as_float(y0[j].y << 16) + w1 * __uint_as_float(y1[j].y << 16); y.w = w0 * __uint_as_float(y0[j].y & 0xffff0000u) + w1 * __uint_as_float(y1[j].y & 0xffff0000u);
                v[j] += g4[j] * y; }
            if (mode == 0) {
#pragma unroll
                for (int j = 0; j < 4; ++j) hr[64 * j] = v[j]; } }
        float ss = 0.f;
#pragma unroll
        for (int j = 0; j < 4; ++j) ss += (v[j].x * v[j].x + v[j].y * v[j].y) + (v[j].z * v[j].z + v[j].w * v[j].w);
        const float rstd = 1.0f / sqrtf(wave_sum(ss) * (1.0f / D) + EPS);
        if (mode == 0) { const float* m = modn + (size_t)mod_index(r) * 6 * D;
#pragma unroll
            for (int j = 0; j < 4; ++j) { const int k0 = 4 * (lane + 64 * j); const f32x4v g4 = *(const f32x4v*)(gn + k0), sc4 = *(const f32x4v*)(m + D + k0), sh4 = *(const f32x4v*)(m + k0);
                const f32x4v o = v[j] * rstd * g4 * (sc4 + 1.0f) + sh4; *(uint2*)(outb + (size_t)r * D + k0) = make_uint2(cvt_pk_bf16(o.x, o.y), cvt_pk_bf16(o.z, o.w)); }
        } else { const int b = r / RPB, tl = t - CTX;
#pragma unroll
            for (int j = 0; j < 4; ++j) { const int k0 = 4 * (lane + 64 * j); *(f32x4v*)(outf + ((size_t)b * SEQ + tl) * D + k0) = v[j] * rstd * *(const f32x4v*)(gn + k0); } } } };
struct FinalNormW { int n; int pad; const float* h; const float* g; float* out;
    __device__ __forceinline__ void wave(int x, int lane, PG8_LAS unsigned char*) const { const int b = x / SEQ, tl = x % SEQ;
        const f32x4v* hr = (const f32x4v*)(h + ((size_t)b * RPB + CTX + tl) * D) + lane; f32x4v v[4]; float ss = 0.f;
#pragma unroll
        for (int j = 0; j < 4; ++j) { v[j] = hr[64 * j]; ss += (v[j].x * v[j].x + v[j].y * v[j].y) + (v[j].z * v[j].z + v[j].w * v[j].w); }
        const float rstd = 1.0f / sqrtf(wave_sum(ss) * (1.0f / D) + EPS);
#pragma unroll
        for (int j = 0; j < 4; ++j) { const int k0 = 4 * (lane + 64 * j); *(f32x4v*)(out + (size_t)x * D + k0) = v[j] * rstd * *(const f32x4v*)(g + k0); } } };
struct TransW { int n; int K, N, rs, ro, f8; const float* src; bf16* dst; size_t sstride, dstride;
    __device__ __forceinline__ void loadt(f32x4v (&v)[8], int tile, int lane) const { const int nblk = N / 32, ipm = (K / 64) * nblk; const int mat = tile / ipm, r = tile % ipm, kb = r / nblk, nb = r % nblk;
        const float* W = src + (size_t)mat * sstride + (size_t)(64 * kb + (lane >> 3)) * N + 32 * nb + 4 * (lane & 7);
#pragma unroll
        for (int i = 0; i < 8; ++i) v[i] = *(const f32x4v*)(W + (size_t)(8 * i) * N); }
    __device__ __forceinline__ void emit(const f32x4v (&v)[8], int tile, int lane, PG8_LAS float* scr) const { const int nblk = N / 32, ipm = (K / 64) * nblk; const int mat = tile / ipm, r = tile % ipm, kb = r / nblk, nb = r % nblk, k0 = 64 * kb, n0 = 32 * nb;
        const int kr = lane >> 3, nq = lane & 7;
#pragma unroll
        for (int i = 0; i < 8; ++i) { PG8_LAS float* sp = scr + (8 * i + kr) * 33 + 4 * nq; sp[0] = v[i].x; sp[1] = v[i].y; sp[2] = v[i].z; sp[3] = v[i].w; }
        LDS_WAIT();
        const int c = lane & 7;
        if (f8) { unsigned char* WT8 = (unsigned char*)dst + (size_t)mat * dstride; const float sc = __builtin_amdgcn_ldexpf(1.0f, f8);
#pragma unroll
            for (int j = 0; j < 4; ++j) { const int nn = (lane >> 3) + 8 * j; const PG8_LAS float* sp = scr + (8 * c) * 33 + nn; int w0 = 0, w1 = 0;
                w0 = __builtin_amdgcn_cvt_pk_fp8_f32(sp[0 * 33] * sc, sp[1 * 33] * sc, w0, false); w0 = __builtin_amdgcn_cvt_pk_fp8_f32(sp[2 * 33] * sc, sp[3 * 33] * sc, w0, true);
                w1 = __builtin_amdgcn_cvt_pk_fp8_f32(sp[4 * 33] * sc, sp[5 * 33] * sc, w1, false); w1 = __builtin_amdgcn_cvt_pk_fp8_f32(sp[6 * 33] * sc, sp[7 * 33] * sc, w1, true);
                *(uint2*)(WT8 + ((size_t)(n0 + nn) * rs + ro) * K + k0 + 8 * c) = make_uint2((unsigned)w0, (unsigned)w1); }
        } else { bf16* WT = dst + (size_t)mat * dstride;
#pragma unroll
            for (int j = 0; j < 4; ++j) { const int nn = (lane >> 3) + 8 * j; const PG8_LAS float* sp = scr + (8 * c) * 33 + nn;
                uint4 o; o.x = cvt_pk_bf16(sp[0 * 33], sp[1 * 33]); o.y = cvt_pk_bf16(sp[2 * 33], sp[3 * 33]); o.z = cvt_pk_bf16(sp[4 * 33], sp[5 * 33]); o.w = cvt_pk_bf16(sp[6 * 33], sp[7 * 33]);
                *(uint4*)(WT + ((size_t)(n0 + nn) * rs + ro) * K + k0 + 8 * c) = o; } }
        LDS_WAIT(); }
    __device__ __forceinline__ void wave(int item, int lane, PG8_LAS unsigned char* lw) const {
        PG8_LAS float* scr = (PG8_LAS float*)lw;
        const int t0 = 2 * item, t1 = 2 * item + 1; const bool two = t1 < tiles; f32x4v va[8], vb[8];
        loadt(va, t0, lane); if (two) loadt(vb, t1, lane);
        emit(va, t0, lane, scr); if (two) emit(vb, t1, lane, scr);
    } int tiles, pad2; };

template <int MT, int NT, int KS, class PA, class PB>
__device__ __forceinline__ void wave_mma(PA A, int lda, PB Bt, int ldb, pg8::f32x4 (&acc)[MT][NT], int lane) {
    const int r = lane & 15, q = lane >> 4;
#pragma unroll
    for (int ks = 0; ks < KS; ++ks) { pg8::bf16x8 a[MT], b[NT];
#pragma unroll
        for (int m = 0; m < MT; ++m) a[m] = *(const pg8::bf16x8*)(A + (size_t)(m * 16 + r) * lda + ks * 32 + q * 8);
#pragma unroll
        for (int n = 0; n < NT; ++n) b[n] = *(const pg8::bf16x8*)(Bt + (size_t)(n * 16 + r) * ldb + ks * 32 + q * 8);
#pragma unroll
        for (int m = 0; m < MT; ++m)
#pragma unroll
            for (int n = 0; n < NT; ++n) acc[m][n] = __builtin_amdgcn_mfma_f32_16x16x32_bf16(a[m], b[n], acc[m][n], 0, 0, 0); }
}
__device__ __forceinline__ float chunk_cumsum(float x, int d, int lane, float& tot) { float pre = x;
#pragma unroll
    for (int o = 1; o < 64; o <<= 1) { const float t = __shfl_up(pre, o); if (lane >= o) pre += t; }
    tot = __shfl(pre, 63); return d == 0 ? pre : tot - pre + x; }
struct MlPrepW2 { int n; int pad; const bf16* p; const float* cw; const float* cb; const float* gb; bf16* lab;
    __device__ __forceinline__ void wave(int it, int lane, PG8_LAS unsigned char* lw) const { typedef LaLay<96, 112> L;
        const int hh = it & 3; int y = it >> 2; const int blk = y % NBLK; y /= NBLK; const int b = y % NB, d = y / NB; const size_t item = ((size_t)b * NBLK + blk) * 4 + hh;
        const int tb = blk * 64; const size_t rb = (size_t)b * RPB + tb; const bool first_blk = (tb == 0 || tb == CTX), last_blk = (tb + 63 == CTX - 1 || tb + 63 == RPB - 1);
        PG8_LAS bf16* X = (PG8_LAS bf16*)lw; PG8_LAS float* SQ = (PG8_LAS float*)(lw + 14336); PG8_LAS float* SK = SQ + 64;
        { const bf16* pr = p + (rb + lane) * PS; const float gI = bf2f(pr[MG + (2 * d) * 4 + hh]) + gb[(2 * d) * 4 + hh], gF = bf2f(pr[MG + (2 * d + 1) * 4 + hh]) + gb[(2 * d + 1) * 4 + hh];
          float tot; const float Fc = chunk_cumsum(logsigmoidf_(gF), d, lane, tot); SQ[lane] = fexp(Fc); SK[lane] = fexp(gI - Fc) * 0.10206207261596577f;
          float* dec = (float*)(lab + L::dec) + ((size_t)d * LA_NI + item) * 96; const float dv = fexp(tot); dec[lane] = dv; if (lane < 32) dec[64 + lane] = dv; }
#pragma unroll 1
        for (int mat = 0; mat < 2; ++mat) { const int col0 = MQ + mat * 384 + hh * 96;
            pg8::v4i_t v[13];
#pragma unroll
            for (int k = 0; k < 13; ++k) { const int pi = lane + 64 * k, rw = pi / 12, c = pi % 12; const bool zero = (pi >= 792) || (rw == 0 && first_blk) || (rw == 65 && last_blk);
                v[k] = (pg8::v4i_t){0, 0, 0, 0}; if (!zero) v[k] = *(const pg8::v4i_t*)(p + (rb + rw - 1) * PS + col0 + c * 8); }
#pragma unroll
            for (int k = 0; k < 13; ++k) { const int pi = lane + 64 * k, rw = pi / 12, c = pi % 12; if (pi < 792) *(PG8_LAS pg8::v4i_t*)(X + rw * 104 + c * 8) = v[k]; }
            LDS_WAIT();
            unsigned o0[32], o1[32];
            const PG8_LAS float* SC = mat ? SK : SQ;
#pragma unroll
            for (int ps = 0; ps < 2; ++ps) { const int i = lane + 64 * ps; const bool act = i < 96; const int ci = mat * 384 + hh * 96 + (act ? i : 0);
                const float w0 = cw[ci], w1 = cw[768 + ci], w2 = cw[1536 + ci], bs = cb[ci]; const PG8_LAS bf16* xc = X + (act ? i : 0);
                float xa = bf2f(xc[0]), xb = bf2f(xc[104]);
#pragma unroll
                for (int s2 = 0; s2 < 32; ++s2) { const float x2 = bf2f(xc[(2 * s2 + 2) * 104]), x3 = bf2f(xc[(2 * s2 + 3) * 104]);
                    const float va = siluf(w0 * xa + w1 * xb + w2 * x2 + bs) * SC[2 * s2], vb = siluf(w0 * xb + w1 * x2 + w2 * x3 + bs) * SC[2 * s2 + 1];
                    const unsigned pk = cvt_pk_bf16(va, vb); if (ps == 0) o0[s2] = pk; else o1[s2] = pk; xa = x2; xb = x3; } }
            LDS_WAIT();
#pragma unroll
            for (int s2 = 0; s2 < 32; ++s2) { const int c0 = lane, t0 = 2 * s2;
                X[((t0 >> 4) * 3 + (c0 >> 5)) * 512 + ((((c0 & 31) >> 3) << 4) + (t0 & 15)) * 8 + (c0 & 7)] = (bf16)(o0[s2] & 0xffffu); X[((t0 >> 4) * 3 + (c0 >> 5)) * 512 + ((((c0 & 31) >> 3) << 4) + ((t0 + 1) & 15)) * 8 + (c0 & 7)] = (bf16)(o0[s2] >> 16);
                if (lane < 32) { const int c1 = 64 + lane; X[((t0 >> 4) * 3 + (c1 >> 5)) * 512 + ((((c1 & 31) >> 3) << 4) + (t0 & 15)) * 8 + (c1 & 7)] = (bf16)(o1[s2] & 0xffffu); X[((t0 >> 4) * 3 + (c1 >> 5)) * 512 + ((((c1 & 31) >> 3) << 4) + ((t0 + 1) & 15)) * 8 + (c1 & 7)] = (bf16)(o1[s2] >> 16); } }
            LDS_WAIT();
            { bf16* dst = lab + (mat ? L::kin : L::qin) + ((size_t)d * LA_NI + item) * 64 * 96;
#pragma unroll
              for (int k = 0; k < 12; ++k) { const int pi = lane + 64 * k; const pg8::v4i_t w = *(const PG8_LAS pg8::v4i_t*)(X + pi * 8); *(pg8::v4i_t*)(dst + (size_t)pi * 8) = w; } }
            LDS_WAIT();
            if (mat == 1) {
#pragma unroll
                for (int s2 = 0; s2 < 32; ++s2) { const int c0 = lane, t0 = 2 * s2;
                    *(PG8_LAS unsigned*)(X + ((c0 >> 4) * 2 + (t0 >> 5)) * 512 + ((((t0 & 31) >> 3) << 4) + (c0 & 15)) * 8 + (t0 & 7)) = o0[s2];
                    if (lane < 32) { const int c1 = 64 + lane; *(PG8_LAS unsigned*)(X + ((c1 >> 4) * 2 + (t0 >> 5)) * 512 + ((((t0 & 31) >> 3) << 4) + (c1 & 15)) * 8 + (t0 & 7)) = o1[s2]; } }
                LDS_WAIT();
                bf16* dst = lab + L::koutT + ((size_t)d * LA_NI + item) * 96 * 64;
#pragma unroll
                for (int k = 0; k < 12; ++k) { const int pi = lane + 64 * k; const pg8::v4i_t w = *(const PG8_LAS pg8::v4i_t*)(X + pi * 8); *(pg8::v4i_t*)(dst + (size_t)pi * 8) = w; }
                LDS_WAIT(); } } } };

struct GlaPrepW2 { int n; int pad; const bf16* p; const float* wa2; const float* ba; bf16* lab;
    __device__ __forceinline__ void wave(int it, int lane, PG8_LAS unsigned char* lw) const { typedef LaLay<64, 96> L;
        const int hh = it & 3; int y = it >> 2; const int blk = y % NBLK; y /= NBLK; const int b = y % NB, d = y / NB; const size_t item = ((size_t)b * NBLK + blk) * 4 + hh; const size_t rb = (size_t)b * RPB + blk * 64;
        PG8_LAS bf16* LR = (PG8_LAS bf16*)lw; PG8_LAS bf16* Q = LR + 64 * 16; PG8_LAS bf16* K = Q + 64 * 48; PG8_LAS bf16* X = (PG8_LAS bf16*)lw;
        pg8::v4i_t v[14];
#pragma unroll
        for (int k = 0; k < 2; ++k) { const int pi = lane + 64 * k; v[k] = *(const pg8::v4i_t*)(p + (rb + (pi >> 1)) * PS + GLR + (pi & 1) * 8); }
#pragma unroll
        for (int k = 0; k < 6; ++k) { const int pi = lane + 64 * k, rw = pi / 6, c = pi % 6; v[2 + k] = *(const pg8::v4i_t*)(p + (rb + rw) * PS + GQ + hh * 48 + c * 8); v[8 + k] = *(const pg8::v4i_t*)(p + (rb + rw) * PS + GK + hh * 48 + c * 8); }
#pragma unroll
        for (int k = 0; k < 2; ++k) { const int pi = lane + 64 * k; *(PG8_LAS pg8::v4i_t*)(LR + pi * 8) = v[k]; }
#pragma unroll
        for (int k = 0; k < 6; ++k) { const int pi = lane + 64 * k; *(PG8_LAS pg8::v4i_t*)(Q + pi * 8) = v[2 + k]; *(PG8_LAS pg8::v4i_t*)(K + pi * 8) = v[8 + k]; }
        LDS_WAIT();
        const bool act = lane < 48; const int i = act ? lane : 0; const int j = hh * 48 + i; float w[16];
#pragma unroll
        for (int q = 0; q < 16; ++q) w[q] = wa2[((size_t)d * 16 + q) * 192 + j];
        const float bj = ba[d * 192 + j]; float c = 0.f; unsigned oq[32], ok[32];
#pragma unroll
        for (int p2 = 0; p2 < 32; ++p2) { float qv[2], kv[2];
#pragma unroll
            for (int h2 = 0; h2 < 2; ++h2) { const int pp = 2 * p2 + h2; const int tok = d == 0 ? pp : 63 - pp; const pg8::v4i_t l0 = *(const PG8_LAS pg8::v4i_t*)(LR + tok * 16), l1 = *(const PG8_LAS pg8::v4i_t*)(LR + tok * 16 + 8);
                const unsigned u[8] = {(unsigned)l0.x, (unsigned)l0.y, (unsigned)l0.z, (unsigned)l0.w, (unsigned)l1.x, (unsigned)l1.y, (unsigned)l1.z, (unsigned)l1.w}; float z = bj;
#pragma unroll
                for (int q = 0; q < 8; ++q) { z += __uint_as_float(u[q] << 16) * w[2 * q]; z += __uint_as_float(u[q] & 0xffff0000u) * w[2 * q + 1]; }
                c += logsigmoidf_(z) * (1.0f / 16.0f); qv[h2] = bf2f(Q[tok * 48 + i]) * 0.14433756729740643f * fexp(c); kv[h2] = bf2f(K[tok * 48 + i]) * fexp(-c); }
            oq[p2] = act ? cvt_pk_bf16(qv[0], qv[1]) : 0u; ok[p2] = act ? cvt_pk_bf16(kv[0], kv[1]) : 0u; }
        { float* dec = (float*)(lab + L::dec) + ((size_t)d * LA_NI + item) * 64; dec[lane] = act ? fexp(c) : 0.f; }
        LDS_WAIT();
#pragma unroll 1
        for (int im = 0; im < 2; ++im) {
#pragma unroll
            for (int p2 = 0; p2 < 32; ++p2) { const unsigned o = im ? ok[p2] : oq[p2]; const int ta = d == 0 ? 2 * p2 : 63 - 2 * p2, tb2 = d == 0 ? 2 * p2 + 1 : 62 - 2 * p2; const int cb = (lane >> 5) * 512 + (((lane & 31) >> 3) << 4) * 8 + (lane & 7);
                X[(ta >> 4) * 1024 + cb + (ta & 15) * 8] = (bf16)(o & 0xffffu); X[(tb2 >> 4) * 1024 + cb + (tb2 & 15) * 8] = (bf16)(o >> 16); }
            LDS_WAIT();
            bf16* dst = lab + (im ? L::kin : L::qin) + ((size_t)d * LA_NI + item) * 64 * 64;
#pragma unroll
            for (int k = 0; k < 8; ++k) { const int pi = lane + 64 * k; const pg8::v4i_t wv = *(const PG8_LAS pg8::v4i_t*)(X + pi * 8); *(pg8::v4i_t*)(dst + (size_t)pi * 8) = wv; }
            LDS_WAIT(); }
#pragma unroll
        for (int p2 = 0; p2 < 32; ++p2) { const unsigned o = ok[p2]; const int tl = d == 0 ? 2 * p2 : 62 - 2 * p2; const unsigned ov = d == 0 ? o : ((o >> 16) | (o << 16));
            *(PG8_LAS unsigned*)(X + ((lane >> 4) * 2 + (tl >> 5)) * 512 + ((((tl & 31) >> 3) << 4) + (lane & 15)) * 8 + (tl & 7)) = ov; }
        LDS_WAIT();
        { bf16* dst = lab + L::koutT + ((size_t)d * LA_NI + item) * 64 * 64;
#pragma unroll
          for (int k = 0; k < 8; ++k) { const int pi = lane + 64 * k; const pg8::v4i_t wv = *(const PG8_LAS pg8::v4i_t*)(X + pi * 8); *(pg8::v4i_t*)(dst + (size_t)pi * 8) = wv; } }
        LDS_WAIT(); } };

template <int NV, int VOFF> struct VTW { int n; int pad; const bf16* p; bf16* vT;
    __device__ __forceinline__ void wave(int it, int lane, PG8_LAS unsigned char* lw) const { const int hh = it & 3; const int bb = it >> 2; const size_t r0 = (size_t)(bb / NBLK) * RPB + (bb % NBLK) * 64;
        PG8_LAS bf16* t = (PG8_LAS bf16*)lw; pg8::v4i_t v[12];
#pragma unroll
        for (int k = 0; k < 12; ++k) { const int pi = lane + 64 * k, rw = pi / 12, c = pi % 12; v[k] = *(const pg8::v4i_t*)(p + (r0 + rw) * PS + VOFF + hh * 96 + c * 8); }
#pragma unroll
        for (int k = 0; k < 12; ++k) { const int pi = lane + 64 * k, rw = pi / 12, c = pi % 12; *(PG8_LAS pg8::v4i_t*)(t + rw * 104 + c * 8) = v[k]; }
        LDS_WAIT();
        bf16* o = vT + (size_t)it * NV * 64 + (size_t)lane * 8; const int jr = lane & 15, sq = (lane >> 4) * 8;
#pragma unroll
        for (int jt = 0; jt < 6; ++jt)
#pragma unroll
            for (int ks = 0; ks < 2; ++ks) { const PG8_LAS bf16* c0 = t + (ks * 32 + sq) * 104 + jt * 16 + jr; pg8::v4i_t w;
                w.x = (int)((unsigned)c0[0] | ((unsigned)c0[104] << 16)); w.y = (int)((unsigned)c0[208] | ((unsigned)c0[312] << 16)); w.z = (int)((unsigned)c0[416] | ((unsigned)c0[520] << 16)); w.w = (int)((unsigned)c0[624] | ((unsigned)c0[728] << 16));
                *(pg8::v4i_t*)(o + (jt * 2 + ks) * 512) = w; }
        if (NV > 96) { const int f = jr == 0 ? 0x3f803f80 : 0; const pg8::v4i_t w = {f, f, f, f};
#pragma unroll
            for (int ks = 0; ks < 2; ++ks) *(pg8::v4i_t*)(o + (12 + ks) * 512) = w; }
        LDS_WAIT(); } };

template <int DKP, int NV, int NG> struct ChainW { int n; int pad; bf16* lab;
    static constexpr int CG = DKP / (16 * NG), MT = NV / 16;
    struct Fr { pg8::bf16x8 a[2]; pg8::bf16x8 b[NG][2]; float dc[NG]; };
    __device__ __forceinline__ void load(Fr& f, int d, int b, int hh, int jt, int cg, int step, int r, int q) const { typedef LaLay<DKP, NV> L; const int blk = chain_blk(d, step); const size_t item = ((size_t)b * NBLK + blk) * 4 + hh; const int ln = q * 16 + r;
        const bf16* A = lab + L::vT + item * NV * 64 + ((size_t)(jt * 2) * 64 + ln) * 8; const bf16* Bt = lab + L::koutT + ((size_t)d * LA_NI + item) * DKP * 64 + ((size_t)(cg * NG * 2) * 64 + ln) * 8;
        const float* dec = (const float*)(lab + L::dec) + ((size_t)d * LA_NI + item) * DKP + cg * (16 * NG) + r;
#pragma unroll
        for (int ks = 0; ks < 2; ++ks) f.a[ks] = *(const pg8::bf16x8*)(A + ks * 512);
#pragma unroll
        for (int nn = 0; nn < NG; ++nn) {
#pragma unroll
            for (int ks = 0; ks < 2; ++ks) f.b[nn][ks] = *(const pg8::bf16x8*)(Bt + (nn * 2 + ks) * 512);
            f.dc[nn] = dec[nn * 16]; } }
    __device__ __forceinline__ void process(const Fr& f, pg8::f32x4 (&S)[NG], int d, int b, int hh, int jt, int cg, int step, int r, int q, PG8_LAS unsigned char* lw) const { typedef LaLay<DKP, NV> L;
        pg8::f32x4 acc[NG];
#pragma unroll
        for (int nn = 0; nn < NG; ++nn) acc[nn] = (pg8::f32x4){0.f, 0.f, 0.f, 0.f};
#pragma unroll
        for (int ks = 0; ks < 2; ++ks)
#pragma unroll
            for (int nn = 0; nn < NG; ++nn) acc[nn] = __builtin_amdgcn_mfma_f32_16x16x32_bf16(f.a[ks], f.b[nn][ks], acc[nn], 0, 0, 0);
        const int blk = chain_blk(d, step); const size_t item = ((size_t)b * NBLK + blk) * 4 + hh; PG8_LAS bf16* lt = (PG8_LAS bf16*)lw;
#pragma unroll
        for (int nn = 0; nn < NG; ++nn)
#pragma unroll
            for (int e = 0; e < 4; ++e) { const int col = nn * 16 + r; lt[(col >> 5) * 512 + ((((col & 31) >> 3) << 4) + q * 4 + e) * 8 + (col & 7)] = f2bf(S[nn][e]); S[nn][e] = f.dc[nn] * (S[nn][e] + acc[nn][e]); }
        LDS_WAIT();
        bf16* out = lab + L::sT + ((size_t)d * LA_NI + item) * NV * DKP + ((size_t)(jt * (DKP / 32) + cg * (NG / 2)) * 64 + q * 16 + r) * 8;
#pragma unroll
        for (int tl = 0; tl < NG / 2; ++tl) { const pg8::v4i_t pv = *(const PG8_LAS pg8::v4i_t*)(lt + (tl * 64 + q * 16 + r) * 8); *(pg8::v4i_t*)(out + tl * 512) = pv; }
        LDS_WAIT(); }
    __device__ __forceinline__ void wave(int it, int lane, PG8_LAS unsigned char* lw) const {
        const int cg = it % CG; int c = it / CG; const int jt = c % MT; c /= MT; const int hh = c % 4; c /= 4; const int b = c % NB, d = c / NB; const int r = lane & 15, q = lane >> 4;
        pg8::f32x4 S[NG];
#pragma unroll
        for (int nn = 0; nn < NG; ++nn) S[nn] = (pg8::f32x4){0.f, 0.f, 0.f, 0.f};
        auto cl = [](int st) { return st < NBLK ? st : NBLK - 1; };
        Fr f0, f1, f2, f3; load(f0, d, b, hh, jt, cg, 0, r, q); load(f1, d, b, hh, jt, cg, cl(1), r, q); load(f2, d, b, hh, jt, cg, cl(2), r, q);
        static_assert(NBLK % 4 == 0 || NBLK < 4, "ChainW walks the chain four blocks per trip");
        for (int step = 0; step + 3 < NBLK; step += 4) {
            load(f3, d, b, hh, jt, cg, step + 3, r, q);
            process(f0, S, d, b, hh, jt, cg, step, r, q, lw);
            load(f0, d, b, hh, jt, cg, cl(step + 4), r, q);
            process(f1, S, d, b, hh, jt, cg, step + 1, r, q, lw);
            load(f1, d, b, hh, jt, cg, cl(step + 5), r, q);
            process(f2, S, d, b, hh, jt, cg, step + 2, r, q, lw);
            load(f2, d, b, hh, jt, cg, cl(step + 6), r, q);
            process(f3, S, d, b, hh, jt, cg, step + 3, r, q, lw); }
        if (NBLK < 4) { process(f0, S, d, b, hh, jt, cg, 0, r, q, lw); if (NBLK > 1) process(f1, S, d, b, hh, jt, cg, 1, r, q, lw); if (NBLK > 2) process(f2, S, d, b, hh, jt, cg, 2, r, q, lw); } } };
template <int DKP, int NV, bool ISML> struct OutW { int n; int pad; const bf16* lab; const bf16* p; const float* gain; bf16* mix;
    __device__ __forceinline__ void wave(int it, int lane, PG8_LAS unsigned char* lw) const { typedef LaLay<DKP, NV> L; constexpr int NT = NV / 16, KQ = DKP / 32; typedef pg8::bf16x8 frag;
        const size_t item = (size_t)(it >> 1); const int half = it & 1, hh = (int)(item % 4); const size_t bb = item / 4; const size_t r0 = (bb / NBLK) * RPB + (bb % NBLK) * 64; const int t0 = half * 32;
        const int r = lane & 15, q = lane >> 4; PG8_LAS bf16* latt = (PG8_LAS bf16*)lw;
        pg8::f32x4 acc[2][NT], hs[2][6];
#pragma unroll
        for (int m = 0; m < 2; ++m) {
#pragma unroll
            for (int nn = 0; nn < NT; ++nn) acc[m][nn] = (pg8::f32x4){0.f, 0.f, 0.f, 0.f};
#pragma unroll
            for (int nn = 0; nn < 6; ++nn) hs[m][nn] = (pg8::f32x4){0.f, 0.f, 0.f, 0.f}; }
        const bf16* vp = lab + L::vT + item * NV * 64 + (size_t)lane * 8;
#pragma unroll
        for (int d = 0; d < 2; ++d) {
            const bf16* qp = lab + L::qin + ((size_t)d * LA_NI + item) * 64 * DKP + ((size_t)(t0 / 16) * KQ * 64 + lane) * 8; const bf16* kp = lab + L::kin + ((size_t)d * LA_NI + item) * 64 * DKP + (size_t)lane * 8;
            const bf16* sp = lab + L::sT + ((size_t)d * LA_NI + item) * NV * DKP + (size_t)lane * 8;
            frag qa[2][KQ], sf[NT][KQ];
#pragma unroll
            for (int m = 0; m < 2; ++m)
#pragma unroll
                for (int ks = 0; ks < KQ; ++ks) qa[m][ks] = *(const frag*)(qp + (m * KQ + ks) * 512);
#pragma unroll
            for (int nn = 0; nn < NT; ++nn)
#pragma unroll
                for (int ks = 0; ks < KQ; ++ks) sf[nn][ks] = *(const frag*)(sp + (nn * KQ + ks) * 512);
            frag kf[4][KQ], vf[NT][2];
            if constexpr (!ISML) {
#pragma unroll
                for (int nn = 0; nn < 4; ++nn)
#pragma unroll
                    for (int ks = 0; ks < KQ; ++ks) kf[nn][ks] = *(const frag*)(kp + (nn * KQ + ks) * 512);
#pragma unroll
                for (int nn = 0; nn < NT; ++nn)
#pragma unroll
                    for (int ks = 0; ks < 2; ++ks) vf[nn][ks] = *(const frag*)(vp + (nn * 2 + ks) * 512); }
#pragma unroll
            for (int ks = 0; ks < KQ; ++ks)
#pragma unroll
                for (int m = 0; m < 2; ++m)
#pragma unroll
                    for (int nn = 0; nn < NT; ++nn) acc[m][nn] = __builtin_amdgcn_mfma_f32_16x16x32_bf16(qa[m][ks], sf[nn][ks], acc[m][nn], 0, 0, 0);
            if constexpr (ISML) {
#pragma unroll
            for (int nn = 0; nn < 4; ++nn)
#pragma unroll
                for (int ks = 0; ks < KQ; ++ks) kf[nn][ks] = *(const frag*)(kp + (nn * KQ + ks) * 512); }
            pg8::f32x4 at[2][4];
#pragma unroll
            for (int m = 0; m < 2; ++m)
#pragma unroll
                for (int nn = 0; nn < 4; ++nn) at[m][nn] = (pg8::f32x4){0.f, 0.f, 0.f, 0.f};
#pragma unroll
            for (int ks = 0; ks < KQ; ++ks)
#pragma unroll
                for (int m = 0; m < 2; ++m)
#pragma unroll
                    for (int nn = 0; nn < 4; ++nn) at[m][nn] = __builtin_amdgcn_mfma_f32_16x16x32_bf16(qa[m][ks], kf[nn][ks], at[m][nn], 0, 0, 0);
            if constexpr (ISML) {
#pragma unroll
            for (int nn = 0; nn < NT; ++nn)
#pragma unroll
                for (int ks = 0; ks < 2; ++ks) vf[nn][ks] = *(const frag*)(vp + (nn * 2 + ks) * 512); }
#pragma unroll
            for (int m = 0; m < 2; ++m)
#pragma unroll
                for (int nn = 0; nn < 4; ++nn)
#pragma unroll
                    for (int e = 0; e < 4; ++e) { const int tl = m * 16 + q * 4 + e, tt = t0 + tl, sx = nn * 16 + r; const bool valid = d == 0 ? (sx <= tt) : (sx >= tt);
                        latt[tl * 72 + sx] = f2bf(valid ? at[m][nn][e] : 0.f); }
            LDS_WAIT();
            frag af[2][2];
#pragma unroll
            for (int m = 0; m < 2; ++m)
#pragma unroll
                for (int ks = 0; ks < 2; ++ks) af[m][ks] = *(const PG8_LAS frag*)(latt + (m * 16 + r) * 72 + ks * 32 + q * 8);
#pragma unroll
            for (int ks = 0; ks < 2; ++ks)
#pragma unroll
                for (int m = 0; m < 2; ++m)
#pragma unroll
                    for (int nn = 0; nn < NT; ++nn) acc[m][nn] = __builtin_amdgcn_mfma_f32_16x16x32_bf16(af[m][ks], vf[nn][ks], acc[m][nn], 0, 0, 0);
            LDS_WAIT();
            if (ISML) {
#pragma unroll
                for (int m = 0; m < 2; ++m)
#pragma unroll
                    for (int e = 0; e < 4; ++e) { const float den = __shfl(acc[m][NT - 1][e], lane & 48); const float inv = 1.0f / fmaxf(fabsf(den), 1.0f);
#pragma unroll
                        for (int nn = 0; nn < 6; ++nn) { hs[m][nn][e] += acc[m][nn][e] * inv; acc[m][nn][e] = 0.f; }
                        acc[m][NT - 1][e] = 0.f; } } }
#pragma unroll
        for (int m = 0; m < 2; ++m)
#pragma unroll
            for (int e = 0; e < 4; ++e) { float ss = 0.f;
#pragma unroll
                for (int nn = 0; nn < 6; ++nn) { const float o = ISML ? hs[m][nn][e] : acc[m][nn][e]; ss += o * o; }
                ss += __shfl_xor(ss, 1); ss += __shfl_xor(ss, 2); ss += __shfl_xor(ss, 4); ss += __shfl_xor(ss, 8);
                const float rstd = 1.0f / sqrtf(ss * (1.0f / 96.0f) + EPS); PG8_LAS float* fo = (PG8_LAS float*)lw + (m * 16 + q * 4 + e) * 100;
#pragma unroll
                for (int nn = 0; nn < 6; ++nn) { const int j = nn * 16 + r; const float o = ISML ? hs[m][nn][e] : acc[m][nn][e]; fo[j] = o * rstd * gain[j]; } }
        LDS_WAIT();
        uint4 gv[6];
#pragma unroll
        for (int k = 0; k < 6; ++k) { const int pi = lane + 64 * k, rw = pi / 12, c8 = pi % 12; gv[k] = *(const uint4*)(p + (r0 + t0 + rw) * PS + (ISML ? MO : GG) + hh * 96 + c8 * 8); }
#pragma unroll
        for (int k = 0; k < 6; ++k) { const int pi = lane + 64 * k, rw = pi / 12, c8 = pi % 12; const PG8_LAS float* fr = (const PG8_LAS float*)lw + rw * 100 + c8 * 8;
            const pg8::f32x4 a0 = *(const PG8_LAS pg8::f32x4*)fr, a1 = *(const PG8_LAS pg8::f32x4*)(fr + 4); const unsigned gw[4] = {gv[k].x, gv[k].y, gv[k].z, gv[k].w}; float gt[8];
#pragma unroll
            for (int e = 0; e < 4; ++e) { const float g0 = __uint_as_float(gw[e] << 16), g1 = __uint_as_float(gw[e] & 0xffff0000u); gt[2 * e] = ISML ? fast_sigmoid(g0) : fast_silu(g0); gt[2 * e + 1] = ISML ? fast_sigmoid(g1) : fast_silu(g1); }
            uint4 ov; ov.x = cvt_pk_bf16(a0[0] * gt[0], a0[1] * gt[1]); ov.y = cvt_pk_bf16(a0[2] * gt[2], a0[3] * gt[3]); ov.z = cvt_pk_bf16(a1[0] * gt[4], a1[1] * gt[5]); ov.w = cvt_pk_bf16(a1[2] * gt[6], a1[3] * gt[7]);
            *(uint4*)(mix + (r0 + t0 + rw) * D + (ISML ? 640 : 0) + hh * 96 + c8 * 8) = ov; }
        LDS_WAIT(); } };

struct OutWG { int n; int pad; const bf16* lab; const bf16* p; const float* gain; bf16* mix;
    __device__ __forceinline__ void wave(int it, int lane, PG8_LAS unsigned char* lw) const { constexpr int DKP = 64, NV = 96; typedef LaLay<DKP, NV> L; constexpr int NT = 6, KQ = 2; typedef pg8::bf16x8 frag;
        const size_t item = (size_t)it; const int hh = (int)(item % 4); const size_t bb = item / 4; const size_t r0 = (bb / NBLK) * RPB + (bb % NBLK) * 64;
        const int r = lane & 15, q = lane >> 4; PG8_LAS bf16* latt = (PG8_LAS bf16*)lw;
        pg8::f32x4 acc[4][NT];
#pragma unroll
        for (int m = 0; m < 4; ++m)
#pragma unroll
            for (int nn = 0; nn < NT; ++nn) acc[m][nn] = (pg8::f32x4){0.f, 0.f, 0.f, 0.f};
        const bf16* vp = lab + L::vT + item * NV * 64 + (size_t)lane * 8;
#pragma unroll
        for (int d = 0; d < 2; ++d) {
            const bf16* qp = lab + L::qin + ((size_t)d * LA_NI + item) * 64 * DKP + (size_t)lane * 8; const bf16* kp = lab + L::kin + ((size_t)d * LA_NI + item) * 64 * DKP + (size_t)lane * 8;
            const bf16* sp = lab + L::sT + ((size_t)d * LA_NI + item) * NV * DKP + (size_t)lane * 8;
            frag qa[4][KQ], kf[4][KQ];
            { frag sf[NT][KQ];
#pragma unroll
            for (int m = 0; m < 4; ++m)
#pragma unroll
                for (int ks = 0; ks < KQ; ++ks) qa[m][ks] = *(const frag*)(qp + (m * KQ + ks) * 512);
#pragma unroll
            for (int nn = 0; nn < NT; ++nn)
#pragma unroll
                for (int ks = 0; ks < KQ; ++ks) sf[nn][ks] = *(const frag*)(sp + (nn * KQ + ks) * 512);
#pragma unroll
            for (int nn = 0; nn < 4; ++nn)
#pragma unroll
                for (int ks = 0; ks < KQ; ++ks) kf[nn][ks] = *(const frag*)(kp + (nn * KQ + ks) * 512);
#pragma unroll
            for (int ks = 0; ks < KQ; ++ks)
#pragma unroll
                for (int m = 0; m < 4; ++m)
#pragma unroll
                    for (int nn = 0; nn < NT; ++nn) acc[m][nn] = __builtin_amdgcn_mfma_f32_16x16x32_bf16(qa[m][ks], sf[nn][ks], acc[m][nn], 0, 0, 0); }
            __builtin_amdgcn_sched_barrier(0);
            frag vf[NT][2];
#pragma unroll
            for (int hp = 0; hp < 2; ++hp) { pg8::f32x4 at[2][4];
                if (hp == 1) { __builtin_amdgcn_sched_barrier(0);
#pragma unroll
                    for (int nn = 0; nn < NT; ++nn)
#pragma unroll
                        for (int ks = 0; ks < 2; ++ks) vf[nn][ks] = *(const frag*)(vp + (nn * 2 + ks) * 512);
                    __builtin_amdgcn_sched_barrier(0); }
#pragma unroll
                for (int m = 0; m < 2; ++m)
#pragma unroll
                    for (int nn = 0; nn < 4; ++nn) at[m][nn] = (pg8::f32x4){0.f, 0.f, 0.f, 0.f};
#pragma unroll
                for (int ks = 0; ks < KQ; ++ks)
#pragma unroll
                    for (int m = 0; m < 2; ++m)
#pragma unroll
                        for (int nn = 0; nn < 4; ++nn) at[m][nn] = __builtin_amdgcn_mfma_f32_16x16x32_bf16(qa[2 * hp + m][ks], kf[nn][ks], at[m][nn], 0, 0, 0);
#pragma unroll
                for (int m = 0; m < 2; ++m)
#pragma unroll
                    for (int nn = 0; nn < 4; ++nn)
#pragma unroll
                        for (int e = 0; e < 4; ++e) { const int tt = hp * 32 + m * 16 + q * 4 + e, sx = nn * 16 + r; const bool valid = d == 0 ? (sx <= tt) : (sx >= tt);
                            latt[tt * 72 + sx] = f2bf(valid ? at[m][nn][e] : 0.f); } }
            LDS_WAIT();
            frag af[4][2];
#pragma unroll
            for (int m = 0; m < 4; ++m)
#pragma unroll
                for (int ks = 0; ks < 2; ++ks) af[m][ks] = *(const PG8_LAS frag*)(latt + (m * 16 + r) * 72 + ks * 32 + q * 8);
#pragma unroll
            for (int ks = 0; ks < 2; ++ks)
#pragma unroll
                for (int m = 0; m < 4; ++m)
#pragma unroll
                    for (int nn = 0; nn < NT; ++nn) acc[m][nn] = __builtin_amdgcn_mfma_f32_16x16x32_bf16(af[m][ks], vf[nn][ks], acc[m][nn], 0, 0, 0);
            LDS_WAIT(); }
#pragma unroll
        for (int hp = 0; hp < 2; ++hp) { const int t0 = hp * 32;
#pragma unroll
            for (int m = 0; m < 2; ++m)
#pragma unroll
                for (int e = 0; e < 4; ++e) { float ss = 0.f;
#pragma unroll
                    for (int nn = 0; nn < 6; ++nn) { const float o = acc[2 * hp + m][nn][e]; ss += o * o; }
                    ss += __shfl_xor(ss, 1); ss += __shfl_xor(ss, 2); ss += __shfl_xor(ss, 4); ss += __shfl_xor(ss, 8);
                    const float rstd = 1.0f / sqrtf(ss * (1.0f / 96.0f) + EPS); PG8_LAS float* fo = (PG8_LAS float*)lw + (m * 16 + q * 4 + e) * 100;
#pragma unroll
                    for (int nn = 0; nn < 6; ++nn) { const int j = nn * 16 + r; fo[j] = acc[2 * hp + m][nn][e] * rstd * gain[j]; } }
            LDS_WAIT();
            uint4 gv[6];
#pragma unroll
            for (int k = 0; k < 6; ++k) { const int pi = lane + 64 * k, rw = pi / 12, c8 = pi % 12; gv[k] = *(const uint4*)(p + (r0 + t0 + rw) * PS + GG + hh * 96 + c8 * 8); }
#pragma unroll
            for (int k = 0; k < 6; ++k) { const int pi = lane + 64 * k, rw = pi / 12, c8 = pi % 12; const PG8_LAS float* fr = (const PG8_LAS float*)lw + rw * 100 + c8 * 8;
                const pg8::f32x4 a0 = *(const PG8_LAS pg8::f32x4*)fr, a1 = *(const PG8_LAS pg8::f32x4*)(fr + 4); const unsigned gw[4] = {gv[k].x, gv[k].y, gv[k].z, gv[k].w}; float gt[8];
#pragma unroll
                for (int e = 0; e < 4; ++e) { const float g0 = __uint_as_float(gw[e] << 16), g1 = __uint_as_float(gw[e] & 0xffff0000u); gt[2 * e] = fast_silu(g0); gt[2 * e + 1] = fast_silu(g1); }
                uint4 ov; ov.x = cvt_pk_bf16(a0[0] * gt[0], a0[1] * gt[1]); ov.y = cvt_pk_bf16(a0[2] * gt[2], a0[3] * gt[3]); ov.z = cvt_pk_bf16(a1[0] * gt[4], a1[1] * gt[5]); ov.w = cvt_pk_bf16(a1[2] * gt[6], a1[3] * gt[7]);
                *(uint4*)(mix + (r0 + t0 + rw) * D + hh * 96 + c8 * 8) = ov; }
            LDS_WAIT(); } } };

#ifdef MULTI_LAUNCH
template <class F> __global__ void __launch_bounds__(256) k_run(F f) {
    for (long i = (long)blockIdx.x * blockDim.x + threadIdx.x; i < f.n; i += (long)gridDim.x * blockDim.x) f(i);
}
template <class F> __global__ void __launch_bounds__(512, 2) k_wrun(F f) {
    extern __shared__ __attribute__((aligned(16))) unsigned char shm[];
    const int wid = threadIdx.x >> 6, lane = threadIdx.x & 63;
    for (int it = blockIdx.x * 8 + wid; it < f.n; it += gridDim.x * 8) f.wave(it, lane, (PG8_LAS unsigned char*)shm + wid * 16384);
}
template <class F> __global__ void __launch_bounds__(512, 2) k_gemm(GemmDesc g, F e) {
    extern __shared__ __attribute__((aligned(16))) unsigned char shm[];
    pg8::gemm_phase<F>((PG8_LAS unsigned char*)shm, g, e, (int)gridDim.x, (int)blockIdx.x);
}
struct Ctx { hipStream_t stream; int ncu; const void* const* tbl;
    void mark(int) const {} void probe_out(float*) const {}
    template <int I> const float* inp() const { return (const float*)tbl[I]; }
    template <class F> void run(const F& f, bool sync = true, int ioff = 0) {
        if (f.n <= 0) return; long nb = (f.n + 255) / 256; if (nb > 256L * 32) nb = 256L * 32;
        hipLaunchKernelGGL(k_run<F>, dim3((unsigned)nb), dim3(256), 0, stream, f); }
    template <class F> void wrun(const F& f, bool sync = true, int woff = 0) {
        static bool attr_set = false;
        if (!attr_set) { (void)hipFuncSetAttribute((const void*)k_wrun<F>, hipFuncAttributeMaxDynamicSharedMemorySize, pg8::STAGE_BYTES); attr_set = true; }
        hipLaunchKernelGGL(k_wrun<F>, dim3(ncu), dim3(512), pg8::STAGE_BYTES, stream, f); }
    template <class F> void gemm(const GemmDesc& g, const F& e) {
        static bool attr_set = false;
        if (!attr_set) { (void)hipFuncSetAttribute((const void*)k_gemm<F>, hipFuncAttributeMaxDynamicSharedMemorySize, pg8::STAGE_BYTES); attr_set = true; }
        hipLaunchKernelGGL(k_gemm<F>, dim3(ncu), dim3(512), pg8::STAGE_BYTES, stream, g, e); }
};
#else
#ifndef PROBE_A
#define PROBE_A -1
#endif
#ifndef PROBE_B
#define PROBE_B -1
#endif
struct Ctx { XcdBarrier bar; PG8_LAS unsigned char* lds; int gtid, nthr;
    __device__ __forceinline__ void mark(int id) const { if (PROBE_A >= 0 && blockIdx.x == 0 && threadIdx.x == 0) { volatile PG8_LAS unsigned long long* t = (volatile PG8_LAS unsigned long long*)(lds + pg8::STAGE_BYTES + 400);
            if (id == PROBE_A) t[0] = __builtin_amdgcn_s_memrealtime(); if (id == PROBE_B) t[1] = __builtin_amdgcn_s_memrealtime(); } }
    __device__ __forceinline__ void probe_out(float* o) const { if (PROBE_A >= 0 && blockIdx.x == 0 && threadIdx.x == 0) { volatile PG8_LAS unsigned long long* t = (volatile PG8_LAS unsigned long long*)(lds + pg8::STAGE_BYTES + 400);
            o[0] += (float)(t[1] - t[0]) * 0.1f; } }
    template <int I> __device__ __forceinline__ const float* inp() const { unsigned off = pg8::STAGE_BYTES + 64 + 8 * I; asm volatile("" : "+v"(off));
        const PG8_LAS unsigned* t = (const PG8_LAS unsigned*)(lds + off);
        const unsigned lo = __builtin_amdgcn_readfirstlane(t[0]), hi = __builtin_amdgcn_readfirstlane(t[1]);
        return (const float*)(const __attribute__((address_space(1))) float*)(((unsigned long long)hi << 32) | lo); }
    template <class F> __device__ __forceinline__ void run(const F& f, bool sync = true, int ioff = 0) {
        int i0 = gtid - ioff; asm volatile("" : "+v"(i0)); if (i0 < 0) i0 += nthr;
        const int n = (int)f.n; int st = (int)nthr; asm volatile("" : "+s"(st));
        for (int i = i0; i < n; i += st) f((long)i);
        if (sync) xcd_barrier(bar); }
    template <class F> __device__ __forceinline__ void wrun(const F& f, bool sync = true, int woff = 0) {
        int t0 = threadIdx.x; asm volatile("" : "+v"(t0));
        const int wid = __builtin_amdgcn_readfirstlane(t0 >> 6), lane = t0 & 63; const int nw = (int)gridDim.x * 8; int w0 = (int)blockIdx.x * 8 + wid - woff; if (w0 < 0) w0 += nw;
        for (int it = w0; it < f.n; it += nw) { int ln = lane; asm volatile("" : "+v"(ln));
            f.wave(it, ln, lds + wid * 16384); }
        if (sync) xcd_barrier(bar); }
    template <class F> __device__ __forceinline__ void gemm(const GemmDesc& g, const F& e) {
        pg8::gemm_phase<F>(lds, g, e, (int)gridDim.x, (int)blockIdx.x);
        xcd_barrier(bar); }
    template <class F> __device__ __forceinline__ void gemm8(const GemmDesc& g, const F& e) {
        pg8::gemm_phase<F, true, false>(lds, g, e, (int)gridDim.x, (int)blockIdx.x);
        xcd_barrier(bar); }
};
#endif
#else
struct Ctx { const void* const* tbl;
void mark(int) const {} void probe_out(float*) const {}
template <int I> const float* inp() const { return (const float*)tbl[I]; }
template <class F> void run(const F& f, bool sync = true, int ioff = 0) {
#pragma omp parallel for schedule(static)
    for (long i = 0; i < f.n; ++i) f(i);
}
template <class F> void gemm(const GemmDesc& g, const F& e) {
    int M = g.M; if (g.ntile) { int nt = g.ntile[0] - g.tile0; if (nt < 0) nt = 0; if (nt * 256 < M) M = nt * 256; }
#pragma omp parallel for schedule(dynamic, 4)
    for (int r = 0; r < M; ++r) {
        int ar = r; if (g.arow) { ar = g.arow[(size_t)g.tile0 * 256 + r]; if (ar < 0) ar = 0; }
        const bf16* a = g.A + (size_t)ar * g.lda; const bf16* B = g.Bt + (g.tile_e ? (size_t)g.tile_e[g.tile0 + r / 256] * g.e_stride : (g.tdiv ? (size_t)((r / 256) / g.tdiv) * g.e_stride : 0));
        static thread_local float af[4096]; for (int k = 0; k < g.K; ++k) af[k] = bf2f(a[k]);
        for (int c0 = 0; c0 < g.N; c0 += 8) { float v[8];
            for (int j = 0; j < 8; ++j) { const bf16* bt = B + (size_t)(c0 + j) * g.ldb; float s = 0.f; for (int k = 0; k < g.K; ++k) s += af[k] * bf2f(bt[k]); v[j] = s; }
            e.apply8(r, c0, v); }
    }
}
};
#endif

struct Inputs { const float *x, *c, *ctx, *c_ctx, *w_ada, *b_ada, *norm1, *norm2, *w_in, *w_out, *gla_wa2, *gla_ba, *gla_norm, *s5_lam_re, *s5_lam_im, *s5_log_dt, *s5_b_re, *s5_b_im,
    *s5_c_re, *s5_c_im, *s5_d, *s5_glu_w, *s5_glu_b, *ml_conv_w, *ml_conv_b, *ml_gate_b, *ml_norm, *ffn_w1, *ffn_w3, *ffn_w2, *moe_router, *moe_w1, *moe_w3, *moe_w2, *norm_f; };

#define INP(name) (cx.template inp<offsetof(Inputs, name) / 8>())
#ifndef PROBE_REP
#define PROBE_REP -1
#endif
#ifndef PROBE_L
#define PROBE_L -1
#endif
#define REPEAT(k) if constexpr (false) {} else for (int rep_ = 0; rep_ < 1; ++rep_)
#define SEC_BEGIN(k) { auto sec_ = [&]() __attribute__((always_inline)) {
#define SEC_END(k) }; sec_(); if constexpr (PROBE_REP == (k) && (PROBE_L == l || PROBE_L < 0)) sec_(); }
#define WSB ((unsigned char*)cx.template inp<36>())
#ifdef HOST_EMU
#define S5TABBASE (WSB + WS.s5tab)
#else
#define S5TABBASE ((unsigned char*)cx.template inp<35>() + ABUF_BYTES)
#endif
#define out ((float*)cx.template inp<35>())
#define mod ((float*)(WSB + WS.mod))
#define h ((float*)(WSB + WS.h))
#define abuf ((bf16*)cx.template inp<35>())
#define winT ((bf16*)(WSB + WS.winT))
#define woutT ((bf16*)(WSB + WS.woutT))
#define w13T ((bf16*)(WSB + WS.w13T))
#define w2T ((bf16*)(WSB + WS.w2T))
#define pbuf ((bf16*)(WSB + WS.pbuf))
#define obuf ((float*)(WSB + WS.obuf))
#define lab ((bf16*)(WSB + WS.lab))
#define labg ((bf16*)(WSB + WS.labg))
#define s5disc ((float*)(S5TABBASE + S5T.disc))
#define s5K ((float*)(S5TABBASE + S5T.K))
#define s5apow ((float*)(S5TABBASE + S5T.apow))
#define s5bbar ((float*)(S5TABBASE + S5T.bbar))
#define s5TB ((bf16*)(S5TABBASE + S5T.TB))
#define s5EB ((bf16*)(S5TABBASE + S5T.EB))
#define s5uG ((bf16*)(WSB + WS.s5uG))
#define s5est ((float*)(WSB + WS.s5est))
#define zbuf ((bf16*)(WSB + WS.zbuf))
#define gluT ((bf16*)(S5TABBASE + S5T.gluT))
#define act ((bf16*)(WSB + WS.act))
#define mw13T ((bf16*)(WSB + WS.mw13T))
#define mw2T ((bf16*)(WSB + WS.mw2T))
#define mact ((bf16*)(WSB + WS.mact))
#define xs8 ((unsigned char*)(WSB + WS.xs8))
#define yrow ((bf16*)(WSB + WS.yrow))
#define rt_e ((int*)(WSB + WS.rt_e))
#define rt_w ((float*)(WSB + WS.rt_w))
#define rt_dest ((int*)(WSB + WS.rt_dest))
#define segcnt ((int*)(WSB + WS.segcnt))
#define ecnt ((int*)(WSB + WS.ecnt))
#define row_token ((int*)(WSB + WS.row_token))
#define tile_e ((int*)(WSB + WS.tile_e))
#define ntile ((int*)(WSB + WS.ntile))
#define modl (mod + (size_t)l * NMOD * 6 * D)
#define silc ((float*)(WSB + WS.silc))
#define postab ((float*)(WSB + WS.postab))
#define modpart ((float*)(WSB + WS.uni))
template <int l, class X> HD void layer_fwd(X& cx) {
    constexpr bool last = (l == DEPTH - 1);
    cx.mark(10 * (l + 1));
        REPEAT(1) {
#ifdef HOST_EMU
        cx.run(NormModK{(long)NR, h, INP(norm1) + (size_t)l * D, modl, 0, D, abuf, nullptr, nullptr, nullptr, 0, 0, nullptr});
#else
        if constexpr (!(l > 0 && (l - 1) % 2 == 1)) cx.wrun(NormModW{NR / 2, 0, D, 0, h, INP(norm1) + (size_t)l * D, modl, abuf, nullptr, nullptr, nullptr, nullptr, 0, 0});
#endif
        }
        cx.mark(10 * (l + 1) + 1);
        SEC_BEGIN(2) cx.gemm(GemmDesc{abuf, winT + (size_t)l * PS * D, nullptr, nullptr, nullptr, 0, NR, PS, D, 0, D, D, 0, 0}, EpiStoreBf16{pbuf, PS, 0}); SEC_END(2)
        cx.mark(10 * (l + 1) + 2);
        SEC_BEGIN(3) { typedef LaLay<64, 96> LG; typedef LaLay<96, 112> LM;
#ifdef HOST_EMU
        cx.run(GlaFused{(long)2 * NB * NBLK * 192, pbuf, INP(gla_wa2) + (size_t)l * 2 * 16 * 192, INP(gla_ba) + (size_t)l * 2 * 192, labg}, false);
#else
        cx.wrun(GlaPrepW2{2 * NB * NBLK * 4, 0, pbuf, INP(gla_wa2) + (size_t)l * 2 * 16 * 192, INP(gla_ba) + (size_t)l * 2 * 192, labg}, false);
#endif
#ifdef HOST_EMU
        cx.run(MlFused{(long)2 * NB * NBLK * 384, pbuf, INP(ml_conv_w) + (size_t)l * 3 * 768, INP(ml_conv_b) + (size_t)l * 768, INP(ml_gate_b) + (size_t)l * 16, lab}, false, 77824);
#else
        cx.wrun(MlPrepW2{2 * NB * NBLK * 4, 0, pbuf, INP(ml_conv_w) + (size_t)l * 3 * 768, INP(ml_conv_b) + (size_t)l * 768, INP(ml_gate_b) + (size_t)l * 16, lab}, false, (2 * NB * NBLK * 4) % 2048);
#endif
#ifdef HOST_EMU
        cx.run(VTFused<96, GV>{(long)LA_NI * 96, pbuf, labg + LG::vT}, false, 102400);
#else
        cx.wrun(VTW<96, GV>{(int)LA_NI, 0, pbuf, labg + LG::vT}, false, (4 * NB * NBLK * 4) % 2048);
#endif
        cx.run(S5Disc{(long)2 * 16 * 64, INP(s5_lam_re) + (size_t)l * 2048, INP(s5_lam_im) + (size_t)l * 2048, INP(s5_log_dt) + (size_t)l * 32, s5disc}, false);
        cx.run(S5Apow{(long)2 * 16 * 65 * 64, INP(s5_lam_re) + (size_t)l * 2048, INP(s5_lam_im) + (size_t)l * 2048, INP(s5_log_dt) + (size_t)l * 32, s5apow}, false);
        cx.run(TransposeK{(long)256 * 256, INP(s5_glu_w) + (size_t)l * 65536, nullptr, gluT, 256, 256, 256}, false);
#ifdef HOST_EMU
        cx.run(VTFused<112, MV>{(long)LA_NI * 112, pbuf, lab + LM::vT}, true, 49152);
#else
        cx.wrun(VTW<112, MV>{(int)LA_NI, 0, pbuf, lab + LM::vT}, true, (4 * NB * NBLK * 4 + (int)LA_NI) % 2048);
#endif
#ifdef HOST_EMU
        cx.run(S5Bbar{(long)2 * 16 * 64 * 16, s5disc, INP(s5_b_re) + (size_t)l * 16384, INP(s5_b_im) + (size_t)l * 16384, s5bbar}, false);
        cx.run(StatesRef<64, 96>{(long)2 * LA_NI * 96 * 64, labg});
        cx.run(StatesRef<96, 112>{(long)2 * LA_NI * 112 * 96, lab});
        cx.run(CarryT<96, 112>{(long)2 * NB * 4 * 112 * 96, lab}, false);
        cx.run(CarryT<64, 96>{(long)2 * NB * 4 * 96 * 64, labg});
#else
        cx.run(S5Bbar{(long)2 * 16 * 64 * 16, s5disc, INP(s5_b_re) + (size_t)l * 16384, INP(s5_b_im) + (size_t)l * 16384, s5bbar}, false);
        cx.wrun(ChainW<96, 112, 2>{2 * NB * 4 * 7 * 3, 0, lab}, false);
        cx.wrun(ChainW<64, 96, 4>{2 * NB * 4 * 6, 0, labg}, true, (2 * NB * 4 * 7 * 3) % 2048);
#endif
        cx.run(S5K2{(long)2 * 16 * 64 * 256, s5apow, s5bbar, INP(s5_c_re) + (size_t)l * 16384, INP(s5_c_im) + (size_t)l * 16384, s5K}, false);
        cx.run(S5BuildEB{(long)16 * 256 * 128, s5apow, s5bbar, s5EB}, false);
#ifdef HOST_EMU
        cx.run(OutRef<64, 96, false>{(long)NR * 384, labg, obuf});
        cx.run(HeadFin{(long)NR * 4, pbuf, obuf, INP(gla_norm) + (size_t)l * 96, abuf, 0});
        cx.run(OutRef<96, 112, true>{(long)NR * 384, lab, obuf});
        cx.run(HeadFin{(long)NR * 4, pbuf, obuf, INP(ml_norm) + (size_t)l * 96, abuf, 1});
#else
        cx.wrun(OutW<96, 112, true>{2 * (int)LA_NI, 0, lab, pbuf, INP(ml_norm) + (size_t)l * 96, abuf}, false);
        cx.wrun(OutWG{(int)LA_NI, 0, labg, pbuf, INP(gla_norm) + (size_t)l * 96, abuf}, true, (2 * (int)LA_NI) % 2048);
#endif
        } SEC_END(3)
        cx.mark(10 * (l + 1) + 3);
        cx.mark(10 * (l + 1) + 4);
        SEC_BEGIN(5) {
        cx.run(S5BuildTB{(long)16 * 1024 * (S5K_ / 8), s5apow, INP(s5_c_re) + (size_t)l * 16384, INP(s5_c_im) + (size_t)l * 16384, s5K, s5TB}, false);
        cx.run(S5BuildU{(long)16 * S5RB * 128, pbuf, s5uG});
        cx.gemm(GemmDesc{s5uG, s5EB, nullptr, nullptr, nullptr, (size_t)256 * 1024, 16 * S5RG, 256, 1024, 0, S5K_, 1024, S5RG / 256, 0}, EpiStoreF32{s5est, 256, 0});
        cx.run(S5Carry2{(long)NB * 16 * 2 * 64, s5apow, s5est, s5uG});
        cx.gemm(GemmDesc{s5uG, s5TB, nullptr, nullptr, nullptr, (size_t)1024 * S5K_, 16 * S5RG, 1024, S5K_, 0, S5K_, S5K_, S5RG / 256, 0}, EpiS5Z{pbuf, INP(s5_d) + (size_t)l * 256, zbuf});
        cx.gemm(mk_gemm(zbuf, 256, gluT, 256, NR, 256, 256), EpiGlu{zbuf, INP(s5_glu_b) + (size_t)l * 256, abuf});
        } SEC_END(5)
        cx.mark(10 * (l + 1) + 5);
        cx.gemm(GemmDesc{abuf, woutT + (size_t)l * D * D, nullptr, nullptr, nullptr, 0, NR, D, D, 0, D, D, 0, 0}, EpiResid{h, modl, 2 * D});
        cx.mark(10 * (l + 1) + 6);
        if constexpr (l % 2 == 0) { constexpr int j = l / 2;
            SEC_BEGIN(6) {
#ifdef HOST_EMU
            cx.run(NormModK{(long)NR, h, INP(norm2) + (size_t)l * D, modl, 3 * D, 4 * D, abuf, nullptr, nullptr, nullptr, 0, 0, nullptr});
#else
            cx.wrun(NormModW{NR / 2, 3 * D, 4 * D, 0, h, INP(norm2) + (size_t)l * D, modl, abuf, nullptr, nullptr, nullptr, nullptr, 0, 1});
#endif
#ifdef HOST_EMU
            cx.gemm(GemmDesc{abuf, w13T + (size_t)j * 2 * DFF * D, nullptr, nullptr, nullptr, 0, NR, 2 * DFF, D, 0, D, D, 0, 0}, EpiSwiGLU{act, DFF, 0});
#else
            cx.gemm8(GemmDesc{abuf, (const bf16*)((const unsigned char*)w13T + (size_t)j * 2 * DFF * D), nullptr, nullptr, nullptr, 0, NR, 2 * DFF, D, 0, D, D, 0, -W8S},
#if FP8_DOWN_DENSE
                EpiSwiGLU8{(unsigned char*)act, DFF, 0});
#else
                EpiSwiGLU{act, DFF, 0});
#endif
#endif
            } SEC_END(6)
#if FP8_DOWN_DENSE && !defined(HOST_EMU)
            cx.gemm8(GemmDesc{act, (const bf16*)((const unsigned char*)w2T + (size_t)j * D * DFF), nullptr, nullptr, nullptr, 0, NR, D, DFF, 0, DFF, DFF, 0, -(W8S + A8S)}, EpiResid{h, modl, 5 * D});
#else
            cx.gemm(GemmDesc{act, w2T + (size_t)j * D * DFF, nullptr, nullptr, nullptr, 0, NR, D, DFF, 0, DFF, DFF, 0, 0}, EpiResid{h, modl, 5 * D});
#endif
        } else { constexpr int j = l / 2; const int nseg = (NR + 63) / 64;
            SEC_BEGIN(7) {
#ifdef HOST_EMU
            for (int e = 0; e < NE; ++e) { const size_t wo = ((size_t)j * NE + e) * D * DFF;
                cx.run(TransposeK{(long)2 * DFF * D, INP(moe_w1) + wo, INP(moe_w3) + wo, mw13T + (size_t)e * 2 * DFF * D, D, DFF, 2 * DFF});
                cx.run(TransposeK{(long)D * DFF, INP(moe_w2) + wo, nullptr, mw2T + (size_t)e * D * DFF, DFF, D, D}); }
            cx.run(ZeroInt{(long)NE * nseg, segcnt});
            cx.run(MoeFillNeg{(long)MOE_MAXT * 256, row_token});
            cx.run(NormModK{(long)NR, h, INP(norm2) + (size_t)l * D, modl, 3 * D, 4 * D, abuf, INP(moe_router) + (size_t)j * D * NE, rt_e, rt_w, last ? 1 : 0, nseg, segcnt});
            cx.run(MoePrefix{(long)NE, segcnt, ecnt, nseg});
#else
            cx.wrun(TransW{((NE * (D / 64) * (DFF / 32)) + 1) / 2, D, DFF, 2, 0, W8S, INP(moe_w1) + (size_t)j * NE * D * DFF, mw13T, (size_t)D * DFF, (size_t)2 * DFF * D, (NE * (D / 64) * (DFF / 32)), 0}, false);
            cx.wrun(TransW{((NE * (D / 64) * (DFF / 32)) + 1) / 2, D, DFF, 2, 1, W8S, INP(moe_w3) + (size_t)j * NE * D * DFF, mw13T, (size_t)D * DFF, (size_t)2 * DFF * D, (NE * (D / 64) * (DFF / 32)), 0}, false);
            cx.wrun(TransW{((NE * (DFF / 64) * (D / 32)) + 1) / 2, DFF, D, 1, 0, FP8_DOWN_MOE ? W8S : 0, INP(moe_w2) + (size_t)j * NE * DFF * D, mw2T, (size_t)DFF * D, (size_t)D * DFF, (NE * (DFF / 64) * (D / 32)), 0}, false);
            cx.run(MoeFillNeg{(long)MOE_MAXT * 256, row_token}, false);
            cx.run(ZeroInt{(long)NE * nseg, segcnt});
            cx.wrun(NormModW{NR / 2, 3 * D, 4 * D, last ? 1 : 0, h, INP(norm2) + (size_t)l * D, modl, abuf, INP(moe_router) + (size_t)j * D * NE, rt_e, rt_w, segcnt, nseg, 1});
            cx.wrun(MoePrefixW{NE, nseg, segcnt, ecnt});
#endif
            cx.run(MoeTiles2{(long)MOE_MAXT, ecnt, tile_e, ntile}, false);
            cx.run(MoeAssign{(long)NE * nseg, rt_e, segcnt, ecnt, rt_dest, row_token, nseg});
#ifdef HOST_EMU
            cx.gemm(GemmDesc{abuf, mw13T, tile_e, ntile, row_token, (size_t)2 * DFF * D, MOE_MAXT * 256, 2 * DFF, D, 0, D, D, 0, 0}, EpiSwiGLU{mact, DFF, 0});
#else
            for (int t0 = 0; t0 < MOE_MAXT; t0 += MOE_XT) { const int nt = (MOE_MAXT - t0 < MOE_XT) ? MOE_MAXT - t0 : MOE_XT;
                cx.run(MoeGather8{(long)nt * 256 * (D / 16), (const unsigned char*)abuf, row_token, xs8, t0 * 256, 0});
                cx.gemm8(GemmDesc{(const bf16*)xs8, mw13T, tile_e, ntile, nullptr, (size_t)2 * DFF * D / 2, nt * 256, 2 * DFF, D, t0, D, D, 0, -W8S},
#if FP8_DOWN_MOE
                    EpiSwiGLU8{(unsigned char*)mact + (size_t)t0 * 256 * DFF, DFF, 0}); }
#else
                    EpiSwiGLU{mact + (size_t)t0 * 256 * DFF, DFF, 0}); }
#endif
#endif
#if FP8_DOWN_MOE && !defined(HOST_EMU)
            cx.gemm8(GemmDesc{mact, mw2T, tile_e, ntile, nullptr, (size_t)D * DFF / 2, MOE_MAXT * 256, D, DFF, 0, DFF, DFF, 0, -(W8S + A8S)}, EpiStoreBf16{yrow, D, 0});
#else
            cx.gemm(GemmDesc{mact, mw2T, tile_e, ntile, nullptr, (size_t)D * DFF, MOE_MAXT * 256, D, DFF, 0, DFF, DFF, 0, 0}, EpiStoreBf16{yrow, D, 0});
#endif
            } SEC_END(7)
#ifdef HOST_EMU
            cx.run(MoeCombine{(long)NR * D / 8, h, yrow, rt_e, rt_w, rt_dest, modl, 5 * D});
#else
            if constexpr (last) cx.wrun(CombineNormW{NR, 1, 5 * D, 0, h, yrow, rt_e, rt_w, rt_dest, modl, INP(norm_f), modl, abuf, out});
            else cx.wrun(CombineNormW{NR, 0, 5 * D, 0, h, yrow, rt_e, rt_w, rt_dest, modl, INP(norm1) + (size_t)(l + 1) * D, mod + (size_t)(l + 1) * NMOD * 6 * D, abuf, out});
#endif
        }
        cx.mark(10 * (l + 1) + 7);
    }
template <class X> HD void forward(X& cx) {
    cx.mark(0);
    constexpr int l = 0; (void)l;
    cx.run(PosTab{(long)2 * GRID_W * 512, postab}, false);
    cx.run(SiluC{(long)NMOD * D, INP(c), INP(c_ctx), silc});
    cx.run(InitH{(long)NR * D / 4, INP(x), INP(ctx), postab, h}, false);
#ifdef HOST_EMU
    for (int l = 0; l < DEPTH; ++l) {
        cx.run(TransposeK{(long)PS * D, INP(w_in) + (size_t)l * D * DPROJ, nullptr, winT + (size_t)l * PS * D, D, DPROJ, PS});
        cx.run(TransposeK{(long)D * D, INP(w_out) + (size_t)l * D * D, nullptr, woutT + (size_t)l * D * D, D, D, D});
        if (l % 2 == 0) { const int j = l / 2;
            cx.run(TransposeK{(long)2 * DFF * D, INP(ffn_w1) + (size_t)j * D * DFF, INP(ffn_w3) + (size_t)j * D * DFF, w13T + (size_t)j * 2 * DFF * D, D, DFF, 2 * DFF});
            cx.run(TransposeK{(long)D * DFF, INP(ffn_w2) + (size_t)j * DFF * D, nullptr, w2T + (size_t)j * D * DFF, DFF, D, D}); }
    }
#else
    cx.wrun(TransW{((DEPTH * (D / 64) * (DPROJ / 32)) + 1) / 2, D, DPROJ, 1, 0, 0, INP(w_in), winT, (size_t)D * DPROJ, (size_t)PS * D, (DEPTH * (D / 64) * (DPROJ / 32)), 0}, false);
    for (int l = 0; l < DEPTH; ++l) cx.run(ZeroBf16{(long)(PS - DPROJ) * D, winT + ((size_t)l * PS + DPROJ) * D}, false);
    cx.wrun(TransW{((DEPTH * (D / 64) * (D / 32)) + 1) / 2, D, D, 1, 0, 0, INP(w_out), woutT, (size_t)D * D, (size_t)D * D, (DEPTH * (D / 64) * (D / 32)), 0}, false);
    cx.wrun(TransW{((((DEPTH + 1) / 2) * (D / 64) * (DFF / 32)) + 1) / 2, D, DFF, 2, 0, W8S, INP(ffn_w1), w13T, (size_t)D * DFF, (size_t)2 * DFF * D, (((DEPTH + 1) / 2) * (D / 64) * (DFF / 32)), 0}, false);
    cx.wrun(TransW{((((DEPTH + 1) / 2) * (D / 64) * (DFF / 32)) + 1) / 2, D, DFF, 2, 1, W8S, INP(ffn_w3), w13T, (size_t)D * DFF, (size_t)2 * DFF * D, (((DEPTH + 1) / 2) * (D / 64) * (DFF / 32)), 0}, false);
    cx.wrun(TransW{((((DEPTH + 1) / 2) * (DFF / 64) * (D / 32)) + 1) / 2, DFF, D, 1, 0, FP8_DOWN_DENSE ? W8S : 0, INP(ffn_w2), w2T, (size_t)DFF * D, (size_t)D * DFF, (((DEPTH + 1) / 2) * (DFF / 64) * (D / 32)), 0}, false);
#endif
    cx.run(ModPart{(long)MODKC * DEPTH * 6 * D, silc, INP(w_ada), modpart});
    cx.run(ModReduce{(long)DEPTH * NMOD * 6 * D, modpart, INP(b_ada), mod});
    cx.mark(1);
    layer_fwd<0>(cx);
    if constexpr (DEPTH > 1) layer_fwd<1>(cx);
    if constexpr (DEPTH > 2) layer_fwd<2>(cx);
    if constexpr (DEPTH > 3) layer_fwd<3>(cx);
    static_assert(DEPTH <= 4, "unrolled for DEPTH <= 4");
#ifdef HOST_EMU
    cx.run(FinalNorm{(long)NB * SEQ, h, INP(norm_f), out});
#else
    if constexpr ((DEPTH - 1) % 2 == 0) cx.wrun(FinalNormW{NB * SEQ, 0, h, INP(norm_f), out});
#endif
    cx.mark(99);
    cx.probe_out(out);
}

#undef silc
#undef postab
#undef modpart
#undef mod
#undef h
#undef abuf
#undef winT
#undef woutT
#undef w13T
#undef w2T
#undef pbuf
#undef obuf
#undef lab
#undef labg
#undef s5disc
#undef s5K
#undef s5apow
#undef s5bbar
#undef s5TB
#undef s5EB
#undef s5uG
#undef s5est
#undef zbuf
#undef gluT
#undef act
#undef mw13T
#undef mw2T
#undef mact
#undef xs8
#undef yrow
#undef rt_e
#undef rt_w
#undef rt_dest
#undef segcnt
#undef ecnt
#undef row_token
#undef tile_e
#undef ntile
#undef WSB
#undef S5TABBASE
#undef out
#undef modl
#ifndef HOST_EMU
#ifndef MULTI_LAUNCH
constexpr int MEGA_LDS = pg8::STAGE_BYTES + 512;
struct MegaArgs { const void* p[37]; };
__global__ void __launch_bounds__(512, 2) mega_fwd(MegaArgs a) {
    extern __shared__ __attribute__((aligned(16))) unsigned char shm[];
    PG8_LAS unsigned char* lds = (PG8_LAS unsigned char*)shm;
    volatile LAS unsigned* xbw = (volatile LAS unsigned*)(lds + pg8::STAGE_BYTES);
    if (threadIdx.x < 4) xbw[threadIdx.x] = 0u;
    if (threadIdx.x < 37) ((PG8_LAS unsigned long long*)(lds + pg8::STAGE_BYTES + 64))[threadIdx.x] = (unsigned long long)a.p[threadIdx.x];
    __syncthreads();
    Ctx cx; cx.lds = lds;
    cx.bar = xcd_barrier_post((unsigned*)((unsigned char*)cx.inp<36>() + WS.ctl), xbw);
    cx.gtid = (int)(blockIdx.x * blockDim.x + threadIdx.x); cx.nthr = (int)(gridDim.x * blockDim.x);
    forward(cx);
}
#endif
extern "C" void kernel_launch(void* const* d_in, const int* in_sizes, int n_in, void* d_out, int out_size, void* d_ws, size_t ws_size, hipStream_t stream) {
    static int ncu = 0;
    if (ncu == 0) { int dev = 0; (void)hipGetDevice(&dev); (void)hipDeviceGetAttribute(&ncu, hipDeviceAttributeMultiprocessorCount, dev); if (ncu <= 0) ncu = 256;
#ifndef MULTI_LAUNCH
        if (hipFuncSetAttribute((const void*)mega_fwd, hipFuncAttributeMaxDynamicSharedMemorySize, MEGA_LDS) != hipSuccess) { fprintf(stderr, "kernel_launch: hipFuncSetAttribute failed\n"); }
#endif
    }
    if (n_in != 35 || ws_size < WS.end || out_size != NB * SEQ * D) { fprintf(stderr, "kernel_launch: unexpected sizes n_in %d ws %zu (need %zu) out %d\n", n_in, ws_size, (size_t)WS.end, out_size); return; }
#ifdef MULTI_LAUNCH
    const void* tbl[37]; for (int i = 0; i < 35; ++i) tbl[i] = d_in[i]; tbl[35] = d_out; tbl[36] = d_ws;
    Ctx cx{stream, ncu, tbl};
    forward(cx);
#else
    (void)hipMemsetAsync((unsigned char*)d_ws + WS.ctl, 0, 1 << 20, stream);
    MegaArgs a{}; for (int i = 0; i < 35; ++i) a.p[i] = d_in[i];
    a.p[35] = d_out; a.p[36] = d_ws;
    hipLaunchKernelGGL(mega_fwd, dim3(ncu), dim3(512), MEGA_LDS, stream, a);
#endif
}
#endif
```

```cpp
#ifndef HOST_EMU
#include <hip/hip_runtime.h>
#define HD __host__ __device__ __forceinline__
#define UNROLL _Pragma("unroll")
#else
#include <cmath>
#include <cstdio>
#include <cstdlib>
#include <cstring>
#include <cstdint>
#define HD inline
#define UNROLL
#endif
#include <math.h>
#include <stdint.h>
#include <stddef.h>
#include <stdio.h>

#ifndef CFG_NB
#define CFG_NB 8
#endif
#ifndef CFG_SEQ
#define CFG_SEQ 4096
#endif
#ifndef CFG_CTX
#define CFG_CTX 256
#endif
#ifndef CFG_DEPTH
#define CFG_DEPTH 4
#endif
constexpr int NB = CFG_NB, SEQ = CFG_SEQ, CTX = CFG_CTX, DEPTH = CFG_DEPTH;
constexpr int D = 1024, GRID_W = 64;
constexpr int RPB = CTX + SEQ;
constexpr int NR = NB * RPB;
constexpr int NBLK = RPB / 64, CB = CTX / 64;
constexpr int DPROJ = 2976, PS = 3072;
constexpr int GQ = 0, GK = 192, GV = 384, GLR = 768, GG = 784, SU = 1168, MQ = 1424, MK = 1808, MV = 2192, MO = 2576, MG = 2960;
constexpr int DFF = 2816, NE = 8;
constexpr int NMOD = NB + 1;
constexpr float EPS = 1e-6f;
constexpr int MOE_MAXT = (2 * NR + NE * 255) / 256 + 1;
#ifndef FP8_DOWN_DENSE
#define FP8_DOWN_DENSE 1
#endif
#ifndef FP8_DOWN_MOE
#define FP8_DOWN_MOE 1
#endif
constexpr int MOE_XT = MOE_MAXT;

typedef unsigned short bf16;
struct __attribute__((aligned(16))) U4 { uint32_t x, y, z, w; };
HD float bf2f(bf16 v) { uint32_t u = ((uint32_t)v) << 16; float f; memcpy(&f, &u, 4); return f; }
HD bf16 f2bf(float f) { uint32_t u; memcpy(&u, &f, 4); u += 0x7fffu + ((u >> 16) & 1u); return (bf16)(u >> 16); }
#if defined(HOST_EMU)
HD float siluf(float x) { return x / (1.0f + expf(-x)); }
HD float sigmoidf_(float x) { return 1.0f / (1.0f + expf(-x)); }
HD float logsigmoidf_(float x) { return x < 0.f ? x - log1pf(expf(x)) : -log1pf(expf(-x)); }
HD float fexp(float x) { return expf(x); }
#else
__host__ __device__ __forceinline__ float fexp(float x) { return __builtin_amdgcn_exp2f(x * 1.4426950408889634f); }
__host__ __device__ __forceinline__ float siluf(float x) { return x * __builtin_amdgcn_rcpf(1.0f + fexp(-x)); }
__host__ __device__ __forceinline__ float sigmoidf_(float x) { return __builtin_amdgcn_rcpf(1.0f + fexp(-x)); }
__host__ __device__ __forceinline__ float logsigmoidf_(float x) { return fminf(x, 0.f) - 0.6931471805599453f * __builtin_amdgcn_logf(1.0f + fexp(-fabsf(x))); }
#endif
HD float gelu_tanhf(float x) { return 0.5f * x * (1.0f + tanhf(0.7978845608028654f * (x + 0.044715f * x * x * x))); }
#ifndef HOST_EMU
typedef float f4_t __attribute__((ext_vector_type(4)));
__device__ __forceinline__ unsigned cvt_pk_bf16(float lo, float hi) { unsigned r; asm("v_cvt_pk_bf16_f32 %0, %1, %2" : "=v"(r) : "v"(lo), "v"(hi)); return r; }
__device__ __forceinline__ void store8_bf16(bf16* dst, const float* v) { uint4 w; w.x = cvt_pk_bf16(v[0], v[1]); w.y = cvt_pk_bf16(v[2], v[3]); w.z = cvt_pk_bf16(v[4], v[5]); w.w = cvt_pk_bf16(v[6], v[7]); *(uint4*)dst = w; }
__device__ __forceinline__ void load8_bf16(const bf16* src, float* v) { const uint4 w = *(const uint4*)src; const unsigned u[4] = {w.x, w.y, w.z, w.w};
#pragma unroll
    for (int i = 0; i < 4; ++i) { v[2 * i] = __uint_as_float(u[i] << 16); v[2 * i + 1] = __uint_as_float(u[i] & 0xffff0000u); } }
__device__ __forceinline__ float fast_silu(float x) { return x * __builtin_amdgcn_rcpf(1.0f + __expf(-x)); }
__device__ __forceinline__ float fast_sigmoid(float x) { return __builtin_amdgcn_rcpf(1.0f + __expf(-x)); }
#endif
HD int mod_index(int r) { const int b = r / RPB, t = r % RPB; return t < CTX ? NB : b; }
HD int chain_blk(int d, int step) { return d == 0 ? step : (step < CB ? CB - 1 - step : NBLK - 1 - (step - CB)); }
HD int blk_row(int b, int blk, int d, int pp) { return b * RPB + blk * 64 + (d == 0 ? pp : 63 - pp); }

constexpr size_t LA_NI = (size_t)NB * NBLK * 4;
HD size_t tile_off(int row, int col, int KT) { return ((size_t)((row >> 4) * KT + (col >> 5)) * 64 + (size_t)((((col & 31) >> 3) << 4) + (row & 15))) * 8 + (col & 7); }
template <int DKP, int NV> struct LaLay {
    static constexpr int KQ = DKP / 32;
    static constexpr size_t qin = 0;
    static constexpr size_t kin = qin + (size_t)2 * NR * 4 * DKP;
    static constexpr size_t koutT = kin + (size_t)2 * NR * 4 * DKP;
    static constexpr size_t vT = koutT + (size_t)2 * LA_NI * DKP * 64;
    static constexpr size_t sT = vT + LA_NI * NV * 64;
    static constexpr size_t dec = sT + (size_t)2 * LA_NI * NV * DKP;
    static constexpr size_t end = dec + (size_t)2 * 2 * LA_NI * DKP;
    HD static size_t q_at(int d, size_t item, int tok, int i) { return qin + ((size_t)d * LA_NI + item) * 64 * DKP + tile_off(tok, i, KQ); }
    HD static size_t k_at(int d, size_t item, int tok, int i) { return kin + ((size_t)d * LA_NI + item) * 64 * DKP + tile_off(tok, i, KQ); }
    HD static size_t kt_at(int d, size_t item, int i, int tok) { return koutT + ((size_t)d * LA_NI + item) * DKP * 64 + tile_off(i, tok, 2); }
    HD static size_t v_at(size_t item, int j, int tok) { return vT + item * NV * 64 + tile_off(j, tok, 2); }
    HD static size_t s_at(int d, size_t item, int j, int i) { return sT + ((size_t)d * LA_NI + item) * NV * DKP + tile_off(j, i, KQ); }
};
constexpr size_t al256(size_t x) { return (x + 255) & ~(size_t)255; }
struct WsMap {
    size_t ctl, mod, silc, postab, h, abuf, winT, woutT, w13T, w2T, uni, end_fixed;
    size_t pbuf, lab, labg, obuf, s5tab, s5uG, s5est, zbuf, end_mix;
    size_t act, end_ffn;
    size_t mw13T, mw2T, xs8, mact, yrow, rt_e, rt_w, rt_dest, segcnt, ecnt, row_token, tile_e, ntile, end_moe;
    size_t end;
};
constexpr WsMap make_map() {
    WsMap m{}; size_t o = 0;
    m.ctl = o; o += 1 << 20;
    m.mod = o; o += al256((size_t)DEPTH * NMOD * 6 * D * 4);
    m.silc = o; o += al256((size_t)NMOD * D * 4);
    m.postab = o; o += al256((size_t)2 * GRID_W * 512 * 4);
    m.h = o; o += al256((size_t)NR * D * 4);
    m.abuf = o;
    m.winT = o; o += al256((size_t)DEPTH * PS * D * 2);
    m.woutT = o; o += al256((size_t)DEPTH * D * D * 2);
    m.w13T = o; o += al256((size_t)((DEPTH + 1) / 2) * 2 * DFF * D * 2);
    m.w2T = o; o += al256((size_t)((DEPTH + 1) / 2) * D * DFF * 2);
    m.uni = o; m.end_fixed = o;
    o = m.uni;
    m.pbuf = o; o += al256((size_t)NR * PS * 2);
    m.lab = o;
    { size_t o2 = m.lab;
      m.s5uG = o2; o2 += al256((size_t)16 * ((NB * NBLK + 255) / 256 * 256) * 1280 * 2);
      m.s5est = o2; o2 += al256((size_t)16 * ((NB * NBLK + 255) / 256 * 256) * 256 * 4);
      m.zbuf = o2; o2 += al256((size_t)NR * 256 * 2);
      const size_t la_bytes = al256(LaLay<96, 112>::end * 2);
      o = m.lab + (la_bytes > o2 - m.lab ? la_bytes : o2 - m.lab); }
    m.labg = o; o += al256(LaLay<64, 96>::end * 2);
    m.obuf = o;
#ifdef HOST_EMU
    o += al256((size_t)NR * 384 * 4);
    m.s5tab = o; o += (size_t)64 << 20;
#endif
    m.end_mix = o;
    o = m.uni;
    m.act = o; o += al256((size_t)NR * DFF * 2);
    m.end_ffn = o;
    o = m.uni;
    m.mw13T = o; o += al256((size_t)NE * 2 * DFF * D);
#ifdef HOST_EMU
    o += al256((size_t)NE * 2 * DFF * D);
#endif
    m.mw2T = o; o += al256((size_t)NE * D * DFF * 2);
    m.xs8 = o; o += al256((size_t)MOE_XT * 256 * D);
#if FP8_DOWN_MOE && !defined(HOST_EMU)
    m.mact = o; o += al256((size_t)MOE_MAXT * 256 * DFF);
#else
    m.mact = o; o += al256((size_t)MOE_MAXT * 256 * DFF * 2);
#endif
    m.yrow = o; o += al256((size_t)MOE_MAXT * 256 * D * 2);
    m.rt_e = o; o += al256((size_t)NR * 2 * 4);
    m.rt_w = o; o += al256((size_t)NR * 2 * 4);
    m.rt_dest = o; o += al256((size_t)NR * 2 * 4);
    m.segcnt = o; o += al256((size_t)NE * (NR / 64 + 1) * 4);
    m.ecnt = o; o += al256((size_t)64 * 4);
    m.row_token = o; o += al256((size_t)MOE_MAXT * 256 * 4);
    m.tile_e = o; o += al256((size_t)MOE_MAXT * 4);
    m.ntile = o; o += 256;
    m.end_moe = o;
    m.end = m.end_mix > m.end_moe ? m.end_mix : m.end_moe; if (m.end_ffn > m.end) m.end = m.end_ffn;
    return m;
}
constexpr WsMap WS = make_map();
struct S5Tab { size_t disc, K, apow, bbar, TB, EB, gluT, end; };
constexpr S5Tab make_s5tab() { S5Tab t{}; size_t o = 0;
    t.disc = o; o += al256((size_t)2 * 16 * 64 * 4 * 4); t.K = o; o += al256((size_t)2 * 16 * 64 * 256 * 4); t.apow = o; o += al256((size_t)2 * 16 * 65 * 64 * 2 * 4); t.bbar = o; o += al256((size_t)2 * 16 * 64 * 16 * 2 * 4);
    t.TB = o; o += al256((size_t)16 * 1024 * 1280 * 2); t.EB = o; o += al256((size_t)16 * 256 * 1024 * 2); t.gluT = o; o += al256((size_t)256 * 256 * 2); t.end = o; return t; }
constexpr S5Tab S5T = make_s5tab();
constexpr size_t ABUF_BYTES = al256((size_t)NR * D * 2);
#ifndef HOST_EMU
static_assert(ABUF_BYTES + S5T.end <= (size_t)NB * SEQ * D * 4, "the bf16 row buffer and the S5 tables must fit in d_out");
#endif

struct PosTab { long n; float* tab;
    HD void operator()(long i) const { const int cc = (int)(i % 512); const int pos = (int)((i / 512) % GRID_W); const int j = cc & 255; const float omega = expf(-9.210340371976184f * (float)j / 256.0f); const float ang = (float)pos * omega;
        tab[i] = (cc & 256) ? cosf(ang) : sinf(ang); } };
struct __attribute__((aligned(16))) F4 { float x, y, z, w; };
struct InitH { long n; const float* x; const float* ctx; const float* tab; float* h;
    HD void operator()(long i) const { const int r = (int)(i / (D / 4)), c = (int)(i % (D / 4)) * 4; const int b = r / RPB, t = r % RPB; F4 v;
        if (t < CTX) v = *(const F4*)(ctx + ((size_t)b * CTX + t) * D + c);
        else { const int tl = t - CTX, row = tl / GRID_W, col = tl % GRID_W; const F4 xv = *(const F4*)(x + ((size_t)b * SEQ + tl) * D + c);
            const F4 pe = *(const F4*)(tab + (c < 512 ? (size_t)row * 512 + c : (size_t)(GRID_W + col) * 512 + (c - 512))); v.x = xv.x + pe.x; v.y = xv.y + pe.y; v.z = xv.z + pe.z; v.w = xv.w + pe.w; }
        *(F4*)(h + (size_t)r * D + c) = v; } };
struct ModK { long n; const float* c; const float* cctx; const float* w_ada; const float* b_ada; float* mod;
    HD void operator()(long i) const { const int l = (int)(i / (6 * D)), j = (int)(i % (6 * D));
        float acc[NMOD];
        for (int m = 0; m < NMOD; ++m) acc[m] = b_ada[(size_t)l * 6 * D + j];
        const float* w = w_ada + (size_t)l * D * 6 * D + j;
        for (int k = 0; k < D; ++k) { const float wv = w[(size_t)k * 6 * D];
            for (int m = 0; m < NMOD; ++m) { const float cv = (m < NB) ? c[m * D + k] : cctx[k]; acc[m] += siluf(cv) * wv; } }
        for (int m = 0; m < NMOD; ++m) mod[((size_t)l * NMOD + m) * 6 * D + j] = acc[m]; } };
struct TransposeK { long n; const float* a; const float* b; bf16* dst; int K, N, NP, pad;
    HD void operator()(long i) const { const int nn = (int)(i / K), k = (int)(i % K);
        float v = 0.f;
        if (b) { const int j = nn >> 1; v = (nn & 1) ? b[(size_t)k * N + j] : a[(size_t)k * N + j]; }
        else if (nn < N) v = a[(size_t)k * N + nn];
        dst[i] = f2bf(v); } };
struct NormModK { long n; const float* h; const float* g; const float* mod; int sh_off, sc_off; bf16* out; const float* wr; int* rt_e; float* rt_w; int skip_ctx, nseg; int* segcnt;
    HD void operator()(long r) const { const float* hr = h + (size_t)r * D; float ss = 0.f;
        for (int k = 0; k < D; ++k) ss += hr[k] * hr[k];
        const float rstd = 1.0f / sqrtf(ss / D + EPS); const float* m = mod + (size_t)mod_index((int)r) * 6 * D;
        float lg[NE]; for (int e = 0; e < NE; ++e) lg[e] = 0.f;
        for (int k = 0; k < D; ++k) { const float v = hr[k] * rstd * g[k] * (1.0f + m[sc_off + k]) + m[sh_off + k]; out[(size_t)r * D + k] = f2bf(v);
            if (wr) for (int e = 0; e < NE; ++e) lg[e] += v * wr[k * NE + e]; }
        if (wr) { int e0 = 0; float b0 = lg[0]; for (int e = 1; e < NE; ++e) if (lg[e] > b0) { b0 = lg[e]; e0 = e; }
            int e1 = -1; float b1 = -3.0e38f; for (int e = 0; e < NE; ++e) if (e != e0 && lg[e] > b1) { b1 = lg[e]; e1 = e; }
            const float w1 = 1.0f / (1.0f + expf(b1 - b0));
            const bool skip = skip_ctx && ((int)(r % RPB) < CTX);
            rt_e[2 * r] = skip ? -1 : e0; rt_e[2 * r + 1] = skip ? -1 : e1; rt_w[2 * r] = w1; rt_w[2 * r + 1] = 1.0f - w1;
            if (!skip) { __atomic_fetch_add(&segcnt[(size_t)e0 * nseg + r / 64], 1, __ATOMIC_RELAXED); __atomic_fetch_add(&segcnt[(size_t)e1 * nseg + r / 64], 1, __ATOMIC_RELAXED); } } } };

struct SiluC { long n; const float* c; const float* cctx; float* sc;
    HD void operator()(long i) const { const int m = (int)(i / D), k = (int)(i % D); sc[i] = siluf(m < NB ? c[m * D + k] : cctx[k]); } };
constexpr int A8S = 2;
constexpr int W8S = 6;
constexpr int MODKC = 8;
struct ModPart { long n; const float* sc; const float* w_ada; float* part;
    HD void operator()(long i) const { const int j = (int)(i % (6 * D)); long y = i / (6 * D); const int l = (int)(y % DEPTH), kc = (int)(y / DEPTH);
        float acc[NMOD]; for (int m = 0; m < NMOD; ++m) acc[m] = 0.f;
        const float* w = w_ada + ((size_t)l * D + (size_t)kc * (D / MODKC)) * 6 * D + j; const float* s0 = sc + kc * (D / MODKC);
        for (int k = 0; k < D / MODKC; ++k) { const float wv = w[(size_t)k * 6 * D];
            for (int m = 0; m < NMOD; ++m) acc[m] += s0[m * D + k] * wv; }
        for (int m = 0; m < NMOD; ++m) part[(((size_t)kc * DEPTH + l) * NMOD + m) * 6 * D + j] = acc[m]; } };
struct ModReduce { long n; const float* part; const float* b_ada; float* mod;
    HD void operator()(long i) const { const int j = (int)(i % (6 * D)); long y = i / (6 * D); const int m = (int)(y % NMOD), l = (int)(y / NMOD); float a = b_ada[(size_t)l * 6 * D + j];
        for (int kc = 0; kc < MODKC; ++kc) a += part[(((size_t)kc * DEPTH + l) * NMOD + m) * 6 * D + j];
        mod[i] = a; } };
struct ZeroBf16 { long n; bf16* p; HD void operator()(long i) const { p[i] = 0; } };
HD uint32_t pk2(float lo, float hi) { return (uint32_t)f2bf(lo) | ((uint32_t)f2bf(hi) << 16); }
struct GlaFused { long n; const bf16* p; const float* wa2; const float* ba; bf16* lab;
    struct Ld { U4 l0[4], l1[4]; bf16 q[4], k[4]; };
    HD void load4(Ld& L_, const bf16* pe, int pstep, int j) const { UNROLL for (int e = 0; e < 4; ++e) { const bf16* pt = pe + e * pstep; const U4* lr = (const U4*)(pt + GLR); L_.l0[e] = lr[0]; L_.l1[e] = lr[1]; L_.q[e] = pt[GQ + j]; L_.k[e] = pt[GK + j]; } }
    HD void operator()(long x) const { typedef LaLay<64, 96> L; const int xi = (int)x; const int j = xi % 192; int y = xi / 192; const int blk = y % NBLK; y /= NBLK; const int b = y % NB, d = y / NB;
        const int hh = j / 48, i = j % 48; const size_t item = (size_t)(b * NBLK + blk) * 4 + hh; float w[16]; UNROLL for (int q = 0; q < 16; ++q) w[q] = wa2[(d * 16 + q) * 192 + j];
        const float bj = ba[d * 192 + j]; float c = 0.f;
        const int s_first = d == 0 ? 0 : 63, dir = d == 0 ? 1 : -1; const int r_first = b * RPB + blk * 64 + s_first;
        const bf16* pr = p + (size_t)r_first * PS; const int pstep = dir * PS; Ld cur, nxt; load4(cur, pr, pstep, j); float ko[8];
        for (int g4 = 0; g4 < 16; ++g4) {
            if (g4 < 15) load4(nxt, pr + 4 * pstep, pstep, j);
            UNROLL for (int e = 0; e < 4; ++e) { const uint32_t u[8] = {cur.l0[e].x, cur.l0[e].y, cur.l0[e].z, cur.l0[e].w, cur.l1[e].x, cur.l1[e].y, cur.l1[e].z, cur.l1[e].w}; float z = bj;
                UNROLL for (int q = 0; q < 8; ++q) { z += bf2f((bf16)(u[q] & 0xffffu)) * w[2 * q]; z += bf2f((bf16)(u[q] >> 16)) * w[2 * q + 1]; }
                c += logsigmoidf_(z) * (1.0f / 16.0f); const float kk = bf2f(cur.k[e]) * fexp(-c); const int tok = s_first + dir * (g4 * 4 + e);
                lab[L::q_at(d, item, tok, i)] = f2bf(bf2f(cur.q[e]) * 0.14433756729740643f * fexp(c)); lab[L::k_at(d, item, tok, i)] = f2bf(kk); ko[(g4 & 1) * 4 + e] = kk;
                if (i < 16) { lab[L::q_at(d, item, tok, 48 + i)] = 0; lab[L::k_at(d, item, tok, 48 + i)] = 0; } }
            pr += 4 * pstep;
            if (g4 & 1) { U4 v; const int c8 = g4 >> 1; const int s0 = d == 0 ? c8 * 8 : 56 - c8 * 8;
                v.x = d == 0 ? pk2(ko[0], ko[1]) : pk2(ko[7], ko[6]); v.y = d == 0 ? pk2(ko[2], ko[3]) : pk2(ko[5], ko[4]); v.z = d == 0 ? pk2(ko[4], ko[5]) : pk2(ko[3], ko[2]); v.w = d == 0 ? pk2(ko[6], ko[7]) : pk2(ko[1], ko[0]);
                *(U4*)(lab + L::kt_at(d, item, i, s0)) = v; if (i < 16) { U4 zz; zz.x = zz.y = zz.z = zz.w = 0u; *(U4*)(lab + L::kt_at(d, item, 48 + i, s0)) = zz; } }
            cur = nxt; }
        float* dec = (float*)(lab + L::dec) + ((size_t)d * LA_NI + item) * 64; dec[i] = fexp(c); if (i < 16) dec[48 + i] = 0.f; } };
template <int NV, int VOFF> struct VTFused { long n; const bf16* p; bf16* vT;
    HD void operator()(long x) const { const int xi = (int)x; const int j = xi % NV; const int item = xi / NV; const int hh = item % 4; const int bb = item / 4; const int r0 = (bb / NBLK) * RPB + (bb % NBLK) * 64;
        const bf16* pc = p + (size_t)r0 * PS + VOFF + hh * 96 + (j < 96 ? j : 0); const uint32_t fill = j == 96 ? 0x3f803f80u : 0u; uint32_t t[32];
        UNROLL for (int q = 0; q < 32; ++q) t[q] = (uint32_t)pc[(2 * q) * PS] | ((uint32_t)pc[(2 * q + 1) * PS] << 16);
        UNROLL for (int c8 = 0; c8 < 8; ++c8) { U4 v; v.x = j < 96 ? t[4 * c8] : fill; v.y = j < 96 ? t[4 * c8 + 1] : fill; v.z = j < 96 ? t[4 * c8 + 2] : fill; v.w = j < 96 ? t[4 * c8 + 3] : fill;
            *(U4*)(vT + (size_t)item * NV * 64 + tile_off(j, 8 * c8, 2)) = v; } } };
struct MlFused { long n; const bf16* p; const float* cw; const float* cb; const float* gb; bf16* lab;
    struct Ld { bf16 q[4][3], k[4][3], gi[4], gf[4]; };
    HD void load4(Ld& L_, const bf16* pe, int pstep, int t0, int dir, int cq, int ck, int gi, int gf) const {
        UNROLL for (int e = 0; e < 4; ++e) { const int t = t0 + dir * e; const bool first = (t == 0 || t == CTX), last = (t == CTX - 1 || t == RPB - 1); const bf16* pt = pe + e * pstep;
            L_.q[e][1] = pt[cq]; L_.k[e][1] = pt[ck]; L_.q[e][0] = first ? (bf16)0 : pt[cq - PS]; L_.k[e][0] = first ? (bf16)0 : pt[ck - PS]; L_.q[e][2] = last ? (bf16)0 : pt[cq + PS]; L_.k[e][2] = last ? (bf16)0 : pt[ck + PS];
            L_.gi[e] = pt[gi]; L_.gf[e] = pt[gf]; } }
    HD void operator()(long x) const { typedef LaLay<96, 112> L; const int xi = (int)x; const int i = xi % 96; int y = xi / 96; const int hh = y % 4; y /= 4; const int blk = y % NBLK; y /= NBLK; const int b = y % NB, d = y / NB;
        const size_t item = (size_t)(b * NBLK + blk) * 4 + hh; const int cq = MQ + hh * 96 + i, ck = MQ + 384 + hh * 96 + i;
        const float q0 = cw[cq - MQ], q1 = cw[768 + cq - MQ], q2 = cw[1536 + cq - MQ], qb = cb[cq - MQ], k0 = cw[ck - MQ], k1 = cw[768 + ck - MQ], k2 = cw[1536 + ck - MQ], kb = cb[ck - MQ];
        const int gi = MG + (2 * d) * 4 + hh, gf = MG + (2 * d + 1) * 4 + hh; const float bi = gb[(2 * d) * 4 + hh], bf_ = gb[(2 * d + 1) * 4 + hh]; float Fc = 0.f;
        const int s_first = d == 0 ? 0 : 63, dir = d == 0 ? 1 : -1; const int t_first = blk * 64 + s_first; const int r_first = b * RPB + t_first;
        const bf16* pr = p + (size_t)r_first * PS; const int pstep = dir * PS; Ld cur, nxt; load4(cur, pr, pstep, t_first, dir, cq, ck, gi, gf); float ko[8];
        for (int g4 = 0; g4 < 16; ++g4) {
            if (g4 < 15) load4(nxt, pr + 4 * pstep, pstep, t_first + dir * (g4 * 4 + 4), dir, cq, ck, gi, gf);
            UNROLL for (int e = 0; e < 4; ++e) { const float yq = q0 * bf2f(cur.q[e][0]) + q1 * bf2f(cur.q[e][1]) + q2 * bf2f(cur.q[e][2]), yk = k0 * bf2f(cur.k[e][0]) + k1 * bf2f(cur.k[e][1]) + k2 * bf2f(cur.k[e][2]);
                const float qc = siluf(yq + qb), kc = siluf(yk + kb) * 0.10206207261596577f; Fc += logsigmoidf_(bf2f(cur.gf[e]) + bf_); const float kk = kc * fexp(bf2f(cur.gi[e]) + bi - Fc); const int tok = s_first + dir * (g4 * 4 + e);
                lab[L::q_at(d, item, tok, i)] = f2bf(qc * fexp(Fc)); lab[L::k_at(d, item, tok, i)] = f2bf(kk); ko[(g4 & 1) * 4 + e] = kk; }
            pr += 4 * pstep;
            if (g4 & 1) { U4 v; const int c8 = g4 >> 1; const int s0 = d == 0 ? c8 * 8 : 56 - c8 * 8;
                v.x = d == 0 ? pk2(ko[0], ko[1]) : pk2(ko[7], ko[6]); v.y = d == 0 ? pk2(ko[2], ko[3]) : pk2(ko[5], ko[4]); v.z = d == 0 ? pk2(ko[4], ko[5]) : pk2(ko[3], ko[2]); v.w = d == 0 ? pk2(ko[6], ko[7]) : pk2(ko[1], ko[0]);
                *(U4*)(lab + L::kt_at(d, item, i, s0)) = v; }
            cur = nxt; }
        ((float*)(lab + L::dec))[((size_t)d * LA_NI + item) * 96 + i] = fexp(Fc); } };
template <int DKP, int NV> struct StatesRef { long n; bf16* lab;
    HD void operator()(long x) const { typedef LaLay<DKP, NV> L; const int i = (int)(x % DKP); long y = x / DKP; const int j = (int)(y % NV); y /= NV; const size_t item = (size_t)(y % LA_NI); const int d = (int)(y / LA_NI); float acc = 0.f;
        for (int sx = 0; sx < 64; ++sx) acc += bf2f(lab[L::v_at(item, j, sx)]) * bf2f(lab[L::kt_at(d, item, i, sx)]);
        lab[L::s_at(d, item, j, i)] = f2bf(acc); } };
constexpr int CARRY_CH = (NBLK % 17 == 0) ? 17 : ((NBLK % 4 == 0) ? 4 : 1);
template <int DKP, int NV> struct CarryT { long n; bf16* lab;
    HD void operator()(long x) const { typedef LaLay<DKP, NV> L; const int xi = (int)x; const int i = xi % DKP; int y = xi / DKP; const int j = y % NV; y /= NV; const int hh = y % 4; y /= 4; const int b = y % NB, d = y / NB;
        const float* dec = (const float*)(lab + L::dec); float sv = 0.f;
        for (int step = 0; step < NBLK; ++step) { const size_t item = (size_t)(b * NBLK + chain_blk(d, step)) * 4 + hh; const size_t o = L::s_at(d, item, j, i);
            const float tv = bf2f(lab[o]), dv = dec[((size_t)d * LA_NI + item) * DKP + i]; lab[o] = f2bf(sv); sv = dv * (sv + tv); } } };
template <int DKP, int NV, bool ISML> struct OutRef { long n; const bf16* lab; float* obuf;
    HD void operator()(long x) const { typedef LaLay<DKP, NV> L; const int j = (int)(x % 96); long y = x / 96; const int hh = (int)(y % 4); const int r = (int)(y / 4); const int b = r / RPB, t = r % RPB, blk = t / 64, tt = t % 64;
        const size_t item = ((size_t)b * NBLK + blk) * 4 + hh; float hv = 0.f;
        for (int d = 0; d < 2; ++d) { float num = 0.f, den = 0.f;
            for (int sx = 0; sx < 64; ++sx) { const bool valid = d == 0 ? (sx <= tt) : (sx >= tt); if (!valid) continue;
                float a = 0.f; for (int i = 0; i < DKP; ++i) a += bf2f(lab[L::q_at(d, item, tt, i)]) * bf2f(lab[L::k_at(d, item, sx, i)]);
                a = bf2f(f2bf(a)); num += a * bf2f(lab[L::v_at(item, j, sx)]); if (ISML) den += a * bf2f(lab[L::v_at(item, 96, sx)]); }
            for (int i = 0; i < DKP; ++i) { const float qv = bf2f(lab[L::q_at(d, item, tt, i)]); num += qv * bf2f(lab[L::s_at(d, item, j, i)]); if (ISML) den += qv * bf2f(lab[L::s_at(d, item, 96, i)]); }
            hv += ISML ? num / fmaxf(fabsf(den), 1.0f) : num; }
        obuf[x] = hv; } };
struct HeadFin { long n; const bf16* p; const float* obuf; const float* gain; bf16* mix; int mode, pad;
    HD void operator()(long x) const { const int hh = (int)(x % 4), r = (int)(x / 4); const float* o = obuf + (size_t)r * 384 + hh * 96; float ss = 0.f;
        for (int j = 0; j < 96; ++j) ss += o[j] * o[j];
        const float rstd = 1.0f / sqrtf(ss / 96.0f + EPS);
        for (int j = 0; j < 96; ++j) { const float gv = bf2f(p[(size_t)r * PS + (mode ? MO : GG) + hh * 96 + j]); const float gt = mode ? sigmoidf_(gv) : siluf(gv);
            mix[(size_t)r * D + (mode ? 640 : 0) + hh * 96 + j] = f2bf(o[j] * rstd * gain[j] * gt); } } };

struct S5Disc { long n; const float* lre; const float* lim; const float* ldt; float* disc;
    HD void operator()(long x) const { const int nn = (int)(x % 64); const int dg = (int)(x / 64); const float dt = expf(ldt[dg]); const float lr = lre[x], li = lim[x];
        const float mag = expf(lr * dt), ar = mag * cosf(li * dt), ai = mag * sinf(li * dt), den = lr * lr + li * li, pr = ar - 1.0f, pi = ai;
        disc[x * 4 + 0] = lr * dt; disc[x * 4 + 1] = li * dt; disc[x * 4 + 2] = (pr * lr + pi * li) / den; disc[x * 4 + 3] = (pi * lr - pr * li) / den; (void)nn; } };
HD void s5_apow(const float* disc4, float tau, float& ar, float& ai) { const float mag = expf(disc4[0] * tau); ar = mag * cosf(disc4[1] * tau); ai = mag * sinf(disc4[1] * tau); }
struct ZeroInt { long n; int* p; HD void operator()(long i) const { p[i] = 0; } };
struct MoePrefix { long n; int* segcnt; int* ecnt; int nseg, pad;
    HD void operator()(long e) const { int c = 0; for (int sg = 0; sg < nseg; ++sg) { const int v = segcnt[(size_t)e * nseg + sg]; segcnt[(size_t)e * nseg + sg] = c; c += v; } ecnt[e] = c; } };
struct MoeTiles2 { long n; const int* ecnt; int* tile_e; int* ntile;
    HD void operator()(long t) const { int acc = 0, ef = 0; for (int e = 0; e < NE; ++e) { const int nt = (ecnt[e] + 255) / 256; if (t >= acc && t < acc + nt) ef = e; acc += nt; } tile_e[t] = ef; if (t == 0) ntile[0] = acc; } };
struct MoeFillNeg { long n; int* row_token; HD void operator()(long i) const { row_token[i] = -1; } };
struct MoeAssign { long n; const int* rt_e; const int* segcnt; const int* ecnt; int* rt_dest; int* row_token; int nseg, pad;
    HD void operator()(long x) const { const int seg = (int)(x % nseg), e = (int)(x / nseg); int pstart = 0; for (int q = 0; q < e; ++q) pstart += (ecnt[q] + 255) / 256 * 256;
        int pos = pstart + segcnt[(size_t)e * nseg + seg];
        for (int r = seg * 64; r < seg * 64 + 64 && r < NR; ++r) for (int k = 0; k < 2; ++k) if (rt_e[2 * r + k] == e) { rt_dest[2 * r + k] = pos; row_token[pos] = r; ++pos; } } };
struct MoeGather8 { long n; const unsigned char* f8; const int* row_token; unsigned char* xs; int row0, pad;
    HD void operator()(long i) const { const int lr = (int)(i / (D / 16)), c = (int)(i % (D / 16)) * 16; const int tok = row_token[row0 + lr];
        U4 v; v.x = v.y = v.z = v.w = 0u; if (tok >= 0) v = *(const U4*)(f8 + (size_t)tok * D + c); *(U4*)(xs + (size_t)lr * D + c) = v; } };
struct MoeCombine { long n; float* h; const bf16* yrow; const int* rt_e; const float* rt_w; const int* rt_dest; const float* mod; int g_off, pad;
    HD void operator()(long i) const { const int r = (int)(i / (D / 8)), c = (int)(i % (D / 8)) * 8; if (rt_e[2 * r] < 0) return;
        const U4 y0 = *(const U4*)(yrow + (size_t)rt_dest[2 * r] * D + c), y1 = *(const U4*)(yrow + (size_t)rt_dest[2 * r + 1] * D + c); const float w0 = rt_w[2 * r], w1 = rt_w[2 * r + 1];
        const float* g = mod + (size_t)mod_index(r) * 6 * D + g_off + c; float* hp = h + (size_t)r * D + c; const F4 g0 = *(const F4*)g, g1 = *(const F4*)(g + 4); F4 h0 = *(const F4*)hp, h1 = *(const F4*)(hp + 4);
        const uint32_t a[4] = {y0.x, y0.y, y0.z, y0.w}, bq[4] = {y1.x, y1.y, y1.z, y1.w}; float yv[8];
        UNROLL for (int q = 0; q < 4; ++q) { yv[2 * q] = w0 * bf2f((bf16)(a[q] & 0xffffu)) + w1 * bf2f((bf16)(bq[q] & 0xffffu)); yv[2 * q + 1] = w0 * bf2f((bf16)(a[q] >> 16)) + w1 * bf2f((bf16)(bq[q] >> 16)); }
        h0.x += g0.x * yv[0]; h0.y += g0.y * yv[1]; h0.z += g0.z * yv[2]; h0.w += g0.w * yv[3]; h1.x += g1.x * yv[4]; h1.y += g1.y * yv[5]; h1.z += g1.z * yv[6]; h1.w += g1.w * yv[7];
        *(F4*)hp = h0; *(F4*)(hp + 4) = h1; } };
struct FinalNorm { long n; const float* h; const float* g; float* out;
    HD void operator()(long x) const { const int b = (int)(x / SEQ), tl = (int)(x % SEQ); const float* hr = h + ((size_t)b * RPB + CTX + tl) * D; float ss = 0.f;
        for (int k = 0; k < D; ++k) ss += hr[k] * hr[k];
        const float rstd = 1.0f / sqrtf(ss / D + EPS); for (int k = 0; k < D; ++k) out[(size_t)x * D + k] = hr[k] * rstd * g[k]; } };

struct EpiStoreBf16 { bf16* out; int ld; int row_off;
    HD void apply8(int row, int col0, const float* v) const { bf16* o = out + (size_t)(row - row_off) * ld + col0;
#ifndef HOST_EMU
        store8_bf16(o, v);
#else
        for (int i = 0; i < 8; ++i) o[i] = f2bf(v[i]);
#endif
    } };
struct EpiSwiGLU { bf16* out; int ld; int row_off;
    HD void apply8(int row, int col0, const float* v) const { bf16* o = out + (size_t)(row - row_off) * ld + col0 / 2;
#ifndef HOST_EMU
        uint2 w; w.x = cvt_pk_bf16(fast_silu(v[0]) * v[1], fast_silu(v[2]) * v[3]); w.y = cvt_pk_bf16(fast_silu(v[4]) * v[5], fast_silu(v[6]) * v[7]); *(uint2*)o = w;
#else
        for (int i = 0; i < 4; ++i) o[i] = f2bf(siluf(v[2 * i]) * v[2 * i + 1]);
#endif
    } };
#ifndef HOST_EMU
struct EpiSwiGLU8 { unsigned char* out; int ld; int row_off;
    __device__ __forceinline__ void apply8(int row, int col0, const float* v) const { unsigned char* o = out + (size_t)(row - row_off) * ld + col0 / 2; const float sc = (float)(1 << A8S);
        float a0 = fast_silu(v[0]) * v[1] * sc, a1 = fast_silu(v[2]) * v[3] * sc, a2 = fast_silu(v[4]) * v[5] * sc, a3 = fast_silu(v[6]) * v[7] * sc;
        a0 = __builtin_amdgcn_fmed3f(a0, -440.f, 440.f); a1 = __builtin_amdgcn_fmed3f(a1, -440.f, 440.f); a2 = __builtin_amdgcn_fmed3f(a2, -440.f, 440.f); a3 = __builtin_amdgcn_fmed3f(a3, -440.f, 440.f);
        int w = 0; w = __builtin_amdgcn_cvt_pk_fp8_f32(a0, a1, w, false); w = __builtin_amdgcn_cvt_pk_fp8_f32(a2, a3, w, true); *(unsigned*)o = (unsigned)w; } };
#endif
struct EpiResid { float* h; const float* mod; int g_off, pad;
    HD void apply8(int row, int col0, const float* v) const { float* o = h + (size_t)row * D + col0; const float* g = mod + (size_t)mod_index(row) * 6 * D + g_off + col0;
#ifndef HOST_EMU
        const f4_t g0 = *(const f4_t*)g, g1 = *(const f4_t*)(g + 4); f4_t h0 = *(const f4_t*)o, h1 = *(const f4_t*)(o + 4);
        h0 += g0 * (f4_t){v[0], v[1], v[2], v[3]}; h1 += g1 * (f4_t){v[4], v[5], v[6], v[7]}; *(f4_t*)o = h0; *(f4_t*)(o + 4) = h1;
#else
        for (int i = 0; i < 8; ++i) o[i] += g[i] * v[i];
#endif
    } };

struct GemmDesc { const bf16* A; const bf16* Bt; const int* tile_e; const int* ntile; const int* arow; size_t e_stride; int M, N, K, tile0, lda, ldb, tdiv, pad; };
HD GemmDesc mk_gemm(const bf16* A, int lda, const bf16* Bt, int ldb, int M, int N, int K) { return GemmDesc{A, Bt, nullptr, nullptr, nullptr, 0, M, N, K, 0, lda, ldb, 0, 0}; }

constexpr int S5RB = NB * NBLK;
constexpr int S5RG = (S5RB + 255) / 256 * 256;
constexpr int S5K_ = 1280;
HD void s5_bbar(const float* d4, float br, float bi, float& bbr, float& bbi) { bbr = d4[2] * br - d4[3] * bi; bbi = d4[2] * bi + d4[3] * br; }
struct S5Apow { long n; const float* lre; const float* lim; const float* ldt; float* apow;
    HD void operator()(long x) const { const int nn = (int)(x % 64); long y = x / 64; const int tau = (int)(y % 65); const int dg = (int)(y / 65); const float dt = expf(ldt[dg]);
        const float lr = lre[(size_t)dg * 64 + nn] * dt, li = lim[(size_t)dg * 64 + nn] * dt; const float mag = expf(lr * (float)tau); apow[x * 2] = mag * cosf(li * (float)tau); apow[x * 2 + 1] = mag * sinf(li * (float)tau); } };
struct S5Bbar { long n; const float* disc; const float* bre; const float* bim; float* bbar;
    HD void operator()(long x) const { const int pp = (int)(x % 16); long y = x / 16; const int nn = (int)(y % 64); y /= 64; const int g = (int)(y % 16), d = (int)(y / 16); (void)d;
        const float* d4 = disc + (y * 64 + nn) * 4; float br, bi; s5_bbar(d4, bre[((size_t)g * 64 + nn) * 16 + pp], bim[((size_t)g * 64 + nn) * 16 + pp], br, bi); bbar[x * 2] = br; bbar[x * 2 + 1] = bi; } };
struct S5K2 { long n; const float* apow; const float* bbar; const float* cre; const float* cim; float* Kt;
    HD void operator()(long x) const { const int p2 = (int)(x % 16); long y = x / 16; const int p1 = (int)(y % 16); y /= 16; const int tau = (int)(y % 64); y /= 64; const int g = (int)(y % 16), d = (int)(y / 16); float acc = 0.f;
        const float* ap = apow + (((size_t)d * 16 + g) * 65 + tau) * 64 * 2; const float* bb = bbar + (((size_t)d * 16 + g) * 64) * 16 * 2;
        for (int nn = 0; nn < 64; ++nn) { const float ar = ap[nn * 2], ai = ap[nn * 2 + 1], bbr = bb[(nn * 16 + p2) * 2], bbi = bb[(nn * 16 + p2) * 2 + 1];
            acc += cre[((size_t)g * 16 + p1) * 64 + nn] * (ar * bbr - ai * bbi) - cim[((size_t)g * 16 + p1) * 64 + nn] * (ar * bbi + ai * bbr); }
        Kt[x] = acc; } };
struct S5BuildTB { long n; const float* apow; const float* cre; const float* cim; const float* Kt; bf16* TB;
    HD void operator()(long x) const { const int k0 = (int)(x % (S5K_ / 8)) * 8; long y = x / (S5K_ / 8); const int tp = (int)(y % 1024), g = (int)(y / 1024); const int t = tp >> 4, p1 = tp & 15; float v[8];
        if (k0 < 1024) { const int sx = k0 >> 4, p2 = k0 & 15; const float* kf = Kt + ((((size_t)0 * 16 + g) * 64 + (sx <= t ? t - sx : 0)) * 16 + p1) * 16 + p2; const float* kb = Kt + ((((size_t)1 * 16 + g) * 64 + (sx >= t ? sx - t : 0)) * 16 + p1) * 16 + p2;
            UNROLL for (int q = 0; q < 8; ++q) v[q] = (sx <= t ? kf[q] : 0.f) + (sx >= t ? kb[q] : 0.f);
        } else { const int kk = k0 - 1024, d = kk >> 7, n0 = (kk & 127) >> 1; const int pt = d == 0 ? t : 63 - t; const float* ap = apow + ((((size_t)d * 16 + g) * 65 + pt + 1) * 64 + n0) * 2;
            UNROLL for (int q = 0; q < 4; ++q) { const float ar = ap[2 * q], ai = ap[2 * q + 1], cr = cre[((size_t)g * 16 + p1) * 64 + n0 + q], ci = cim[((size_t)g * 16 + p1) * 64 + n0 + q]; v[2 * q] = cr * ar - ci * ai; v[2 * q + 1] = -(cr * ai + ci * ar); } }
        U4 o; o.x = pk2(v[0], v[1]); o.y = pk2(v[2], v[3]); o.z = pk2(v[4], v[5]); o.w = pk2(v[6], v[7]); *(U4*)(TB + x * 8) = o; } };
struct S5BuildEB { long n; const float* apow; const float* bbar; bf16* EB;
    HD void operator()(long x) const { const int k0 = (int)(x % 128) * 8; long y = x / 128; const int col = (int)(y % 256), g = (int)(y / 256); const int d = col >> 7, nn = (col & 127) >> 1, ri = col & 1, sx = k0 >> 4, p2 = k0 & 15;
        const float* ap = apow + ((((size_t)d * 16 + g) * 65 + (d == 0 ? 63 - sx : sx)) * 64 + nn) * 2; const float* bb = bbar + ((((size_t)d * 16 + g) * 64 + nn) * 16 + p2) * 2; const float ar = ap[0], ai = ap[1]; float v[8];
        UNROLL for (int q = 0; q < 8; ++q) { const float bbr = bb[2 * q], bbi = bb[2 * q + 1]; v[q] = ri == 0 ? (ar * bbr - ai * bbi) : (ar * bbi + ai * bbr); }
        U4 o; o.x = pk2(v[0], v[1]); o.y = pk2(v[2], v[3]); o.z = pk2(v[4], v[5]); o.w = pk2(v[6], v[7]); *(U4*)(EB + x * 8) = o; } };
struct S5BuildU { long n; const bf16* p; bf16* uG;
    HD void operator()(long x) const { const int k0 = (int)(x % 128) * 8; long y = x / 128; const int rb = (int)(y % S5RB), g = (int)(y / S5RB); const int b = rb / NBLK, blk = rb % NBLK;
        *(U4*)(uG + ((size_t)g * S5RG + rb) * S5K_ + k0) = *(const U4*)(p + ((size_t)b * RPB + blk * 64 + (k0 >> 4)) * PS + SU + g * 16 + (k0 & 15)); } };
struct S5Carry2 { long n; const float* apow; const float* est; bf16* uG;
    HD void operator()(long x) const { const int nn = (int)(x % 64); long y = x / 64; const int d = (int)(y % 2); y /= 2; const int g = (int)(y % 16), b = (int)(y / 16);
        const float* ap = apow + ((((size_t)d * 16 + g) * 65 + 64) * 64 + nn) * 2; const float ar = ap[0], ai = ap[1]; float sr = 0.f, si = 0.f;
        for (int s0 = 0; s0 < NBLK; s0 += CARRY_CH) { float tr[CARRY_CH], ti[CARRY_CH];
            UNROLL for (int e = 0; e < CARRY_CH; ++e) { const size_t row = (size_t)g * S5RG + (size_t)b * NBLK + chain_blk(d, s0 + e); tr[e] = est[row * 256 + d * 128 + 2 * nn]; ti[e] = est[row * 256 + d * 128 + 2 * nn + 1]; }
            UNROLL for (int e = 0; e < CARRY_CH; ++e) { const size_t row = (size_t)g * S5RG + (size_t)b * NBLK + chain_blk(d, s0 + e);
                uG[row * S5K_ + 1024 + d * 128 + 2 * nn] = f2bf(sr); uG[row * S5K_ + 1024 + d * 128 + 2 * nn + 1] = f2bf(si);
                const float nr = ar * sr - ai * si + tr[e], ni = ar * si + ai * sr + ti[e]; sr = nr; si = ni; } } } };
struct EpiStoreF32 { float* out; int ld; int pad;
    HD void apply8(int row, int col0, const float* v) const { float* o = out + (size_t)row * ld + col0;
#ifndef HOST_EMU
        *(f4_t*)o = (f4_t){v[0], v[1], v[2], v[3]}; *(f4_t*)(o + 4) = (f4_t){v[4], v[5], v[6], v[7]};
#else
        for (int i = 0; i < 8; ++i) o[i] = v[i];
#endif
    } };
struct EpiS5Z { const bf16* p; const float* dskip; bf16* zbuf;
    HD void apply8(int row, int col0, const float* v) const { const int g = row / S5RG, rb = row % S5RG; if (rb >= S5RB) return; const int b = rb / NBLK, blk = rb % NBLK, t = col0 >> 4, p0 = col0 & 15;
        const size_t r = (size_t)b * RPB + blk * 64 + t; const int c = g * 16 + p0;
#ifndef HOST_EMU
        float u[8], z[8]; load8_bf16(p + r * PS + SU + c, u); const f4_t d0 = *(const f4_t*)(dskip + c), d1 = *(const f4_t*)(dskip + c + 4); const float dd[8] = {d0.x, d0.y, d0.z, d0.w, d1.x, d1.y, d1.z, d1.w};
#pragma unroll
        for (int i = 0; i < 8; ++i) { const float x = v[i] + dd[i] * u[i]; const float y = 0.7978845608028654f * (x + 0.044715f * x * x * x); const float th = 1.0f - 2.0f * __builtin_amdgcn_rcpf(1.0f + __expf(2.0f * y)); z[i] = 0.5f * x * (1.0f + th); }
        store8_bf16(zbuf + r * 256 + c, z);
#else
        for (int i = 0; i < 8; ++i) zbuf[r * 256 + c + i] = f2bf(gelu_tanhf(v[i] + dskip[c + i] * bf2f(p[r * PS + SU + c + i])));
#endif
    } };
struct EpiGlu { const bf16* zbuf; const float* gb; bf16* mix;
    HD void apply8(int row, int col0, const float* v) const {
#ifndef HOST_EMU
        float z[8], o[8]; load8_bf16(zbuf + (size_t)row * 256 + col0, z); const f4_t b0 = *(const f4_t*)(gb + col0), b1 = *(const f4_t*)(gb + col0 + 4); const float bb[8] = {b0.x, b0.y, b0.z, b0.w, b1.x, b1.y, b1.z, b1.w};
#pragma unroll
        for (int i = 0; i < 8; ++i) o[i] = z[i] * fast_sigmoid(v[i] + bb[i]);
        store8_bf16(mix + (size_t)row * D + 384 + col0, o);
#else
        for (int i = 0; i < 8; ++i) mix[(size_t)row * D + 384 + col0 + i] = f2bf(bf2f(zbuf[(size_t)row * 256 + col0 + i]) * sigmoidf_(v[i] + gb[col0 + i]));
#endif
    } };

#ifndef HOST_EMU
namespace pg8 {
#define PG8_LAS __attribute__((address_space(3)))
typedef short bf16x8 __attribute__((ext_vector_type(8)));
typedef float f32x4 __attribute__((ext_vector_type(4)));
typedef int v4i_t __attribute__((ext_vector_type(4)));
typedef int v8i_t __attribute__((ext_vector_type(8)));
constexpr int BM = 256, BK = 64, HALF = 128, HTB = HALF * BK * 2, STAGE_BYTES = 8 * HTB, NXCD = 8, WGM = 8;
__device__ __forceinline__ int lds_byte(int r, int c) { const int st = (r >> 4) * 2 + (c >> 5), rr = r & 15, cc = c & 31, ob = rr * 64 + cc * 2; return st * 1024 + (ob ^ (((ob >> 9) & 1) << 5)); }
__device__ __forceinline__ void stage_rc(int b, int& R, int& C) { const int st = b / 1024, sb = b % 1024, swz = sb ^ (((sb >> 9) & 1) << 5); R = (st >> 1) * 16 + swz / 64; C = (st & 1) * 32 + (swz % 64) / 2; }
__device__ __forceinline__ int perm32(int rho) { const int n = rho >> 4, i = rho & 15; return 8 * (i >> 2) + 4 * n + (i & 3); }
struct Unit { int pm, pn; };
struct StaticOrder {
    int nM, nN, nwg, G, c;
    __device__ void init(int M, int N, int G_, int c_) { nM = M / BM; nN = N / BM; nwg = nM * nN; G = G_; c = c_; }
    __device__ bool next(int i, Unit& u) const {
        const long L = (long)i * G + c; if (L >= nwg) return false;
        int wgid = (int)L; { const int q = nwg / NXCD, r = nwg % NXCD, xcd = wgid % NXCD, off = wgid / NXCD; wgid = (xcd < r ? xcd * (q + 1) : r * (q + 1) + (xcd - r) * q) + off; }
        const int nig = WGM * nN, gid = wgid / nig, fm = gid * WGM, gsz = (nM - fm) < WGM ? (nM - fm) : WGM;
        u.pm = fm + ((wgid % nig) % gsz); u.pn = (wgid % nig) / gsz; return true;
    }
};
template <class F> __device__ __forceinline__ void epi_apply(const F& f, const f32x4 (&acc)[2][2][4][2], const Unit& u, int wr, int wc, int fr, int fq) {
    const int row0 = u.pm * BM + wr * 64 + fr, col0 = u.pn * BM + wc * 32 + 8 * fq;
#pragma unroll
    for (int ai = 0; ai < 2; ++ai)
#pragma unroll
        for (int m = 0; m < 4; ++m)
#pragma unroll
            for (int bj = 0; bj < 2; ++bj) { const f32x4 v0 = acc[ai][bj][m][0], v1 = acc[ai][bj][m][1];
                const float v[8] = {v0[0], v0[1], v0[2], v0[3], v1[0], v1[1], v1[2], v1[3]};
                f.apply8(row0 + ai * HALF + m * 16, col0 + bj * HALF, v); }
}
#ifndef PG8_SP2
#define PG8_SP2 true
#endif
#ifndef PG8_ALIGN
#define PG8_ALIGN true
#endif
template <class F, bool FP8 = false, bool GATHER = false, bool SP2 = PG8_SP2, bool ALIGN_EPI = PG8_ALIGN>
__device__ __forceinline__ void gemm_phase(PG8_LAS unsigned char* lds, const GemmDesc g, const F& E, int G_, int c_) {
    int tid_ = threadIdx.x; asm volatile("" : "+v"(tid_));
    const int tid = tid_, wid = __builtin_amdgcn_readfirstlane(tid >> 6), lane = tid & 63, wr = wid >> 2, wc = wid & 3, fr = lane & 15, fq = lane >> 4;
    const int K = g.K, nt = FP8 ? K / 128 : K / BK; constexpr unsigned EB = FP8 ? 1u : 2u;
    int M = g.M; if (g.ntile) { int ntl = g.ntile[0] - g.tile0; ntl = ntl < 0 ? 0 : ntl; if (ntl * BM < M) M = ntl * BM; }
    StaticOrder S; S.init(M, g.N, G_, c_);
    unsigned voffB[1]; int RA[2]; unsigned CA[2];
#pragma unroll
    for (int i = 0; i < 2; ++i) { int R, C; stage_rc(tid * 16 + i * 8192, R, C); const int Rb = (R & ~31) + perm32(R & 31);
        RA[i] = R; CA[i] = (unsigned)C * 2u; if (i == 0) voffB[0] = (unsigned)Rb * (unsigned)g.ldb * EB + (unsigned)C * 2u; }
    const size_t pieceB = (size_t)64 * g.ldb * EB;
    const unsigned lda2 = (unsigned)g.lda * EB;
    const size_t kstep = (size_t)(BK * 2);
    const size_t hstepA = (size_t)HALF * g.lda * EB, hstepB = (size_t)HALF * g.ldb * EB;
    const size_t tstepA = 2 * hstepA, tstepB = 2 * hstepB;
    const unsigned ldsw = (unsigned)wid * 1024u; int sc8v = (127 + g.pad / 2) * 0x01010101;
    if constexpr (FP8) asm volatile("" : "+v"(sc8v));
    const int aoff = lds_byte(wr * 64 + fr, fq * 8), boff = lds_byte(wc * 32 + fr, fq * 8);
#define PG8_SA(b, h) (((b) * 2 + (h)) * HTB)
#define PG8_SB(b, h) ((4 + (b) * 2 + (h)) * HTB)
#define PG8_STAGE(bufoff, gbase, voff) do { _Pragma("unroll") for (int _i = 0; _i < 2; ++_i) \
        __builtin_amdgcn_global_load_lds((const unsigned*)((const char*)(gbase) + (voff)[_i]), (PG8_LAS unsigned*)(lds + (bufoff) + ldsw + _i * 8192), 16, 0, 0); } while (0)
#define PG8_STAGEB(bufoff, gbase) do { _Pragma("unroll") for (int _i = 0; _i < 2; ++_i) \
        __builtin_amdgcn_global_load_lds((const unsigned*)((const char*)(gbase) + _i * pieceB + voffB[0]), (PG8_LAS unsigned*)(lds + (bufoff) + ldsw + _i * 8192), 16, 0, 0); } while (0)
#define PG8_RD(off) (*(const PG8_LAS bf16x8*)(lds + (off)))
#define PG8_LDA(dst, b, h) do { if constexpr (FP8) { _Pragma("unroll") for (int m = 0; m < 4; ++m) { dst##8[m].lo = __builtin_bit_cast(v4i_t, PG8_RD(PG8_SA(b, h) + aoff + m * 2048)); dst##8[m].hi = __builtin_bit_cast(v4i_t, PG8_RD(PG8_SA(b, h) + aoff + m * 2048 + 1024)); } } else { \
        _Pragma("unroll") for (int m = 0; m < 4; ++m) _Pragma("unroll") for (int k = 0; k < 2; ++k) dst[m][k] = PG8_RD(PG8_SA(b, h) + aoff + m * 2048 + k * 1024); } } while (0)
#define PG8_LDB(dst, b, h) do { if constexpr (FP8) { _Pragma("unroll") for (int n = 0; n < 2; ++n) { dst##8[n].lo = __builtin_bit_cast(v4i_t, PG8_RD(PG8_SB(b, h) + boff + n * 2048)); dst##8[n].hi = __builtin_bit_cast(v4i_t, PG8_RD(PG8_SB(b, h) + boff + n * 2048 + 1024)); } } else { \
        _Pragma("unroll") for (int n = 0; n < 2; ++n) _Pragma("unroll") for (int k = 0; k < 2; ++k) dst[n][k] = PG8_RD(PG8_SB(b, h) + boff + n * 2048 + k * 1024); } } while (0)
#define PG8_CAT(x0, x1) __builtin_shufflevector(__builtin_bit_cast(v4i_t, x0), __builtin_bit_cast(v4i_t, x1), 0, 1, 2, 3, 4, 5, 6, 7)
#define PG8_MMA(ai, bj, At, Bt) do { __builtin_amdgcn_s_setprio(1); if constexpr (FP8) { _Pragma("unroll") for (int m = 0; m < 4; ++m) _Pragma("unroll") for (int n = 0; n < 2; ++n) \
        asm volatile("v_mfma_scale_f32_16x16x128_f8f6f4 %0, %1, %2, %0, %3, %4 op_sel_hi:[0,0,0]" : "+v"(acc[ai][bj][m][n]) : "v"(Bt##8[n]), "v"(At##8[m]), "v"(sc8v), "v"(sc8v)); } else { \
        _Pragma("unroll") for (int m = 0; m < 4; ++m) _Pragma("unroll") for (int n = 0; n < 2; ++n) _Pragma("unroll") for (int k = 0; k < 2; ++k) \
        acc[ai][bj][m][n] = __builtin_amdgcn_mfma_f32_16x16x32_bf16(Bt[n][k], At[m][k], acc[ai][bj][m][n], 0, 0, 0); } __builtin_amdgcn_s_setprio(0); } while (0)
#define PG8_WAIT_V(n) asm volatile("s_waitcnt vmcnt(" #n ")" ::: "memory")
#define PG8_WAIT_L(n) asm volatile("s_waitcnt lgkmcnt(" #n ")" ::: "memory")
#define PG8_BAR __builtin_amdgcn_s_barrier()
#define PG8_SCHED __builtin_amdgcn_sched_barrier(0)
#define PG8_MKVO(u, vo, base) do { if constexpr (GATHER) { base = (const char*)g.A; int _t = tid; asm volatile("" : "+v"(_t));     \
            _Pragma("unroll") for (int _i = 0; _i < 2; ++_i) { int _R, _C; stage_rc(_t * 16 + _i * 8192, _R, _C); _Pragma("unroll") for (int _h = 0; _h < 2; ++_h) { \
            int _row = g.arow[(size_t)(g.tile0 + (u).pm) * BM + _h * HALF + _R]; _row = _row < 0 ? 0 : _row; vo[_h][_i] = (unsigned)_row * lda2 + (unsigned)_C * 2u; } } } \
        else { base = (const char*)g.A + (size_t)(u).pm * tstepA; _Pragma("unroll") for (int _h = 0; _h < 2; ++_h) _Pragma("unroll") for (int _i = 0; _i < 2; ++_i) vo[_h][_i] = (unsigned)(_h * HALF + RA[_i]) * lda2 + CA[_i]; } } while (0)
#define PG8_BBASE(u) ((const char*)g.Bt + (g.tile_e ? (size_t)g.tile_e[g.tile0 + (u).pm] * g.e_stride * 2 : (g.tdiv ? (size_t)((u).pm / g.tdiv) * g.e_stride * 2 : (size_t)0)) + (size_t)(u).pn * tstepB)
    Unit cur, nxt; int ui = 0;
    if (!S.next(0, cur)) return;
    f32x4 acc[2][2][4][2];
#pragma unroll
    for (int a = 0; a < 2; ++a)
#pragma unroll
        for (int b = 0; b < 2; ++b)
#pragma unroll
            for (int m = 0; m < 4; ++m)
#pragma unroll
                for (int n = 0; n < 2; ++n) acc[a][b][m][n] = (f32x4){0.f, 0.f, 0.f, 0.f};
    bf16x8 At[4][2], B0[2][2], B1[2][2]; v8i_t At8[4], B08[2], B18[2];
    const char* cA; unsigned voC[2][2], voN[2][2]; PG8_MKVO(cur, voC, cA); const char* cB = PG8_BBASE(cur);
    if constexpr (SP2) {
        PG8_STAGEB(PG8_SB(0, 0), cB); PG8_STAGEB(PG8_SB(0, 1), cB + hstepB); PG8_STAGE(PG8_SA(0, 0), cA, voC[0]); PG8_STAGE(PG8_SA(0, 1), cA, voC[1]);
        if (wr == 1) PG8_BAR;
        PG8_WAIT_V(2); PG8_BAR;
        PG8_STAGEB(PG8_SB(1, 0), cB + kstep); PG8_STAGE(PG8_SA(1, 0), cA + kstep, voC[0]); PG8_STAGEB(PG8_SB(1, 1), cB + hstepB + kstep);
        PG8_WAIT_V(6); PG8_BAR;
    } else {
    PG8_STAGEB(PG8_SB(0, 0), cB); PG8_STAGE(PG8_SA(0, 0), cA, voC[0]); PG8_STAGEB(PG8_SB(0, 1), cB + hstepB); PG8_STAGE(PG8_SA(0, 1), cA, voC[1]);
    if (wr == 1) PG8_BAR;
    PG8_WAIT_V(4); PG8_BAR;
    PG8_STAGEB(PG8_SB(1, 0), cB + kstep); PG8_STAGE(PG8_SA(1, 0), cA + kstep, voC[0]); PG8_STAGEB(PG8_SB(1, 1), cB + hstepB + kstep);
    PG8_WAIT_V(6); PG8_BAR;
    }
    for (;;) {
        const bool has_next = S.next(ui + 1, nxt);
        const char* nA = cA; if constexpr (!GATHER) { if (has_next) nA = (const char*)g.A + (size_t)nxt.pm * tstepA; } else if (has_next) PG8_MKVO(nxt, voN, nA); else { _Pragma("unroll") for (int _h = 0; _h < 2; ++_h) _Pragma("unroll") for (int _i = 0; _i < 2; ++_i) voN[_h][_i] = voC[_h][_i]; }
        const char* nB = has_next ? PG8_BBASE(nxt) : cB;
        for (int t = 0; t < nt; t += 2) {
            const bool last = (t == nt - 2);
            const char* a1 = cA + (size_t)(t + 1) * kstep;
            const char* a2 = last ? nA : cA + (size_t)(t + 2) * kstep; const char* b2 = last ? nB : cB + (size_t)(t + 2) * kstep;
            const char* a3 = a2 + kstep; const char* b3 = b2 + kstep;
            if constexpr (SP2) {
            PG8_LDB(B0, 0, 0); PG8_LDB(B1, 0, 1); PG8_SCHED; PG8_LDA(At, 0, 0); PG8_STAGE(PG8_SA(1, 1), a1, voC[1]);
            if constexpr (GATHER) if (last) { _Pragma("unroll") for (int _h = 0; _h < 2; ++_h) _Pragma("unroll") for (int _i = 0; _i < 2; ++_i) voC[_h][_i] = voN[_h][_i]; }
            PG8_WAIT_V(8); PG8_WAIT_L(0); PG8_BAR; PG8_MMA(0, 0, At, B0); PG8_MMA(0, 1, At, B1); PG8_BAR; PG8_SCHED;
            PG8_LDA(At, 0, 1); PG8_STAGEB(PG8_SB(0, 0), b2); PG8_STAGEB(PG8_SB(0, 1), b2 + hstepB); PG8_STAGE(PG8_SA(0, 0), a2, voC[0]);
            PG8_WAIT_V(8); PG8_WAIT_L(0); PG8_BAR; PG8_MMA(1, 0, At, B0); PG8_MMA(1, 1, At, B1); PG8_BAR; PG8_SCHED;
            PG8_LDB(B0, 1, 0); PG8_LDB(B1, 1, 1); PG8_SCHED; PG8_LDA(At, 1, 0); PG8_STAGE(PG8_SA(0, 1), a2, voC[1]);
            PG8_WAIT_V(8); PG8_WAIT_L(0); PG8_BAR; PG8_MMA(0, 0, At, B0); PG8_MMA(0, 1, At, B1); PG8_BAR; PG8_SCHED;
            PG8_LDA(At, 1, 1); PG8_STAGEB(PG8_SB(1, 0), b3); PG8_STAGEB(PG8_SB(1, 1), b3 + hstepB); PG8_STAGE(PG8_SA(1, 0), a3, voC[0]);
            PG8_WAIT_V(8); PG8_WAIT_L(0); PG8_BAR; PG8_MMA(1, 0, At, B0); PG8_MMA(1, 1, At, B1); PG8_BAR; PG8_SCHED;
            } else {
            PG8_LDB(B0, 0, 0); PG8_SCHED; PG8_LDA(At, 0, 0); PG8_STAGE(PG8_SA(1, 1), a1, voC[1]);
            if constexpr (GATHER) if (last) { _Pragma("unroll") for (int _h = 0; _h < 2; ++_h) _Pragma("unroll") for (int _i = 0; _i < 2; ++_i) voC[_h][_i] = voN[_h][_i]; }
            PG8_WAIT_L(8); PG8_BAR; PG8_WAIT_L(0); PG8_MMA(0, 0, At, B0); PG8_BAR; PG8_SCHED;
            PG8_LDB(B1, 0, 1); PG8_STAGEB(PG8_SB(0, 0), b2);
            PG8_BAR; PG8_WAIT_L(0); PG8_MMA(0, 1, At, B1); PG8_BAR;
            PG8_LDA(At, 0, 1); PG8_STAGE(PG8_SA(0, 0), a2, voC[0]);
            PG8_BAR; PG8_WAIT_L(0); PG8_MMA(1, 0, At, B0); PG8_BAR; PG8_SCHED;
            PG8_STAGEB(PG8_SB(0, 1), b2 + hstepB);
            PG8_WAIT_V(6); PG8_BAR; PG8_MMA(1, 1, At, B1); PG8_BAR;
            PG8_LDB(B0, 1, 0); PG8_SCHED; PG8_LDA(At, 1, 0); PG8_STAGE(PG8_SA(0, 1), a2, voC[1]);
            PG8_WAIT_L(8); PG8_BAR; PG8_WAIT_L(0); PG8_MMA(0, 0, At, B0); PG8_BAR; PG8_SCHED;
            PG8_LDB(B1, 1, 1); PG8_STAGEB(PG8_SB(1, 0), b3);
            PG8_BAR; PG8_WAIT_L(0); PG8_MMA(0, 1, At, B1); PG8_BAR;
            PG8_LDA(At, 1, 1); PG8_STAGE(PG8_SA(1, 0), a3, voC[0]);
            PG8_BAR; PG8_WAIT_L(0); PG8_MMA(1, 0, At, B0); PG8_BAR; PG8_SCHED;
            PG8_STAGEB(PG8_SB(1, 1), b3 + hstepB);
            PG8_WAIT_V(6); PG8_BAR; PG8_MMA(1, 1, At, B1); PG8_BAR;
            }
        }
        if constexpr (ALIGN_EPI) { if (wr == 0) PG8_BAR; }
        if constexpr (FP8) asm volatile("s_nop 15\n\ts_nop 15" ::: "memory");
        epi_apply(E, acc, cur, wr, wc, fr, fq);
        if (!has_next) break;
#pragma unroll
        for (int a = 0; a < 2; ++a)
#pragma unroll
            for (int b = 0; b < 2; ++b)
#pragma unroll
                for (int m = 0; m < 4; ++m)
#pragma unroll
                    for (int n = 0; n < 2; ++n) acc[a][b][m][n] = (f32x4){0.f, 0.f, 0.f, 0.f};
        cur = nxt; cA = nA; cB = nB; ++ui;
        if constexpr (ALIGN_EPI) { if (wr == 1) PG8_BAR; }
    }
    PG8_WAIT_V(0);
    if constexpr (!ALIGN_EPI) { if (wr == 0) PG8_BAR; }
    PG8_BAR;
#undef PG8_SA
#undef PG8_SB
#undef PG8_STAGE
#undef PG8_STAGEB
#undef PG8_LDA
#undef PG8_LDB
#undef PG8_MMA
#undef PG8_CAT
#undef PG8_RD
#undef PG8_WAIT_V
#undef PG8_WAIT_L
#undef PG8_BAR
#undef PG8_SCHED
#undef PG8_BBASE
#undef PG8_MKVO
}
}

#define XB_TMO      128
#define XB_XCNT(j)  (256  + 64 * (j))
#define XB_XSUB(j)  (1280 + 64 * (j))
#define XB_XGEN(j)  (2304 + 64 * (j))
#define XB_TOP      3328
#define XB_TOPGEN   3392
#define XCD_BAR_WORDS 3456
#define XB_SPIN_CAP (1u << 20)
#define LAS __attribute__((address_space(3)))
__device__ __forceinline__ unsigned xb_ld(unsigned* p)              { return __hip_atomic_load(p, __ATOMIC_RELAXED, __HIP_MEMORY_SCOPE_AGENT); }
__device__ __forceinline__ unsigned xb_add(unsigned* p, unsigned v) { return __hip_atomic_fetch_add(p, v, __ATOMIC_RELAXED, __HIP_MEMORY_SCOPE_AGENT); }
__device__ __forceinline__ unsigned xb_xcc_id() { return (unsigned)__builtin_amdgcn_s_getreg((3 << 11) | 20) & 0xFu; }
#define XB_SPIN(cond, bar) do { unsigned _sp = 0; while (cond) { __builtin_amdgcn_s_sleep(1); \
    if ((++_sp & 255u) == 0u) { if (xb_ld(&(bar)[XB_TMO])) break; if (_sp > XB_SPIN_CAP) { atomicAdd(&(bar)[XB_TMO], 1u); break; } } } } while (0)
struct XcdBarrier { unsigned* bar; unsigned x; volatile LAS unsigned* st; };
__device__ __forceinline__ XcdBarrier xcd_barrier_post(unsigned* bar, volatile LAS unsigned* st) {
    XcdBarrier b; b.bar = bar; b.x = xb_xcc_id(); b.st = st;
    if (threadIdx.x == 0) (void)xb_add(&bar[XB_XCNT(b.x)], 1u);
    return b;
}
__device__ __forceinline__ void xcd_barrier_complete(unsigned* bar, unsigned x, unsigned& nloc, unsigned& nx) {
    const unsigned G = gridDim.x * gridDim.y * gridDim.z;
    unsigned sum, cnt, mine, sp = 0u;
    for (;;) {
        sum = 0u; cnt = 0u; mine = 0u;
#pragma unroll
        for (unsigned j = 0; j < 16; ++j) { const unsigned c = xb_ld(&bar[XB_XCNT(j)]); sum += c; cnt += (c > 0u) ? 1u : 0u; mine = (j == x) ? c : mine; }
        if (sum == G) break;
        __builtin_amdgcn_s_sleep(1);
        if ((++sp & 255u) == 0u) { if (xb_ld(&bar[XB_TMO])) break; if (sp > XB_SPIN_CAP) { atomicAdd(&bar[XB_TMO], 1u); break; } }
    }
    nloc = mine > 0u ? mine : 1u; nx = cnt > 0u ? cnt : 1u;
}
__device__ __forceinline__ void xcd_barrier(const XcdBarrier& b) {
    asm volatile("s_waitcnt vmcnt(0)" ::: "memory");
    __syncthreads();
    if (threadIdx.x == 0) {
        unsigned* bar = b.bar; asm volatile("" : "+s"(bar));
        __builtin_amdgcn_s_waitcnt(0);
        unsigned nloc = b.st[0], nx = b.st[1];
        if (nloc == 0u) { xcd_barrier_complete(bar, b.x, nloc, nx); b.st[0] = nloc; b.st[1] = nx; }
        const unsigned old = xb_add(&bar[XB_XSUB(b.x)], 1u);
        const unsigned gen = old / nloc;
        if (old + 1u == (gen + 1u) * nloc) {
            __builtin_amdgcn_fence(__ATOMIC_RELEASE, "agent");
            asm volatile("s_waitcnt vmcnt(0)" ::: "memory");
            const unsigned og = xb_add(&bar[XB_TOP], 1u);
            const unsigned tg = og / nx;
            if (og + 1u == (tg + 1u) * nx) xb_add(&bar[XB_TOPGEN], 1u);
            else XB_SPIN(xb_ld(&bar[XB_TOPGEN]) == tg, bar);
            __builtin_amdgcn_fence(__ATOMIC_ACQUIRE, "agent");
            xb_add(&bar[XB_XGEN(b.x)], 1u);
            asm volatile("s_waitcnt vmcnt(0)" ::: "memory");
        } else {
            XB_SPIN(xb_ld(&bar[XB_XGEN(b.x)]) == gen, bar);
            __builtin_amdgcn_fence(__ATOMIC_ACQUIRE, "agent");
            asm volatile("s_waitcnt vmcnt(0)" ::: "memory");
        }
    }
    __syncthreads();
}

__device__ __forceinline__ float wave_sum(float v) {
#pragma unroll
    for (int o = 1; o < 64; o <<= 1) v += __shfl_xor(v, o);
    return v;
}
typedef float f32x4v __attribute__((ext_vector_type(4)));
__device__ __forceinline__ unsigned pk2bf(float lo, float hi) { return (unsigned)f2bf(lo) | ((unsigned)f2bf(hi) << 16); }
#define LDS_WAIT() asm volatile("s_waitcnt lgkmcnt(0)" ::: "memory")
struct NormModW { int n; int sh_off; int sc_off; int skip_ctx; const float* h; const float* g; const float* mod; bf16* out; const float* wr; int* rt_e; float* rt_w; int* segcnt; int nseg, f8;
    __device__ __forceinline__ void wave(int it, int lane, PG8_LAS unsigned char*) const {
        f32x4v v[2][4]; float ss[2] = {0.f, 0.f};
#pragma unroll
        for (int q = 0; q < 2; ++q) { const f32x4v* hr = (const f32x4v*)(h + (size_t)(2 * it + q) * D) + lane;
#pragma unroll
            for (int j = 0; j < 4; ++j) v[q][j] = hr[64 * j]; }
#pragma unroll
        for (int q = 0; q < 2; ++q) {
#pragma unroll
            for (int j = 0; j < 4; ++j) ss[q] += (v[q][j].x * v[q][j].x + v[q][j].y * v[q][j].y) + (v[q][j].z * v[q][j].z + v[q][j].w * v[q][j].w); }
#pragma unroll
        for (int q = 0; q < 2; ++q) { const int r = 2 * it + q;
        const float rstd = 1.0f / sqrtf(wave_sum(ss[q]) * (1.0f / D) + EPS); const float* m = mod + (size_t)mod_index(r) * 6 * D;
        float lg[NE];
#pragma unroll
        for (int e = 0; e < NE; ++e) lg[e] = 0.f;
#pragma unroll
        for (int j = 0; j < 4; ++j) { const int k0 = 4 * (lane + 64 * j); const f32x4v g4 = *(const f32x4v*)(g + k0), sc4 = *(const f32x4v*)(m + sc_off + k0), sh4 = *(const f32x4v*)(m + sh_off + k0);
            const f32x4v o = v[q][j] * rstd * g4 * (sc4 + 1.0f) + sh4;
            if (f8) { int w8 = 0; w8 = __builtin_amdgcn_cvt_pk_fp8_f32(o.x, o.y, w8, false); w8 = __builtin_amdgcn_cvt_pk_fp8_f32(o.z, o.w, w8, true); *(int*)((unsigned char*)out + (size_t)r * D + k0) = w8; }
            else *(uint2*)(out + (size_t)r * D + k0) = make_uint2(cvt_pk_bf16(o.x, o.y), cvt_pk_bf16(o.z, o.w));
            if (wr) {
#pragma unroll
                for (int i = 0; i < 4; ++i) { const f32x4v w0 = *(const f32x4v*)(wr + (size_t)(k0 + i) * NE), w1 = *(const f32x4v*)(wr + (size_t)(k0 + i) * NE + 4); const float ov = o[i];
                    lg[0] += ov * w0.x; lg[1] += ov * w0.y; lg[2] += ov * w0.z; lg[3] += ov * w0.w; lg[4] += ov * w1.x; lg[5] += ov * w1.y; lg[6] += ov * w1.z; lg[7] += ov * w1.w; } } }
        if (wr) {
#pragma unroll
            for (int e = 0; e < NE; ++e) lg[e] = wave_sum(lg[e]);
            int e0 = 0; float b0 = lg[0];
#pragma unroll
            for (int e = 1; e < NE; ++e) if (lg[e] > b0) { b0 = lg[e]; e0 = e; }
            int e1 = -1; float b1 = -3.0e38f;
#pragma unroll
            for (int e = 0; e < NE; ++e) if (e != e0 && lg[e] > b1) { b1 = lg[e]; e1 = e; }
            const float w1 = 1.0f / (1.0f + expf(b1 - b0)); const bool skip = skip_ctx && ((r % RPB) < CTX);
            if (lane == 0) { rt_e[2 * r] = skip ? -1 : e0; rt_e[2 * r + 1] = skip ? -1 : e1; rt_w[2 * r] = w1; rt_w[2 * r + 1] = 1.0f - w1;
                if (!skip) { atomicAdd(&segcnt[(size_t)e0 * nseg + r / 64], 1); atomicAdd(&segcnt[(size_t)e1 * nseg + r / 64], 1); } } }
        }
    } };
struct MoePrefixW { int n; int nseg; int* segcnt; int* ecnt;
    __device__ __forceinline__ void wave(int e, int lane, PG8_LAS unsigned char*) const { constexpr int PER = ((NR + 63) / 64 + 63) / 64; int v[PER]; int tot = 0;
#pragma unroll
        for (int k = 0; k < PER; ++k) { const int sg = lane * PER + k; v[k] = sg < nseg ? segcnt[(size_t)e * nseg + sg] : 0; tot += v[k]; }
        int incl = tot;
#pragma unroll
        for (int o = 1; o < 64; o <<= 1) { const int t = __shfl_up(incl, o); if (lane >= o) incl += t; }
        int run = incl - tot;
#pragma unroll
        for (int k = 0; k < PER; ++k) { const int sg = lane * PER + k; if (sg < nseg) segcnt[(size_t)e * nseg + sg] = run; run += v[k]; }
        if (lane == 63) ecnt[e] = incl; } };
struct CombineNormW { int n; int mode; int g_off; int pad; float* h; const bf16* yrow; const int* rt_e; const float* rt_w; const int* rt_dest; const float* modc; const float* gn; const float* modn; bf16* outb; float* outf;
    __device__ __forceinline__ void wave(int r, int lane, PG8_LAS unsigned char*) const {
        const int t = r % RPB; if (mode == 1 && t < CTX) return;
        f32x4v* hr = (f32x4v*)(h + (size_t)r * D) + lane; f32x4v v[4];
#pragma unroll
        for (int j = 0; j < 4; ++j) v[j] = hr[64 * j];
        const int e0 = rt_e[2 * r];
        if (e0 >= 0) { const size_t d0 = (size_t)rt_dest[2 * r], d1 = (size_t)rt_dest[2 * r + 1]; const float w0 = rt_w[2 * r], w1 = rt_w[2 * r + 1]; const float* gt = modc + (size_t)mod_index(r) * 6 * D + g_off;
            uint2 y0[4], y1[4]; f32x4v g4[4];
#pragma unroll
            for (int j = 0; j < 4; ++j) { const int k0 = 4 * (lane + 64 * j); y0[j] = *(const uint2*)(yrow + d0 * D + k0); y1[j] = *(const uint2*)(yrow + d1 * D + k0); g4[j] = *(const f32x4v*)(gt + k0); }
#pragma unroll
            for (int j = 0; j < 4; ++j) { f32x4v y;
                y.x = w0 * __uint_as_float(y0[j].x << 16) + w1 * __uint_as_float(y1[j].x << 16); y.y = w0 * __uint_as_float(y0[j].x & 0xffff0000u) + w1 * __uint_as_float(y1[j].x & 0xffff0000u);
                y.z = w0 * __uint_as_float(y0[j].y << 16) + w1 * __uint_as_float(y1[j].y << 16); y.w = w0 * __uint_as_float(y0[j].y & 0xffff0000u) + w1 * __uint_as_float(y1[j].y & 0xffff0000u);
                v[j] += g4[j] * y; }
            if (mode == 0) {
#pragma unroll
                for (int j = 0; j < 4; ++j) hr[64 * j] = v[j]; } }
        float ss = 0.f;
#pragma unroll
        for (int j = 0; j < 4; ++j) ss += (v[j].x * v[j].x + v[j].y * v[j].y) + (v[j].z * v[j].z + v[j].w * v[j].w);
        const float rstd = 1.0f / sqrtf(wave_sum(ss) * (1.0f / D) + EPS);
        if (mode == 0) { const float* m = modn + (size_t)mod_index(r) * 6 * D;
#pragma unroll
            for (int j = 0; j < 4; ++j) { const int k0 = 4 * (lane + 64 * j); const f32x4v g4 = *(const f32x4v*)(gn + k0), sc4 = *(const f32x4v*)(m + D + k0), sh4 = *(const f32x4v*)(m + k0);
                const f32x4v o = v[j] * rstd * g4 * (sc4 + 1.0f) + sh4; *(uint2*)(outb + (size_t)r * D + k0) = make_uint2(cvt_pk_bf16(o.x, o.y), cvt_pk_bf16(o.z, o.w)); }
        } else { const int b = r / RPB, tl = t - CTX;
#pragma unroll
            for (int j = 0; j < 4; ++j) { const int k0 = 4 * (lane + 64 * j); *(f32x4v*)(outf + ((size_t)b * SEQ + tl) * D + k0) = v[j] * rstd * *(const f32x4v*)(gn + k0); } } } };
struct FinalNormW { int n; int pad; const float* h; const float* g; float* out;
    __device__ __forceinline__ void wave(int x, int lane, PG8_LAS unsigned char*) const { const int b = x / SEQ, tl = x % SEQ;
        const f32x4v* hr = (const f32x4v*)(h + ((size_t)b * RPB + CTX + tl) * D) + lane; f32x4v v[4]; float ss = 0.f;
#pragma unroll
        for (int j = 0; j < 4; ++j) { v[j] = hr[64 * j]; ss += (v[j].x * v[j].x + v[j].y * v[j].y) + (v[j].z * v[j].z + v[j].w * v[j].w); }
        const float rstd = 1.0f / sqrtf(wave_sum(ss) * (1.0f / D) + EPS);
#pragma unroll
        for (int j = 0; j < 4; ++j) { const int k0 = 4 * (lane + 64 * j); *(f32x4v*)(out + (size_t)x * D + k0) = v[j] * rstd * *(const f32x4v*)(g + k0); } } };
struct TransW { int n; int K, N, rs, ro, f8; const float* src; bf16* dst; size_t sstride, dstride;
    __device__ __forceinline__ void loadt(f32x4v (&v)[8], int tile, int lane) const { const int nblk = N / 32, ipm = (K / 64) * nblk; const int mat = tile / ipm, r = tile % ipm, kb = r / nblk, nb = r % nblk;
        const float* W = src + (size_t)mat * sstride + (size_t)(64 * kb + (lane >> 3)) * N + 32 * nb + 4 * (lane & 7);
#pragma unroll
        for (int i = 0; i < 8; ++i) v[i] = *(const f32x4v*)(W + (size_t)(8 * i) * N); }
    __device__ __forceinline__ void emit(const f32x4v (&v)[8], int tile, int lane, PG8_LAS float* scr) const { const int nblk = N / 32, ipm = (K / 64) * nblk; const int mat = tile / ipm, r = tile % ipm, kb = r / nblk, nb = r % nblk, k0 = 64 * kb, n0 = 32 * nb;
        const int kr = lane >> 3, nq = lane & 7;
#pragma unroll
        for (int i = 0; i < 8; ++i) { PG8_LAS float* sp = scr + (8 * i + kr) * 33 + 4 * nq; sp[0] = v[i].x; sp[1] = v[i].y; sp[2] = v[i].z; sp[3] = v[i].w; }
        LDS_WAIT();
        const int c = lane & 7;
        if (f8) { unsigned char* WT8 = (unsigned char*)dst + (size_t)mat * dstride; const float sc = __builtin_amdgcn_ldexpf(1.0f, f8);
#pragma unroll
            for (int j = 0; j < 4; ++j) { const int nn = (lane >> 3) + 8 * j; const PG8_LAS float* sp = scr + (8 * c) * 33 + nn; int w0 = 0, w1 = 0;
                w0 = __builtin_amdgcn_cvt_pk_fp8_f32(sp[0 * 33] * sc, sp[1 * 33] * sc, w0, false); w0 = __builtin_amdgcn_cvt_pk_fp8_f32(sp[2 * 33] * sc, sp[3 * 33] * sc, w0, true);
                w1 = __builtin_amdgcn_cvt_pk_fp8_f32(sp[4 * 33] * sc, sp[5 * 33] * sc, w1, false); w1 = __builtin_amdgcn_cvt_pk_fp8_f32(sp[6 * 33] * sc, sp[7 * 33] * sc, w1, true);
                *(uint2*)(WT8 + ((size_t)(n0 + nn) * rs + ro) * K + k0 + 8 * c) = make_uint2((unsigned)w0, (unsigned)w1); }
        } else { bf16* WT = dst + (size_t)mat * dstride;
#pragma unroll
            for (int j = 0; j < 4; ++j) { const int nn = (lane >> 3) + 8 * j; const PG8_LAS float* sp = scr + (8 * c) * 33 + nn;
                uint4 o; o.x = cvt_pk_bf16(sp[0 * 33], sp[1 * 33]); o.y = cvt_pk_bf16(sp[2 * 33], sp[3 * 33]); o.z = cvt_pk_bf16(sp[4 * 33], sp[5 * 33]); o.w = cvt_pk_bf16(sp[6 * 33], sp[7 * 33]);
                *(uint4*)(WT + ((size_t)(n0 + nn) * rs + ro) * K + k0 + 8 * c) = o; } }
        LDS_WAIT(); }
    __device__ __forceinline__ void wave(int item, int lane, PG8_LAS unsigned char* lw) const {
        PG8_LAS float* scr = (PG8_LAS float*)lw;
        const int t0 = 2 * item, t1 = 2 * item + 1; const bool two = t1 < tiles; f32x4v va[8], vb[8];
        loadt(va, t0, lane); if (two) loadt(vb, t1, lane);
        emit(va, t0, lane, scr); if (two) emit(vb, t1, lane, scr);
    } int tiles, pad2; };

template <int MT, int NT, int KS, class PA, class PB>
__device__ __forceinline__ void wave_mma(PA A, int lda, PB Bt, int ldb, pg8::f32x4 (&acc)[MT][NT], int lane) {
    const int r = lane & 15, q = lane >> 4;
#pragma unroll
    for (int ks = 0; ks < KS; ++ks) { pg8::bf16x8 a[MT], b[NT];
#pragma unroll
        for (int m = 0; m < MT; ++m) a[m] = *(const pg8::bf16x8*)(A + (size_t)(m * 16 + r) * lda + ks * 32 + q * 8);
#pragma unroll
        for (int n = 0; n < NT; ++n) b[n] = *(const pg8::bf16x8*)(Bt + (size_t)(n * 16 + r) * ldb + ks * 32 + q * 8);
#pragma unroll
        for (int m = 0; m < MT; ++m)
#pragma unroll
            for (int n = 0; n < NT; ++n) acc[m][n] = __builtin_amdgcn_mfma_f32_16x16x32_bf16(a[m], b[n], acc[m][n], 0, 0, 0); }
}
__device__ __forceinline__ float chunk_cumsum(float x, int d, int lane, float& tot) { float pre = x;
#pragma unroll
    for (int o = 1; o < 64; o <<= 1) { const float t = __shfl_up(pre, o); if (lane >= o) pre += t; }
    tot = __shfl(pre, 63); return d == 0 ? pre : tot - pre + x; }
struct MlPrepW2 { int n; int pad; const bf16* p; const float* cw; const float* cb; const float* gb; bf16* lab;
    __device__ __forceinline__ void wave(int it, int lane, PG8_LAS unsigned char* lw) const { typedef LaLay<96, 112> L;
        const int hh = it & 3; int y = it >> 2; const int blk = y % NBLK; y /= NBLK; const int b = y % NB, d = y / NB; const size_t item = ((size_t)b * NBLK + blk) * 4 + hh;
        const int tb = blk * 64; const size_t rb = (size_t)b * RPB + tb; const bool first_blk = (tb == 0 || tb == CTX), last_blk = (tb + 63 == CTX - 1 || tb + 63 == RPB - 1);
        PG8_LAS bf16* X = (PG8_LAS bf16*)lw; PG8_LAS float* SQ = (PG8_LAS float*)(lw + 14336); PG8_LAS float* SK = SQ + 64;
        { const bf16* pr = p + (rb + lane) * PS; const float gI = bf2f(pr[MG + (2 * d) * 4 + hh]) + gb[(2 * d) * 4 + hh], gF = bf2f(pr[MG + (2 * d + 1) * 4 + hh]) + gb[(2 * d + 1) * 4 + hh];
          float tot; const float Fc = chunk_cumsum(logsigmoidf_(gF), d, lane, tot); SQ[lane] = fexp(Fc); SK[lane] = fexp(gI - Fc) * 0.10206207261596577f;
          float* dec = (float*)(lab + L::dec) + ((size_t)d * LA_NI + item) * 96; const float dv = fexp(tot); dec[lane] = dv; if (lane < 32) dec[64 + lane] = dv; }
#pragma unroll 1
        for (int mat = 0; mat < 2; ++mat) { const int col0 = MQ + mat * 384 + hh * 96;
            pg8::v4i_t v[13];
#pragma unroll
            for (int k = 0; k < 13; ++k) { const int pi = lane + 64 * k, rw = pi / 12, c = pi % 12; const bool zero = (pi >= 792) || (rw == 0 && first_blk) || (rw == 65 && last_blk);
                v[k] = (pg8::v4i_t){0, 0, 0, 0}; if (!zero) v[k] = *(const pg8::v4i_t*)(p + (rb + rw - 1) * PS + col0 + c * 8); }
#pragma unroll
            for (int k = 0; k < 13; ++k) { const int pi = lane + 64 * k, rw = pi / 12, c = pi % 12; if (pi < 792) *(PG8_LAS pg8::v4i_t*)(X + rw * 104 + c * 8) = v[k]; }
            LDS_WAIT();
            unsigned o0[32], o1[32];
            const PG8_LAS float* SC = mat ? SK : SQ;
#pragma unroll
            for (int ps = 0; ps < 2; ++ps) { const int i = lane + 64 * ps; const bool act = i < 96; const int ci = mat * 384 + hh * 96 + (act ? i : 0);
                const float w0 = cw[ci], w1 = cw[768 + ci], w2 = cw[1536 + ci], bs = cb[ci]; const PG8_LAS bf16* xc = X + (act ? i : 0);
                float xa = bf2f(xc[0]), xb = bf2f(xc[104]);
#pragma unroll
                for (int s2 = 0; s2 < 32; ++s2) { const float x2 = bf2f(xc[(2 * s2 + 2) * 104]), x3 = bf2f(xc[(2 * s2 + 3) * 104]);
                    const float va = siluf(w0 * xa + w1 * xb + w2 * x2 + bs) * SC[2 * s2], vb = siluf(w0 * xb + w1 * x2 + w2 * x3 + bs) * SC[2 * s2 + 1];
                    const unsigned pk = cvt_pk_bf16(va, vb); if (ps == 0) o0[s2] = pk; else o1[s2] = pk; xa = x2; xb = x3; } }
            LDS_WAIT();
#pragma unroll
            for (int s2 = 0; s2 < 32; ++s2) { const int c0 = lane, t0 = 2 * s2;
                X[((t0 >> 4) * 3 + (c0 >> 5)) * 512 + ((((c0 & 31) >> 3) << 4) + (t0 & 15)) * 8 + (c0 & 7)] = (bf16)(o0[s2] & 0xffffu); X[((t0 >> 4) * 3 + (c0 >> 5)) * 512 + ((((c0 & 31) >> 3) << 4) + ((t0 + 1) & 15)) * 8 + (c0 & 7)] = (bf16)(o0[s2] >> 16);
                if (lane < 32) { const int c1 = 64 + lane; X[((t0 >> 4) * 3 + (c1 >> 5)) * 512 + ((((c1 & 31) >> 3) << 4) + (t0 & 15)) * 8 + (c1 & 7)] = (bf16)(o1[s2] & 0xffffu); X[((t0 >> 4) * 3 + (c1 >> 5)) * 512 + ((((c1 & 31) >> 3) << 4) + ((t0 + 1) & 15)) * 8 + (c1 & 7)] = (bf16)(o1[s2] >> 16); } }
            LDS_WAIT();
            { bf16* dst = lab + (mat ? L::kin : L::qin) + ((size_t)d * LA_NI + item) * 64 * 96;
#pragma unroll
              for (int k = 0; k < 12; ++k) { const int pi = lane + 64 * k; const pg8::v4i_t w = *(const PG8_LAS pg8::v4i_t*)(X + pi * 8); *(pg8::v4i_t*)(dst + (size_t)pi * 8) = w; } }
            LDS_WAIT();
            if (mat == 1) {
#pragma unroll
                for (int s2 = 0; s2 < 32; ++s2) { const int c0 = lane, t0 = 2 * s2;
                    *(PG8_LAS unsigned*)(X + ((c0 >> 4) * 2 + (t0 >> 5)) * 512 + ((((t0 & 31) >> 3) << 4) + (c0 & 15)) * 8 + (t0 & 7)) = o0[s2];
                    if (lane < 32) { const int c1 = 64 + lane; *(PG8_LAS unsigned*)(X + ((c1 >> 4) * 2 + (t0 >> 5)) * 512 + ((((t0 & 31) >> 3) << 4) + (c1 & 15)) * 8 + (t0 & 7)) = o1[s2]; } }
                LDS_WAIT();
                bf16* dst = lab + L::koutT + ((size_t)d * LA_NI + item) * 96 * 64;
#pragma unroll
                for (int k = 0; k < 12; ++k) { const int pi = lane + 64 * k; const pg8::v4i_t w = *(const PG8_LAS pg8::v4i_t*)(X + pi * 8); *(pg8::v4i_t*)(dst + (size_t)pi * 8) = w; }
                LDS_WAIT(); } } } };

struct GlaPrepW2 { int n; int pad; const bf16* p; const float* wa2; const float* ba; bf16* lab;
    __device__ __forceinline__ void wave(int it, int lane, PG8_LAS unsigned char* lw) const { typedef LaLay<64, 96> L;
        const int hh = it & 3; int y = it >> 2; const int blk = y % NBLK; y /= NBLK; const int b = y % NB, d = y / NB; const size_t item = ((size_t)b * NBLK + blk) * 4 + hh; const size_t rb = (size_t)b * RPB + blk * 64;
        PG8_LAS bf16* LR = (PG8_LAS bf16*)lw; PG8_LAS bf16* Q = LR + 64 * 16; PG8_LAS bf16* K = Q + 64 * 48; PG8_LAS bf16* X = (PG8_LAS bf16*)lw;
        pg8::v4i_t v[14];
#pragma unroll
        for (int k = 0; k < 2; ++k) { const int pi = lane + 64 * k; v[k] = *(const pg8::v4i_t*)(p + (rb + (pi >> 1)) * PS + GLR + (pi & 1) * 8); }
#pragma unroll
        for (int k = 0; k < 6; ++k) { const int pi = lane + 64 * k, rw = pi / 6, c = pi % 6; v[2 + k] = *(const pg8::v4i_t*)(p + (rb + rw) * PS + GQ + hh * 48 + c * 8); v[8 + k] = *(const pg8::v4i_t*)(p + (rb + rw) * PS + GK + hh * 48 + c * 8); }
#pragma unroll
        for (int k = 0; k < 2; ++k) { const int pi = lane + 64 * k; *(PG8_LAS pg8::v4i_t*)(LR + pi * 8) = v[k]; }
#pragma unroll
        for (int k = 0; k < 6; ++k) { const int pi = lane + 64 * k; *(PG8_LAS pg8::v4i_t*)(Q + pi * 8) = v[2 + k]; *(PG8_LAS pg8::v4i_t*)(K + pi * 8) = v[8 + k]; }
        LDS_WAIT();
        const bool act = lane < 48; const int i = act ? lane : 0; const int j = hh * 48 + i; float w[16];
#pragma unroll
        for (int q = 0; q < 16; ++q) w[q] = wa2[((size_t)d * 16 + q) * 192 + j];
        const float bj = ba[d * 192 + j]; float c = 0.f; unsigned oq[32], ok[32];
#pragma unroll
        for (int p2 = 0; p2 < 32; ++p2) { float qv[2], kv[2];
#pragma unroll
            for (int h2 = 0; h2 < 2; ++h2) { const int pp = 2 * p2 + h2; const int tok = d == 0 ? pp : 63 - pp; const pg8::v4i_t l0 = *(const PG8_LAS pg8::v4i_t*)(LR + tok * 16), l1 = *(const PG8_LAS pg8::v4i_t*)(LR + tok * 16 + 8);
                const unsigned u[8] = {(unsigned)l0.x, (unsigned)l0.y, (unsigned)l0.z, (unsigned)l0.w, (unsigned)l1.x, (unsigned)l1.y, (unsigned)l1.z, (unsigned)l1.w}; float z = bj;
#pragma unroll
                for (int q = 0; q < 8; ++q) { z += __uint_as_float(u[q] << 16) * w[2 * q]; z += __uint_as_float(u[q] & 0xffff0000u) * w[2 * q + 1]; }
                c += logsigmoidf_(z) * (1.0f / 16.0f); qv[h2] = bf2f(Q[tok * 48 + i]) * 0.14433756729740643f * fexp(c); kv[h2] = bf2f(K[tok * 48 + i]) * fexp(-c); }
            oq[p2] = act ? cvt_pk_bf16(qv[0], qv[1]) : 0u; ok[p2] = act ? cvt_pk_bf16(kv[0], kv[1]) : 0u; }
        { float* dec = (float*)(lab + L::dec) + ((size_t)d * LA_NI + item) * 64; dec[lane] = act ? fexp(c) : 0.f; }
        LDS_WAIT();
#pragma unroll 1
        for (int im = 0; im < 2; ++im) {
#pragma unroll
            for (int p2 = 0; p2 < 32; ++p2) { const unsigned o = im ? ok[p2] : oq[p2]; const int ta = d == 0 ? 2 * p2 : 63 - 2 * p2, tb2 = d == 0 ? 2 * p2 + 1 : 62 - 2 * p2; const int cb = (lane >> 5) * 512 + (((lane & 31) >> 3) << 4) * 8 + (lane & 7);
                X[(ta >> 4) * 1024 + cb + (ta & 15) * 8] = (bf16)(o & 0xffffu); X[(tb2 >> 4) * 1024 + cb + (tb2 & 15) * 8] = (bf16)(o >> 16); }
            LDS_WAIT();
            bf16* dst = lab + (im ? L::kin : L::qin) + ((size_t)d * LA_NI + item) * 64 * 64;
#pragma unroll
            for (int k = 0; k < 8; ++k) { const int pi = lane + 64 * k; const pg8::v4i_t wv = *(const PG8_LAS pg8::v4i_t*)(X + pi * 8); *(pg8::v4i_t*)(dst + (size_t)pi * 8) = wv; }
            LDS_WAIT(); }
#pragma unroll
        for (int p2 = 0; p2 < 32; ++p2) { const unsigned o = ok[p2]; const int tl = d == 0 ? 2 * p2 : 62 - 2 * p2; const unsigned ov = d == 0 ? o : ((o >> 16) | (o << 16));
            *(PG8_LAS unsigned*)(X + ((lane >> 4) * 2 + (tl >> 5)) * 512 + ((((tl & 31) >> 3) << 4) + (lane & 15)) * 8 + (tl & 7)) = ov; }
        LDS_WAIT();
        { bf16* dst = lab + L::koutT + ((size_t)d * LA_NI + item) * 64 * 64;
#pragma unroll
          for (int k = 0; k < 8; ++k) { const int pi = lane + 64 * k; const pg8::v4i_t wv = *(const PG8_LAS pg8::v4i_t*)(X + pi * 8); *(pg8::v4i_t*)(dst + (size_t)pi * 8) = wv; } }
        LDS_WAIT(); } };

template <int NV, int VOFF> struct VTW { int n; int pad; const bf16* p; bf16* vT;
    __device__ __forceinline__ void wave(int it, int lane, PG8_LAS unsigned char* lw) const { const int hh = it & 3; const int bb = it >> 2; const size_t r0 = (size_t)(bb / NBLK) * RPB + (bb % NBLK) * 64;
        PG8_LAS bf16* t = (PG8_LAS bf16*)lw; pg8::v4i_t v[12];
#pragma unroll
        for (int k = 0; k < 12; ++k) { const int pi = lane + 64 * k, rw = pi / 12, c = pi % 12; v[k] = *(const pg8::v4i_t*)(p + (r0 + rw) * PS + VOFF + hh * 96 + c * 8); }
#pragma unroll
        for (int k = 0; k < 12; ++k) { const int pi = lane + 64 * k, rw = pi / 12, c = pi % 12; *(PG8_LAS pg8::v4i_t*)(t + rw * 104 + c * 8) = v[k]; }
        LDS_WAIT();
        bf16* o = vT + (size_t)it * NV * 64 + (size_t)lane * 8; const int jr = lane & 15, sq = (lane >> 4) * 8;
#pragma unroll
        for (int jt = 0; jt < 6; ++jt)
#pragma unroll
            for (int ks = 0; ks < 2; ++ks) { const PG8_LAS bf16* c0 = t + (ks * 32 + sq) * 104 + jt * 16 + jr; pg8::v4i_t w;
                w.x = (int)((unsigned)c0[0] | ((unsigned)c0[104] << 16)); w.y = (int)((unsigned)c0[208] | ((unsigned)c0[312] << 16)); w.z = (int)((unsigned)c0[416] | ((unsigned)c0[520] << 16)); w.w = (int)((unsigned)c0[624] | ((unsigned)c0[728] << 16));
                *(pg8::v4i_t*)(o + (jt * 2 + ks) * 512) = w; }
        if (NV > 96) { const int f = jr == 0 ? 0x3f803f80 : 0; const pg8::v4i_t w = {f, f, f, f};
#pragma unroll
            for (int ks = 0; ks < 2; ++ks) *(pg8::v4i_t*)(o + (12 + ks) * 512) = w; }
        LDS_WAIT(); } };

template <int DKP, int NV, int NG, int MR = 1> struct ChainW { int n; int pad; bf16* lab;
    static constexpr int CG = DKP / (16 * NG), MT = NV / 16, MG = (MT + MR - 1) / MR;
    struct Fr { pg8::bf16x8 a[MR][2]; pg8::bf16x8 b[NG][2]; float dc[NG]; };
    __device__ __forceinline__ static int jt_of(int jg, int i) { const int j = jg * MR + i; return j < MT ? j : MT - 1; }
    __device__ __forceinline__ void load(Fr& f, int d, int b, int hh, int jg, int cg, int step, int r, int q) const { typedef LaLay<DKP, NV> L; const int blk = chain_blk(d, step); const size_t item = ((size_t)b * NBLK + blk) * 4 + hh; const int ln = q * 16 + r;
        const bf16* Bt = lab + L::koutT + ((size_t)d * LA_NI + item) * DKP * 64 + ((size_t)(cg * NG * 2) * 64 + ln) * 8;
        const float* dec = (const float*)(lab + L::dec) + ((size_t)d * LA_NI + item) * DKP + cg * (16 * NG) + r;
#pragma unroll
        for (int i = 0; i < MR; ++i) { const bf16* A = lab + L::vT + item * NV * 64 + ((size_t)(jt_of(jg, i) * 2) * 64 + ln) * 8;
#pragma unroll
            for (int ks = 0; ks < 2; ++ks) f.a[i][ks] = *(const pg8::bf16x8*)(A + ks * 512); }
#pragma unroll
        for (int nn = 0; nn < NG; ++nn) {
#pragma unroll
            for (int ks = 0; ks < 2; ++ks) f.b[nn][ks] = *(const pg8::bf16x8*)(Bt + (nn * 2 + ks) * 512);
            f.dc[nn] = dec[nn * 16]; } }
    __device__ __forceinline__ void process(const Fr& f, pg8::f32x4 (&S)[MR][NG], int d, int b, int hh, int jg, int cg, int step, int r, int q, PG8_LAS unsigned char* lw) const { typedef LaLay<DKP, NV> L;
        pg8::f32x4 acc[MR][NG];
#pragma unroll
        for (int i = 0; i < MR; ++i)
#pragma unroll
            for (int nn = 0; nn < NG; ++nn) acc[i][nn] = (pg8::f32x4){0.f, 0.f, 0.f, 0.f};
#pragma unroll
        for (int ks = 0; ks < 2; ++ks)
#pragma unroll
            for (int i = 0; i < MR; ++i)
#pragma unroll
                for (int nn = 0; nn < NG; ++nn) acc[i][nn] = __builtin_amdgcn_mfma_f32_16x16x32_bf16(f.a[i][ks], f.b[nn][ks], acc[i][nn], 0, 0, 0);
        const int blk = chain_blk(d, step); const size_t item = ((size_t)b * NBLK + blk) * 4 + hh; PG8_LAS bf16* lt = (PG8_LAS bf16*)lw;
#pragma unroll
        for (int i = 0; i < MR; ++i)
#pragma unroll
            for (int nn = 0; nn < NG; ++nn)
#pragma unroll
                for (int e = 0; e < 4; ++e) { const int col = nn * 16 + r; lt[i * (NG / 2) * 512 + (col >> 5) * 512 + ((((col & 31) >> 3) << 4) + q * 4 + e) * 8 + (col & 7)] = f2bf(S[i][nn][e]); S[i][nn][e] = f.dc[nn] * (S[i][nn][e] + acc[i][nn][e]); }
        LDS_WAIT();
#pragma unroll
        for (int i = 0; i < MR; ++i) { bf16* out = lab + L::sT + ((size_t)d * LA_NI + item) * NV * DKP + ((size_t)(jt_of(jg, i) * (DKP / 32) + cg * (NG / 2)) * 64 + q * 16 + r) * 8;
#pragma unroll
            for (int tl = 0; tl < NG / 2; ++tl) { const pg8::v4i_t pv = *(const PG8_LAS pg8::v4i_t*)(lt + ((i * (NG / 2) + tl) * 64 + q * 16 + r) * 8); *(pg8::v4i_t*)(out + tl * 512) = pv; } }
        LDS_WAIT(); }
    __device__ __forceinline__ void wave(int it, int lane, PG8_LAS unsigned char* lw) const {
        const int cg = it % CG; int c = it / CG; const int jt = c % MG; c /= MG; const int hh = c % 4; c /= 4; const int b = c % NB, d = c / NB; const int r = lane & 15, q = lane >> 4;
        pg8::f32x4 S[MR][NG];
#pragma unroll
        for (int i = 0; i < MR; ++i)
#pragma unroll
            for (int nn = 0; nn < NG; ++nn) S[i][nn] = (pg8::f32x4){0.f, 0.f, 0.f, 0.f};
        auto cl = [](int st) { return st < NBLK ? st : NBLK - 1; };
        Fr f0, f1, f2, f3; load(f0, d, b, hh, jt, cg, 0, r, q); load(f1, d, b, hh, jt, cg, cl(1), r, q); load(f2, d, b, hh, jt, cg, cl(2), r, q);
        static_assert(NBLK % 4 == 0 || NBLK < 4, "ChainW walks the chain four blocks per trip");
        for (int step = 0; step + 3 < NBLK; step += 4) {
            load(f3, d, b, hh, jt, cg, step + 3, r, q);
            process(f0, S, d, b, hh, jt, cg, step, r, q, lw);
            load(f0, d, b, hh, jt, cg, cl(step + 4), r, q);
            process(f1, S, d, b, hh, jt, cg, step + 1, r, q, lw);
            load(f1, d, b, hh, jt, cg, cl(step + 5), r, q);
            process(f2, S, d, b, hh, jt, cg, step + 2, r, q, lw);
            load(f2, d, b, hh, jt, cg, cl(step + 6), r, q);
            process(f3, S, d, b, hh, jt, cg, step + 3, r, q, lw); }
        if (NBLK < 4) { process(f0, S, d, b, hh, jt, cg, 0, r, q, lw); if (NBLK > 1) process(f1, S, d, b, hh, jt, cg, 1, r, q, lw); if (NBLK > 2) process(f2, S, d, b, hh, jt, cg, 2, r, q, lw); } } };
template <int DKP, int NV, bool ISML> struct OutW { int n; int pad; const bf16* lab; const bf16* p; const float* gain; bf16* mix;
    __device__ __forceinline__ void wave(int it, int lane, PG8_LAS unsigned char* lw) const { typedef LaLay<DKP, NV> L; constexpr int NT = NV / 16, KQ = DKP / 32; typedef pg8::bf16x8 frag;
        const size_t item = (size_t)(it >> 1); const int half = it & 1, hh = (int)(item % 4); const size_t bb = item / 4; const size_t r0 = (bb / NBLK) * RPB + (bb % NBLK) * 64; const int t0 = half * 32;
        const int r = lane & 15, q = lane >> 4; PG8_LAS bf16* latt = (PG8_LAS bf16*)lw;
        pg8::f32x4 acc[2][NT], hs[2][6];
#pragma unroll
        for (int m = 0; m < 2; ++m) {
#pragma unroll
            for (int nn = 0; nn < NT; ++nn) acc[m][nn] = (pg8::f32x4){0.f, 0.f, 0.f, 0.f};
#pragma unroll
            for (int nn = 0; nn < 6; ++nn) hs[m][nn] = (pg8::f32x4){0.f, 0.f, 0.f, 0.f}; }
        const bf16* vp = lab + L::vT + item * NV * 64 + (size_t)lane * 8;
#pragma unroll
        for (int d = 0; d < 2; ++d) {
            const bf16* qp = lab + L::qin + ((size_t)d * LA_NI + item) * 64 * DKP + ((size_t)(t0 / 16) * KQ * 64 + lane) * 8; const bf16* kp = lab + L::kin + ((size_t)d * LA_NI + item) * 64 * DKP + (size_t)lane * 8;
            const bf16* sp = lab + L::sT + ((size_t)d * LA_NI + item) * NV * DKP + (size_t)lane * 8;
            frag qa[2][KQ], sf[NT][KQ];
#pragma unroll
            for (int m = 0; m < 2; ++m)
#pragma unroll
                for (int ks = 0; ks < KQ; ++ks) qa[m][ks] = *(const frag*)(qp + (m * KQ + ks) * 512);
#pragma unroll
            for (int nn = 0; nn < NT; ++nn)
#pragma unroll
                for (int ks = 0; ks < KQ; ++ks) sf[nn][ks] = *(const frag*)(sp + (nn * KQ + ks) * 512);
            frag kf[4][KQ], vf[NT][2];
            if constexpr (!ISML) {
#pragma unroll
                for (int nn = 0; nn < 4; ++nn)
#pragma unroll
                    for (int ks = 0; ks < KQ; ++ks) kf[nn][ks] = *(const frag*)(kp + (nn * KQ + ks) * 512);
#pragma unroll
                for (int nn = 0; nn < NT; ++nn)
#pragma unroll
                    for (int ks = 0; ks < 2; ++ks) vf[nn][ks] = *(const frag*)(vp + (nn * 2 + ks) * 512); }
#pragma unroll
            for (int ks = 0; ks < KQ; ++ks)
#pragma unroll
                for (int m = 0; m < 2; ++m)
#pragma unroll
                    for (int nn = 0; nn < NT; ++nn) acc[m][nn] = __builtin_amdgcn_mfma_f32_16x16x32_bf16(qa[m][ks], sf[nn][ks], acc[m][nn], 0, 0, 0);
            if constexpr (ISML) {
#pragma unroll
            for (int nn = 0; nn < 4; ++nn)
#pragma unroll
                for (int ks = 0; ks < KQ; ++ks) kf[nn][ks] = *(const frag*)(kp + (nn * KQ + ks) * 512); }
            pg8::f32x4 at[2][4];
#pragma unroll
            for (int m = 0; m < 2; ++m)
#pragma unroll
                for (int nn = 0; nn < 4; ++nn) at[m][nn] = (pg8::f32x4){0.f, 0.f, 0.f, 0.f};
#pragma unroll
            for (int ks = 0; ks < KQ; ++ks)
#pragma unroll
                for (int m = 0; m < 2; ++m)
#pragma unroll
                    for (int nn = 0; nn < 4; ++nn) at[m][nn] = __builtin_amdgcn_mfma_f32_16x16x32_bf16(qa[m][ks], kf[nn][ks], at[m][nn], 0, 0, 0);
            if constexpr (ISML) {
#pragma unroll
            for (int nn = 0; nn < NT; ++nn)
#pragma unroll
                for (int ks = 0; ks < 2; ++ks) vf[nn][ks] = *(const frag*)(vp + (nn * 2 + ks) * 512); }
#pragma unroll
            for (int m = 0; m < 2; ++m)
#pragma unroll
                for (int nn = 0; nn < 4; ++nn)
#pragma unroll
                    for (int e = 0; e < 4; ++e) { const int tl = m * 16 + q * 4 + e, tt = t0 + tl, sx = nn * 16 + r; const bool valid = d == 0 ? (sx <= tt) : (sx >= tt);
                        latt[tl * 72 + sx] = f2bf(valid ? at[m][nn][e] : 0.f); }
            LDS_WAIT();
            frag af[2][2];
#pragma unroll
            for (int m = 0; m < 2; ++m)
#pragma unroll
                for (int ks = 0; ks < 2; ++ks) af[m][ks] = *(const PG8_LAS frag*)(latt + (m * 16 + r) * 72 + ks * 32 + q * 8);
#pragma unroll
            for (int ks = 0; ks < 2; ++ks)
#pragma unroll
                for (int m = 0; m < 2; ++m)
#pragma unroll
                    for (int nn = 0; nn < NT; ++nn) acc[m][nn] = __builtin_amdgcn_mfma_f32_16x16x32_bf16(af[m][ks], vf[nn][ks], acc[m][nn], 0, 0, 0);
            LDS_WAIT();
            if (ISML) {
#pragma unroll
                for (int m = 0; m < 2; ++m)
#pragma unroll
                    for (int e = 0; e < 4; ++e) { const float den = __shfl(acc[m][NT - 1][e], lane & 48); const float inv = 1.0f / fmaxf(fabsf(den), 1.0f);
#pragma unroll
                        for (int nn = 0; nn < 6; ++nn) { hs[m][nn][e] += acc[m][nn][e] * inv; acc[m][nn][e] = 0.f; }
                        acc[m][NT - 1][e] = 0.f; } } }
#pragma unroll
        for (int m = 0; m < 2; ++m)
#pragma unroll
            for (int e = 0; e < 4; ++e) { float ss = 0.f;
#pragma unroll
                for (int nn = 0; nn < 6; ++nn) { const float o = ISML ? hs[m][nn][e] : acc[m][nn][e]; ss += o * o; }
                ss += __shfl_xor(ss, 1); ss += __shfl_xor(ss, 2); ss += __shfl_xor(ss, 4); ss += __shfl_xor(ss, 8);
                const float rstd = 1.0f / sqrtf(ss * (1.0f / 96.0f) + EPS); PG8_LAS float* fo = (PG8_LAS float*)lw + (m * 16 + q * 4 + e) * 100;
#pragma unroll
                for (int nn = 0; nn < 6; ++nn) { const int j = nn * 16 + r; const float o = ISML ? hs[m][nn][e] : acc[m][nn][e]; fo[j] = o * rstd * gain[j]; } }
        LDS_WAIT();
        uint4 gv[6];
#pragma unroll
        for (int k = 0; k < 6; ++k) { const int pi = lane + 64 * k, rw = pi / 12, c8 = pi % 12; gv[k] = *(const uint4*)(p + (r0 + t0 + rw) * PS + (ISML ? MO : GG) + hh * 96 + c8 * 8); }
#pragma unroll
        for (int k = 0; k < 6; ++k) { const int pi = lane + 64 * k, rw = pi / 12, c8 = pi % 12; const PG8_LAS float* fr = (const PG8_LAS float*)lw + rw * 100 + c8 * 8;
            const pg8::f32x4 a0 = *(const PG8_LAS pg8::f32x4*)fr, a1 = *(const PG8_LAS pg8::f32x4*)(fr + 4); const unsigned gw[4] = {gv[k].x, gv[k].y, gv[k].z, gv[k].w}; float gt[8];
#pragma unroll
            for (int e = 0; e < 4; ++e) { const float g0 = __uint_as_float(gw[e] << 16), g1 = __uint_as_float(gw[e] & 0xffff0000u); gt[2 * e] = ISML ? fast_sigmoid(g0) : fast_silu(g0); gt[2 * e + 1] = ISML ? fast_sigmoid(g1) : fast_silu(g1); }
            uint4 ov; ov.x = cvt_pk_bf16(a0[0] * gt[0], a0[1] * gt[1]); ov.y = cvt_pk_bf16(a0[2] * gt[2], a0[3] * gt[3]); ov.z = cvt_pk_bf16(a1[0] * gt[4], a1[1] * gt[5]); ov.w = cvt_pk_bf16(a1[2] * gt[6], a1[3] * gt[7]);
            *(uint4*)(mix + (r0 + t0 + rw) * D + (ISML ? 640 : 0) + hh * 96 + c8 * 8) = ov; }
        LDS_WAIT(); } };

struct OutWG { int n; int pad; const bf16* lab; const bf16* p; const float* gain; bf16* mix;
    __device__ __forceinline__ void wave(int it, int lane, PG8_LAS unsigned char* lw) const { constexpr int DKP = 64, NV = 96; typedef LaLay<DKP, NV> L; constexpr int NT = 6, KQ = 2; typedef pg8::bf16x8 frag;
        const size_t item = (size_t)it; const int hh = (int)(item % 4); const size_t bb = item / 4; const size_t r0 = (bb / NBLK) * RPB + (bb % NBLK) * 64;
        const int r = lane & 15, q = lane >> 4; PG8_LAS bf16* latt = (PG8_LAS bf16*)lw;
        pg8::f32x4 acc[4][NT];
#pragma unroll
        for (int m = 0; m < 4; ++m)
#pragma unroll
            for (int nn = 0; nn < NT; ++nn) acc[m][nn] = (pg8::f32x4){0.f, 0.f, 0.f, 0.f};
        const bf16* vp = lab + L::vT + item * NV * 64 + (size_t)lane * 8;
#pragma unroll
        for (int d = 0; d < 2; ++d) {
            const bf16* qp = lab + L::qin + ((size_t)d * LA_NI + item) * 64 * DKP + (size_t)lane * 8; const bf16* kp = lab + L::kin + ((size_t)d * LA_NI + item) * 64 * DKP + (size_t)lane * 8;
            const bf16* sp = lab + L::sT + ((size_t)d * LA_NI + item) * NV * DKP + (size_t)lane * 8;
            frag qa[4][KQ], kf[4][KQ];
            { frag sf[NT][KQ];
#pragma unroll
            for (int m = 0; m < 4; ++m)
#pragma unroll
                for (int ks = 0; ks < KQ; ++ks) qa[m][ks] = *(const frag*)(qp + (m * KQ + ks) * 512);
#pragma unroll
            for (int nn = 0; nn < NT; ++nn)
#pragma unroll
                for (int ks = 0; ks < KQ; ++ks) sf[nn][ks] = *(const frag*)(sp + (nn * KQ + ks) * 512);
#pragma unroll
            for (int nn = 0; nn < 4; ++nn)
#pragma unroll
                for (int ks = 0; ks < KQ; ++ks) kf[nn][ks] = *(const frag*)(kp + (nn * KQ + ks) * 512);
#pragma unroll
            for (int ks = 0; ks < KQ; ++ks)
#pragma unroll
                for (int m = 0; m < 4; ++m)
#pragma unroll
                    for (int nn = 0; nn < NT; ++nn) acc[m][nn] = __builtin_amdgcn_mfma_f32_16x16x32_bf16(qa[m][ks], sf[nn][ks], acc[m][nn], 0, 0, 0); }
            __builtin_amdgcn_sched_barrier(0);
            frag vf[NT][2];
#pragma unroll
            for (int hp = 0; hp < 2; ++hp) { pg8::f32x4 at[2][4];
                if (hp == 1) { __builtin_amdgcn_sched_barrier(0);
#pragma unroll
                    for (int nn = 0; nn < NT; ++nn)
#pragma unroll
                        for (int ks = 0; ks < 2; ++ks) vf[nn][ks] = *(const frag*)(vp + (nn * 2 + ks) * 512);
                    __builtin_amdgcn_sched_barrier(0); }
#pragma unroll
                for (int m = 0; m < 2; ++m)
#pragma unroll
                    for (int nn = 0; nn < 4; ++nn) at[m][nn] = (pg8::f32x4){0.f, 0.f, 0.f, 0.f};
#pragma unroll
                for (int ks = 0; ks < KQ; ++ks)
#pragma unroll
                    for (int m = 0; m < 2; ++m)
#pragma unroll
                        for (int nn = 0; nn < 4; ++nn) at[m][nn] = __builtin_amdgcn_mfma_f32_16x16x32_bf16(qa[2 * hp + m][ks], kf[nn][ks], at[m][nn], 0, 0, 0);
#pragma unroll
                for (int m = 0; m < 2; ++m)
#pragma unroll
                    for (int nn = 0; nn < 4; ++nn)
#pragma unroll
                        for (int e = 0; e < 4; ++e) { const int tt = hp * 32 + m * 16 + q * 4 + e, sx = nn * 16 + r; const bool valid = d == 0 ? (sx <= tt) : (sx >= tt);
                            latt[tt * 72 + sx] = f2bf(valid ? at[m][nn][e] : 0.f); } }
            LDS_WAIT();
            frag af[4][2];
#pragma unroll
            for (int m = 0; m < 4; ++m)
#pragma unroll
                for (int ks = 0; ks < 2; ++ks) af[m][ks] = *(const PG8_LAS frag*)(latt + (m * 16 + r) * 72 + ks * 32 + q * 8);
#pragma unroll
            for (int ks = 0; ks < 2; ++ks)
#pragma unroll
                for (int m = 0; m < 4; ++m)
#pragma unroll
                    for (int nn = 0; nn < NT; ++nn) acc[m][nn] = __builtin_amdgcn_mfma_f32_16x16x32_bf16(af[m][ks], vf[nn][ks], acc[m][nn], 0, 0, 0);
            LDS_WAIT(); }
#pragma unroll
        for (int hp = 0; hp < 2; ++hp) { const int t0 = hp * 32;
#pragma unroll
            for (int m = 0; m < 2; ++m)
#pragma unroll
                for (int e = 0; e < 4; ++e) { float ss = 0.f;
#pragma unroll
                    for (int nn = 0; nn < 6; ++nn) { const float o = acc[2 * hp + m][nn][e]; ss += o * o; }
                    ss += __shfl_xor(ss, 1); ss += __shfl_xor(ss, 2); ss += __shfl_xor(ss, 4); ss += __shfl_xor(ss, 8);
                    const float rstd = 1.0f / sqrtf(ss * (1.0f / 96.0f) + EPS); PG8_LAS float* fo = (PG8_LAS float*)lw + (m * 16 + q * 4 + e) * 100;
#pragma unroll
                    for (int nn = 0; nn < 6; ++nn) { const int j = nn * 16 + r; fo[j] = acc[2 * hp + m][nn][e] * rstd * gain[j]; } }
            LDS_WAIT();
            uint4 gv[6];
#pragma unroll
            for (int k = 0; k < 6; ++k) { const int pi = lane + 64 * k, rw = pi / 12, c8 = pi % 12; gv[k] = *(const uint4*)(p + (r0 + t0 + rw) * PS + GG + hh * 96 + c8 * 8); }
#pragma unroll
            for (int k = 0; k < 6; ++k) { const int pi = lane + 64 * k, rw = pi / 12, c8 = pi % 12; const PG8_LAS float* fr = (const PG8_LAS float*)lw + rw * 100 + c8 * 8;
                const pg8::f32x4 a0 = *(const PG8_LAS pg8::f32x4*)fr, a1 = *(const PG8_LAS pg8::f32x4*)(fr + 4); const unsigned gw[4] = {gv[k].x, gv[k].y, gv[k].z, gv[k].w}; float gt[8];
#pragma unroll
                for (int e = 0; e < 4; ++e) { const float g0 = __uint_as_float(gw[e] << 16), g1 = __uint_as_float(gw[e] & 0xffff0000u); gt[2 * e] = fast_silu(g0); gt[2 * e + 1] = fast_silu(g1); }
                uint4 ov; ov.x = cvt_pk_bf16(a0[0] * gt[0], a0[1] * gt[1]); ov.y = cvt_pk_bf16(a0[2] * gt[2], a0[3] * gt[3]); ov.z = cvt_pk_bf16(a1[0] * gt[4], a1[1] * gt[5]); ov.w = cvt_pk_bf16(a1[2] * gt[6], a1[3] * gt[7]);
                *(uint4*)(mix + (r0 + t0 + rw) * D + hh * 96 + c8 * 8) = ov; }
            LDS_WAIT(); } } };

#ifdef MULTI_LAUNCH
template <class F> __global__ void __launch_bounds__(256) k_run(F f) {
    for (long i = (long)blockIdx.x * blockDim.x + threadIdx.x; i < f.n; i += (long)gridDim.x * blockDim.x) f(i);
}
template <class F> __global__ void __launch_bounds__(512, 2) k_wrun(F f) {
    extern __shared__ __attribute__((aligned(16))) unsigned char shm[];
    const int wid = threadIdx.x >> 6, lane = threadIdx.x & 63;
    for (int it = blockIdx.x * 8 + wid; it < f.n; it += gridDim.x * 8) f.wave(it, lane, (PG8_LAS unsigned char*)shm + wid * 16384);
}
template <class F> __global__ void __launch_bounds__(512, 2) k_gemm(GemmDesc g, F e) {
    extern __shared__ __attribute__((aligned(16))) unsigned char shm[];
    pg8::gemm_phase<F>((PG8_LAS unsigned char*)shm, g, e, (int)gridDim.x, (int)blockIdx.x);
}
struct Ctx { hipStream_t stream; int ncu; const void* const* tbl;
    void mark(int) const {} void probe_out(float*) const {}
    template <int I> const float* inp() const { return (const float*)tbl[I]; }
    template <class F> void run(const F& f, bool sync = true, int ioff = 0) {
        if (f.n <= 0) return; long nb = (f.n + 255) / 256; if (nb > 256L * 32) nb = 256L * 32;
        hipLaunchKernelGGL(k_run<F>, dim3((unsigned)nb), dim3(256), 0, stream, f); }
    template <class F> void wrun(const F& f, bool sync = true, int woff = 0) {
        static bool attr_set = false;
        if (!attr_set) { (void)hipFuncSetAttribute((const void*)k_wrun<F>, hipFuncAttributeMaxDynamicSharedMemorySize, pg8::STAGE_BYTES); attr_set = true; }
        hipLaunchKernelGGL(k_wrun<F>, dim3(ncu), dim3(512), pg8::STAGE_BYTES, stream, f); }
    template <class F> void gemm(const GemmDesc& g, const F& e) {
        static bool attr_set = false;
        if (!attr_set) { (void)hipFuncSetAttribute((const void*)k_gemm<F>, hipFuncAttributeMaxDynamicSharedMemorySize, pg8::STAGE_BYTES); attr_set = true; }
        hipLaunchKernelGGL(k_gemm<F>, dim3(ncu), dim3(512), pg8::STAGE_BYTES, stream, g, e); }
};
#else
#ifndef PROBE_A
#define PROBE_A -1
#endif
#ifndef PROBE_B
#define PROBE_B -1
#endif
struct Ctx { XcdBarrier bar; PG8_LAS unsigned char* lds; int gtid, nthr;
    __device__ __forceinline__ void mark(int id) const { if (PROBE_A >= 0 && blockIdx.x == 0 && threadIdx.x == 0) { volatile PG8_LAS unsigned long long* t = (volatile PG8_LAS unsigned long long*)(lds + pg8::STAGE_BYTES + 400);
            if (id == PROBE_A) t[0] = __builtin_amdgcn_s_memrealtime(); if (id == PROBE_B) t[1] = __builtin_amdgcn_s_memrealtime(); } }
    __device__ __forceinline__ void probe_out(float* o) const { if (PROBE_A >= 0 && blockIdx.x == 0 && threadIdx.x == 0) { volatile PG8_LAS unsigned long long* t = (volatile PG8_LAS unsigned long long*)(lds + pg8::STAGE_BYTES + 400);
            o[0] += (float)(t[1] - t[0]) * 0.1f; } }
    template <int I> __device__ __forceinline__ const float* inp() const { unsigned off = pg8::STAGE_BYTES + 64 + 8 * I; asm volatile("" : "+v"(off));
        const PG8_LAS unsigned* t = (const PG8_LAS unsigned*)(lds + off);
        const unsigned lo = __builtin_amdgcn_readfirstlane(t[0]), hi = __builtin_amdgcn_readfirstlane(t[1]);
        return (const float*)(const __attribute__((address_space(1))) float*)(((unsigned long long)hi << 32) | lo); }
    template <class F> __device__ __forceinline__ void run(const F& f, bool sync = true, int ioff = 0) {
        int i0 = gtid - ioff; asm volatile("" : "+v"(i0)); if (i0 < 0) i0 += nthr;
        const int n = (int)f.n; int st = (int)nthr; asm volatile("" : "+s"(st));
        for (int i = i0; i < n; i += st) f((long)i);
        if (sync) xcd_barrier(bar); }
    template <class F> __device__ __forceinline__ void wrun(const F& f, bool sync = true, int woff = 0) {
        int t0 = threadIdx.x; asm volatile("" : "+v"(t0));
        const int wid = __builtin_amdgcn_readfirstlane(t0 >> 6), lane = t0 & 63; const int nw = (int)gridDim.x * 8; int w0 = (int)blockIdx.x * 8 + wid - woff; if (w0 < 0) w0 += nw;
        for (int it = w0; it < f.n; it += nw) { int ln = lane; asm volatile("" : "+v"(ln));
            f.wave(it, ln, lds + wid * 16384); }
        if (sync) xcd_barrier(bar); }
    template <class F> __device__ __forceinline__ void gemm(const GemmDesc& g, const F& e) {
        pg8::gemm_phase<F>(lds, g, e, (int)gridDim.x, (int)blockIdx.x);
        xcd_barrier(bar); }
    template <class F> __device__ __forceinline__ void gemm8(const GemmDesc& g, const F& e) {
        pg8::gemm_phase<F, true, false>(lds, g, e, (int)gridDim.x, (int)blockIdx.x);
        xcd_barrier(bar); }
};
#endif
#else
struct Ctx { const void* const* tbl;
void mark(int) const {} void probe_out(float*) const {}
template <int I> const float* inp() const { return (const float*)tbl[I]; }
template <class F> void run(const F& f, bool sync = true, int ioff = 0) {
#pragma omp parallel for schedule(static)
    for (long i = 0; i < f.n; ++i) f(i);
}
template <class F> void gemm(const GemmDesc& g, const F& e) {
    int M = g.M; if (g.ntile) { int nt = g.ntile[0] - g.tile0; if (nt < 0) nt = 0; if (nt * 256 < M) M = nt * 256; }
#pragma omp parallel for schedule(dynamic, 4)
    for (int r = 0; r < M; ++r) {
        int ar = r; if (g.arow) { ar = g.arow[(size_t)g.tile0 * 256 + r]; if (ar < 0) ar = 0; }
        const bf16* a = g.A + (size_t)ar * g.lda; const bf16* B = g.Bt + (g.tile_e ? (size_t)g.tile_e[g.tile0 + r / 256] * g.e_stride : (g.tdiv ? (size_t)((r / 256) / g.tdiv) * g.e_stride : 0));
        static thread_local float af[4096]; for (int k = 0; k < g.K; ++k) af[k] = bf2f(a[k]);
        for (int c0 = 0; c0 < g.N; c0 += 8) { float v[8];
            for (int j = 0; j < 8; ++j) { const bf16* bt = B + (size_t)(c0 + j) * g.ldb; float s = 0.f; for (int k = 0; k < g.K; ++k) s += af[k] * bf2f(bt[k]); v[j] = s; }
            e.apply8(r, c0, v); }
    }
}
};
#endif

struct Inputs { const float *x, *c, *ctx, *c_ctx, *w_ada, *b_ada, *norm1, *norm2, *w_in, *w_out, *gla_wa2, *gla_ba, *gla_norm, *s5_lam_re, *s5_lam_im, *s5_log_dt, *s5_b_re, *s5_b_im,
    *s5_c_re, *s5_c_im, *s5_d, *s5_glu_w, *s5_glu_b, *ml_conv_w, *ml_conv_b, *ml_gate_b, *ml_norm, *ffn_w1, *ffn_w3, *ffn_w2, *moe_router, *moe_w1, *moe_w3, *moe_w2, *norm_f; };

#define INP(name) (cx.template inp<offsetof(Inputs, name) / 8>())
#ifndef PROBE_REP
#define PROBE_REP -1
#endif
#ifndef PROBE_L
#define PROBE_L -1
#endif
#define REPEAT(k) if constexpr (false) {} else for (int rep_ = 0; rep_ < 1; ++rep_)
#define SEC_BEGIN(k) { auto sec_ = [&]() __attribute__((always_inline)) {
#define SEC_END(k) }; sec_(); if constexpr (PROBE_REP == (k) && (PROBE_L == l || PROBE_L < 0)) sec_(); }
#define WSB ((unsigned char*)cx.template inp<36>())
#ifdef HOST_EMU
#define S5TABBASE (WSB + WS.s5tab)
#else
#define S5TABBASE ((unsigned char*)cx.template inp<35>() + ABUF_BYTES)
#endif
#define out ((float*)cx.template inp<35>())
#define mod ((float*)(WSB + WS.mod))
#define h ((float*)(WSB + WS.h))
#define abuf ((bf16*)cx.template inp<35>())
#define winT ((bf16*)(WSB + WS.winT))
#define woutT ((bf16*)(WSB + WS.woutT))
#define w13T ((bf16*)(WSB + WS.w13T))
#define w2T ((bf16*)(WSB + WS.w2T))
#define pbuf ((bf16*)(WSB + WS.pbuf))
#define obuf ((float*)(WSB + WS.obuf))
#define lab ((bf16*)(WSB + WS.lab))
#define labg ((bf16*)(WSB + WS.labg))
#define s5disc ((float*)(S5TABBASE + S5T.disc))
#define s5K ((float*)(S5TABBASE + S5T.K))
#define s5apow ((float*)(S5TABBASE + S5T.apow))
#define s5bbar ((float*)(S5TABBASE + S5T.bbar))
#define s5TB ((bf16*)(S5TABBASE + S5T.TB))
#define s5EB ((bf16*)(S5TABBASE + S5T.EB))
#define s5uG ((bf16*)(WSB + WS.s5uG))
#define s5est ((float*)(WSB + WS.s5est))
#define zbuf ((bf16*)(WSB + WS.zbuf))
#define gluT ((bf16*)(S5TABBASE + S5T.gluT))
#define act ((bf16*)(WSB + WS.act))
#define mw13T ((bf16*)(WSB + WS.mw13T))
#define mw2T ((bf16*)(WSB + WS.mw2T))
#define mact ((bf16*)(WSB + WS.mact))
#define xs8 ((unsigned char*)(WSB + WS.xs8))
#define yrow ((bf16*)(WSB + WS.yrow))
#define rt_e ((int*)(WSB + WS.rt_e))
#define rt_w ((float*)(WSB + WS.rt_w))
#define rt_dest ((int*)(WSB + WS.rt_dest))
#define segcnt ((int*)(WSB + WS.segcnt))
#define ecnt ((int*)(WSB + WS.ecnt))
#define row_token ((int*)(WSB + WS.row_token))
#define tile_e ((int*)(WSB + WS.tile_e))
#define ntile ((int*)(WSB + WS.ntile))
#define modl (mod + (size_t)l * NMOD * 6 * D)
#define silc ((float*)(WSB + WS.silc))
#define postab ((float*)(WSB + WS.postab))
#define modpart ((float*)(WSB + WS.uni))
template <int l, class X> HD void layer_fwd(X& cx) {
    constexpr bool last = (l == DEPTH - 1);
    cx.mark(10 * (l + 1));
        REPEAT(1) {
#ifdef HOST_EMU
        cx.run(NormModK{(long)NR, h, INP(norm1) + (size_t)l * D, modl, 0, D, abuf, nullptr, nullptr, nullptr, 0, 0, nullptr});
#else
        if constexpr (!(l > 0 && (l - 1) % 2 == 1)) cx.wrun(NormModW{NR / 2, 0, D, 0, h, INP(norm1) + (size_t)l * D, modl, abuf, nullptr, nullptr, nullptr, nullptr, 0, 0});
#endif
        }
        cx.mark(10 * (l + 1) + 1);
        SEC_BEGIN(2) cx.gemm(GemmDesc{abuf, winT + (size_t)l * PS * D, nullptr, nullptr, nullptr, 0, NR, PS, D, 0, D, D, 0, 0}, EpiStoreBf16{pbuf, PS, 0}); SEC_END(2)
        cx.mark(10 * (l + 1) + 2);
        SEC_BEGIN(3) { typedef LaLay<64, 96> LG; typedef LaLay<96, 112> LM;
#ifdef HOST_EMU
        cx.run(GlaFused{(long)2 * NB * NBLK * 192, pbuf, INP(gla_wa2) + (size_t)l * 2 * 16 * 192, INP(gla_ba) + (size_t)l * 2 * 192, labg}, false);
#else
        cx.wrun(GlaPrepW2{2 * NB * NBLK * 4, 0, pbuf, INP(gla_wa2) + (size_t)l * 2 * 16 * 192, INP(gla_ba) + (size_t)l * 2 * 192, labg}, false);
#endif
#ifdef HOST_EMU
        cx.run(MlFused{(long)2 * NB * NBLK * 384, pbuf, INP(ml_conv_w) + (size_t)l * 3 * 768, INP(ml_conv_b) + (size_t)l * 768, INP(ml_gate_b) + (size_t)l * 16, lab}, false, 77824);
#else
        cx.wrun(MlPrepW2{2 * NB * NBLK * 4, 0, pbuf, INP(ml_conv_w) + (size_t)l * 3 * 768, INP(ml_conv_b) + (size_t)l * 768, INP(ml_gate_b) + (size_t)l * 16, lab}, false, (2 * NB * NBLK * 4) % 2048);
#endif
#ifdef HOST_EMU
        cx.run(VTFused<96, GV>{(long)LA_NI * 96, pbuf, labg + LG::vT}, false, 102400);
#else
        cx.wrun(VTW<96, GV>{(int)LA_NI, 0, pbuf, labg + LG::vT}, false, (4 * NB * NBLK * 4) % 2048);
#endif
        cx.run(S5Disc{(long)2 * 16 * 64, INP(s5_lam_re) + (size_t)l * 2048, INP(s5_lam_im) + (size_t)l * 2048, INP(s5_log_dt) + (size_t)l * 32, s5disc}, false);
        cx.run(S5Apow{(long)2 * 16 * 65 * 64, INP(s5_lam_re) + (size_t)l * 2048, INP(s5_lam_im) + (size_t)l * 2048, INP(s5_log_dt) + (size_t)l * 32, s5apow}, false);
        cx.run(TransposeK{(long)256 * 256, INP(s5_glu_w) + (size_t)l * 65536, nullptr, gluT, 256, 256, 256}, false);
#ifdef HOST_EMU
        cx.run(VTFused<112, MV>{(long)LA_NI * 112, pbuf, lab + LM::vT}, true, 49152);
#else
        cx.wrun(VTW<112, MV>{(int)LA_NI, 0, pbuf, lab + LM::vT}, true, (4 * NB * NBLK * 4 + (int)LA_NI) % 2048);
#endif
#ifdef HOST_EMU
        cx.run(S5Bbar{(long)2 * 16 * 64 * 16, s5disc, INP(s5_b_re) + (size_t)l * 16384, INP(s5_b_im) + (size_t)l * 16384, s5bbar}, false);
        cx.run(StatesRef<64, 96>{(long)2 * LA_NI * 96 * 64, labg});
        cx.run(StatesRef<96, 112>{(long)2 * LA_NI * 112 * 96, lab});
        cx.run(CarryT<96, 112>{(long)2 * NB * 4 * 112 * 96, lab}, false);
        cx.run(CarryT<64, 96>{(long)2 * NB * 4 * 96 * 64, labg});
#else
        cx.run(S5Bbar{(long)2 * 16 * 64 * 16, s5disc, INP(s5_b_re) + (size_t)l * 16384, INP(s5_b_im) + (size_t)l * 16384, s5bbar}, false);
        cx.wrun(ChainW<96, 112, 2, 2>{2 * NB * 4 * 4 * 3, 0, lab}, false);
        cx.wrun(ChainW<64, 96, 2, 2>{2 * NB * 4 * 3 * 2, 0, labg}, true, (2 * NB * 4 * 4 * 3) % 2048);
#endif
        cx.run(S5K2{(long)2 * 16 * 64 * 256, s5apow, s5bbar, INP(s5_c_re) + (size_t)l * 16384, INP(s5_c_im) + (size_t)l * 16384, s5K}, false);
        cx.run(S5BuildEB{(long)16 * 256 * 128, s5apow, s5bbar, s5EB}, false);
#ifdef HOST_EMU
        cx.run(OutRef<64, 96, false>{(long)NR * 384, labg, obuf});
        cx.run(HeadFin{(long)NR * 4, pbuf, obuf, INP(gla_norm) + (size_t)l * 96, abuf, 0});
        cx.run(OutRef<96, 112, true>{(long)NR * 384, lab, obuf});
        cx.run(HeadFin{(long)NR * 4, pbuf, obuf, INP(ml_norm) + (size_t)l * 96, abuf, 1});
#else
        cx.wrun(OutW<96, 112, true>{2 * (int)LA_NI, 0, lab, pbuf, INP(ml_norm) + (size_t)l * 96, abuf}, false);
        cx.wrun(OutWG{(int)LA_NI, 0, labg, pbuf, INP(gla_norm) + (size_t)l * 96, abuf}, true, (2 * (int)LA_NI) % 2048);
#endif
        } SEC_END(3)
        cx.mark(10 * (l + 1) + 3);
        cx.mark(10 * (l + 1) + 4);
        SEC_BEGIN(5) {
        cx.run(S5BuildTB{(long)16 * 1024 * (S5K_ / 8), s5apow, INP(s5_c_re) + (size_t)l * 16384, INP(s5_c_im) + (size_t)l * 16384, s5K, s5TB}, false);
        cx.run(S5BuildU{(long)16 * S5RB * 128, pbuf, s5uG});
        cx.gemm(GemmDesc{s5uG, s5EB, nullptr, nullptr, nullptr, (size_t)256 * 1024, 16 * S5RG, 256, 1024, 0, S5K_, 1024, S5RG / 256, 0}, EpiStoreF32{s5est, 256, 0});
        cx.run(S5Carry2{(long)NB * 16 * 2 * 64, s5apow, s5est, s5uG});
        cx.gemm(GemmDesc{s5uG, s5TB, nullptr, nullptr, nullptr, (size_t)1024 * S5K_, 16 * S5RG, 1024, S5K_, 0, S5K_, S5K_, S5RG / 256, 0}, EpiS5Z{pbuf, INP(s5_d) + (size_t)l * 256, zbuf});
        cx.gemm(mk_gemm(zbuf, 256, gluT, 256, NR, 256, 256), EpiGlu{zbuf, INP(s5_glu_b) + (size_t)l * 256, abuf});
        } SEC_END(5)
        cx.mark(10 * (l + 1) + 5);
        cx.gemm(GemmDesc{abuf, woutT + (size_t)l * D * D, nullptr, nullptr, nullptr, 0, NR, D, D, 0, D, D, 0, 0}, EpiResid{h, modl, 2 * D});
        cx.mark(10 * (l + 1) + 6);
        if constexpr (l % 2 == 0) { constexpr int j = l / 2;
            SEC_BEGIN(6) {
#ifdef HOST_EMU
            cx.run(NormModK{(long)NR, h, INP(norm2) + (size_t)l * D, modl, 3 * D, 4 * D, abuf, nullptr, nullptr, nullptr, 0, 0, nullptr});
#else
            cx.wrun(NormModW{NR / 2, 3 * D, 4 * D, 0, h, INP(norm2) + (size_t)l * D, modl, abuf, nullptr, nullptr, nullptr, nullptr, 0, 1});
#endif
#ifdef HOST_EMU
            cx.gemm(GemmDesc{abuf, w13T + (size_t)j * 2 * DFF * D, nullptr, nullptr, nullptr, 0, NR, 2 * DFF, D, 0, D, D, 0, 0}, EpiSwiGLU{act, DFF, 0});
#else
            cx.gemm8(GemmDesc{abuf, (const bf16*)((const unsigned char*)w13T + (size_t)j * 2 * DFF * D), nullptr, nullptr, nullptr, 0, NR, 2 * DFF, D, 0, D, D, 0, -W8S},
#if FP8_DOWN_DENSE
                EpiSwiGLU8{(unsigned char*)act, DFF, 0});
#else
                EpiSwiGLU{act, DFF, 0});
#endif
#endif
            } SEC_END(6)
#if FP8_DOWN_DENSE && !defined(HOST_EMU)
            cx.gemm8(GemmDesc{act, (const bf16*)((const unsigned char*)w2T + (size_t)j * D * DFF), nullptr, nullptr, nullptr, 0, NR, D, DFF, 0, DFF, DFF, 0, -(W8S + A8S)}, EpiResid{h, modl, 5 * D});
#else
            cx.gemm(GemmDesc{act, w2T + (size_t)j * D * DFF, nullptr, nullptr, nullptr, 0, NR, D, DFF, 0, DFF, DFF, 0, 0}, EpiResid{h, modl, 5 * D});
#endif
        } else { constexpr int j = l / 2; const int nseg = (NR + 63) / 64;
            SEC_BEGIN(7) {
#ifdef HOST_EMU
            for (int e = 0; e < NE; ++e) { const size_t wo = ((size_t)j * NE + e) * D * DFF;
                cx.run(TransposeK{(long)2 * DFF * D, INP(moe_w1) + wo, INP(moe_w3) + wo, mw13T + (size_t)e * 2 * DFF * D, D, DFF, 2 * DFF});
                cx.run(TransposeK{(long)D * DFF, INP(moe_w2) + wo, nullptr, mw2T + (size_t)e * D * DFF, DFF, D, D}); }
            cx.run(ZeroInt{(long)NE * nseg, segcnt});
            cx.run(MoeFillNeg{(long)MOE_MAXT * 256, row_token});
            cx.run(NormModK{(long)NR, h, INP(norm2) + (size_t)l * D, modl, 3 * D, 4 * D, abuf, INP(moe_router) + (size_t)j * D * NE, rt_e, rt_w, last ? 1 : 0, nseg, segcnt});
            cx.run(MoePrefix{(long)NE, segcnt, ecnt, nseg});
#else
            cx.wrun(TransW{((NE * (D / 64) * (DFF / 32)) + 1) / 2, D, DFF, 2, 0, W8S, INP(moe_w1) + (size_t)j * NE * D * DFF, mw13T, (size_t)D * DFF, (size_t)2 * DFF * D, (NE * (D / 64) * (DFF / 32)), 0}, false);
            cx.wrun(TransW{((NE * (D / 64) * (DFF / 32)) + 1) / 2, D, DFF, 2, 1, W8S, INP(moe_w3) + (size_t)j * NE * D * DFF, mw13T, (size_t)D * DFF, (size_t)2 * DFF * D, (NE * (D / 64) * (DFF / 32)), 0}, false);
            cx.wrun(TransW{((NE * (DFF / 64) * (D / 32)) + 1) / 2, DFF, D, 1, 0, FP8_DOWN_MOE ? W8S : 0, INP(moe_w2) + (size_t)j * NE * DFF * D, mw2T, (size_t)DFF * D, (size_t)D * DFF, (NE * (DFF / 64) * (D / 32)), 0}, false);
            cx.run(MoeFillNeg{(long)MOE_MAXT * 256, row_token}, false);
            cx.run(ZeroInt{(long)NE * nseg, segcnt});
            cx.wrun(NormModW{NR / 2, 3 * D, 4 * D, last ? 1 : 0, h, INP(norm2) + (size_t)l * D, modl, abuf, INP(moe_router) + (size_t)j * D * NE, rt_e, rt_w, segcnt, nseg, 1});
            cx.wrun(MoePrefixW{NE, nseg, segcnt, ecnt});
#endif
            cx.run(MoeTiles2{(long)MOE_MAXT, ecnt, tile_e, ntile}, false);
            cx.run(MoeAssign{(long)NE * nseg, rt_e, segcnt, ecnt, rt_dest, row_token, nseg});
#ifdef HOST_EMU
            cx.gemm(GemmDesc{abuf, mw13T, tile_e, ntile, row_token, (size_t)2 * DFF * D, MOE_MAXT * 256, 2 * DFF, D, 0, D, D, 0, 0}, EpiSwiGLU{mact, DFF, 0});
#else
            for (int t0 = 0; t0 < MOE_MAXT; t0 += MOE_XT) { const int nt = (MOE_MAXT - t0 < MOE_XT) ? MOE_MAXT - t0 : MOE_XT;
                cx.run(MoeGather8{(long)nt * 256 * (D / 16), (const unsigned char*)abuf, row_token, xs8, t0 * 256, 0});
                cx.gemm8(GemmDesc{(const bf16*)xs8, mw13T, tile_e, ntile, nullptr, (size_t)2 * DFF * D / 2, nt * 256, 2 * DFF, D, t0, D, D, 0, -W8S},
#if FP8_DOWN_MOE
                    EpiSwiGLU8{(unsigned char*)mact + (size_t)t0 * 256 * DFF, DFF, 0}); }
#else
                    EpiSwiGLU{mact + (size_t)t0 * 256 * DFF, DFF, 0}); }
#endif
#endif
#if FP8_DOWN_MOE && !defined(HOST_EMU)
            cx.gemm8(GemmDesc{mact, mw2T, tile_e, ntile, nullptr, (size_t)D * DFF / 2, MOE_MAXT * 256, D, DFF, 0, DFF, DFF, 0, -(W8S + A8S)}, EpiStoreBf16{yrow, D, 0});
#else
            cx.gemm(GemmDesc{mact, mw2T, tile_e, ntile, nullptr, (size_t)D * DFF, MOE_MAXT * 256, D, DFF, 0, DFF, DFF, 0, 0}, EpiStoreBf16{yrow, D, 0});
#endif
            } SEC_END(7)
#ifdef HOST_EMU
            cx.run(MoeCombine{(long)NR * D / 8, h, yrow, rt_e, rt_w, rt_dest, modl, 5 * D});
#else
            if constexpr (last) cx.wrun(CombineNormW{NR, 1, 5 * D, 0, h, yrow, rt_e, rt_w, rt_dest, modl, INP(norm_f), modl, abuf, out});
            else cx.wrun(CombineNormW{NR, 0, 5 * D, 0, h, yrow, rt_e, rt_w, rt_dest, modl, INP(norm1) + (size_t)(l + 1) * D, mod + (size_t)(l + 1) * NMOD * 6 * D, abuf, out});
#endif
        }
        cx.mark(10 * (l + 1) + 7);
    }
template <class X> HD void forward(X& cx) {
    cx.mark(0);
    constexpr int l = 0; (void)l;
    cx.run(PosTab{(long)2 * GRID_W * 512, postab}, false);
    cx.run(SiluC{(long)NMOD * D, INP(c), INP(c_ctx), silc});
    cx.run(InitH{(long)NR * D / 4, INP(x), INP(ctx), postab, h}, false);
#ifdef HOST_EMU
    for (int l = 0; l < DEPTH; ++l) {
        cx.run(TransposeK{(long)PS * D, INP(w_in) + (size_t)l * D * DPROJ, nullptr, winT + (size_t)l * PS * D, D, DPROJ, PS});
        cx.run(TransposeK{(long)D * D, INP(w_out) + (size_t)l * D * D, nullptr, woutT + (size_t)l * D * D, D, D, D});
        if (l % 2 == 0) { const int j = l / 2;
            cx.run(TransposeK{(long)2 * DFF * D, INP(ffn_w1) + (size_t)j * D * DFF, INP(ffn_w3) + (size_t)j * D * DFF, w13T + (size_t)j * 2 * DFF * D, D, DFF, 2 * DFF});
            cx.run(TransposeK{(long)D * DFF, INP(ffn_w2) + (size_t)j * DFF * D, nullptr, w2T + (size_t)j * D * DFF, DFF, D, D}); }
    }
#else
    cx.wrun(TransW{((DEPTH * (D / 64) * (DPROJ / 32)) + 1) / 2, D, DPROJ, 1, 0, 0, INP(w_in), winT, (size_t)D * DPROJ, (size_t)PS * D, (DEPTH * (D / 64) * (DPROJ / 32)), 0}, false);
    for (int l = 0; l < DEPTH; ++l) cx.run(ZeroBf16{(long)(PS - DPROJ) * D, winT + ((size_t)l * PS + DPROJ) * D}, false);
    cx.wrun(TransW{((DEPTH * (D / 64) * (D / 32)) + 1) / 2, D, D, 1, 0, 0, INP(w_out), woutT, (size_t)D * D, (size_t)D * D, (DEPTH * (D / 64) * (D / 32)), 0}, false);
    cx.wrun(TransW{((((DEPTH + 1) / 2) * (D / 64) * (DFF / 32)) + 1) / 2, D, DFF, 2, 0, W8S, INP(ffn_w1), w13T, (size_t)D * DFF, (size_t)2 * DFF * D, (((DEPTH + 1) / 2) * (D / 64) * (DFF / 32)), 0}, false);
    cx.wrun(TransW{((((DEPTH + 1) / 2) * (D / 64) * (DFF / 32)) + 1) / 2, D, DFF, 2, 1, W8S, INP(ffn_w3), w13T, (size_t)D * DFF, (size_t)2 * DFF * D, (((DEPTH + 1) / 2) * (D / 64) * (DFF / 32)), 0}, false);
    cx.wrun(TransW{((((DEPTH + 1) / 2) * (DFF / 64) * (D / 32)) + 1) / 2, DFF, D, 1, 0, FP8_DOWN_DENSE ? W8S : 0, INP(ffn_w2), w2T, (size_t)DFF * D, (size_t)D * DFF, (((DEPTH + 1) / 2) * (DFF / 64) * (D / 32)), 0}, false);
#endif
    cx.run(ModPart{(long)MODKC * DEPTH * 6 * D, silc, INP(w_ada), modpart});
    cx.run(ModReduce{(long)DEPTH * NMOD * 6 * D, modpart, INP(b_ada), mod});
    cx.mark(1);
    layer_fwd<0>(cx);
    if constexpr (DEPTH > 1) layer_fwd<1>(cx);
    if constexpr (DEPTH > 2) layer_fwd<2>(cx);
    if constexpr (DEPTH > 3) layer_fwd<3>(cx);
    static_assert(DEPTH <= 4, "unrolled for DEPTH <= 4");
#ifdef HOST_EMU
    cx.run(FinalNorm{(long)NB * SEQ, h, INP(norm_f), out});
#else
    if constexpr ((DEPTH - 1) % 2 == 0) cx.wrun(FinalNormW{NB * SEQ, 0, h, INP(norm_f), out});
#endif
    cx.mark(99);
    cx.probe_out(out);
}

#undef silc
#undef postab
#undef modpart
#undef mod
#undef h
#undef abuf
#undef winT
#undef woutT
#undef w13T
#undef w2T
#undef pbuf
#undef obuf
#undef lab
#undef labg
#undef s5disc
#undef s5K
#undef s5apow
#undef s5bbar
#undef s5TB
#undef s5EB
#undef s5uG
#undef s5est
#undef zbuf
#undef gluT
#undef act
#undef mw13T
#undef mw2T
#undef mact
#undef xs8
#undef yrow
#undef rt_e
#undef rt_w
#undef rt_dest
#undef segcnt
#undef ecnt
#undef row_token
#undef tile_e
#undef ntile
#undef WSB
#undef S5TABBASE
#undef out
#undef modl
#ifndef HOST_EMU
#ifndef MULTI_LAUNCH
constexpr int MEGA_LDS = pg8::STAGE_BYTES + 512;
struct MegaArgs { const void* p[37]; };
__global__ void __launch_bounds__(512, 2) mega_fwd(MegaArgs a) {
    extern __shared__ __attribute__((aligned(16))) unsigned char shm[];
    PG8_LAS unsigned char* lds = (PG8_LAS unsigned char*)shm;
    volatile LAS unsigned* xbw = (volatile LAS unsigned*)(lds + pg8::STAGE_BYTES);
    if (threadIdx.x < 4) xbw[threadIdx.x] = 0u;
    if (threadIdx.x < 37) ((PG8_LAS unsigned long long*)(lds + pg8::STAGE_BYTES + 64))[threadIdx.x] = (unsigned long long)a.p[threadIdx.x];
    __syncthreads();
    Ctx cx; cx.lds = lds;
    cx.bar = xcd_barrier_post((unsigned*)((unsigned char*)cx.inp<36>() + WS.ctl), xbw);
    cx.gtid = (int)(blockIdx.x * blockDim.x + threadIdx.x); cx.nthr = (int)(gridDim.x * blockDim.x);
    forward(cx);
}
#endif
extern "C" void kernel_launch(void* const* d_in, const int* in_sizes, int n_in, void* d_out, int out_size, void* d_ws, size_t ws_size, hipStream_t stream) {
    static int ncu = 0;
    if (ncu == 0) { int dev = 0; (void)hipGetDevice(&dev); (void)hipDeviceGetAttribute(&ncu, hipDeviceAttributeMultiprocessorCount, dev); if (ncu <= 0) ncu = 256;
#ifndef MULTI_LAUNCH
        if (hipFuncSetAttribute((const void*)mega_fwd, hipFuncAttributeMaxDynamicSharedMemorySize, MEGA_LDS) != hipSuccess) { fprintf(stderr, "kernel_launch: hipFuncSetAttribute failed\n"); }
#endif
    }
    if (n_in != 35 || ws_size < WS.end || out_size != NB * SEQ * D) { fprintf(stderr, "kernel_launch: unexpected sizes n_in %d ws %zu (need %zu) out %d\n", n_in, ws_size, (size_t)WS.end, out_size); return; }
#ifdef MULTI_LAUNCH
    const void* tbl[37]; for (int i = 0; i < 35; ++i) tbl[i] = d_in[i]; tbl[35] = d_out; tbl[36] = d_ws;
    Ctx cx{stream, ncu, tbl};
    forward(cx);
#else
    (void)hipMemsetAsync((unsigned char*)d_ws + WS.ctl, 0, 1 << 20, stream);
    MegaArgs a{}; for (int i = 0; i < 35; ++i) a.p[i] = d_in[i];
    a.p[35] = d_out; a.p[36] = d_ws;
    hipLaunchKernelGGL(mega_fwd, dim3(ncu), dim3(512), MEGA_LDS, stream, a);
#endif
}
#endif
```

```cpp
#ifndef HOST_EMU
#include <hip/hip_runtime.h>
#define HD __host__ __device__ __forceinline__
#define UNROLL _Pragma("unroll")
#else
#include <cmath>
#include <cstdio>
#include <cstdlib>
#include <cstring>
#include <cstdint>
#define HD inline
#define UNROLL
#endif
#include <math.h>
#include <stdint.h>
#include <stddef.h>
#include <stdio.h>

#ifndef CFG_NB
#define CFG_NB 8
#endif
#ifndef CFG_SEQ
#define CFG_SEQ 4096
#endif
#ifndef CFG_CTX
#define CFG_CTX 256
#endif
#ifndef CFG_DEPTH
#define CFG_DEPTH 4
#endif
constexpr int NB = CFG_NB, SEQ = CFG_SEQ, CTX = CFG_CTX, DEPTH = CFG_DEPTH;
constexpr int D = 1024, GRID_W = 64;
constexpr int RPB = CTX + SEQ;
constexpr int NR = NB * RPB;
constexpr int NBLK = RPB / 64, CB = CTX / 64;
constexpr int DPROJ = 2976, PS = 3072;
constexpr int GQ = 0, GK = 192, GV = 384, GLR = 768, GG = 784, SU = 1168, MQ = 1424, MK = 1808, MV = 2192, MO = 2576, MG = 2960;
constexpr int DFF = 2816, NE = 8;
constexpr int NMOD = NB + 1;
constexpr float EPS = 1e-6f;
constexpr int MOE_MAXT = (2 * NR + NE * 255) / 256 + 1;
#ifndef FP8_DOWN_DENSE
#define FP8_DOWN_DENSE 1
#endif
#ifndef FP8_DOWN_MOE
#define FP8_DOWN_MOE 1
#endif
constexpr int MOE_XT = MOE_MAXT;

typedef unsigned short bf16;
struct __attribute__((aligned(16))) U4 { uint32_t x, y, z, w; };
HD float bf2f(bf16 v) { uint32_t u = ((uint32_t)v) << 16; float f; memcpy(&f, &u, 4); return f; }
HD bf16 f2bf(float f) { uint32_t u; memcpy(&u, &f, 4); u += 0x7fffu + ((u >> 16) & 1u); return (bf16)(u >> 16); }
#if defined(HOST_EMU)
HD float siluf(float x) { return x / (1.0f + expf(-x)); }
HD float sigmoidf_(float x) { return 1.0f / (1.0f + expf(-x)); }
HD float logsigmoidf_(float x) { return x < 0.f ? x - log1pf(expf(x)) : -log1pf(expf(-x)); }
HD float fexp(float x) { return expf(x); }
#else
__host__ __device__ __forceinline__ float fexp(float x) { return __builtin_amdgcn_exp2f(x * 1.4426950408889634f); }
__host__ __device__ __forceinline__ float siluf(float x) { return x * __builtin_amdgcn_rcpf(1.0f + fexp(-x)); }
__host__ __device__ __forceinline__ float sigmoidf_(float x) { return __builtin_amdgcn_rcpf(1.0f + fexp(-x)); }
__host__ __device__ __forceinline__ float logsigmoidf_(float x) { return fminf(x, 0.f) - 0.6931471805599453f * __builtin_amdgcn_logf(1.0f + fexp(-fabsf(x))); }
#endif
HD float gelu_tanhf(float x) { return 0.5f * x * (1.0f + tanhf(0.7978845608028654f * (x + 0.044715f * x * x * x))); }
#ifndef HOST_EMU
typedef float f4_t __attribute__((ext_vector_type(4)));
__device__ __forceinline__ unsigned cvt_pk_bf16(float lo, float hi) { unsigned r; asm("v_cvt_pk_bf16_f32 %0, %1, %2" : "=v"(r) : "v"(lo), "v"(hi)); return r; }
__device__ __forceinline__ void store8_bf16(bf16* dst, const float* v) { uint4 w; w.x = cvt_pk_bf16(v[0], v[1]); w.y = cvt_pk_bf16(v[2], v[3]); w.z = cvt_pk_bf16(v[4], v[5]); w.w = cvt_pk_bf16(v[6], v[7]); *(uint4*)dst = w; }
__device__ __forceinline__ void load8_bf16(const bf16* src, float* v) { const uint4 w = *(const uint4*)src; const unsigned u[4] = {w.x, w.y, w.z, w.w};
#pragma unroll
    for (int i = 0; i < 4; ++i) { v[2 * i] = __uint_as_float(u[i] << 16); v[2 * i + 1] = __uint_as_float(u[i] & 0xffff0000u); } }
__device__ __forceinline__ float fast_silu(float x) { return x * __builtin_amdgcn_rcpf(1.0f + __expf(-x)); }
__device__ __forceinline__ float fast_sigmoid(float x) { return __builtin_amdgcn_rcpf(1.0f + __expf(-x)); }
#endif
HD int mod_index(int r) { const int b = r / RPB, t = r % RPB; return t < CTX ? NB : b; }
HD int chain_blk(int d, int step) { return d == 0 ? step : (step < CB ? CB - 1 - step : NBLK - 1 - (step - CB)); }
HD int blk_row(int b, int blk, int d, int pp) { return b * RPB + blk * 64 + (d == 0 ? pp : 63 - pp); }

constexpr size_t LA_NI = (size_t)NB * NBLK * 4;
HD size_t tile_off(int row, int col, int KT) { return ((size_t)((row >> 4) * KT + (col >> 5)) * 64 + (size_t)((((col & 31) >> 3) << 4) + (row & 15))) * 8 + (col & 7); }
template <int DKP, int NV> struct LaLay {
    static constexpr int KQ = DKP / 32;
    static constexpr size_t qin = 0;
    static constexpr size_t kin = qin + (size_t)2 * NR * 4 * DKP;
    static constexpr size_t koutT = kin + (size_t)2 * NR * 4 * DKP;
    static constexpr size_t vT = koutT + (size_t)2 * LA_NI * DKP * 64;
    static constexpr size_t sT = vT + LA_NI * NV * 64;
    static constexpr size_t dec = sT + (size_t)2 * LA_NI * NV * DKP;
    static constexpr size_t end = dec + (size_t)2 * 2 * LA_NI * DKP;
    HD static size_t q_at(int d, size_t item, int tok, int i) { return qin + ((size_t)d * LA_NI + item) * 64 * DKP + tile_off(tok, i, KQ); }
    HD static size_t k_at(int d, size_t item, int tok, int i) { return kin + ((size_t)d * LA_NI + item) * 64 * DKP + tile_off(tok, i, KQ); }
    HD static size_t kt_at(int d, size_t item, int i, int tok) { return koutT + ((size_t)d * LA_NI + item) * DKP * 64 + tile_off(i, tok, 2); }
    HD static size_t v_at(size_t item, int j, int tok) { return vT + item * NV * 64 + tile_off(j, tok, 2); }
    HD static size_t s_at(int d, size_t item, int j, int i) { return sT + ((size_t)d * LA_NI + item) * NV * DKP + tile_off(j, i, KQ); }
};
constexpr size_t al256(size_t x) { return (x + 255) & ~(size_t)255; }
struct WsMap {
    size_t ctl, mod, silc, postab, h, abuf, winT, woutT, w13T, w2T, uni, end_fixed;
    size_t pbuf, lab, labg, obuf, s5tab, s5uG, s5est, zbuf, end_mix;
    size_t act, end_ffn;
    size_t mw13T, mw2T, xs8, mact, yrow, rt_e, rt_w, rt_dest, segcnt, ecnt, row_token, tile_e, ntile, end_moe;
    size_t end;
};
constexpr WsMap make_map() {
    WsMap m{}; size_t o = 0;
    m.ctl = o; o += 1 << 20;
    m.mod = o; o += al256((size_t)DEPTH * NMOD * 6 * D * 4);
    m.silc = o; o += al256((size_t)NMOD * D * 4);
    m.postab = o; o += al256((size_t)2 * GRID_W * 512 * 4);
    m.h = o; o += al256((size_t)NR * D * 4);
    m.abuf = o;
    m.winT = o; o += al256((size_t)DEPTH * PS * D * 2);
    m.woutT = o; o += al256((size_t)DEPTH * D * D * 2);
    m.w13T = o; o += al256((size_t)((DEPTH + 1) / 2) * 2 * DFF * D * 2);
    m.w2T = o; o += al256((size_t)((DEPTH + 1) / 2) * D * DFF * 2);
    m.uni = o; m.end_fixed = o;
    o = m.uni;
    m.pbuf = o; o += al256((size_t)NR * PS * 2);
    m.lab = o;
    { size_t o2 = m.lab;
      m.s5uG = o2; o2 += al256((size_t)16 * ((NB * NBLK + 255) / 256 * 256) * 1280 * 2);
      m.s5est = o2; o2 += al256((size_t)16 * ((NB * NBLK + 255) / 256 * 256) * 256 * 4);
      m.zbuf = o2; o2 += al256((size_t)NR * 256 * 2);
      const size_t la_bytes = al256(LaLay<96, 112>::end * 2);
      o = m.lab + (la_bytes > o2 - m.lab ? la_bytes : o2 - m.lab); }
    m.labg = o; o += al256(LaLay<64, 96>::end * 2);
    m.obuf = o;
#ifdef HOST_EMU
    o += al256((size_t)NR * 384 * 4);
    m.s5tab = o; o += (size_t)64 << 20;
#endif
    m.end_mix = o;
    o = m.uni;
    m.act = o; o += al256((size_t)NR * DFF * 2);
    m.end_ffn = o;
    o = m.uni;
    m.mw13T = o; o += al256((size_t)NE * 2 * DFF * D);
#ifdef HOST_EMU
    o += al256((size_t)NE * 2 * DFF * D);
#endif
    m.mw2T = o; o += al256((size_t)NE * D * DFF * 2);
    m.xs8 = o; o += al256((size_t)MOE_XT * 256 * D);
#if FP8_DOWN_MOE && !defined(HOST_EMU)
    m.mact = o; o += al256((size_t)MOE_MAXT * 256 * DFF);
#else
    m.mact = o; o += al256((size_t)MOE_MAXT * 256 * DFF * 2);
#endif
    m.yrow = o; o += al256((size_t)MOE_MAXT * 256 * D * 2);
    m.rt_e = o; o += al256((size_t)NR * 2 * 4);
    m.rt_w = o; o += al256((size_t)NR * 2 * 4);
    m.rt_dest = o; o += al256((size_t)NR * 2 * 4);
    m.segcnt = o; o += al256((size_t)NE * (NR / 64 + 1) * 4);
    m.ecnt = o; o += al256((size_t)64 * 4);
    m.row_token = o; o += al256((size_t)MOE_MAXT * 256 * 4);
    m.tile_e = o; o += al256((size_t)MOE_MAXT * 4);
    m.ntile = o; o += 256;
    m.end_moe = o;
    m.end = m.end_mix > m.end_moe ? m.end_mix : m.end_moe; if (m.end_ffn > m.end) m.end = m.end_ffn;
    return m;
}
constexpr WsMap WS = make_map();
struct S5Tab { size_t disc, K, apow, bbar, TB, EB, gluT, end; };
constexpr S5Tab make_s5tab() { S5Tab t{}; size_t o = 0;
    t.disc = o; o += al256((size_t)2 * 16 * 64 * 4 * 4); t.K = o; o += al256((size_t)2 * 16 * 64 * 256 * 4); t.apow = o; o += al256((size_t)2 * 16 * 65 * 64 * 2 * 4); t.bbar = o; o += al256((size_t)2 * 16 * 64 * 16 * 2 * 4);
    t.TB = o; o += al256((size_t)16 * 1024 * 1280 * 2); t.EB = o; o += al256((size_t)16 * 256 * 1024 * 2); t.gluT = o; o += al256((size_t)256 * 256 * 2); t.end = o; return t; }
constexpr S5Tab S5T = make_s5tab();
constexpr size_t ABUF_BYTES = al256((size_t)NR * D * 2);
#ifndef HOST_EMU
static_assert(ABUF_BYTES + S5T.end <= (size_t)NB * SEQ * D * 4, "the bf16 row buffer and the S5 tables must fit in d_out");
#endif

struct PosTab { long n; float* tab;
    HD void operator()(long i) const { const int cc = (int)(i % 512); const int pos = (int)((i / 512) % GRID_W); const int j = cc & 255; const float omega = expf(-9.210340371976184f * (float)j / 256.0f); const float ang = (float)pos * omega;
        tab[i] = (cc & 256) ? cosf(ang) : sinf(ang); } };
struct __attribute__((aligned(16))) F4 { float x, y, z, w; };
struct InitH { long n; const float* x; const float* ctx; const float* tab; float* h;
    HD void operator()(long i) const { const int r = (int)(i / (D / 4)), c = (int)(i % (D / 4)) * 4; const int b = r / RPB, t = r % RPB; F4 v;
        if (t < CTX) v = *(const F4*)(ctx + ((size_t)b * CTX + t) * D + c);
        else { const int tl = t - CTX, row = tl / GRID_W, col = tl % GRID_W; const F4 xv = *(const F4*)(x + ((size_t)b * SEQ + tl) * D + c);
            const F4 pe = *(const F4*)(tab + (c < 512 ? (size_t)row * 512 + c : (size_t)(GRID_W + col) * 512 + (c - 512))); v.x = xv.x + pe.x; v.y = xv.y + pe.y; v.z = xv.z + pe.z; v.w = xv.w + pe.w; }
        *(F4*)(h + (size_t)r * D + c) = v; } };
struct ModK { long n; const float* c; const float* cctx; const float* w_ada; const float* b_ada; float* mod;
    HD void operator()(long i) const { const int l = (int)(i / (6 * D)), j = (int)(i % (6 * D));
        float acc[NMOD];
        for (int m = 0; m < NMOD; ++m) acc[m] = b_ada[(size_t)l * 6 * D + j];
        const float* w = w_ada + (size_t)l * D * 6 * D + j;
        for (int k = 0; k < D; ++k) { const float wv = w[(size_t)k * 6 * D];
            for (int m = 0; m < NMOD; ++m) { const float cv = (m < NB) ? c[m * D + k] : cctx[k]; acc[m] += siluf(cv) * wv; } }
        for (int m = 0; m < NMOD; ++m) mod[((size_t)l * NMOD + m) * 6 * D + j] = acc[m]; } };
struct TransposeK { long n; const float* a; const float* b; bf16* dst; int K, N, NP, pad;
    HD void operator()(long i) const { const int nn = (int)(i / K), k = (int)(i % K);
        float v = 0.f;
        if (b) { const int j = nn >> 1; v = (nn & 1) ? b[(size_t)k * N + j] : a[(size_t)k * N + j]; }
        else if (nn < N) v = a[(size_t)k * N + nn];
        dst[i] = f2bf(v); } };
struct NormModK { long n; const float* h; const float* g; const float* mod; int sh_off, sc_off; bf16* out; const float* wr; int* rt_e; float* rt_w; int skip_ctx, nseg; int* segcnt;
    HD void operator()(long r) const { const float* hr = h + (size_t)r * D; float ss = 0.f;
        for (int k = 0; k < D; ++k) ss += hr[k] * hr[k];
        const float rstd = 1.0f / sqrtf(ss / D + EPS); const float* m = mod + (size_t)mod_index((int)r) * 6 * D;
        float lg[NE]; for (int e = 0; e < NE; ++e) lg[e] = 0.f;
        for (int k = 0; k < D; ++k) { const float v = hr[k] * rstd * g[k] * (1.0f + m[sc_off + k]) + m[sh_off + k]; out[(size_t)r * D + k] = f2bf(v);
            if (wr) for (int e = 0; e < NE; ++e) lg[e] += v * wr[k * NE + e]; }
        if (wr) { int e0 = 0; float b0 = lg[0]; for (int e = 1; e < NE; ++e) if (lg[e] > b0) { b0 = lg[e]; e0 = e; }
            int e1 = -1; float b1 = -3.0e38f; for (int e = 0; e < NE; ++e) if (e != e0 && lg[e] > b1) { b1 = lg[e]; e1 = e; }
            const float w1 = 1.0f / (1.0f + expf(b1 - b0));
            const bool skip = skip_ctx && ((int)(r % RPB) < CTX);
            rt_e[2 * r] = skip ? -1 : e0; rt_e[2 * r + 1] = skip ? -1 : e1; rt_w[2 * r] = w1; rt_w[2 * r + 1] = 1.0f - w1;
            if (!skip) { __atomic_fetch_add(&segcnt[(size_t)e0 * nseg + r / 64], 1, __ATOMIC_RELAXED); __atomic_fetch_add(&segcnt[(size_t)e1 * nseg + r / 64], 1, __ATOMIC_RELAXED); } } } };

struct SiluC { long n; const float* c; const float* cctx; float* sc;
    HD void operator()(long i) const { const int m = (int)(i / D), k = (int)(i % D); sc[i] = siluf(m < NB ? c[m * D + k] : cctx[k]); } };
constexpr int A8S = 2;
constexpr int W8S = 6;
constexpr int MODKC = 8;
struct ModPart { long n; const float* sc; const float* w_ada; float* part;
    HD void operator()(long i) const { const int j = (int)(i % (6 * D)); long y = i / (6 * D); const int l = (int)(y % DEPTH), kc = (int)(y / DEPTH);
        float acc[NMOD]; for (int m = 0; m < NMOD; ++m) acc[m] = 0.f;
        const float* w = w_ada + ((size_t)l * D + (size_t)kc * (D / MODKC)) * 6 * D + j; const float* s0 = sc + kc * (D / MODKC);
        for (int k = 0; k < D / MODKC; ++k) { const float wv = w[(size_t)k * 6 * D];
            for (int m = 0; m < NMOD; ++m) acc[m] += s0[m * D + k] * wv; }
        for (int m = 0; m < NMOD; ++m) part[(((size_t)kc * DEPTH + l) * NMOD + m) * 6 * D + j] = acc[m]; } };
struct ModReduce { long n; const float* part; const float* b_ada; float* mod;
    HD void operator()(long i) const { const int j = (int)(i % (6 * D)); long y = i / (6 * D); const int m = (int)(y % NMOD), l = (int)(y / NMOD); float a = b_ada[(size_t)l * 6 * D + j];
        for (int kc = 0; kc < MODKC; ++kc) a += part[(((size_t)kc * DEPTH + l) * NMOD + m) * 6 * D + j];
        mod[i] = a; } };
struct ZeroBf16 { long n; bf16* p; HD void operator()(long i) const { p[i] = 0; } };
HD uint32_t pk2(float lo, float hi) { return (uint32_t)f2bf(lo) | ((uint32_t)f2bf(hi) << 16); }
struct GlaFused { long n; const bf16* p; const float* wa2; const float* ba; bf16* lab;
    struct Ld { U4 l0[4], l1[4]; bf16 q[4], k[4]; };
    HD void load4(Ld& L_, const bf16* pe, int pstep, int j) const { UNROLL for (int e = 0; e < 4; ++e) { const bf16* pt = pe + e * pstep; const U4* lr = (const U4*)(pt + GLR); L_.l0[e] = lr[0]; L_.l1[e] = lr[1]; L_.q[e] = pt[GQ + j]; L_.k[e] = pt[GK + j]; } }
    HD void operator()(long x) const { typedef LaLay<64, 96> L; const int xi = (int)x; const int j = xi % 192; int y = xi / 192; const int blk = y % NBLK; y /= NBLK; const int b = y % NB, d = y / NB;
        const int hh = j / 48, i = j % 48; const size_t item = (size_t)(b * NBLK + blk) * 4 + hh; float w[16]; UNROLL for (int q = 0; q < 16; ++q) w[q] = wa2[(d * 16 + q) * 192 + j];
        const float bj = ba[d * 192 + j]; float c = 0.f;
        const int s_first = d == 0 ? 0 : 63, dir = d == 0 ? 1 : -1; const int r_first = b * RPB + blk * 64 + s_first;
        const bf16* pr = p + (size_t)r_first * PS; const int pstep = dir * PS; Ld cur, nxt; load4(cur, pr, pstep, j); float ko[8];
        for (int g4 = 0; g4 < 16; ++g4) {
            if (g4 < 15) load4(nxt, pr + 4 * pstep, pstep, j);
            UNROLL for (int e = 0; e < 4; ++e) { const uint32_t u[8] = {cur.l0[e].x, cur.l0[e].y, cur.l0[e].z, cur.l0[e].w, cur.l1[e].x, cur.l1[e].y, cur.l1[e].z, cur.l1[e].w}; float z = bj;
                UNROLL for (int q = 0; q < 8; ++q) { z += bf2f((bf16)(u[q] & 0xffffu)) * w[2 * q]; z += bf2f((bf16)(u[q] >> 16)) * w[2 * q + 1]; }
                c += logsigmoidf_(z) * (1.0f / 16.0f); const float kk = bf2f(cur.k[e]) * fexp(-c); const int tok = s_first + dir * (g4 * 4 + e);
                lab[L::q_at(d, item, tok, i)] = f2bf(bf2f(cur.q[e]) * 0.14433756729740643f * fexp(c)); lab[L::k_at(d, item, tok, i)] = f2bf(kk); ko[(g4 & 1) * 4 + e] = kk;
                if (i < 16) { lab[L::q_at(d, item, tok, 48 + i)] = 0; lab[L::k_at(d, item, tok, 48 + i)] = 0; } }
            pr += 4 * pstep;
            if (g4 & 1) { U4 v; const int c8 = g4 >> 1; const int s0 = d == 0 ? c8 * 8 : 56 - c8 * 8;
                v.x = d == 0 ? pk2(ko[0], ko[1]) : pk2(ko[7], ko[6]); v.y = d == 0 ? pk2(ko[2], ko[3]) : pk2(ko[5], ko[4]); v.z = d == 0 ? pk2(ko[4], ko[5]) : pk2(ko[3], ko[2]); v.w = d == 0 ? pk2(ko[6], ko[7]) : pk2(ko[1], ko[0]);
                *(U4*)(lab + L::kt_at(d, item, i, s0)) = v; if (i < 16) { U4 zz; zz.x = zz.y = zz.z = zz.w = 0u; *(U4*)(lab + L::kt_at(d, item, 48 + i, s0)) = zz; } }
            cur = nxt; }
        float* dec = (float*)(lab + L::dec) + ((size_t)d * LA_NI + item) * 64; dec[i] = fexp(c); if (i < 16) dec[48 + i] = 0.f; } };
template <int NV, int VOFF> struct VTFused { long n; const bf16* p; bf16* vT;
    HD void operator()(long x) const { const int xi = (int)x; const int j = xi % NV; const int item = xi / NV; const int hh = item % 4; const int bb = item / 4; const int r0 = (bb / NBLK) * RPB + (bb % NBLK) * 64;
        const bf16* pc = p + (size_t)r0 * PS + VOFF + hh * 96 + (j < 96 ? j : 0); const uint32_t fill = j == 96 ? 0x3f803f80u : 0u; uint32_t t[32];
        UNROLL for (int q = 0; q < 32; ++q) t[q] = (uint32_t)pc[(2 * q) * PS] | ((uint32_t)pc[(2 * q + 1) * PS] << 16);
        UNROLL for (int c8 = 0; c8 < 8; ++c8) { U4 v; v.x = j < 96 ? t[4 * c8] : fill; v.y = j < 96 ? t[4 * c8 + 1] : fill; v.z = j < 96 ? t[4 * c8 + 2] : fill; v.w = j < 96 ? t[4 * c8 + 3] : fill;
            *(U4*)(vT + (size_t)item * NV * 64 + tile_off(j, 8 * c8, 2)) = v; } } };
struct MlFused { long n; const bf16* p; const float* cw; const float* cb; const float* gb; bf16* lab;
    struct Ld { bf16 q[4][3], k[4][3], gi[4], gf[4]; };
    HD void load4(Ld& L_, const bf16* pe, int pstep, int t0, int dir, int cq, int ck, int gi, int gf) const {
        UNROLL for (int e = 0; e < 4; ++e) { const int t = t0 + dir * e; const bool first = (t == 0 || t == CTX), last = (t == CTX - 1 || t == RPB - 1); const bf16* pt = pe + e * pstep;
            L_.q[e][1] = pt[cq]; L_.k[e][1] = pt[ck]; L_.q[e][0] = first ? (bf16)0 : pt[cq - PS]; L_.k[e][0] = first ? (bf16)0 : pt[ck - PS]; L_.q[e][2] = last ? (bf16)0 : pt[cq + PS]; L_.k[e][2] = last ? (bf16)0 : pt[ck + PS];
            L_.gi[e] = pt[gi]; L_.gf[e] = pt[gf]; } }
    HD void operator()(long x) const { typedef LaLay<96, 112> L; const int xi = (int)x; const int i = xi % 96; int y = xi / 96; const int hh = y % 4; y /= 4; const int blk = y % NBLK; y /= NBLK; const int b = y % NB, d = y / NB;
        const size_t item = (size_t)(b * NBLK + blk) * 4 + hh; const int cq = MQ + hh * 96 + i, ck = MQ + 384 + hh * 96 + i;
        const float q0 = cw[cq - MQ], q1 = cw[768 + cq - MQ], q2 = cw[1536 + cq - MQ], qb = cb[cq - MQ], k0 = cw[ck - MQ], k1 = cw[768 + ck - MQ], k2 = cw[1536 + ck - MQ], kb = cb[ck - MQ];
        const int gi = MG + (2 * d) * 4 + hh, gf = MG + (2 * d + 1) * 4 + hh; const float bi = gb[(2 * d) * 4 + hh], bf_ = gb[(2 * d + 1) * 4 + hh]; float Fc = 0.f;
        const int s_first = d == 0 ? 0 : 63, dir = d == 0 ? 1 : -1; const int t_first = blk * 64 + s_first; const int r_first = b * RPB + t_first;
        const bf16* pr = p + (size_t)r_first * PS; const int pstep = dir * PS; Ld cur, nxt; load4(cur, pr, pstep, t_first, dir, cq, ck, gi, gf); float ko[8];
        for (int g4 = 0; g4 < 16; ++g4) {
            if (g4 < 15) load4(nxt, pr + 4 * pstep, pstep, t_first + dir * (g4 * 4 + 4), dir, cq, ck, gi, gf);
            UNROLL for (int e = 0; e < 4; ++e) { const float yq = q0 * bf2f(cur.q[e][0]) + q1 * bf2f(cur.q[e][1]) + q2 * bf2f(cur.q[e][2]), yk = k0 * bf2f(cur.k[e][0]) + k1 * bf2f(cur.k[e][1]) + k2 * bf2f(cur.k[e][2]);
                const float qc = siluf(yq + qb), kc = siluf(yk + kb) * 0.10206207261596577f; Fc += logsigmoidf_(bf2f(cur.gf[e]) + bf_); const float kk = kc * fexp(bf2f(cur.gi[e]) + bi - Fc); const int tok = s_first + dir * (g4 * 4 + e);
                lab[L::q_at(d, item, tok, i)] = f2bf(qc * fexp(Fc)); lab[L::k_at(d, item, tok, i)] = f2bf(kk); ko[(g4 & 1) * 4 + e] = kk; }
            pr += 4 * pstep;
            if (g4 & 1) { U4 v; const int c8 = g4 >> 1; const int s0 = d == 0 ? c8 * 8 : 56 - c8 * 8;
                v.x = d == 0 ? pk2(ko[0], ko[1]) : pk2(ko[7], ko[6]); v.y = d == 0 ? pk2(ko[2], ko[3]) : pk2(ko[5], ko[4]); v.z = d == 0 ? pk2(ko[4], ko[5]) : pk2(ko[3], ko[2]); v.w = d == 0 ? pk2(ko[6], ko[7]) : pk2(ko[1], ko[0]);
                *(U4*)(lab + L::kt_at(d, item, i, s0)) = v; }
            cur = nxt; }
        ((float*)(lab + L::dec))[((size_t)d * LA_NI + item) * 96 + i] = fexp(Fc); } };
template <int DKP, int NV> struct StatesRef { long n; bf16* lab;
    HD void operator()(long x) const { typedef LaLay<DKP, NV> L; const int i = (int)(x % DKP); long y = x / DKP; const int j = (int)(y % NV); y /= NV; const size_t item = (size_t)(y % LA_NI); const int d = (int)(y / LA_NI); float acc = 0.f;
        for (int sx = 0; sx < 64; ++sx) acc += bf2f(lab[L::v_at(item, j, sx)]) * bf2f(lab[L::kt_at(d, item, i, sx)]);
        lab[L::s_at(d, item, j, i)] = f2bf(acc); } };
constexpr int CARRY_CH = (NBLK % 17 == 0) ? 17 : ((NBLK % 4 == 0) ? 4 : 1);
template <int DKP, int NV> struct CarryT { long n; bf16* lab;
    HD void operator()(long x) const { typedef LaLay<DKP, NV> L; const int xi = (int)x; const int i = xi % DKP; int y = xi / DKP; const int j = y % NV; y /= NV; const int hh = y % 4; y /= 4; const int b = y % NB, d = y / NB;
        const float* dec = (const float*)(lab + L::dec); float sv = 0.f;
        for (int step = 0; step < NBLK; ++step) { const size_t item = (size_t)(b * NBLK + chain_blk(d, step)) * 4 + hh; const size_t o = L::s_at(d, item, j, i);
            const float tv = bf2f(lab[o]), dv = dec[((size_t)d * LA_NI + item) * DKP + i]; lab[o] = f2bf(sv); sv = dv * (sv + tv); } } };
template <int DKP, int NV, bool ISML> struct OutRef { long n; const bf16* lab; float* obuf;
    HD void operator()(long x) const { typedef LaLay<DKP, NV> L; const int j = (int)(x % 96); long y = x / 96; const int hh = (int)(y % 4); const int r = (int)(y / 4); const int b = r / RPB, t = r % RPB, blk = t / 64, tt = t % 64;
        const size_t item = ((size_t)b * NBLK + blk) * 4 + hh; float hv = 0.f;
        for (int d = 0; d < 2; ++d) { float num = 0.f, den = 0.f;
            for (int sx = 0; sx < 64; ++sx) { const bool valid = d == 0 ? (sx <= tt) : (sx >= tt); if (!valid) continue;
                float a = 0.f; for (int i = 0; i < DKP; ++i) a += bf2f(lab[L::q_at(d, item, tt, i)]) * bf2f(lab[L::k_at(d, item, sx, i)]);
                a = bf2f(f2bf(a)); num += a * bf2f(lab[L::v_at(item, j, sx)]); if (ISML) den += a * bf2f(lab[L::v_at(item, 96, sx)]); }
            for (int i = 0; i < DKP; ++i) { const float qv = bf2f(lab[L::q_at(d, item, tt, i)]); num += qv * bf2f(lab[L::s_at(d, item, j, i)]); if (ISML) den += qv * bf2f(lab[L::s_at(d, item, 96, i)]); }
            hv += ISML ? num / fmaxf(fabsf(den), 1.0f) : num; }
        obuf[x] = hv; } };
struct HeadFin { long n; const bf16* p; const float* obuf; const float* gain; bf16* mix; int mode, pad;
    HD void operator()(long x) const { const int hh = (int)(x % 4), r = (int)(x / 4); const float* o = obuf + (size_t)r * 384 + hh * 96; float ss = 0.f;
        for (int j = 0; j < 96; ++j) ss += o[j] * o[j];
        const float rstd = 1.0f / sqrtf(ss / 96.0f + EPS);
        for (int j = 0; j < 96; ++j) { const float gv = bf2f(p[(size_t)r * PS + (mode ? MO : GG) + hh * 96 + j]); const float gt = mode ? sigmoidf_(gv) : siluf(gv);
            mix[(size_t)r * D + (mode ? 640 : 0) + hh * 96 + j] = f2bf(o[j] * rstd * gain[j] * gt); } } };

struct S5Disc { long n; const float* lre; const float* lim; const float* ldt; float* disc;
    HD void operator()(long x) const { const int nn = (int)(x % 64); const int dg = (int)(x / 64); const float dt = expf(ldt[dg]); const float lr = lre[x], li = lim[x];
        const float mag = expf(lr * dt), ar = mag * cosf(li * dt), ai = mag * sinf(li * dt), den = lr * lr + li * li, pr = ar - 1.0f, pi = ai;
        disc[x * 4 + 0] = lr * dt; disc[x * 4 + 1] = li * dt; disc[x * 4 + 2] = (pr * lr + pi * li) / den; disc[x * 4 + 3] = (pi * lr - pr * li) / den; (void)nn; } };
HD void s5_apow(const float* disc4, float tau, float& ar, float& ai) { const float mag = expf(disc4[0] * tau); ar = mag * cosf(disc4[1] * tau); ai = mag * sinf(disc4[1] * tau); }
struct ZeroInt { long n; int* p; HD void operator()(long i) const { p[i] = 0; } };
struct MoePrefix { long n; int* segcnt; int* ecnt; int nseg, pad;
    HD void operator()(long e) const { int c = 0; for (int sg = 0; sg < nseg; ++sg) { const int v = segcnt[(size_t)e * nseg + sg]; segcnt[(size_t)e * nseg + sg] = c; c += v; } ecnt[e] = c; } };
struct MoeTiles2 { long n; const int* ecnt; int* tile_e; int* ntile;
    HD void operator()(long t) const { int acc = 0, ef = 0; for (int e = 0; e < NE; ++e) { const int nt = (ecnt[e] + 255) / 256; if (t >= acc && t < acc + nt) ef = e; acc += nt; } tile_e[t] = ef; if (t == 0) ntile[0] = acc; } };
struct MoeFillNeg { long n; int* row_token; HD void operator()(long i) const { row_token[i] = -1; } };
struct MoeAssign { long n; const int* rt_e; const int* segcnt; const int* ecnt; int* rt_dest; int* row_token; int nseg, pad;
    HD void operator()(long x) const { const int seg = (int)(x % nseg), e = (int)(x / nseg); int pstart = 0; for (int q = 0; q < e; ++q) pstart += (ecnt[q] + 255) / 256 * 256;
        int pos = pstart + segcnt[(size_t)e * nseg + seg];
        for (int r = seg * 64; r < seg * 64 + 64 && r < NR; ++r) for (int k = 0; k < 2; ++k) if (rt_e[2 * r + k] == e) { rt_dest[2 * r + k] = pos; row_token[pos] = r; ++pos; } } };
struct MoeGather8 { long n; const unsigned char* f8; const int* row_token; unsigned char* xs; int row0, pad;
    HD void operator()(long i) const { const int lr = (int)(i / (D / 16)), c = (int)(i % (D / 16)) * 16; const int tok = row_token[row0 + lr];
        U4 v; v.x = v.y = v.z = v.w = 0u; if (tok >= 0) v = *(const U4*)(f8 + (size_t)tok * D + c); *(U4*)(xs + (size_t)lr * D + c) = v; } };
struct MoeCombine { long n; float* h; const bf16* yrow; const int* rt_e; const float* rt_w; const int* rt_dest; const float* mod; int g_off, pad;
    HD void operator()(long i) const { const int r = (int)(i / (D / 8)), c = (int)(i % (D / 8)) * 8; if (rt_e[2 * r] < 0) return;
        const U4 y0 = *(const U4*)(yrow + (size_t)rt_dest[2 * r] * D + c), y1 = *(const U4*)(yrow + (size_t)rt_dest[2 * r + 1] * D + c); const float w0 = rt_w[2 * r], w1 = rt_w[2 * r + 1];
        const float* g = mod + (size_t)mod_index(r) * 6 * D + g_off + c; float* hp = h + (size_t)r * D + c; const F4 g0 = *(const F4*)g, g1 = *(const F4*)(g + 4); F4 h0 = *(const F4*)hp, h1 = *(const F4*)(hp + 4);
        const uint32_t a[4] = {y0.x, y0.y, y0.z, y0.w}, bq[4] = {y1.x, y1.y, y1.z, y1.w}; float yv[8];
        UNROLL for (int q = 0; q < 4; ++q) { yv[2 * q] = w0 * bf2f((bf16)(a[q] & 0xffffu)) + w1 * bf2f((bf16)(bq[q] & 0xffffu)); yv[2 * q + 1] = w0 * bf2f((bf16)(a[q] >> 16)) + w1 * bf2f((bf16)(bq[q] >> 16)); }
        h0.x += g0.x * yv[0]; h0.y += g0.y * yv[1]; h0.z += g0.z * yv[2]; h0.w += g0.w * yv[3]; h1.x += g1.x * yv[4]; h1.y += g1.y * yv[5]; h1.z += g1.z * yv[6]; h1.w += g1.w * yv[7];
        *(F4*)hp = h0; *(F4*)(hp + 4) = h1; } };
struct FinalNorm { long n; const float* h; const float* g; float* out;
    HD void operator()(long x) const { const int b = (int)(x / SEQ), tl = (int)(x % SEQ); const float* hr = h + ((size_t)b * RPB + CTX + tl) * D; float ss = 0.f;
        for (int k = 0; k < D; ++k) ss += hr[k] * hr[k];
        const float rstd = 1.0f / sqrtf(ss / D + EPS); for (int k = 0; k < D; ++k) out[(size_t)x * D + k] = hr[k] * rstd * g[k]; } };

struct EpiStoreBf16 { bf16* out; int ld; int row_off;
    HD void apply8(int row, int col0, const float* v) const { bf16* o = out + (size_t)(row - row_off) * ld + col0;
#ifndef HOST_EMU
        store8_bf16(o, v);
#else
        for (int i = 0; i < 8; ++i) o[i] = f2bf(v[i]);
#endif
    } };
struct EpiSwiGLU { bf16* out; int ld; int row_off;
    HD void apply8(int row, int col0, const float* v) const { bf16* o = out + (size_t)(row - row_off) * ld + col0 / 2;
#ifndef HOST_EMU
        uint2 w; w.x = cvt_pk_bf16(fast_silu(v[0]) * v[1], fast_silu(v[2]) * v[3]); w.y = cvt_pk_bf16(fast_silu(v[4]) * v[5], fast_silu(v[6]) * v[7]); *(uint2*)o = w;
#else
        for (int i = 0; i < 4; ++i) o[i] = f2bf(siluf(v[2 * i]) * v[2 * i + 1]);
#endif
    } };
#ifndef HOST_EMU
struct EpiSwiGLU8 { unsigned char* out; int ld; int row_off;
    __device__ __forceinline__ void apply8(int row, int col0, const float* v) const { unsigned char* o = out + (size_t)(row - row_off) * ld + col0 / 2; const float sc = (float)(1 << A8S);
        float a0 = fast_silu(v[0]) * v[1] * sc, a1 = fast_silu(v[2]) * v[3] * sc, a2 = fast_silu(v[4]) * v[5] * sc, a3 = fast_silu(v[6]) * v[7] * sc;
        a0 = __builtin_amdgcn_fmed3f(a0, -440.f, 440.f); a1 = __builtin_amdgcn_fmed3f(a1, -440.f, 440.f); a2 = __builtin_amdgcn_fmed3f(a2, -440.f, 440.f); a3 = __builtin_amdgcn_fmed3f(a3, -440.f, 440.f);
        int w = 0; w = __builtin_amdgcn_cvt_pk_fp8_f32(a0, a1, w, false); w = __builtin_amdgcn_cvt_pk_fp8_f32(a2, a3, w, true); *(unsigned*)o = (unsigned)w; } };
#endif
struct EpiResid { float* h; const float* mod; int g_off, pad;
    HD void apply8(int row, int col0, const float* v) const { float* o = h + (size_t)row * D + col0; const float* g = mod + (size_t)mod_index(row) * 6 * D + g_off + col0;
#ifndef HOST_EMU
        const f4_t g0 = *(const f4_t*)g, g1 = *(const f4_t*)(g + 4); f4_t h0 = *(const f4_t*)o, h1 = *(const f4_t*)(o + 4);
        h0 += g0 * (f4_t){v[0], v[1], v[2], v[3]}; h1 += g1 * (f4_t){v[4], v[5], v[6], v[7]}; *(f4_t*)o = h0; *(f4_t*)(o + 4) = h1;
#else
        for (int i = 0; i < 8; ++i) o[i] += g[i] * v[i];
#endif
    } };

struct GemmDesc { const bf16* A; const bf16* Bt; const int* tile_e; const int* ntile; const int* arow; size_t e_stride; int M, N, K, tile0, lda, ldb, tdiv, pad; };
HD GemmDesc mk_gemm(const bf16* A, int lda, const bf16* Bt, int ldb, int M, int N, int K) { return GemmDesc{A, Bt, nullptr, nullptr, nullptr, 0, M, N, K, 0, lda, ldb, 0, 0}; }

constexpr int S5RB = NB * NBLK;
constexpr int S5RG = (S5RB + 255) / 256 * 256;
constexpr int S5K_ = 1280;
HD void s5_bbar(const float* d4, float br, float bi, float& bbr, float& bbi) { bbr = d4[2] * br - d4[3] * bi; bbi = d4[2] * bi + d4[3] * br; }
struct S5Apow { long n; const float* lre; const float* lim; const float* ldt; float* apow;
    HD void operator()(long x) const { const int nn = (int)(x % 64); long y = x / 64; const int tau = (int)(y % 65); const int dg = (int)(y / 65); const float dt = expf(ldt[dg]);
        const float lr = lre[(size_t)dg * 64 + nn] * dt, li = lim[(size_t)dg * 64 + nn] * dt; const float mag = expf(lr * (float)tau); apow[x * 2] = mag * cosf(li * (float)tau); apow[x * 2 + 1] = mag * sinf(li * (float)tau); } };
struct S5Bbar { long n; const float* disc; const float* bre; const float* bim; float* bbar;
    HD void operator()(long x) const { const int pp = (int)(x % 16); long y = x / 16; const int nn = (int)(y % 64); y /= 64; const int g = (int)(y % 16), d = (int)(y / 16); (void)d;
        const float* d4 = disc + (y * 64 + nn) * 4; float br, bi; s5_bbar(d4, bre[((size_t)g * 64 + nn) * 16 + pp], bim[((size_t)g * 64 + nn) * 16 + pp], br, bi); bbar[x * 2] = br; bbar[x * 2 + 1] = bi; } };
struct S5K2 { long n; const float* apow; const float* bbar; const float* cre; const float* cim; float* Kt;
    HD void operator()(long x) const { const int p2 = (int)(x % 16); long y = x / 16; const int p1 = (int)(y % 16); y /= 16; const int tau = (int)(y % 64); y /= 64; const int g = (int)(y % 16), d = (int)(y / 16); float acc = 0.f;
        const float* ap = apow + (((size_t)d * 16 + g) * 65 + tau) * 64 * 2; const float* bb = bbar + (((size_t)d * 16 + g) * 64) * 16 * 2;
        for (int nn = 0; nn < 64; ++nn) { const float ar = ap[nn * 2], ai = ap[nn * 2 + 1], bbr = bb[(nn * 16 + p2) * 2], bbi = bb[(nn * 16 + p2) * 2 + 1];
            acc += cre[((size_t)g * 16 + p1) * 64 + nn] * (ar * bbr - ai * bbi) - cim[((size_t)g * 16 + p1) * 64 + nn] * (ar * bbi + ai * bbr); }
        Kt[x] = acc; } };
struct S5BuildTB { long n; const float* apow; const float* cre; const float* cim; const float* Kt; bf16* TB;
    HD void operator()(long x) const { const int k0 = (int)(x % (S5K_ / 8)) * 8; long y = x / (S5K_ / 8); const int tp = (int)(y % 1024), g = (int)(y / 1024); const int t = tp >> 4, p1 = tp & 15; float v[8];
        if (k0 < 1024) { const int sx = k0 >> 4, p2 = k0 & 15; const float* kf = Kt + ((((size_t)0 * 16 + g) * 64 + (sx <= t ? t - sx : 0)) * 16 + p1) * 16 + p2; const float* kb = Kt + ((((size_t)1 * 16 + g) * 64 + (sx >= t ? sx - t : 0)) * 16 + p1) * 16 + p2;
            UNROLL for (int q = 0; q < 8; ++q) v[q] = (sx <= t ? kf[q] : 0.f) + (sx >= t ? kb[q] : 0.f);
        } else { const int kk = k0 - 1024, d = kk >> 7, n0 = (kk & 127) >> 1; const int pt = d == 0 ? t : 63 - t; const float* ap = apow + ((((size_t)d * 16 + g) * 65 + pt + 1) * 64 + n0) * 2;
            UNROLL for (int q = 0; q < 4; ++q) { const float ar = ap[2 * q], ai = ap[2 * q + 1], cr = cre[((size_t)g * 16 + p1) * 64 + n0 + q], ci = cim[((size_t)g * 16 + p1) * 64 + n0 + q]; v[2 * q] = cr * ar - ci * ai; v[2 * q + 1] = -(cr * ai + ci * ar); } }
        U4 o; o.x = pk2(v[0], v[1]); o.y = pk2(v[2], v[3]); o.z = pk2(v[4], v[5]); o.w = pk2(v[6], v[7]); *(U4*)(TB + x * 8) = o; } };
struct S5BuildEB { long n; const float* apow; const float* bbar; bf16* EB;
    HD void operator()(long x) const { const int k0 = (int)(x % 128) * 8; long y = x / 128; const int col = (int)(y % 256), g = (int)(y / 256); const int d = col >> 7, nn = (col & 127) >> 1, ri = col & 1, sx = k0 >> 4, p2 = k0 & 15;
        const float* ap = apow + ((((size_t)d * 16 + g) * 65 + (d == 0 ? 63 - sx : sx)) * 64 + nn) * 2; const float* bb = bbar + ((((size_t)d * 16 + g) * 64 + nn) * 16 + p2) * 2; const float ar = ap[0], ai = ap[1]; float v[8];
        UNROLL for (int q = 0; q < 8; ++q) { const float bbr = bb[2 * q], bbi = bb[2 * q + 1]; v[q] = ri == 0 ? (ar * bbr - ai * bbi) : (ar * bbi + ai * bbr); }
        U4 o; o.x = pk2(v[0], v[1]); o.y = pk2(v[2], v[3]); o.z = pk2(v[4], v[5]); o.w = pk2(v[6], v[7]); *(U4*)(EB + x * 8) = o; } };
struct S5BuildU { long n; const bf16* p; bf16* uG;
    HD void operator()(long x) const { const int k0 = (int)(x % 128) * 8; long y = x / 128; const int rb = (int)(y % S5RB), g = (int)(y / S5RB); const int b = rb / NBLK, blk = rb % NBLK;
        *(U4*)(uG + ((size_t)g * S5RG + rb) * S5K_ + k0) = *(const U4*)(p + ((size_t)b * RPB + blk * 64 + (k0 >> 4)) * PS + SU + g * 16 + (k0 & 15)); } };
struct S5Carry2 { long n; const float* apow; const float* est; bf16* uG;
    HD void operator()(long x) const { const int nn = (int)(x % 64); long y = x / 64; const int d = (int)(y % 2); y /= 2; const int g = (int)(y % 16), b = (int)(y / 16);
        const float* ap = apow + ((((size_t)d * 16 + g) * 65 + 64) * 64 + nn) * 2; const float ar = ap[0], ai = ap[1]; float sr = 0.f, si = 0.f;
        for (int s0 = 0; s0 < NBLK; s0 += CARRY_CH) { float tr[CARRY_CH], ti[CARRY_CH];
            UNROLL for (int e = 0; e < CARRY_CH; ++e) { const size_t row = (size_t)g * S5RG + (size_t)b * NBLK + chain_blk(d, s0 + e); tr[e] = est[row * 256 + d * 128 + 2 * nn]; ti[e] = est[row * 256 + d * 128 + 2 * nn + 1]; }
            UNROLL for (int e = 0; e < CARRY_CH; ++e) { const size_t row = (size_t)g * S5RG + (size_t)b * NBLK + chain_blk(d, s0 + e);
                uG[row * S5K_ + 1024 + d * 128 + 2 * nn] = f2bf(sr); uG[row * S5K_ + 1024 + d * 128 + 2 * nn + 1] = f2bf(si);
                const float nr = ar * sr - ai * si + tr[e], ni = ar * si + ai * sr + ti[e]; sr = nr; si = ni; } } } };
struct EpiStoreF32 { float* out; int ld; int pad;
    HD void apply8(int row, int col0, const float* v) const { float* o = out + (size_t)row * ld + col0;
#ifndef HOST_EMU
        *(f4_t*)o = (f4_t){v[0], v[1], v[2], v[3]}; *(f4_t*)(o + 4) = (f4_t){v[4], v[5], v[6], v[7]};
#else
        for (int i = 0; i < 8; ++i) o[i] = v[i];
#endif
    } };
struct EpiS5Z { const bf16* p; const float* dskip; bf16* zbuf;
    HD void apply8(int row, int col0, const float* v) const { const int g = row / S5RG, rb = row % S5RG; if (rb >= S5RB) return; const int b = rb / NBLK, blk = rb % NBLK, t = col0 >> 4, p0 = col0 & 15;
        const size_t r = (size_t)b * RPB + blk * 64 + t; const int c = g * 16 + p0;
#ifndef HOST_EMU
        float u[8], z[8]; load8_bf16(p + r * PS + SU + c, u); const f4_t d0 = *(const f4_t*)(dskip + c), d1 = *(const f4_t*)(dskip + c + 4); const float dd[8] = {d0.x, d0.y, d0.z, d0.w, d1.x, d1.y, d1.z, d1.w};
#pragma unroll
        for (int i = 0; i < 8; ++i) { const float x = v[i] + dd[i] * u[i]; const float y = 0.7978845608028654f * (x + 0.044715f * x * x * x); const float th = 1.0f - 2.0f * __builtin_amdgcn_rcpf(1.0f + __expf(2.0f * y)); z[i] = 0.5f * x * (1.0f + th); }
        store8_bf16(zbuf + r * 256 + c, z);
#else
        for (int i = 0; i < 8; ++i) zbuf[r * 256 + c + i] = f2bf(gelu_tanhf(v[i] + dskip[c + i] * bf2f(p[r * PS + SU + c + i])));
#endif
    } };
struct EpiGlu { const bf16* zbuf; const float* gb; bf16* mix;
    HD void apply8(int row, int col0, const float* v) const {
#ifndef HOST_EMU
        float z[8], o[8]; load8_bf16(zbuf + (size_t)row * 256 + col0, z); const f4_t b0 = *(const f4_t*)(gb + col0), b1 = *(const f4_t*)(gb + col0 + 4); const float bb[8] = {b0.x, b0.y, b0.z, b0.w, b1.x, b1.y, b1.z, b1.w};
#pragma unroll
        for (int i = 0; i < 8; ++i) o[i] = z[i] * fast_sigmoid(v[i] + bb[i]);
        store8_bf16(mix + (size_t)row * D + 384 + col0, o);
#else
        for (int i = 0; i < 8; ++i) mix[(size_t)row * D + 384 + col0 + i] = f2bf(bf2f(zbuf[(size_t)row * 256 + col0 + i]) * sigmoidf_(v[i] + gb[col0 + i]));
#endif
    } };

#ifndef HOST_EMU
namespace pg8 {
#define PG8_LAS __attribute__((address_space(3)))
typedef short bf16x8 __attribute__((ext_vector_type(8)));
typedef float f32x4 __attribute__((ext_vector_type(4)));
typedef int v4i_t __attribute__((ext_vector_type(4)));
typedef int v8i_t __attribute__((ext_vector_type(8)));
constexpr int BM = 256, BK = 64, HALF = 128, HTB = HALF * BK * 2, STAGE_BYTES = 8 * HTB, NXCD = 8, WGM = 8;
__device__ __forceinline__ int lds_byte(int r, int c) { const int st = (r >> 4) * 2 + (c >> 5), rr = r & 15, cc = c & 31, ob = rr * 64 + cc * 2; return st * 1024 + (ob ^ (((ob >> 9) & 1) << 5)); }
__device__ __forceinline__ void stage_rc(int b, int& R, int& C) { const int st = b / 1024, sb = b % 1024, swz = sb ^ (((sb >> 9) & 1) << 5); R = (st >> 1) * 16 + swz / 64; C = (st & 1) * 32 + (swz % 64) / 2; }
__device__ __forceinline__ int perm32(int rho) { const int n = rho >> 4, i = rho & 15; return 8 * (i >> 2) + 4 * n + (i & 3); }
struct Unit { int pm, pn; };
struct StaticOrder {
    int nM, nN, nwg, G, c;
    __device__ void init(int M, int N, int G_, int c_) { nM = M / BM; nN = N / BM; nwg = nM * nN; G = G_; c = c_; }
    __device__ bool next(int i, Unit& u) const {
        const long L = (long)i * G + c; if (L >= nwg) return false;
        int wgid = (int)L; { const int q = nwg / NXCD, r = nwg % NXCD, xcd = wgid % NXCD, off = wgid / NXCD; wgid = (xcd < r ? xcd * (q + 1) : r * (q + 1) + (xcd - r) * q) + off; }
        const int nig = WGM * nN, gid = wgid / nig, fm = gid * WGM, gsz = (nM - fm) < WGM ? (nM - fm) : WGM;
        u.pm = fm + ((wgid % nig) % gsz); u.pn = (wgid % nig) / gsz; return true;
    }
};
template <class F> __device__ __forceinline__ void epi_apply(const F& f, const f32x4 (&acc)[2][2][4][2], const Unit& u, int wr, int wc, int fr, int fq) {
    const int row0 = u.pm * BM + wr * 64 + fr, col0 = u.pn * BM + wc * 32 + 8 * fq;
#pragma unroll
    for (int ai = 0; ai < 2; ++ai)
#pragma unroll
        for (int m = 0; m < 4; ++m)
#pragma unroll
            for (int bj = 0; bj < 2; ++bj) { const f32x4 v0 = acc[ai][bj][m][0], v1 = acc[ai][bj][m][1];
                const float v[8] = {v0[0], v0[1], v0[2], v0[3], v1[0], v1[1], v1[2], v1[3]};
                f.apply8(row0 + ai * HALF + m * 16, col0 + bj * HALF, v); }
}
#ifndef PG8_SP2
#define PG8_SP2 true
#endif
#ifndef PG8_ALIGN
#define PG8_ALIGN true
#endif
template <class F, bool FP8 = false, bool GATHER = false, bool SP2 = PG8_SP2, bool ALIGN_EPI = PG8_ALIGN>
__device__ __forceinline__ void gemm_phase(PG8_LAS unsigned char* lds, const GemmDesc g, const F& E, int G_, int c_) {
    int tid_ = threadIdx.x; asm volatile("" : "+v"(tid_));
    const int tid = tid_, wid = __builtin_amdgcn_readfirstlane(tid >> 6), lane = tid & 63, wr = wid >> 2, wc = wid & 3, fr = lane & 15, fq = lane >> 4;
    const int K = g.K, nt = FP8 ? K / 128 : K / BK; constexpr unsigned EB = FP8 ? 1u : 2u;
    int M = g.M; if (g.ntile) { int ntl = g.ntile[0] - g.tile0; ntl = ntl < 0 ? 0 : ntl; if (ntl * BM < M) M = ntl * BM; }
    StaticOrder S; S.init(M, g.N, G_, c_);
    unsigned voffB[1]; int RA[2]; unsigned CA[2];
#pragma unroll
    for (int i = 0; i < 2; ++i) { int R, C; stage_rc(tid * 16 + i * 8192, R, C); const int Rb = (R & ~31) + perm32(R & 31);
        RA[i] = R; CA[i] = (unsigned)C * 2u; if (i == 0) voffB[0] = (unsigned)Rb * (unsigned)g.ldb * EB + (unsigned)C * 2u; }
    const size_t pieceB = (size_t)64 * g.ldb * EB;
    const unsigned lda2 = (unsigned)g.lda * EB;
    const size_t kstep = (size_t)(BK * 2);
    const size_t hstepA = (size_t)HALF * g.lda * EB, hstepB = (size_t)HALF * g.ldb * EB;
    const size_t tstepA = 2 * hstepA, tstepB = 2 * hstepB;
    const unsigned ldsw = (unsigned)wid * 1024u; int sc8v = (127 + g.pad / 2) * 0x01010101;
    if constexpr (FP8) asm volatile("" : "+v"(sc8v));
    const int aoff = lds_byte(wr * 64 + fr, fq * 8), boff = lds_byte(wc * 32 + fr, fq * 8);
#define PG8_SA(b, h) (((b) * 2 + (h)) * HTB)
#define PG8_SB(b, h) ((4 + (b) * 2 + (h)) * HTB)
#define PG8_STAGE(bufoff, gbase, voff) do { _Pragma("unroll") for (int _i = 0; _i < 2; ++_i) \
        __builtin_amdgcn_global_load_lds((const unsigned*)((const char*)(gbase) + (voff)[_i]), (PG8_LAS unsigned*)(lds + (bufoff) + ldsw + _i * 8192), 16, 0, 0); } while (0)
#define PG8_STAGEB(bufoff, gbase) do { _Pragma("unroll") for (int _i = 0; _i < 2; ++_i) \
        __builtin_amdgcn_global_load_lds((const unsigned*)((const char*)(gbase) + _i * pieceB + voffB[0]), (PG8_LAS unsigned*)(lds + (bufoff) + ldsw + _i * 8192), 16, 0, 0); } while (0)
#define PG8_RD(off) (*(const PG8_LAS bf16x8*)(lds + (off)))
#define PG8_LDA(dst, b, h) do { if constexpr (FP8) { _Pragma("unroll") for (int m = 0; m < 4; ++m) { dst##8[m].lo = __builtin_bit_cast(v4i_t, PG8_RD(PG8_SA(b, h) + aoff + m * 2048)); dst##8[m].hi = __builtin_bit_cast(v4i_t, PG8_RD(PG8_SA(b, h) + aoff + m * 2048 + 1024)); } } else { \
        _Pragma("unroll") for (int m = 0; m < 4; ++m) _Pragma("unroll") for (int k = 0; k < 2; ++k) dst[m][k] = PG8_RD(PG8_SA(b, h) + aoff + m * 2048 + k * 1024); } } while (0)
#define PG8_LDB(dst, b, h) do { if constexpr (FP8) { _Pragma("unroll") for (int n = 0; n < 2; ++n) { dst##8[n].lo = __builtin_bit_cast(v4i_t, PG8_RD(PG8_SB(b, h) + boff + n * 2048)); dst##8[n].hi = __builtin_bit_cast(v4i_t, PG8_RD(PG8_SB(b, h) + boff + n * 2048 + 1024)); } } else { \
        _Pragma("unroll") for (int n = 0; n < 2; ++n) _Pragma("unroll") for (int k = 0; k < 2; ++k) dst[n][k] = PG8_RD(PG8_SB(b, h) + boff + n * 2048 + k * 1024); } } while (0)
#define PG8_CAT(x0, x1) __builtin_shufflevector(__builtin_bit_cast(v4i_t, x0), __builtin_bit_cast(v4i_t, x1), 0, 1, 2, 3, 4, 5, 6, 7)
#define PG8_MMA(ai, bj, At, Bt) do { __builtin_amdgcn_s_setprio(1); if constexpr (FP8) { _Pragma("unroll") for (int m = 0; m < 4; ++m) _Pragma("unroll") for (int n = 0; n < 2; ++n) \
        asm volatile("v_mfma_scale_f32_16x16x128_f8f6f4 %0, %1, %2, %0, %3, %4 op_sel_hi:[0,0,0]" : "+v"(acc[ai][bj][m][n]) : "v"(Bt##8[n]), "v"(At##8[m]), "v"(sc8v), "v"(sc8v)); } else { \
        _Pragma("unroll") for (int m = 0; m < 4; ++m) _Pragma("unroll") for (int n = 0; n < 2; ++n) _Pragma("unroll") for (int k = 0; k < 2; ++k) \
        acc[ai][bj][m][n] = __builtin_amdgcn_mfma_f32_16x16x32_bf16(Bt[n][k], At[m][k], acc[ai][bj][m][n], 0, 0, 0); } __builtin_amdgcn_s_setprio(0); } while (0)
#define PG8_WAIT_V(n) asm volatile("s_waitcnt vmcnt(" #n ")" ::: "memory")
#define PG8_WAIT_L(n) asm volatile("s_waitcnt lgkmcnt(" #n ")" ::: "memory")
#define PG8_BAR __builtin_amdgcn_s_barrier()
#define PG8_SCHED __builtin_amdgcn_sched_barrier(0)
#define PG8_MKVO(u, vo, base) do { if constexpr (GATHER) { base = (const char*)g.A; int _t = tid; asm volatile("" : "+v"(_t));     \
            _Pragma("unroll") for (int _i = 0; _i < 2; ++_i) { int _R, _C; stage_rc(_t * 16 + _i * 8192, _R, _C); _Pragma("unroll") for (int _h = 0; _h < 2; ++_h) { \
            int _row = g.arow[(size_t)(g.tile0 + (u).pm) * BM + _h * HALF + _R]; _row = _row < 0 ? 0 : _row; vo[_h][_i] = (unsigned)_row * lda2 + (unsigned)_C * 2u; } } } \
        else { base = (const char*)g.A + (size_t)(u).pm * tstepA; _Pragma("unroll") for (int _h = 0; _h < 2; ++_h) _Pragma("unroll") for (int _i = 0; _i < 2; ++_i) vo[_h][_i] = (unsigned)(_h * HALF + RA[_i]) * lda2 + CA[_i]; } } while (0)
#define PG8_BBASE(u) ((const char*)g.Bt + (g.tile_e ? (size_t)g.tile_e[g.tile0 + (u).pm] * g.e_stride * 2 : (g.tdiv ? (size_t)((u).pm / g.tdiv) * g.e_stride * 2 : (size_t)0)) + (size_t)(u).pn * tstepB)
    Unit cur, nxt; int ui = 0;
    if (!S.next(0, cur)) return;
    f32x4 acc[2][2][4][2];
#pragma unroll
    for (int a = 0; a < 2; ++a)
#pragma unroll
        for (int b = 0; b < 2; ++b)
#pragma unroll
            for (int m = 0; m < 4; ++m)
#pragma unroll
                for (int n = 0; n < 2; ++n) acc[a][b][m][n] = (f32x4){0.f, 0.f, 0.f, 0.f};
    bf16x8 At[4][2], B0[2][2], B1[2][2]; v8i_t At8[4], B08[2], B18[2];
    const char* cA; unsigned voC[2][2], voN[2][2]; PG8_MKVO(cur, voC, cA); const char* cB = PG8_BBASE(cur);
    if constexpr (SP2) {
        PG8_STAGEB(PG8_SB(0, 0), cB); PG8_STAGEB(PG8_SB(0, 1), cB + hstepB); PG8_STAGE(PG8_SA(0, 0), cA, voC[0]); PG8_STAGE(PG8_SA(0, 1), cA, voC[1]);
        if (wr == 1) PG8_BAR;
        PG8_WAIT_V(2); PG8_BAR;
        PG8_STAGEB(PG8_SB(1, 0), cB + kstep); PG8_STAGE(PG8_SA(1, 0), cA + kstep, voC[0]); PG8_STAGEB(PG8_SB(1, 1), cB + hstepB + kstep);
        PG8_WAIT_V(6); PG8_BAR;
    } else {
    PG8_STAGEB(PG8_SB(0, 0), cB); PG8_STAGE(PG8_SA(0, 0), cA, voC[0]); PG8_STAGEB(PG8_SB(0, 1), cB + hstepB); PG8_STAGE(PG8_SA(0, 1), cA, voC[1]);
    if (wr == 1) PG8_BAR;
    PG8_WAIT_V(4); PG8_BAR;
    PG8_STAGEB(PG8_SB(1, 0), cB + kstep); PG8_STAGE(PG8_SA(1, 0), cA + kstep, voC[0]); PG8_STAGEB(PG8_SB(1, 1), cB + hstepB + kstep);
    PG8_WAIT_V(6); PG8_BAR;
    }
    for (;;) {
        const bool has_next = S.next(ui + 1, nxt);
        const char* nA = cA; if constexpr (!GATHER) { if (has_next) nA = (const char*)g.A + (size_t)nxt.pm * tstepA; } else if (has_next) PG8_MKVO(nxt, voN, nA); else { _Pragma("unroll") for (int _h = 0; _h < 2; ++_h) _Pragma("unroll") for (int _i = 0; _i < 2; ++_i) voN[_h][_i] = voC[_h][_i]; }
        const char* nB = has_next ? PG8_BBASE(nxt) : cB;
        for (int t = 0; t < nt; t += 2) {
            const bool last = (t == nt - 2);
            const char* a1 = cA + (size_t)(t + 1) * kstep;
            const char* a2 = last ? nA : cA + (size_t)(t + 2) * kstep; const char* b2 = last ? nB : cB + (size_t)(t + 2) * kstep;
            const char* a3 = a2 + kstep; const char* b3 = b2 + kstep;
            if constexpr (SP2) {
            PG8_LDB(B0, 0, 0); PG8_LDB(B1, 0, 1); PG8_SCHED; PG8_LDA(At, 0, 0); PG8_STAGE(PG8_SA(1, 1), a1, voC[1]);
            if constexpr (GATHER) if (last) { _Pragma("unroll") for (int _h = 0; _h < 2; ++_h) _Pragma("unroll") for (int _i = 0; _i < 2; ++_i) voC[_h][_i] = voN[_h][_i]; }
            PG8_WAIT_V(8); PG8_WAIT_L(0); PG8_BAR; PG8_MMA(0, 0, At, B0); PG8_MMA(0, 1, At, B1); PG8_BAR; PG8_SCHED;
            PG8_LDA(At, 0, 1); PG8_STAGEB(PG8_SB(0, 0), b2); PG8_STAGEB(PG8_SB(0, 1), b2 + hstepB); PG8_STAGE(PG8_SA(0, 0), a2, voC[0]);
            PG8_WAIT_V(8); PG8_WAIT_L(0); PG8_BAR; PG8_MMA(1, 0, At, B0); PG8_MMA(1, 1, At, B1); PG8_BAR; PG8_SCHED;
            PG8_LDB(B0, 1, 0); PG8_LDB(B1, 1, 1); PG8_SCHED; PG8_LDA(At, 1, 0); PG8_STAGE(PG8_SA(0, 1), a2, voC[1]);
            PG8_WAIT_V(8); PG8_WAIT_L(0); PG8_BAR; PG8_MMA(0, 0, At, B0); PG8_MMA(0, 1, At, B1); PG8_BAR; PG8_SCHED;
            PG8_LDA(At, 1, 1); PG8_STAGEB(PG8_SB(1, 0), b3); PG8_STAGEB(PG8_SB(1, 1), b3 + hstepB); PG8_STAGE(PG8_SA(1, 0), a3, voC[0]);
            PG8_WAIT_V(8); PG8_WAIT_L(0); PG8_BAR; PG8_MMA(1, 0, At, B0); PG8_MMA(1, 1, At, B1); PG8_BAR; PG8_SCHED;
            } else {
            PG8_LDB(B0, 0, 0); PG8_SCHED; PG8_LDA(At, 0, 0); PG8_STAGE(PG8_SA(1, 1), a1, voC[1]);
            if constexpr (GATHER) if (last) { _Pragma("unroll") for (int _h = 0; _h < 2; ++_h) _Pragma("unroll") for (int _i = 0; _i < 2; ++_i) voC[_h][_i] = voN[_h][_i]; }
            PG8_WAIT_L(8); PG8_BAR; PG8_WAIT_L(0); PG8_MMA(0, 0, At, B0); PG8_BAR; PG8_SCHED;
            PG8_LDB(B1, 0, 1); PG8_STAGEB(PG8_SB(0, 0), b2);
            PG8_BAR; PG8_WAIT_L(0); PG8_MMA(0, 1, At, B1); PG8_BAR;
            PG8_LDA(At, 0, 1); PG8_STAGE(PG8_SA(0, 0), a2, voC[0]);
            PG8_BAR; PG8_WAIT_L(0); PG8_MMA(1, 0, At, B0); PG8_BAR; PG8_SCHED;
            PG8_STAGEB(PG8_SB(0, 1), b2 + hstepB);
            PG8_WAIT_V(6); PG8_BAR; PG8_MMA(1, 1, At, B1); PG8_BAR;
            PG8_LDB(B0, 1, 0); PG8_SCHED; PG8_LDA(At, 1, 0); PG8_STAGE(PG8_SA(0, 1), a2, voC[1]);
            PG8_WAIT_L(8); PG8_BAR; PG8_WAIT_L(0); PG8_MMA(0, 0, At, B0); PG8_BAR; PG8_SCHED;
            PG8_LDB(B1, 1, 1); PG8_STAGEB(PG8_SB(1, 0), b3);
            PG8_BAR; PG8_WAIT_L(0); PG8_MMA(0, 1, At, B1); PG8_BAR;
            PG8_LDA(At, 1, 1); PG8_STAGE(PG8_SA(1, 0), a3, voC[0]);
            PG8_BAR; PG8_WAIT_L(0); PG8_MMA(1, 0, At, B0); PG8_BAR; PG8_SCHED;
            PG8_STAGEB(PG8_SB(1, 1), b3 + hstepB);
            PG8_WAIT_V(6); PG8_BAR; PG8_MMA(1, 1, At, B1); PG8_BAR;
            }
        }
        if constexpr (ALIGN_EPI) { if (wr == 0) PG8_BAR; }
        if constexpr (FP8) asm volatile("s_nop 15\n\ts_nop 15" ::: "memory");
        epi_apply(E, acc, cur, wr, wc, fr, fq);
        if (!has_next) break;
#pragma unroll
        for (int a = 0; a < 2; ++a)
#pragma unroll
            for (int b = 0; b < 2; ++b)
#pragma unroll
                for (int m = 0; m < 4; ++m)
#pragma unroll
                    for (int n = 0; n < 2; ++n) acc[a][b][m][n] = (f32x4){0.f, 0.f, 0.f, 0.f};
        cur = nxt; cA = nA; cB = nB; ++ui;
        if constexpr (ALIGN_EPI) { if (wr == 1) PG8_BAR; }
    }
    PG8_WAIT_V(0);
    if constexpr (!ALIGN_EPI) { if (wr == 0) PG8_BAR; }
    PG8_BAR;
#undef PG8_SA
#undef PG8_SB
#undef PG8_STAGE
#undef PG8_STAGEB
#undef PG8_LDA
#undef PG8_LDB
#undef PG8_MMA
#undef PG8_CAT
#undef PG8_RD
#undef PG8_WAIT_V
#undef PG8_WAIT_L
#undef PG8_BAR
#undef PG8_SCHED
#undef PG8_BBASE
#undef PG8_MKVO
}
}

#define XB_TMO      128
#define XB_XCNT(j)  (256  + 64 * (j))
#define XB_XSUB(j)  (1280 + 64 * (j))
#define XB_XGEN(j)  (2304 + 64 * (j))
#define XB_TOP      3328
#define XB_TOPGEN   3392
#define XCD_BAR_WORDS 3456
#define XB_SPIN_CAP (1u << 20)
#define LAS __attribute__((address_space(3)))
__device__ __forceinline__ unsigned xb_ld(unsigned* p)              { return __hip_atomic_load(p, __ATOMIC_RELAXED, __HIP_MEMORY_SCOPE_AGENT); }
__device__ __forceinline__ unsigned xb_add(unsigned* p, unsigned v) { return __hip_atomic_fetch_add(p, v, __ATOMIC_RELAXED, __HIP_MEMORY_SCOPE_AGENT); }
__device__ __forceinline__ unsigned xb_xcc_id() { return (unsigned)__builtin_amdgcn_s_getreg((3 << 11) | 20) & 0xFu; }
#define XB_SPIN(cond, bar) do { unsigned _sp = 0; while (cond) { __builtin_amdgcn_s_sleep(1); \
    if ((++_sp & 255u) == 0u) { if (xb_ld(&(bar)[XB_TMO])) break; if (_sp > XB_SPIN_CAP) { atomicAdd(&(bar)[XB_TMO], 1u); break; } } } } while (0)
struct XcdBarrier { unsigned* bar; unsigned x; volatile LAS unsigned* st; };
__device__ __forceinline__ XcdBarrier xcd_barrier_post(unsigned* bar, volatile LAS unsigned* st) {
    XcdBarrier b; b.bar = bar; b.x = xb_xcc_id(); b.st = st;
    if (threadIdx.x == 0) (void)xb_add(&bar[XB_XCNT(b.x)], 1u);
    return b;
}
__device__ __forceinline__ void xcd_barrier_complete(unsigned* bar, unsigned x, unsigned& nloc, unsigned& nx) {
    const unsigned G = gridDim.x * gridDim.y * gridDim.z;
    unsigned sum, cnt, mine, sp = 0u;
    for (;;) {
        sum = 0u; cnt = 0u; mine = 0u;
#pragma unroll
        for (unsigned j = 0; j < 16; ++j) { const unsigned c = xb_ld(&bar[XB_XCNT(j)]); sum += c; cnt += (c > 0u) ? 1u : 0u; mine = (j == x) ? c : mine; }
        if (sum == G) break;
        __builtin_amdgcn_s_sleep(1);
        if ((++sp & 255u) == 0u) { if (xb_ld(&bar[XB_TMO])) break; if (sp > XB_SPIN_CAP) { atomicAdd(&bar[XB_TMO], 1u); break; } }
    }
    nloc = mine > 0u ? mine : 1u; nx = cnt > 0u ? cnt : 1u;
}
__device__ __forceinline__ void xcd_barrier(const XcdBarrier& b) {
    asm volatile("s_waitcnt vmcnt(0)" ::: "memory");
    __syncthreads();
    if (threadIdx.x == 0) {
        unsigned* bar = b.bar; asm volatile("" : "+s"(bar));
        __builtin_amdgcn_s_waitcnt(0);
        unsigned nloc = b.st[0], nx = b.st[1];
        if (nloc == 0u) { xcd_barrier_complete(bar, b.x, nloc, nx); b.st[0] = nloc; b.st[1] = nx; }
        const unsigned old = xb_add(&bar[XB_XSUB(b.x)], 1u);
        const unsigned gen = old / nloc;
        if (old + 1u == (gen + 1u) * nloc) {
            __builtin_amdgcn_fence(__ATOMIC_RELEASE, "agent");
            asm volatile("s_waitcnt vmcnt(0)" ::: "memory");
            const unsigned og = xb_add(&bar[XB_TOP], 1u);
            const unsigned tg = og / nx;
            if (og + 1u == (tg + 1u) * nx) xb_add(&bar[XB_TOPGEN], 1u);
            else XB_SPIN(xb_ld(&bar[XB_TOPGEN]) == tg, bar);
            __builtin_amdgcn_fence(__ATOMIC_ACQUIRE, "agent");
            xb_add(&bar[XB_XGEN(b.x)], 1u);
            asm volatile("s_waitcnt vmcnt(0)" ::: "memory");
        } else {
            XB_SPIN(xb_ld(&bar[XB_XGEN(b.x)]) == gen, bar);
            __builtin_amdgcn_fence(__ATOMIC_ACQUIRE, "agent");
            asm volatile("s_waitcnt vmcnt(0)" ::: "memory");
        }
    }
    __syncthreads();
}

__device__ __forceinline__ float wave_sum(float v) {
#pragma unroll
    for (int o = 1; o < 64; o <<= 1) v += __shfl_xor(v, o);
    return v;
}
typedef float f32x4v __attribute__((ext_vector_type(4)));
__device__ __forceinline__ unsigned pk2bf(float lo, float hi) { return (unsigned)f2bf(lo) | ((unsigned)f2bf(hi) << 16); }
#define LDS_WAIT() asm volatile("s_waitcnt lgkmcnt(0)" ::: "memory")
struct NormModW { int n; int sh_off; int sc_off; int skip_ctx; const float* h; const float* g; const float* mod; bf16* out; const float* wr; int* rt_e; float* rt_w; int* segcnt; int nseg, f8;
    __device__ __forceinline__ void wave(int it, int lane, PG8_LAS unsigned char*) const {
        f32x4v v[2][4]; float ss[2] = {0.f, 0.f};
#pragma unroll
        for (int q = 0; q < 2; ++q) { const f32x4v* hr = (const f32x4v*)(h + (size_t)(2 * it + q) * D) + lane;
#pragma unroll
            for (int j = 0; j < 4; ++j) v[q][j] = hr[64 * j]; }
#pragma unroll
        for (int q = 0; q < 2; ++q) {
#pragma unroll
            for (int j = 0; j < 4; ++j) ss[q] += (v[q][j].x * v[q][j].x + v[q][j].y * v[q][j].y) + (v[q][j].z * v[q][j].z + v[q][j].w * v[q][j].w); }
#pragma unroll
        for (int q = 0; q < 2; ++q) { const int r = 2 * it + q;
        const float rstd = 1.0f / sqrtf(wave_sum(ss[q]) * (1.0f / D) + EPS); const float* m = mod + (size_t)mod_index(r) * 6 * D;
        float lg[NE];
#pragma unroll
        for (int e = 0; e < NE; ++e) lg[e] = 0.f;
#pragma unroll
        for (int j = 0; j < 4; ++j) { const int k0 = 4 * (lane + 64 * j); const f32x4v g4 = *(const f32x4v*)(g + k0), sc4 = *(const f32x4v*)(m + sc_off + k0), sh4 = *(const f32x4v*)(m + sh_off + k0);
            const f32x4v o = v[q][j] * rstd * g4 * (sc4 + 1.0f) + sh4;
            if (f8) { int w8 = 0; w8 = __builtin_amdgcn_cvt_pk_fp8_f32(o.x, o.y, w8, false); w8 = __builtin_amdgcn_cvt_pk_fp8_f32(o.z, o.w, w8, true); *(int*)((unsigned char*)out + (size_t)r * D + k0) = w8; }
            else *(uint2*)(out + (size_t)r * D + k0) = make_uint2(cvt_pk_bf16(o.x, o.y), cvt_pk_bf16(o.z, o.w));
            if (wr) {
#pragma unroll
                for (int i = 0; i < 4; ++i) { const f32x4v w0 = *(const f32x4v*)(wr + (size_t)(k0 + i) * NE), w1 = *(const f32x4v*)(wr + (size_t)(k0 + i) * NE + 4); const float ov = o[i];
                    lg[0] += ov * w0.x; lg[1] += ov * w0.y; lg[2] += ov * w0.z; lg[3] += ov * w0.w; lg[4] += ov * w1.x; lg[5] += ov * w1.y; lg[6] += ov * w1.z; lg[7] += ov * w1.w; } } }
        if (wr) {
#pragma unroll
            for (int e = 0; e < NE; ++e) lg[e] = wave_sum(lg[e]);
            int e0 = 0; float b0 = lg[0];
#pragma unroll
            for (int e = 1; e < NE; ++e) if (lg[e] > b0) { b0 = lg[e]; e0 = e; }
            int e1 = -1; float b1 = -3.0e38f;
#pragma unroll
            for (int e = 0; e < NE; ++e) if (e != e0 && lg[e] > b1) { b1 = lg[e]; e1 = e; }
            const float w1 = 1.0f / (1.0f + expf(b1 - b0)); const bool skip = skip_ctx && ((r % RPB) < CTX);
            if (lane == 0) { rt_e[2 * r] = skip ? -1 : e0; rt_e[2 * r + 1] = skip ? -1 : e1; rt_w[2 * r] = w1; rt_w[2 * r + 1] = 1.0f - w1;
                if (!skip) { atomicAdd(&segcnt[(size_t)e0 * nseg + r / 64], 1); atomicAdd(&segcnt[(size_t)e1 * nseg + r / 64], 1); } } }
        }
    } };
struct MoePrefixW { int n; int nseg; int* segcnt; int* ecnt;
    __device__ __forceinline__ void wave(int e, int lane, PG8_LAS unsigned char*) const { constexpr int PER = ((NR + 63) / 64 + 63) / 64; int v[PER]; int tot = 0;
#pragma unroll
        for (int k = 0; k < PER; ++k) { const int sg = lane * PER + k; v[k] = sg < nseg ? segcnt[(size_t)e * nseg + sg] : 0; tot += v[k]; }
        int incl = tot;
#pragma unroll
        for (int o = 1; o < 64; o <<= 1) { const int t = __shfl_up(incl, o); if (lane >= o) incl += t; }
        int run = incl - tot;
#pragma unroll
        for (int k = 0; k < PER; ++k) { const int sg = lane * PER + k; if (sg < nseg) segcnt[(size_t)e * nseg + sg] = run; run += v[k]; }
        if (lane == 63) ecnt[e] = incl; } };
struct CombineNormW { int n; int mode; int g_off; int pad; float* h; const bf16* yrow; const int* rt_e; const float* rt_w; const int* rt_dest; const float* modc; const float* gn; const float* modn; bf16* outb; float* outf;
    __device__ __forceinline__ void wave(int r, int lane, PG8_LAS unsigned char*) const {
        const int t = r % RPB; if (mode == 1 && t < CTX) return;
        f32x4v* hr = (f32x4v*)(h + (size_t)r * D) + lane; f32x4v v[4];
#pragma unroll
        for (int j = 0; j < 4; ++j) v[j] = hr[64 * j];
        const int e0 = rt_e[2 * r];
        if (e0 >= 0) { const size_t d0 = (size_t)rt_dest[2 * r], d1 = (size_t)rt_dest[2 * r + 1]; const float w0 = rt_w[2 * r], w1 = rt_w[2 * r + 1]; const float* gt = modc + (size_t)mod_index(r) * 6 * D + g_off;
            uint2 y0[4], y1[4]; f32x4v g4[4];
#pragma unroll
            for (int j = 0; j < 4; ++j) { const int k0 = 4 * (lane + 64 * j); y0[j] = *(const uint2*)(yrow + d0 * D + k0); y1[j] = *(const uint2*)(yrow + d1 * D + k0); g4[j] = *(const f32x4v*)(gt + k0); }
#pragma unroll
            for (int j = 0; j < 4; ++j) { f32x4v y;
                y.x = w0 * __uint_as_float(y0[j].x << 16) + w1 * __uint_as_float(y1[j].x << 16); y.y = w0 * __uint_as_float(y0[j].x & 0xffff0000u) + w1 * __uint_as_float(y1[j].x & 0xffff0000u);
                y.z = w0 * __uint_as_float(y0[j].y << 16) + w1 * __uint_as_float(y1[j].y << 16); y.w = w0 * __uint_as_float(y0[j].y & 0xffff0000u) + w1 * __uint_as_float(y1[j].y & 0xffff0000u);
                v[j] += g4[j] * y; }
            if (mode == 0) {
#pragma unroll
                for (int j = 0; j < 4; ++j) hr[64 * j] = v[j]; } }
        float ss = 0.f;
#pragma unroll
        for (int j = 0; j < 4; ++j) ss += (v[j].x * v[j].x + v[j].y * v[j].y) + (v[j].z * v[j].z + v[j].w * v[j].w);
        const float rstd = 1.0f / sqrtf(wave_sum(ss) * (1.0f / D) + EPS);
        if (mode == 0) { const float* m = modn + (size_t)mod_index(r) * 6 * D;
#pragma unroll
            for (int j = 0; j < 4; ++j) { const int k0 = 4 * (lane + 64 * j); const f32x4v g4 = *(const f32x4v*)(gn + k0), sc4 = *(const f32x4v*)(m + D + k0), sh4 = *(const f32x4v*)(m + k0);
                const f32x4v o = v[j] * rstd * g4 * (sc4 + 1.0f) + sh4; *(uint2*)(outb + (size_t)r * D + k0) = make_uint2(cvt_pk_bf16(o.x, o.y), cvt_pk_bf16(o.z, o.w)); }
        } else { const int b = r / RPB, tl = t - CTX;
#pragma unroll
            for (int j = 0; j < 4; ++j) { const int k0 = 4 * (lane + 64 * j); *(f32x4v*)(outf + ((size_t)b * SEQ + tl) * D + k0) = v[j] * rstd * *(const f32x4v*)(gn + k0); } } } };
struct FinalNormW { int n; int pad; const float* h; const float* g; float* out;
    __device__ __forceinline__ void wave(int x, int lane, PG8_LAS unsigned char*) const { const int b = x / SEQ, tl = x % SEQ;
        const f32x4v* hr = (const f32x4v*)(h + ((size_t)b * RPB + CTX + tl) * D) + lane; f32x4v v[4]; float ss = 0.f;
#pragma unroll
        for (int j = 0; j < 4; ++j) { v[j] = hr[64 * j]; ss += (v[j].x * v[j].x + v[j].y * v[j].y) + (v[j].z * v[j].z + v[j].w * v[j].w); }
        const float rstd = 1.0f / sqrtf(wave_sum(ss) * (1.0f / D) + EPS);
#pragma unroll
        for (int j = 0; j < 4; ++j) { const int k0 = 4 * (lane + 64 * j); *(f32x4v*)(out + (size_t)x * D + k0) = v[j] * rstd * *(const f32x4v*)(g + k0); } } };
struct TransW { int n; int K, N, rs, ro, f8; const float* src; bf16* dst; size_t sstride, dstride;
    __device__ __forceinline__ void loadt(f32x4v (&v)[8], int tile, int lane) const { const int nblk = N / 32, ipm = (K / 64) * nblk; const int mat = tile / ipm, r = tile % ipm, kb = r / nblk, nb = r % nblk;
        const float* W = src + (size_t)mat * sstride + (size_t)(64 * kb + (lane >> 3)) * N + 32 * nb + 4 * (lane & 7);
#pragma unroll
        for (int i = 0; i < 8; ++i) v[i] = *(const f32x4v*)(W + (size_t)(8 * i) * N); }
    __device__ __forceinline__ void emit(const f32x4v (&v)[8], int tile, int lane, PG8_LAS float* scr) const { const int nblk = N / 32, ipm = (K / 64) * nblk; const int mat = tile / ipm, r = tile % ipm, kb = r / nblk, nb = r % nblk, k0 = 64 * kb, n0 = 32 * nb;
        const int kr = lane >> 3, nq = lane & 7;
#pragma unroll
        for (int i = 0; i < 8; ++i) { PG8_LAS float* sp = scr + (8 * i + kr) * 33 + 4 * nq; sp[0] = v[i].x; sp[1] = v[i].y; sp[2] = v[i].z; sp[3] = v[i].w; }
        LDS_WAIT();
        const int c = lane & 7;
        if (f8) { unsigned char* WT8 = (unsigned char*)dst + (size_t)mat * dstride; const float sc = __builtin_amdgcn_ldexpf(1.0f, f8);
#pragma unroll
            for (int j = 0; j < 4; ++j) { const int nn = (lane >> 3) + 8 * j; const PG8_LAS float* sp = scr + (8 * c) * 33 + nn; int w0 = 0, w1 = 0;
                w0 = __builtin_amdgcn_cvt_pk_fp8_f32(sp[0 * 33] * sc, sp[1 * 33] * sc, w0, false); w0 = __builtin_amdgcn_cvt_pk_fp8_f32(sp[2 * 33] * sc, sp[3 * 33] * sc, w0, true);
                w1 = __builtin_amdgcn_cvt_pk_fp8_f32(sp[4 * 33] * sc, sp[5 * 33] * sc, w1, false); w1 = __builtin_amdgcn_cvt_pk_fp8_f32(sp[6 * 33] * sc, sp[7 * 33] * sc, w1, true);
                *(uint2*)(WT8 + ((size_t)(n0 + nn) * rs + ro) * K + k0 + 8 * c) = make_uint2((unsigned)w0, (unsigned)w1); }
        } else { bf16* WT = dst + (size_t)mat * dstride;
#pragma unroll
            for (int j = 0; j < 4; ++j) { const int nn = (lane >> 3) + 8 * j; const PG8_LAS float* sp = scr + (8 * c) * 33 + nn;
                uint4 o; o.x = cvt_pk_bf16(sp[0 * 33], sp[1 * 33]); o.y = cvt_pk_bf16(sp[2 * 33], sp[3 * 33]); o.z = cvt_pk_bf16(sp[4 * 33], sp[5 * 33]); o.w = cvt_pk_bf16(sp[6 * 33], sp[7 * 33]);
                *(uint4*)(WT + ((size_t)(n0 + nn) * rs + ro) * K + k0 + 8 * c) = o; } }
        LDS_WAIT(); }
    __device__ __forceinline__ void wave(int item, int lane, PG8_LAS unsigned char* lw) const {
        PG8_LAS float* scr = (PG8_LAS float*)lw;
        const int t0 = 2 * item, t1 = 2 * item + 1; const bool two = t1 < tiles; f32x4v va[8], vb[8];
        loadt(va, t0, lane); if (two) loadt(vb, t1, lane);
        emit(va, t0, lane, scr); if (two) emit(vb, t1, lane, scr);
    } int tiles, pad2; };

template <int MT, int NT, int KS, class PA, class PB>
__device__ __forceinline__ void wave_mma(PA A, int lda, PB Bt, int ldb, pg8::f32x4 (&acc)[MT][NT], int lane) {
    const int r = lane & 15, q = lane >> 4;
#pragma unroll
    for (int ks = 0; ks < KS; ++ks) { pg8::bf16x8 a[MT], b[NT];
#pragma unroll
        for (int m = 0; m < MT; ++m) a[m] = *(const pg8::bf16x8*)(A + (size_t)(m * 16 + r) * lda + ks * 32 + q * 8);
#pragma unroll
        for (int n = 0; n < NT; ++n) b[n] = *(const pg8::bf16x8*)(Bt + (size_t)(n * 16 + r) * ldb + ks * 32 + q * 8);
#pragma unroll
        for (int m = 0; m < MT; ++m)
#pragma unroll
            for (int n = 0; n < NT; ++n) acc[m][n] = __builtin_amdgcn_mfma_f32_16x16x32_bf16(a[m], b[n], acc[m][n], 0, 0, 0); }
}
__device__ __forceinline__ float chunk_cumsum(float x, int d, int lane, float& tot) { float pre = x;
#pragma unroll
    for (int o = 1; o < 64; o <<= 1) { const float t = __shfl_up(pre, o); if (lane >= o) pre += t; }
    tot = __shfl(pre, 63); return d == 0 ? pre : tot - pre + x; }
struct MlPrepW2 { int n; int pad; const bf16* p; const float* cw; const float* cb; const float* gb; bf16* lab;
    __device__ __forceinline__ void wave(int it, int lane, PG8_LAS unsigned char* lw) const { typedef LaLay<96, 112> L;
        const int hh = it & 3; int y = it >> 2; const int blk = y % NBLK; y /= NBLK; const int b = y % NB, d = y / NB; const size_t item = ((size_t)b * NBLK + blk) * 4 + hh;
        const int tb = blk * 64; const size_t rb = (size_t)b * RPB + tb; const bool first_blk = (tb == 0 || tb == CTX), last_blk = (tb + 63 == CTX - 1 || tb + 63 == RPB - 1);
        PG8_LAS bf16* X = (PG8_LAS bf16*)lw; PG8_LAS float* SQ = (PG8_LAS float*)(lw + 14336); PG8_LAS float* SK = SQ + 64;
        { const bf16* pr = p + (rb + lane) * PS; const float gI = bf2f(pr[MG + (2 * d) * 4 + hh]) + gb[(2 * d) * 4 + hh], gF = bf2f(pr[MG + (2 * d + 1) * 4 + hh]) + gb[(2 * d + 1) * 4 + hh];
          float tot; const float Fc = chunk_cumsum(logsigmoidf_(gF), d, lane, tot); SQ[lane] = fexp(Fc); SK[lane] = fexp(gI - Fc) * 0.10206207261596577f;
          float* dec = (float*)(lab + L::dec) + ((size_t)d * LA_NI + item) * 96; const float dv = fexp(tot); dec[lane] = dv; if (lane < 32) dec[64 + lane] = dv; }
#pragma unroll 1
        for (int mat = 0; mat < 2; ++mat) { const int col0 = MQ + mat * 384 + hh * 96;
            pg8::v4i_t v[13];
#pragma unroll
            for (int k = 0; k < 13; ++k) { const int pi = lane + 64 * k, rw = pi / 12, c = pi % 12; const bool zero = (pi >= 792) || (rw == 0 && first_blk) || (rw == 65 && last_blk);
                v[k] = (pg8::v4i_t){0, 0, 0, 0}; if (!zero) v[k] = *(const pg8::v4i_t*)(p + (rb + rw - 1) * PS + col0 + c * 8); }
#pragma unroll
            for (int k = 0; k < 13; ++k) { const int pi = lane + 64 * k, rw = pi / 12, c = pi % 12; if (pi < 792) *(PG8_LAS pg8::v4i_t*)(X + rw * 104 + c * 8) = v[k]; }
            LDS_WAIT();
            unsigned o0[32], o1[32];
            const PG8_LAS float* SC = mat ? SK : SQ;
#pragma unroll
            for (int ps = 0; ps < 2; ++ps) { const int i = lane + 64 * ps; const bool act = i < 96; const int ci = mat * 384 + hh * 96 + (act ? i : 0);
                const float w0 = cw[ci], w1 = cw[768 + ci], w2 = cw[1536 + ci], bs = cb[ci]; const PG8_LAS bf16* xc = X + (act ? i : 0);
                float xa = bf2f(xc[0]), xb = bf2f(xc[104]);
#pragma unroll
                for (int s2 = 0; s2 < 32; ++s2) { const float x2 = bf2f(xc[(2 * s2 + 2) * 104]), x3 = bf2f(xc[(2 * s2 + 3) * 104]);
                    const float va = siluf(w0 * xa + w1 * xb + w2 * x2 + bs) * SC[2 * s2], vb = siluf(w0 * xb + w1 * x2 + w2 * x3 + bs) * SC[2 * s2 + 1];
                    const unsigned pk = cvt_pk_bf16(va, vb); if (ps == 0) o0[s2] = pk; else o1[s2] = pk; xa = x2; xb = x3; } }
            LDS_WAIT();
#pragma unroll
            for (int s2 = 0; s2 < 32; ++s2) { const int c0 = lane, t0 = 2 * s2;
                X[((t0 >> 4) * 3 + (c0 >> 5)) * 512 + ((((c0 & 31) >> 3) << 4) + (t0 & 15)) * 8 + (c0 & 7)] = (bf16)(o0[s2] & 0xffffu); X[((t0 >> 4) * 3 + (c0 >> 5)) * 512 + ((((c0 & 31) >> 3) << 4) + ((t0 + 1) & 15)) * 8 + (c0 & 7)] = (bf16)(o0[s2] >> 16);
                if (lane < 32) { const int c1 = 64 + lane; X[((t0 >> 4) * 3 + (c1 >> 5)) * 512 + ((((c1 & 31) >> 3) << 4) + (t0 & 15)) * 8 + (c1 & 7)] = (bf16)(o1[s2] & 0xffffu); X[((t0 >> 4) * 3 + (c1 >> 5)) * 512 + ((((c1 & 31) >> 3) << 4) + ((t0 + 1) & 15)) * 8 + (c1 & 7)] = (bf16)(o1[s2] >> 16); } }
            LDS_WAIT();
            { bf16* dst = lab + (mat ? L::kin : L::qin) + ((size_t)d * LA_NI + item) * 64 * 96;
#pragma unroll
              for (int k = 0; k < 12; ++k) { const int pi = lane + 64 * k; const pg8::v4i_t w = *(const PG8_LAS pg8::v4i_t*)(X + pi * 8); *(pg8::v4i_t*)(dst + (size_t)pi * 8) = w; } }
            LDS_WAIT();
            if (mat == 1) {
#pragma unroll
                for (int s2 = 0; s2 < 32; ++s2) { const int c0 = lane, t0 = 2 * s2;
                    *(PG8_LAS unsigned*)(X + ((c0 >> 4) * 2 + (t0 >> 5)) * 512 + ((((t0 & 31) >> 3) << 4) + (c0 & 15)) * 8 + (t0 & 7)) = o0[s2];
                    if (lane < 32) { const int c1 = 64 + lane; *(PG8_LAS unsigned*)(X + ((c1 >> 4) * 2 + (t0 >> 5)) * 512 + ((((t0 & 31) >> 3) << 4) + (c1 & 15)) * 8 + (t0 & 7)) = o1[s2]; } }
                LDS_WAIT();
                bf16* dst = lab + L::koutT + ((size_t)d * LA_NI + item) * 96 * 64;
#pragma unroll
                for (int k = 0; k < 12; ++k) { const int pi = lane + 64 * k; const pg8::v4i_t w = *(const PG8_LAS pg8::v4i_t*)(X + pi * 8); *(pg8::v4i_t*)(dst + (size_t)pi * 8) = w; }
                LDS_WAIT(); } } } };

struct GlaPrepW2 { int n; int pad; const bf16* p; const float* wa2; const float* ba; bf16* lab;
    __device__ __forceinline__ void wave(int it, int lane, PG8_LAS unsigned char* lw) const { typedef LaLay<64, 96> L;
        const int hh = it & 3; int y = it >> 2; const int blk = y % NBLK; y /= NBLK; const int b = y % NB, d = y / NB; const size_t item = ((size_t)b * NBLK + blk) * 4 + hh; const size_t rb = (size_t)b * RPB + blk * 64;
        PG8_LAS bf16* LR = (PG8_LAS bf16*)lw; PG8_LAS bf16* Q = LR + 64 * 16; PG8_LAS bf16* K = Q + 64 * 48; PG8_LAS bf16* X = (PG8_LAS bf16*)lw;
        pg8::v4i_t v[14];
#pragma unroll
        for (int k = 0; k < 2; ++k) { const int pi = lane + 64 * k; v[k] = *(const pg8::v4i_t*)(p + (rb + (pi >> 1)) * PS + GLR + (pi & 1) * 8); }
#pragma unroll
        for (int k = 0; k < 6; ++k) { const int pi = lane + 64 * k, rw = pi / 6, c = pi % 6; v[2 + k] = *(const pg8::v4i_t*)(p + (rb + rw) * PS + GQ + hh * 48 + c * 8); v[8 + k] = *(const pg8::v4i_t*)(p + (rb + rw) * PS + GK + hh * 48 + c * 8); }
#pragma unroll
        for (int k = 0; k < 2; ++k) { const int pi = lane + 64 * k; *(PG8_LAS pg8::v4i_t*)(LR + pi * 8) = v[k]; }
#pragma unroll
        for (int k = 0; k < 6; ++k) { const int pi = lane + 64 * k; *(PG8_LAS pg8::v4i_t*)(Q + pi * 8) = v[2 + k]; *(PG8_LAS pg8::v4i_t*)(K + pi * 8) = v[8 + k]; }
        LDS_WAIT();
        const bool act = lane < 48; const int i = act ? lane : 0; const int j = hh * 48 + i; float w[16];
#pragma unroll
        for (int q = 0; q < 16; ++q) w[q] = wa2[((size_t)d * 16 + q) * 192 + j];
        const float bj = ba[d * 192 + j]; float c = 0.f; unsigned oq[32], ok[32];
#pragma unroll
        for (int p2 = 0; p2 < 32; ++p2) { float qv[2], kv[2];
#pragma unroll
            for (int h2 = 0; h2 < 2; ++h2) { const int pp = 2 * p2 + h2; const int tok = d == 0 ? pp : 63 - pp; const pg8::v4i_t l0 = *(const PG8_LAS pg8::v4i_t*)(LR + tok * 16), l1 = *(const PG8_LAS pg8::v4i_t*)(LR + tok * 16 + 8);
                const unsigned u[8] = {(unsigned)l0.x, (unsigned)l0.y, (unsigned)l0.z, (unsigned)l0.w, (unsigned)l1.x, (unsigned)l1.y, (unsigned)l1.z, (unsigned)l1.w}; float z = bj;
#pragma unroll
                for (int q = 0; q < 8; ++q) { z += __uint_as_float(u[q] << 16) * w[2 * q]; z += __uint_as_float(u[q] & 0xffff0000u) * w[2 * q + 1]; }
                c += logsigmoidf_(z) * (1.0f / 16.0f); qv[h2] = bf2f(Q[tok * 48 + i]) * 0.14433756729740643f * fexp(c); kv[h2] = bf2f(K[tok * 48 + i]) * fexp(-c); }
            oq[p2] = act ? cvt_pk_bf16(qv[0], qv[1]) : 0u; ok[p2] = act ? cvt_pk_bf16(kv[0], kv[1]) : 0u; }
        { float* dec = (float*)(lab + L::dec) + ((size_t)d * LA_NI + item) * 64; dec[lane] = act ? fexp(c) : 0.f; }
        LDS_WAIT();
#pragma unroll 1
        for (int im = 0; im < 2; ++im) {
#pragma unroll
            for (int p2 = 0; p2 < 32; ++p2) { const unsigned o = im ? ok[p2] : oq[p2]; const int ta = d == 0 ? 2 * p2 : 63 - 2 * p2, tb2 = d == 0 ? 2 * p2 + 1 : 62 - 2 * p2; const int cb = (lane >> 5) * 512 + (((lane & 31) >> 3) << 4) * 8 + (lane & 7);
                X[(ta >> 4) * 1024 + cb + (ta & 15) * 8] = (bf16)(o & 0xffffu); X[(tb2 >> 4) * 1024 + cb + (tb2 & 15) * 8] = (bf16)(o >> 16); }
            LDS_WAIT();
            bf16* dst = lab + (im ? L::kin : L::qin) + ((size_t)d * LA_NI + item) * 64 * 64;
#pragma unroll
            for (int k = 0; k < 8; ++k) { const int pi = lane + 64 * k; const pg8::v4i_t wv = *(const PG8_LAS pg8::v4i_t*)(X + pi * 8); *(pg8::v4i_t*)(dst + (size_t)pi * 8) = wv; }
            LDS_WAIT(); }
#pragma unroll
        for (int p2 = 0; p2 < 32; ++p2) { const unsigned o = ok[p2]; const int tl = d == 0 ? 2 * p2 : 62 - 2 * p2; const unsigned ov = d == 0 ? o : ((o >> 16) | (o << 16));
            *(PG8_LAS unsigned*)(X + ((lane >> 4) * 2 + (tl >> 5)) * 512 + ((((tl & 31) >> 3) << 4) + (lane & 15)) * 8 + (tl & 7)) = ov; }
        LDS_WAIT();
        { bf16* dst = lab + L::koutT + ((size_t)d * LA_NI + item) * 64 * 64;
#pragma unroll
          for (int k = 0; k < 8; ++k) { const int pi = lane + 64 * k; const pg8::v4i_t wv = *(const PG8_LAS pg8::v4i_t*)(X + pi * 8); *(pg8::v4i_t*)(dst + (size_t)pi * 8) = wv; } }
        LDS_WAIT(); } };

template <int NV, int VOFF> struct VTW { int n; int pad; const bf16* p; bf16* vT;
    __device__ __forceinline__ void wave(int it, int lane, PG8_LAS unsigned char* lw) const { const int hh = it & 3; const int bb = it >> 2; const size_t r0 = (size_t)(bb / NBLK) * RPB + (bb % NBLK) * 64;
        PG8_LAS bf16* t = (PG8_LAS bf16*)lw; pg8::v4i_t v[12];
#pragma unroll
        for (int k = 0; k < 12; ++k) { const int pi = lane + 64 * k, rw = pi / 12, c = pi % 12; v[k] = *(const pg8::v4i_t*)(p + (r0 + rw) * PS + VOFF + hh * 96 + c * 8); }
#pragma unroll
        for (int k = 0; k < 12; ++k) { const int pi = lane + 64 * k, rw = pi / 12, c = pi % 12; *(PG8_LAS pg8::v4i_t*)(t + rw * 104 + c * 8) = v[k]; }
        LDS_WAIT();
        bf16* o = vT + (size_t)it * NV * 64 + (size_t)lane * 8; const int jr = lane & 15, sq = (lane >> 4) * 8;
#pragma unroll
        for (int jt = 0; jt < 6; ++jt)
#pragma unroll
            for (int ks = 0; ks < 2; ++ks) { const PG8_LAS bf16* c0 = t + (ks * 32 + sq) * 104 + jt * 16 + jr; pg8::v4i_t w;
                w.x = (int)((unsigned)c0[0] | ((unsigned)c0[104] << 16)); w.y = (int)((unsigned)c0[208] | ((unsigned)c0[312] << 16)); w.z = (int)((unsigned)c0[416] | ((unsigned)c0[520] << 16)); w.w = (int)((unsigned)c0[624] | ((unsigned)c0[728] << 16));
                *(pg8::v4i_t*)(o + (jt * 2 + ks) * 512) = w; }
        if (NV > 96) { const int f = jr == 0 ? 0x3f803f80 : 0; const pg8::v4i_t w = {f, f, f, f};
#pragma unroll
            for (int ks = 0; ks < 2; ++ks) *(pg8::v4i_t*)(o + (12 + ks) * 512) = w; }
        LDS_WAIT(); } };

template <int DKP, int NV, int NG, int MR = 1> struct ChainW { int n; int pad; bf16* lab;
    static constexpr int CG = DKP / (16 * NG), MT = NV / 16, MG = (MT + MR - 1) / MR;
    struct Fr { pg8::bf16x8 a[MR][2]; pg8::bf16x8 b[NG][2]; float dc[NG]; };
    __device__ __forceinline__ static int jt_of(int jg, int i) { const int j = jg * MR + i; return j < MT ? j : MT - 1; }
    __device__ __forceinline__ void load(Fr& f, int d, int b, int hh, int jg, int cg, int step, int r, int q) const { typedef LaLay<DKP, NV> L; const int blk = chain_blk(d, step); const size_t item = ((size_t)b * NBLK + blk) * 4 + hh; const int ln = q * 16 + r;
        const bf16* Bt = lab + L::koutT + ((size_t)d * LA_NI + item) * DKP * 64 + ((size_t)(cg * NG * 2) * 64 + ln) * 8;
        const float* dec = (const float*)(lab + L::dec) + ((size_t)d * LA_NI + item) * DKP + cg * (16 * NG) + r;
#pragma unroll
        for (int i = 0; i < MR; ++i) { const bf16* A = lab + L::vT + item * NV * 64 + ((size_t)(jt_of(jg, i) * 2) * 64 + ln) * 8;
#pragma unroll
            for (int ks = 0; ks < 2; ++ks) f.a[i][ks] = *(const pg8::bf16x8*)(A + ks * 512); }
#pragma unroll
        for (int nn = 0; nn < NG; ++nn) {
#pragma unroll
            for (int ks = 0; ks < 2; ++ks) f.b[nn][ks] = *(const pg8::bf16x8*)(Bt + (nn * 2 + ks) * 512);
            f.dc[nn] = dec[nn * 16]; } }
    __device__ __forceinline__ void process(const Fr& f, pg8::f32x4 (&S)[MR][NG], int d, int b, int hh, int jg, int cg, int step, int r, int q, PG8_LAS unsigned char* lw) const { typedef LaLay<DKP, NV> L;
        pg8::f32x4 acc[MR][NG];
#pragma unroll
        for (int i = 0; i < MR; ++i)
#pragma unroll
            for (int nn = 0; nn < NG; ++nn) acc[i][nn] = (pg8::f32x4){0.f, 0.f, 0.f, 0.f};
#pragma unroll
        for (int ks = 0; ks < 2; ++ks)
#pragma unroll
            for (int i = 0; i < MR; ++i)
#pragma unroll
                for (int nn = 0; nn < NG; ++nn) acc[i][nn] = __builtin_amdgcn_mfma_f32_16x16x32_bf16(f.a[i][ks], f.b[nn][ks], acc[i][nn], 0, 0, 0);
        const int blk = chain_blk(d, step); const size_t item = ((size_t)b * NBLK + blk) * 4 + hh; PG8_LAS bf16* lt = (PG8_LAS bf16*)lw;
#pragma unroll
        for (int i = 0; i < MR; ++i)
#pragma unroll
            for (int nn = 0; nn < NG; ++nn)
#pragma unroll
                for (int e = 0; e < 4; ++e) { const int col = nn * 16 + r; lt[i * (NG / 2) * 512 + (col >> 5) * 512 + ((((col & 31) >> 3) << 4) + q * 4 + e) * 8 + (col & 7)] = f2bf(S[i][nn][e]); S[i][nn][e] = f.dc[nn] * (S[i][nn][e] + acc[i][nn][e]); }
        LDS_WAIT();
#pragma unroll
        for (int i = 0; i < MR; ++i) { bf16* out = lab + L::sT + ((size_t)d * LA_NI + item) * NV * DKP + ((size_t)(jt_of(jg, i) * (DKP / 32) + cg * (NG / 2)) * 64 + q * 16 + r) * 8;
#pragma unroll
            for (int tl = 0; tl < NG / 2; ++tl) { const pg8::v4i_t pv = *(const PG8_LAS pg8::v4i_t*)(lt + ((i * (NG / 2) + tl) * 64 + q * 16 + r) * 8); *(pg8::v4i_t*)(out + tl * 512) = pv; } }
        LDS_WAIT(); }
    __device__ __forceinline__ void wave(int it, int lane, PG8_LAS unsigned char* lw) const {
        const int cg = it % CG; int c = it / CG; const int jt = c % MG; c /= MG; const int hh = c % 4; c /= 4; const int b = c % NB, d = c / NB; const int r = lane & 15, q = lane >> 4;
        pg8::f32x4 S[MR][NG];
#pragma unroll
        for (int i = 0; i < MR; ++i)
#pragma unroll
            for (int nn = 0; nn < NG; ++nn) S[i][nn] = (pg8::f32x4){0.f, 0.f, 0.f, 0.f};
        auto cl = [](int st) { return st < NBLK ? st : NBLK - 1; };
        Fr f0, f1, f2, f3; load(f0, d, b, hh, jt, cg, 0, r, q); load(f1, d, b, hh, jt, cg, cl(1), r, q); load(f2, d, b, hh, jt, cg, cl(2), r, q);
        static_assert(NBLK % 4 == 0 || NBLK < 4, "ChainW walks the chain four blocks per trip");
        for (int step = 0; step + 3 < NBLK; step += 4) {
            load(f3, d, b, hh, jt, cg, step + 3, r, q);
            process(f0, S, d, b, hh, jt, cg, step, r, q, lw);
            load(f0, d, b, hh, jt, cg, cl(step + 4), r, q);
            process(f1, S, d, b, hh, jt, cg, step + 1, r, q, lw);
            load(f1, d, b, hh, jt, cg, cl(step + 5), r, q);
            process(f2, S, d, b, hh, jt, cg, step + 2, r, q, lw);
            load(f2, d, b, hh, jt, cg, cl(step + 6), r, q);
            process(f3, S, d, b, hh, jt, cg, step + 3, r, q, lw); }
        if (NBLK < 4) { process(f0, S, d, b, hh, jt, cg, 0, r, q, lw); if (NBLK > 1) process(f1, S, d, b, hh, jt, cg, 1, r, q, lw); if (NBLK > 2) process(f2, S, d, b, hh, jt, cg, 2, r, q, lw); } } };
template <class C, int IPC, int WPG, int L0, int LN> struct ChainPlace { int n; C c;
    __device__ __forceinline__ void wave(int slot, int lane, PG8_LAS unsigned char* lw) const {
        const int wg = slot >> 3, wid = slot & 7, xcd = wg & 7, local = wg >> 3; constexpr int GPC = IPC / WPG;
        if (local < L0 || local >= LN || wid >= WPG) return;
        const int l2 = local - L0; const int chain = (l2 / GPC) * 8 + xcd, j = (l2 % GPC) * WPG + wid; const int item = chain * IPC + j;
        if (item < c.n) c.wave(item, lane, lw); } };
template <int DKP, int NV, bool ISML> struct OutW { int n; int pad; const bf16* lab; const bf16* p; const float* gain; bf16* mix;
    __device__ __forceinline__ void wave(int it, int lane, PG8_LAS unsigned char* lw) const { typedef LaLay<DKP, NV> L; constexpr int NT = NV / 16, KQ = DKP / 32; typedef pg8::bf16x8 frag;
        const size_t item = (size_t)(it >> 1); const int half = it & 1, hh = (int)(item % 4); const size_t bb = item / 4; const size_t r0 = (bb / NBLK) * RPB + (bb % NBLK) * 64; const int t0 = half * 32;
        const int r = lane & 15, q = lane >> 4; PG8_LAS bf16* latt = (PG8_LAS bf16*)lw;
        pg8::f32x4 acc[2][NT], hs[2][6];
#pragma unroll
        for (int m = 0; m < 2; ++m) {
#pragma unroll
            for (int nn = 0; nn < NT; ++nn) acc[m][nn] = (pg8::f32x4){0.f, 0.f, 0.f, 0.f};
#pragma unroll
            for (int nn = 0; nn < 6; ++nn) hs[m][nn] = (pg8::f32x4){0.f, 0.f, 0.f, 0.f}; }
        const bf16* vp = lab + L::vT + item * NV * 64 + (size_t)lane * 8;
#pragma unroll
        for (int d = 0; d < 2; ++d) {
            const bf16* qp = lab + L::qin + ((size_t)d * LA_NI + item) * 64 * DKP + ((size_t)(t0 / 16) * KQ * 64 + lane) * 8; const bf16* kp = lab + L::kin + ((size_t)d * LA_NI + item) * 64 * DKP + (size_t)lane * 8;
            const bf16* sp = lab + L::sT + ((size_t)d * LA_NI + item) * NV * DKP + (size_t)lane * 8;
            frag qa[2][KQ], sf[NT][KQ];
#pragma unroll
            for (int m = 0; m < 2; ++m)
#pragma unroll
                for (int ks = 0; ks < KQ; ++ks) qa[m][ks] = *(const frag*)(qp + (m * KQ + ks) * 512);
#pragma unroll
            for (int nn = 0; nn < NT; ++nn)
#pragma unroll
                for (int ks = 0; ks < KQ; ++ks) sf[nn][ks] = *(const frag*)(sp + (nn * KQ + ks) * 512);
            frag kf[4][KQ], vf[NT][2];
            if constexpr (!ISML) {
#pragma unroll
                for (int nn = 0; nn < 4; ++nn)
#pragma unroll
                    for (int ks = 0; ks < KQ; ++ks) kf[nn][ks] = *(const frag*)(kp + (nn * KQ + ks) * 512);
#pragma unroll
                for (int nn = 0; nn < NT; ++nn)
#pragma unroll
                    for (int ks = 0; ks < 2; ++ks) vf[nn][ks] = *(const frag*)(vp + (nn * 2 + ks) * 512); }
#pragma unroll
            for (int ks = 0; ks < KQ; ++ks)
#pragma unroll
                for (int m = 0; m < 2; ++m)
#pragma unroll
                    for (int nn = 0; nn < NT; ++nn) acc[m][nn] = __builtin_amdgcn_mfma_f32_16x16x32_bf16(qa[m][ks], sf[nn][ks], acc[m][nn], 0, 0, 0);
            if constexpr (ISML) {
#pragma unroll
            for (int nn = 0; nn < 4; ++nn)
#pragma unroll
                for (int ks = 0; ks < KQ; ++ks) kf[nn][ks] = *(const frag*)(kp + (nn * KQ + ks) * 512); }
            pg8::f32x4 at[2][4];
#pragma unroll
            for (int m = 0; m < 2; ++m)
#pragma unroll
                for (int nn = 0; nn < 4; ++nn) at[m][nn] = (pg8::f32x4){0.f, 0.f, 0.f, 0.f};
#pragma unroll
            for (int ks = 0; ks < KQ; ++ks)
#pragma unroll
                for (int m = 0; m < 2; ++m)
#pragma unroll
                    for (int nn = 0; nn < 4; ++nn) at[m][nn] = __builtin_amdgcn_mfma_f32_16x16x32_bf16(qa[m][ks], kf[nn][ks], at[m][nn], 0, 0, 0);
            if constexpr (ISML) {
#pragma unroll
            for (int nn = 0; nn < NT; ++nn)
#pragma unroll
                for (int ks = 0; ks < 2; ++ks) vf[nn][ks] = *(const frag*)(vp + (nn * 2 + ks) * 512); }
#pragma unroll
            for (int m = 0; m < 2; ++m)
#pragma unroll
                for (int nn = 0; nn < 4; ++nn)
#pragma unroll
                    for (int e = 0; e < 4; ++e) { const int tl = m * 16 + q * 4 + e, tt = t0 + tl, sx = nn * 16 + r; const bool valid = d == 0 ? (sx <= tt) : (sx >= tt);
                        latt[tl * 72 + sx] = f2bf(valid ? at[m][nn][e] : 0.f); }
            LDS_WAIT();
            frag af[2][2];
#pragma unroll
            for (int m = 0; m < 2; ++m)
#pragma unroll
                for (int ks = 0; ks < 2; ++ks) af[m][ks] = *(const PG8_LAS frag*)(latt + (m * 16 + r) * 72 + ks * 32 + q * 8);
#pragma unroll
            for (int ks = 0; ks < 2; ++ks)
#pragma unroll
                for (int m = 0; m < 2; ++m)
#pragma unroll
                    for (int nn = 0; nn < NT; ++nn) acc[m][nn] = __builtin_amdgcn_mfma_f32_16x16x32_bf16(af[m][ks], vf[nn][ks], acc[m][nn], 0, 0, 0);
            LDS_WAIT();
            if (ISML) {
#pragma unroll
                for (int m = 0; m < 2; ++m)
#pragma unroll
                    for (int e = 0; e < 4; ++e) { const float den = __shfl(acc[m][NT - 1][e], lane & 48); const float inv = 1.0f / fmaxf(fabsf(den), 1.0f);
#pragma unroll
                        for (int nn = 0; nn < 6; ++nn) { hs[m][nn][e] += acc[m][nn][e] * inv; acc[m][nn][e] = 0.f; }
                        acc[m][NT - 1][e] = 0.f; } } }
#pragma unroll
        for (int m = 0; m < 2; ++m)
#pragma unroll
            for (int e = 0; e < 4; ++e) { float ss = 0.f;
#pragma unroll
                for (int nn = 0; nn < 6; ++nn) { const float o = ISML ? hs[m][nn][e] : acc[m][nn][e]; ss += o * o; }
                ss += __shfl_xor(ss, 1); ss += __shfl_xor(ss, 2); ss += __shfl_xor(ss, 4); ss += __shfl_xor(ss, 8);
                const float rstd = 1.0f / sqrtf(ss * (1.0f / 96.0f) + EPS); PG8_LAS float* fo = (PG8_LAS float*)lw + (m * 16 + q * 4 + e) * 100;
#pragma unroll
                for (int nn = 0; nn < 6; ++nn) { const int j = nn * 16 + r; const float o = ISML ? hs[m][nn][e] : acc[m][nn][e]; fo[j] = o * rstd * gain[j]; } }
        LDS_WAIT();
        uint4 gv[6];
#pragma unroll
        for (int k = 0; k < 6; ++k) { const int pi = lane + 64 * k, rw = pi / 12, c8 = pi % 12; gv[k] = *(const uint4*)(p + (r0 + t0 + rw) * PS + (ISML ? MO : GG) + hh * 96 + c8 * 8); }
#pragma unroll
        for (int k = 0; k < 6; ++k) { const int pi = lane + 64 * k, rw = pi / 12, c8 = pi % 12; const PG8_LAS float* fr = (const PG8_LAS float*)lw + rw * 100 + c8 * 8;
            const pg8::f32x4 a0 = *(const PG8_LAS pg8::f32x4*)fr, a1 = *(const PG8_LAS pg8::f32x4*)(fr + 4); const unsigned gw[4] = {gv[k].x, gv[k].y, gv[k].z, gv[k].w}; float gt[8];
#pragma unroll
            for (int e = 0; e < 4; ++e) { const float g0 = __uint_as_float(gw[e] << 16), g1 = __uint_as_float(gw[e] & 0xffff0000u); gt[2 * e] = ISML ? fast_sigmoid(g0) : fast_silu(g0); gt[2 * e + 1] = ISML ? fast_sigmoid(g1) : fast_silu(g1); }
            uint4 ov; ov.x = cvt_pk_bf16(a0[0] * gt[0], a0[1] * gt[1]); ov.y = cvt_pk_bf16(a0[2] * gt[2], a0[3] * gt[3]); ov.z = cvt_pk_bf16(a1[0] * gt[4], a1[1] * gt[5]); ov.w = cvt_pk_bf16(a1[2] * gt[6], a1[3] * gt[7]);
            *(uint4*)(mix + (r0 + t0 + rw) * D + (ISML ? 640 : 0) + hh * 96 + c8 * 8) = ov; }
        LDS_WAIT(); } };

struct OutWG { int n; int pad; const bf16* lab; const bf16* p; const float* gain; bf16* mix;
    __device__ __forceinline__ void wave(int it, int lane, PG8_LAS unsigned char* lw) const { constexpr int DKP = 64, NV = 96; typedef LaLay<DKP, NV> L; constexpr int NT = 6, KQ = 2; typedef pg8::bf16x8 frag;
        const size_t item = (size_t)it; const int hh = (int)(item % 4); const size_t bb = item / 4; const size_t r0 = (bb / NBLK) * RPB + (bb % NBLK) * 64;
        const int r = lane & 15, q = lane >> 4; PG8_LAS bf16* latt = (PG8_LAS bf16*)lw;
        pg8::f32x4 acc[4][NT];
#pragma unroll
        for (int m = 0; m < 4; ++m)
#pragma unroll
            for (int nn = 0; nn < NT; ++nn) acc[m][nn] = (pg8::f32x4){0.f, 0.f, 0.f, 0.f};
        const bf16* vp = lab + L::vT + item * NV * 64 + (size_t)lane * 8;
#pragma unroll
        for (int d = 0; d < 2; ++d) {
            const bf16* qp = lab + L::qin + ((size_t)d * LA_NI + item) * 64 * DKP + (size_t)lane * 8; const bf16* kp = lab + L::kin + ((size_t)d * LA_NI + item) * 64 * DKP + (size_t)lane * 8;
            const bf16* sp = lab + L::sT + ((size_t)d * LA_NI + item) * NV * DKP + (size_t)lane * 8;
            frag qa[4][KQ], kf[4][KQ];
            { frag sf[NT][KQ];
#pragma unroll
            for (int m = 0; m < 4; ++m)
#pragma unroll
                for (int ks = 0; ks < KQ; ++ks) qa[m][ks] = *(const frag*)(qp + (m * KQ + ks) * 512);
#pragma unroll
            for (int nn = 0; nn < NT; ++nn)
#pragma unroll
                for (int ks = 0; ks < KQ; ++ks) sf[nn][ks] = *(const frag*)(sp + (nn * KQ + ks) * 512);
#pragma unroll
            for (int nn = 0; nn < 4; ++nn)
#pragma unroll
                for (int ks = 0; ks < KQ; ++ks) kf[nn][ks] = *(const frag*)(kp + (nn * KQ + ks) * 512);
#pragma unroll
            for (int ks = 0; ks < KQ; ++ks)
#pragma unroll
                for (int m = 0; m < 4; ++m)
#pragma unroll
                    for (int nn = 0; nn < NT; ++nn) acc[m][nn] = __builtin_amdgcn_mfma_f32_16x16x32_bf16(qa[m][ks], sf[nn][ks], acc[m][nn], 0, 0, 0); }
            __builtin_amdgcn_sched_barrier(0);
            frag vf[NT][2];
#pragma unroll
            for (int hp = 0; hp < 2; ++hp) { pg8::f32x4 at[2][4];
                if (hp == 1) { __builtin_amdgcn_sched_barrier(0);
#pragma unroll
                    for (int nn = 0; nn < NT; ++nn)
#pragma unroll
                        for (int ks = 0; ks < 2; ++ks) vf[nn][ks] = *(const frag*)(vp + (nn * 2 + ks) * 512);
                    __builtin_amdgcn_sched_barrier(0); }
#pragma unroll
                for (int m = 0; m < 2; ++m)
#pragma unroll
                    for (int nn = 0; nn < 4; ++nn) at[m][nn] = (pg8::f32x4){0.f, 0.f, 0.f, 0.f};
#pragma unroll
                for (int ks = 0; ks < KQ; ++ks)
#pragma unroll
                    for (int m = 0; m < 2; ++m)
#pragma unroll
                        for (int nn = 0; nn < 4; ++nn) at[m][nn] = __builtin_amdgcn_mfma_f32_16x16x32_bf16(qa[2 * hp + m][ks], kf[nn][ks], at[m][nn], 0, 0, 0);
#pragma unroll
                for (int m = 0; m < 2; ++m)
#pragma unroll
                    for (int nn = 0; nn < 4; ++nn)
#pragma unroll
                        for (int e = 0; e < 4; ++e) { const int tt = hp * 32 + m * 16 + q * 4 + e, sx = nn * 16 + r; const bool valid = d == 0 ? (sx <= tt) : (sx >= tt);
                            latt[tt * 72 + sx] = f2bf(valid ? at[m][nn][e] : 0.f); } }
            LDS_WAIT();
            frag af[4][2];
#pragma unroll
            for (int m = 0; m < 4; ++m)
#pragma unroll
                for (int ks = 0; ks < 2; ++ks) af[m][ks] = *(const PG8_LAS frag*)(latt + (m * 16 + r) * 72 + ks * 32 + q * 8);
#pragma unroll
            for (int ks = 0; ks < 2; ++ks)
#pragma unroll
                for (int m = 0; m < 4; ++m)
#pragma unroll
                    for (int nn = 0; nn < NT; ++nn) acc[m][nn] = __builtin_amdgcn_mfma_f32_16x16x32_bf16(af[m][ks], vf[nn][ks], acc[m][nn], 0, 0, 0);
            LDS_WAIT(); }
#pragma unroll
        for (int hp = 0; hp < 2; ++hp) { const int t0 = hp * 32;
#pragma unroll
            for (int m = 0; m < 2; ++m)
#pragma unroll
                for (int e = 0; e < 4; ++e) { float ss = 0.f;
#pragma unroll
                    for (int nn = 0; nn < 6; ++nn) { const float o = acc[2 * hp + m][nn][e]; ss += o * o; }
                    ss += __shfl_xor(ss, 1); ss += __shfl_xor(ss, 2); ss += __shfl_xor(ss, 4); ss += __shfl_xor(ss, 8);
                    const float rstd = 1.0f / sqrtf(ss * (1.0f / 96.0f) + EPS); PG8_LAS float* fo = (PG8_LAS float*)lw + (m * 16 + q * 4 + e) * 100;
#pragma unroll
                    for (int nn = 0; nn < 6; ++nn) { const int j = nn * 16 + r; fo[j] = acc[2 * hp + m][nn][e] * rstd * gain[j]; } }
            LDS_WAIT();
            uint4 gv[6];
#pragma unroll
            for (int k = 0; k < 6; ++k) { const int pi = lane + 64 * k, rw = pi / 12, c8 = pi % 12; gv[k] = *(const uint4*)(p + (r0 + t0 + rw) * PS + GG + hh * 96 + c8 * 8); }
#pragma unroll
            for (int k = 0; k < 6; ++k) { const int pi = lane + 64 * k, rw = pi / 12, c8 = pi % 12; const PG8_LAS float* fr = (const PG8_LAS float*)lw + rw * 100 + c8 * 8;
                const pg8::f32x4 a0 = *(const PG8_LAS pg8::f32x4*)fr, a1 = *(const PG8_LAS pg8::f32x4*)(fr + 4); const unsigned gw[4] = {gv[k].x, gv[k].y, gv[k].z, gv[k].w}; float gt[8];
#pragma unroll
                for (int e = 0; e < 4; ++e) { const float g0 = __uint_as_float(gw[e] << 16), g1 = __uint_as_float(gw[e] & 0xffff0000u); gt[2 * e] = fast_silu(g0); gt[2 * e + 1] = fast_silu(g1); }
                uint4 ov; ov.x = cvt_pk_bf16(a0[0] * gt[0], a0[1] * gt[1]); ov.y = cvt_pk_bf16(a0[2] * gt[2], a0[3] * gt[3]); ov.z = cvt_pk_bf16(a1[0] * gt[4], a1[1] * gt[5]); ov.w = cvt_pk_bf16(a1[2] * gt[6], a1[3] * gt[7]);
                *(uint4*)(mix + (r0 + t0 + rw) * D + hh * 96 + c8 * 8) = ov; }
            LDS_WAIT(); } } };

#ifdef MULTI_LAUNCH
template <class F> __global__ void __launch_bounds__(256) k_run(F f) {
    for (long i = (long)blockIdx.x * blockDim.x + threadIdx.x; i < f.n; i += (long)gridDim.x * blockDim.x) f(i);
}
template <class F> __global__ void __launch_bounds__(512, 2) k_wrun(F f) {
    extern __shared__ __attribute__((aligned(16))) unsigned char shm[];
    const int wid = threadIdx.x >> 6, lane = threadIdx.x & 63;
    for (int it = blockIdx.x * 8 + wid; it < f.n; it += gridDim.x * 8) f.wave(it, lane, (PG8_LAS unsigned char*)shm + wid * 16384);
}
template <class F> __global__ void __launch_bounds__(512, 2) k_gemm(GemmDesc g, F e) {
    extern __shared__ __attribute__((aligned(16))) unsigned char shm[];
    pg8::gemm_phase<F>((PG8_LAS unsigned char*)shm, g, e, (int)gridDim.x, (int)blockIdx.x);
}
struct Ctx { hipStream_t stream; int ncu; const void* const* tbl;
    void mark(int) const {} void probe_out(float*) const {}
    template <int I> const float* inp() const { return (const float*)tbl[I]; }
    template <class F> void run(const F& f, bool sync = true, int ioff = 0) {
        if (f.n <= 0) return; long nb = (f.n + 255) / 256; if (nb > 256L * 32) nb = 256L * 32;
        hipLaunchKernelGGL(k_run<F>, dim3((unsigned)nb), dim3(256), 0, stream, f); }
    template <class F> void wrun(const F& f, bool sync = true, int woff = 0) {
        static bool attr_set = false;
        if (!attr_set) { (void)hipFuncSetAttribute((const void*)k_wrun<F>, hipFuncAttributeMaxDynamicSharedMemorySize, pg8::STAGE_BYTES); attr_set = true; }
        hipLaunchKernelGGL(k_wrun<F>, dim3(ncu), dim3(512), pg8::STAGE_BYTES, stream, f); }
    template <class F> void gemm(const GemmDesc& g, const F& e) {
        static bool attr_set = false;
        if (!attr_set) { (void)hipFuncSetAttribute((const void*)k_gemm<F>, hipFuncAttributeMaxDynamicSharedMemorySize, pg8::STAGE_BYTES); attr_set = true; }
        hipLaunchKernelGGL(k_gemm<F>, dim3(ncu), dim3(512), pg8::STAGE_BYTES, stream, g, e); }
};
#else
#ifndef PROBE_A
#define PROBE_A -1
#endif
#ifndef PROBE_B
#define PROBE_B -1
#endif
struct Ctx { XcdBarrier bar; PG8_LAS unsigned char* lds; int gtid, nthr;
    __device__ __forceinline__ void mark(int id) const { if (PROBE_A >= 0 && blockIdx.x == 0 && threadIdx.x == 0) { volatile PG8_LAS unsigned long long* t = (volatile PG8_LAS unsigned long long*)(lds + pg8::STAGE_BYTES + 400);
            if (id == PROBE_A) t[0] = __builtin_amdgcn_s_memrealtime(); if (id == PROBE_B) t[1] = __builtin_amdgcn_s_memrealtime(); } }
    __device__ __forceinline__ void probe_out(float* o) const { if (PROBE_A >= 0 && blockIdx.x == 0 && threadIdx.x == 0) { volatile PG8_LAS unsigned long long* t = (volatile PG8_LAS unsigned long long*)(lds + pg8::STAGE_BYTES + 400);
            o[0] += (float)(t[1] - t[0]) * 0.1f; } }
    template <int I> __device__ __forceinline__ const float* inp() const { unsigned off = pg8::STAGE_BYTES + 64 + 8 * I; asm volatile("" : "+v"(off));
        const PG8_LAS unsigned* t = (const PG8_LAS unsigned*)(lds + off);
        const unsigned lo = __builtin_amdgcn_readfirstlane(t[0]), hi = __builtin_amdgcn_readfirstlane(t[1]);
        return (const float*)(const __attribute__((address_space(1))) float*)(((unsigned long long)hi << 32) | lo); }
    template <class F> __device__ __forceinline__ void run(const F& f, bool sync = true, int ioff = 0) {
        int i0 = gtid - ioff; asm volatile("" : "+v"(i0)); if (i0 < 0) i0 += nthr;
        const int n = (int)f.n; int st = (int)nthr; asm volatile("" : "+s"(st));
        for (int i = i0; i < n; i += st) f((long)i);
        if (sync) xcd_barrier(bar); }
    template <class F> __device__ __forceinline__ void wrun(const F& f, bool sync = true, int woff = 0) {
        int t0 = threadIdx.x; asm volatile("" : "+v"(t0));
        const int wid = __builtin_amdgcn_readfirstlane(t0 >> 6), lane = t0 & 63; const int nw = (int)gridDim.x * 8; int w0 = (int)blockIdx.x * 8 + wid - woff; if (w0 < 0) w0 += nw;
        for (int it = w0; it < f.n; it += nw) { int ln = lane; asm volatile("" : "+v"(ln));
            f.wave(it, ln, lds + wid * 16384); }
        if (sync) xcd_barrier(bar); }
    template <class F> __device__ __forceinline__ void gemm(const GemmDesc& g, const F& e) {
        pg8::gemm_phase<F>(lds, g, e, (int)gridDim.x, (int)blockIdx.x);
        xcd_barrier(bar); }
    template <class F> __device__ __forceinline__ void gemm8(const GemmDesc& g, const F& e) {
        pg8::gemm_phase<F, true, false>(lds, g, e, (int)gridDim.x, (int)blockIdx.x);
        xcd_barrier(bar); }
};
#endif
#else
struct Ctx { const void* const* tbl;
void mark(int) const {} void probe_out(float*) const {}
template <int I> const float* inp() const { return (const float*)tbl[I]; }
template <class F> void run(const F& f, bool sync = true, int ioff = 0) {
#pragma omp parallel for schedule(static)
    for (long i = 0; i < f.n; ++i) f(i);
}
template <class F> void gemm(const GemmDesc& g, const F& e) {
    int M = g.M; if (g.ntile) { int nt = g.ntile[0] - g.tile0; if (nt < 0) nt = 0; if (nt * 256 < M) M = nt * 256; }
#pragma omp parallel for schedule(dynamic, 4)
    for (int r = 0; r < M; ++r) {
        int ar = r; if (g.arow) { ar = g.arow[(size_t)g.tile0 * 256 + r]; if (ar < 0) ar = 0; }
        const bf16* a = g.A + (size_t)ar * g.lda; const bf16* B = g.Bt + (g.tile_e ? (size_t)g.tile_e[g.tile0 + r / 256] * g.e_stride : (g.tdiv ? (size_t)((r / 256) / g.tdiv) * g.e_stride : 0));
        static thread_local float af[4096]; for (int k = 0; k < g.K; ++k) af[k] = bf2f(a[k]);
        for (int c0 = 0; c0 < g.N; c0 += 8) { float v[8];
            for (int j = 0; j < 8; ++j) { const bf16* bt = B + (size_t)(c0 + j) * g.ldb; float s = 0.f; for (int k = 0; k < g.K; ++k) s += af[k] * bf2f(bt[k]); v[j] = s; }
            e.apply8(r, c0, v); }
    }
}
};
#endif

struct Inputs { const float *x, *c, *ctx, *c_ctx, *w_ada, *b_ada, *norm1, *norm2, *w_in, *w_out, *gla_wa2, *gla_ba, *gla_norm, *s5_lam_re, *s5_lam_im, *s5_log_dt, *s5_b_re, *s5_b_im,
    *s5_c_re, *s5_c_im, *s5_d, *s5_glu_w, *s5_glu_b, *ml_conv_w, *ml_conv_b, *ml_gate_b, *ml_norm, *ffn_w1, *ffn_w3, *ffn_w2, *moe_router, *moe_w1, *moe_w3, *moe_w2, *norm_f; };

#define INP(name) (cx.template inp<offsetof(Inputs, name) / 8>())
#ifndef PROBE_REP
#define PROBE_REP -1
#endif
#ifndef PROBE_L
#define PROBE_L -1
#endif
#define REPEAT(k) if constexpr (false) {} else for (int rep_ = 0; rep_ < 1; ++rep_)
#define SEC_BEGIN(k) { auto sec_ = [&]() __attribute__((always_inline)) {
#define SEC_END(k) }; sec_(); if constexpr (PROBE_REP == (k) && (PROBE_L == l || PROBE_L < 0)) sec_(); }
#define WSB ((unsigned char*)cx.template inp<36>())
#ifdef HOST_EMU
#define S5TABBASE (WSB + WS.s5tab)
#else
#define S5TABBASE ((unsigned char*)cx.template inp<35>() + ABUF_BYTES)
#endif
#define out ((float*)cx.template inp<35>())
#define mod ((float*)(WSB + WS.mod))
#define h ((float*)(WSB + WS.h))
#define abuf ((bf16*)cx.template inp<35>())
#define winT ((bf16*)(WSB + WS.winT))
#define woutT ((bf16*)(WSB + WS.woutT))
#define w13T ((bf16*)(WSB + WS.w13T))
#define w2T ((bf16*)(WSB + WS.w2T))
#define pbuf ((bf16*)(WSB + WS.pbuf))
#define obuf ((float*)(WSB + WS.obuf))
#define lab ((bf16*)(WSB + WS.lab))
#define labg ((bf16*)(WSB + WS.labg))
#define s5disc ((float*)(S5TABBASE + S5T.disc))
#define s5K ((float*)(S5TABBASE + S5T.K))
#define s5apow ((float*)(S5TABBASE + S5T.apow))
#define s5bbar ((float*)(S5TABBASE + S5T.bbar))
#define s5TB ((bf16*)(S5TABBASE + S5T.TB))
#define s5EB ((bf16*)(S5TABBASE + S5T.EB))
#define s5uG ((bf16*)(WSB + WS.s5uG))
#define s5est ((float*)(WSB + WS.s5est))
#define zbuf ((bf16*)(WSB + WS.zbuf))
#define gluT ((bf16*)(S5TABBASE + S5T.gluT))
#define act ((bf16*)(WSB + WS.act))
#define mw13T ((bf16*)(WSB + WS.mw13T))
#define mw2T ((bf16*)(WSB + WS.mw2T))
#define mact ((bf16*)(WSB + WS.mact))
#define xs8 ((unsigned char*)(WSB + WS.xs8))
#define yrow ((bf16*)(WSB + WS.yrow))
#define rt_e ((int*)(WSB + WS.rt_e))
#define rt_w ((float*)(WSB + WS.rt_w))
#define rt_dest ((int*)(WSB + WS.rt_dest))
#define segcnt ((int*)(WSB + WS.segcnt))
#define ecnt ((int*)(WSB + WS.ecnt))
#define row_token ((int*)(WSB + WS.row_token))
#define tile_e ((int*)(WSB + WS.tile_e))
#define ntile ((int*)(WSB + WS.ntile))
#define modl (mod + (size_t)l * NMOD * 6 * D)
#define silc ((float*)(WSB + WS.silc))
#define postab ((float*)(WSB + WS.postab))
#define modpart ((float*)(WSB + WS.uni))
template <int l, class X> HD void layer_fwd(X& cx) {
    constexpr bool last = (l == DEPTH - 1);
    cx.mark(10 * (l + 1));
        REPEAT(1) {
#ifdef HOST_EMU
        cx.run(NormModK{(long)NR, h, INP(norm1) + (size_t)l * D, modl, 0, D, abuf, nullptr, nullptr, nullptr, 0, 0, nullptr});
#else
        if constexpr (!(l > 0 && (l - 1) % 2 == 1)) cx.wrun(NormModW{NR / 2, 0, D, 0, h, INP(norm1) + (size_t)l * D, modl, abuf, nullptr, nullptr, nullptr, nullptr, 0, 0});
#endif
        }
        cx.mark(10 * (l + 1) + 1);
        SEC_BEGIN(2) cx.gemm(GemmDesc{abuf, winT + (size_t)l * PS * D, nullptr, nullptr, nullptr, 0, NR, PS, D, 0, D, D, 0, 0}, EpiStoreBf16{pbuf, PS, 0}); SEC_END(2)
        cx.mark(10 * (l + 1) + 2);
        SEC_BEGIN(3) { typedef LaLay<64, 96> LG; typedef LaLay<96, 112> LM;
#ifdef HOST_EMU
        cx.run(GlaFused{(long)2 * NB * NBLK * 192, pbuf, INP(gla_wa2) + (size_t)l * 2 * 16 * 192, INP(gla_ba) + (size_t)l * 2 * 192, labg}, false);
#else
        cx.wrun(GlaPrepW2{2 * NB * NBLK * 4, 0, pbuf, INP(gla_wa2) + (size_t)l * 2 * 16 * 192, INP(gla_ba) + (size_t)l * 2 * 192, labg}, false);
#endif
#ifdef HOST_EMU
        cx.run(MlFused{(long)2 * NB * NBLK * 384, pbuf, INP(ml_conv_w) + (size_t)l * 3 * 768, INP(ml_conv_b) + (size_t)l * 768, INP(ml_gate_b) + (size_t)l * 16, lab}, false, 77824);
#else
        cx.wrun(MlPrepW2{2 * NB * NBLK * 4, 0, pbuf, INP(ml_conv_w) + (size_t)l * 3 * 768, INP(ml_conv_b) + (size_t)l * 768, INP(ml_gate_b) + (size_t)l * 16, lab}, false, (2 * NB * NBLK * 4) % 2048);
#endif
#ifdef HOST_EMU
        cx.run(VTFused<96, GV>{(long)LA_NI * 96, pbuf, labg + LG::vT}, false, 102400);
#else
        cx.wrun(VTW<96, GV>{(int)LA_NI, 0, pbuf, labg + LG::vT}, false, (4 * NB * NBLK * 4) % 2048);
#endif
        cx.run(S5Disc{(long)2 * 16 * 64, INP(s5_lam_re) + (size_t)l * 2048, INP(s5_lam_im) + (size_t)l * 2048, INP(s5_log_dt) + (size_t)l * 32, s5disc}, false);
        cx.run(S5Apow{(long)2 * 16 * 65 * 64, INP(s5_lam_re) + (size_t)l * 2048, INP(s5_lam_im) + (size_t)l * 2048, INP(s5_log_dt) + (size_t)l * 32, s5apow}, false);
        cx.run(TransposeK{(long)256 * 256, INP(s5_glu_w) + (size_t)l * 65536, nullptr, gluT, 256, 256, 256}, false);
#ifdef HOST_EMU
        cx.run(VTFused<112, MV>{(long)LA_NI * 112, pbuf, lab + LM::vT}, true, 49152);
#else
        cx.wrun(VTW<112, MV>{(int)LA_NI, 0, pbuf, lab + LM::vT}, true, (4 * NB * NBLK * 4 + (int)LA_NI) % 2048);
#endif
#ifdef HOST_EMU
        cx.run(S5Bbar{(long)2 * 16 * 64 * 16, s5disc, INP(s5_b_re) + (size_t)l * 16384, INP(s5_b_im) + (size_t)l * 16384, s5bbar}, false);
        cx.run(StatesRef<64, 96>{(long)2 * LA_NI * 96 * 64, labg});
        cx.run(StatesRef<96, 112>{(long)2 * LA_NI * 112 * 96, lab});
        cx.run(CarryT<96, 112>{(long)2 * NB * 4 * 112 * 96, lab}, false);
        cx.run(CarryT<64, 96>{(long)2 * NB * 4 * 96 * 64, labg});
#else
        cx.run(S5Bbar{(long)2 * 16 * 64 * 16, s5disc, INP(s5_b_re) + (size_t)l * 16384, INP(s5_b_im) + (size_t)l * 16384, s5bbar}, false);
        static_assert(2 * NB * 4 == 64, "ChainPlace assumes 64 chains");
        cx.wrun(ChainPlace<ChainW<96, 112, 2, 2>, 12, 4, 0, 24>{2048, ChainW<96, 112, 2, 2>{2 * NB * 4 * 4 * 3, 0, lab}}, false);
        cx.wrun(ChainPlace<ChainW<64, 96, 2, 2>, 6, 6, 24, 32>{2048, ChainW<64, 96, 2, 2>{2 * NB * 4 * 3 * 2, 0, labg}}, true);
#endif
        cx.run(S5K2{(long)2 * 16 * 64 * 256, s5apow, s5bbar, INP(s5_c_re) + (size_t)l * 16384, INP(s5_c_im) + (size_t)l * 16384, s5K}, false);
        cx.run(S5BuildEB{(long)16 * 256 * 128, s5apow, s5bbar, s5EB}, false);
#ifdef HOST_EMU
        cx.run(OutRef<64, 96, false>{(long)NR * 384, labg, obuf});
        cx.run(HeadFin{(long)NR * 4, pbuf, obuf, INP(gla_norm) + (size_t)l * 96, abuf, 0});
        cx.run(OutRef<96, 112, true>{(long)NR * 384, lab, obuf});
        cx.run(HeadFin{(long)NR * 4, pbuf, obuf, INP(ml_norm) + (size_t)l * 96, abuf, 1});
#else
        cx.wrun(OutW<96, 112, true>{2 * (int)LA_NI, 0, lab, pbuf, INP(ml_norm) + (size_t)l * 96, abuf}, false);
        cx.wrun(OutWG{(int)LA_NI, 0, labg, pbuf, INP(gla_norm) + (size_t)l * 96, abuf}, true, (2 * (int)LA_NI) % 2048);
#endif
        } SEC_END(3)
        cx.mark(10 * (l + 1) + 3);
        cx.mark(10 * (l + 1) + 4);
        SEC_BEGIN(5) {
        cx.run(S5BuildTB{(long)16 * 1024 * (S5K_ / 8), s5apow, INP(s5_c_re) + (size_t)l * 16384, INP(s5_c_im) + (size_t)l * 16384, s5K, s5TB}, false);
        cx.run(S5BuildU{(long)16 * S5RB * 128, pbuf, s5uG});
        cx.gemm(GemmDesc{s5uG, s5EB, nullptr, nullptr, nullptr, (size_t)256 * 1024, 16 * S5RG, 256, 1024, 0, S5K_, 1024, S5RG / 256, 0}, EpiStoreF32{s5est, 256, 0});
        cx.run(S5Carry2{(long)NB * 16 * 2 * 64, s5apow, s5est, s5uG});
        cx.gemm(GemmDesc{s5uG, s5TB, nullptr, nullptr, nullptr, (size_t)1024 * S5K_, 16 * S5RG, 1024, S5K_, 0, S5K_, S5K_, S5RG / 256, 0}, EpiS5Z{pbuf, INP(s5_d) + (size_t)l * 256, zbuf});
        cx.gemm(mk_gemm(zbuf, 256, gluT, 256, NR, 256, 256), EpiGlu{zbuf, INP(s5_glu_b) + (size_t)l * 256, abuf});
        } SEC_END(5)
        cx.mark(10 * (l + 1) + 5);
        cx.gemm(GemmDesc{abuf, woutT + (size_t)l * D * D, nullptr, nullptr, nullptr, 0, NR, D, D, 0, D, D, 0, 0}, EpiResid{h, modl, 2 * D});
        cx.mark(10 * (l + 1) + 6);
        if constexpr (l % 2 == 0) { constexpr int j = l / 2;
            SEC_BEGIN(6) {
#ifdef HOST_EMU
            cx.run(NormModK{(long)NR, h, INP(norm2) + (size_t)l * D, modl, 3 * D, 4 * D, abuf, nullptr, nullptr, nullptr, 0, 0, nullptr});
#else
            cx.wrun(NormModW{NR / 2, 3 * D, 4 * D, 0, h, INP(norm2) + (size_t)l * D, modl, abuf, nullptr, nullptr, nullptr, nullptr, 0, 1});
#endif
#ifdef HOST_EMU
            cx.gemm(GemmDesc{abuf, w13T + (size_t)j * 2 * DFF * D, nullptr, nullptr, nullptr, 0, NR, 2 * DFF, D, 0, D, D, 0, 0}, EpiSwiGLU{act, DFF, 0});
#else
            cx.gemm8(GemmDesc{abuf, (const bf16*)((const unsigned char*)w13T + (size_t)j * 2 * DFF * D), nullptr, nullptr, nullptr, 0, NR, 2 * DFF, D, 0, D, D, 0, -W8S},
#if FP8_DOWN_DENSE
                EpiSwiGLU8{(unsigned char*)act, DFF, 0});
#else
                EpiSwiGLU{act, DFF, 0});
#endif
#endif
            } SEC_END(6)
#if FP8_DOWN_DENSE && !defined(HOST_EMU)
            cx.gemm8(GemmDesc{act, (const bf16*)((const unsigned char*)w2T + (size_t)j * D * DFF), nullptr, nullptr, nullptr, 0, NR, D, DFF, 0, DFF, DFF, 0, -(W8S + A8S)}, EpiResid{h, modl, 5 * D});
#else
            cx.gemm(GemmDesc{act, w2T + (size_t)j * D * DFF, nullptr, nullptr, nullptr, 0, NR, D, DFF, 0, DFF, DFF, 0, 0}, EpiResid{h, modl, 5 * D});
#endif
        } else { constexpr int j = l / 2; const int nseg = (NR + 63) / 64;
            SEC_BEGIN(7) {
#ifdef HOST_EMU
            for (int e = 0; e < NE; ++e) { const size_t wo = ((size_t)j * NE + e) * D * DFF;
                cx.run(TransposeK{(long)2 * DFF * D, INP(moe_w1) + wo, INP(moe_w3) + wo, mw13T + (size_t)e * 2 * DFF * D, D, DFF, 2 * DFF});
                cx.run(TransposeK{(long)D * DFF, INP(moe_w2) + wo, nullptr, mw2T + (size_t)e * D * DFF, DFF, D, D}); }
            cx.run(ZeroInt{(long)NE * nseg, segcnt});
            cx.run(MoeFillNeg{(long)MOE_MAXT * 256, row_token});
            cx.run(NormModK{(long)NR, h, INP(norm2) + (size_t)l * D, modl, 3 * D, 4 * D, abuf, INP(moe_router) + (size_t)j * D * NE, rt_e, rt_w, last ? 1 : 0, nseg, segcnt});
            cx.run(MoePrefix{(long)NE, segcnt, ecnt, nseg});
#else
            cx.wrun(TransW{((NE * (D / 64) * (DFF / 32)) + 1) / 2, D, DFF, 2, 0, W8S, INP(moe_w1) + (size_t)j * NE * D * DFF, mw13T, (size_t)D * DFF, (size_t)2 * DFF * D, (NE * (D / 64) * (DFF / 32)), 0}, false);
            cx.wrun(TransW{((NE * (D / 64) * (DFF / 32)) + 1) / 2, D, DFF, 2, 1, W8S, INP(moe_w3) + (size_t)j * NE * D * DFF, mw13T, (size_t)D * DFF, (size_t)2 * DFF * D, (NE * (D / 64) * (DFF / 32)), 0}, false);
            cx.wrun(TransW{((NE * (DFF / 64) * (D / 32)) + 1) / 2, DFF, D, 1, 0, FP8_DOWN_MOE ? W8S : 0, INP(moe_w2) + (size_t)j * NE * DFF * D, mw2T, (size_t)DFF * D, (size_t)D * DFF, (NE * (DFF / 64) * (D / 32)), 0}, false);
            cx.run(MoeFillNeg{(long)MOE_MAXT * 256, row_token}, false);
            cx.run(ZeroInt{(long)NE * nseg, segcnt});
            cx.wrun(NormModW{NR / 2, 3 * D, 4 * D, last ? 1 : 0, h, INP(norm2) + (size_t)l * D, modl, abuf, INP(moe_router) + (size_t)j * D * NE, rt_e, rt_w, segcnt, nseg, 1});
            cx.wrun(MoePrefixW{NE, nseg, segcnt, ecnt});
#endif
            cx.run(MoeTiles2{(long)MOE_MAXT, ecnt, tile_e, ntile}, false);
            cx.run(MoeAssign{(long)NE * nseg, rt_e, segcnt, ecnt, rt_dest, row_token, nseg});
#ifdef HOST_EMU
            cx.gemm(GemmDesc{abuf, mw13T, tile_e, ntile, row_token, (size_t)2 * DFF * D, MOE_MAXT * 256, 2 * DFF, D, 0, D, D, 0, 0}, EpiSwiGLU{mact, DFF, 0});
#else
            for (int t0 = 0; t0 < MOE_MAXT; t0 += MOE_XT) { const int nt = (MOE_MAXT - t0 < MOE_XT) ? MOE_MAXT - t0 : MOE_XT;
                cx.run(MoeGather8{(long)nt * 256 * (D / 16), (const unsigned char*)abuf, row_token, xs8, t0 * 256, 0});
                cx.gemm8(GemmDesc{(const bf16*)xs8, mw13T, tile_e, ntile, nullptr, (size_t)2 * DFF * D / 2, nt * 256, 2 * DFF, D, t0, D, D, 0, -W8S},
#if FP8_DOWN_MOE
                    EpiSwiGLU8{(unsigned char*)mact + (size_t)t0 * 256 * DFF, DFF, 0}); }
#else
                    EpiSwiGLU{mact + (size_t)t0 * 256 * DFF, DFF, 0}); }
#endif
#endif
#if FP8_DOWN_MOE && !defined(HOST_EMU)
            cx.gemm8(GemmDesc{mact, mw2T, tile_e, ntile, nullptr, (size_t)D * DFF / 2, MOE_MAXT * 256, D, DFF, 0, DFF, DFF, 0, -(W8S + A8S)}, EpiStoreBf16{yrow, D, 0});
#else
            cx.gemm(GemmDesc{mact, mw2T, tile_e, ntile, nullptr, (size_t)D * DFF, MOE_MAXT * 256, D, DFF, 0, DFF, DFF, 0, 0}, EpiStoreBf16{yrow, D, 0});
#endif
            } SEC_END(7)
#ifdef HOST_EMU
            cx.run(MoeCombine{(long)NR * D / 8, h, yrow, rt_e, rt_w, rt_dest, modl, 5 * D});
#else
            if constexpr (last) cx.wrun(CombineNormW{NR, 1, 5 * D, 0, h, yrow, rt_e, rt_w, rt_dest, modl, INP(norm_f), modl, abuf, out});
            else cx.wrun(CombineNormW{NR, 0, 5 * D, 0, h, yrow, rt_e, rt_w, rt_dest, modl, INP(norm1) + (size_t)(l + 1) * D, mod + (size_t)(l + 1) * NMOD * 6 * D, abuf, out});
#endif
        }
        cx.mark(10 * (l + 1) + 7);
    }
template <class X> HD void forward(X& cx) {
    cx.mark(0);
    constexpr int l = 0; (void)l;
    cx.run(PosTab{(long)2 * GRID_W * 512, postab}, false);
    cx.run(SiluC{(long)NMOD * D, INP(c), INP(c_ctx), silc});
    cx.run(InitH{(long)NR * D / 4, INP(x), INP(ctx), postab, h}, false);
#ifdef HOST_EMU
    for (int l = 0; l < DEPTH; ++l) {
        cx.run(TransposeK{(long)PS * D, INP(w_in) + (size_t)l * D * DPROJ, nullptr, winT + (size_t)l * PS * D, D, DPROJ, PS});
        cx.run(TransposeK{(long)D * D, INP(w_out) + (size_t)l * D * D, nullptr, woutT + (size_t)l * D * D, D, D, D});
        if (l % 2 == 0) { const int j = l / 2;
            cx.run(TransposeK{(long)2 * DFF * D, INP(ffn_w1) + (size_t)j * D * DFF, INP(ffn_w3) + (size_t)j * D * DFF, w13T + (size_t)j * 2 * DFF * D, D, DFF, 2 * DFF});
            cx.run(TransposeK{(long)D * DFF, INP(ffn_w2) + (size_t)j * DFF * D, nullptr, w2T + (size_t)j * D * DFF, DFF, D, D}); }
    }
#else
    cx.wrun(TransW{((DEPTH * (D / 64) * (DPROJ / 32)) + 1) / 2, D, DPROJ, 1, 0, 0, INP(w_in), winT, (size_t)D * DPROJ, (size_t)PS * D, (DEPTH * (D / 64) * (DPROJ / 32)), 0}, false);
    for (int l = 0; l < DEPTH; ++l) cx.run(ZeroBf16{(long)(PS - DPROJ) * D, winT + ((size_t)l * PS + DPROJ) * D}, false);
    cx.wrun(TransW{((DEPTH * (D / 64) * (D / 32)) + 1) / 2, D, D, 1, 0, 0, INP(w_out), woutT, (size_t)D * D, (size_t)D * D, (DEPTH * (D / 64) * (D / 32)), 0}, false);
    cx.wrun(TransW{((((DEPTH + 1) / 2) * (D / 64) * (DFF / 32)) + 1) / 2, D, DFF, 2, 0, W8S, INP(ffn_w1), w13T, (size_t)D * DFF, (size_t)2 * DFF * D, (((DEPTH + 1) / 2) * (D / 64) * (DFF / 32)), 0}, false);
    cx.wrun(TransW{((((DEPTH + 1) / 2) * (D / 64) * (DFF / 32)) + 1) / 2, D, DFF, 2, 1, W8S, INP(ffn_w3), w13T, (size_t)D * DFF, (size_t)2 * DFF * D, (((DEPTH + 1) / 2) * (D / 64) * (DFF / 32)), 0}, false);
    cx.wrun(TransW{((((DEPTH + 1) / 2) * (DFF / 64) * (D / 32)) + 1) / 2, DFF, D, 1, 0, FP8_DOWN_DENSE ? W8S : 0, INP(ffn_w2), w2T, (size_t)DFF * D, (size_t)D * DFF, (((DEPTH + 1) / 2) * (DFF / 64) * (D / 32)), 0}, false);
#endif
    cx.run(ModPart{(long)MODKC * DEPTH * 6 * D, silc, INP(w_ada), modpart});
    cx.run(ModReduce{(long)DEPTH * NMOD * 6 * D, modpart, INP(b_ada), mod});
    cx.mark(1);
    layer_fwd<0>(cx);
    if constexpr (DEPTH > 1) layer_fwd<1>(cx);
    if constexpr (DEPTH > 2) layer_fwd<2>(cx);
    if constexpr (DEPTH > 3) layer_fwd<3>(cx);
    static_assert(DEPTH <= 4, "unrolled for DEPTH <= 4");
#ifdef HOST_EMU
    cx.run(FinalNorm{(long)NB * SEQ, h, INP(norm_f), out});
#else
    if constexpr ((DEPTH - 1) % 2 == 0) cx.wrun(FinalNormW{NB * SEQ, 0, h, INP(norm_f), out});
#endif
    cx.mark(99);
    cx.probe_out(out);
}

#undef silc
#undef postab
#undef modpart
#undef mod
#undef h
#undef abuf
#undef winT
#undef woutT
#undef w13T
#undef w2T
#undef pbuf
#undef obuf
#undef lab
#undef labg
#undef s5disc
#undef s5K
#undef s5apow
#undef s5bbar
#undef s5TB
#undef s5EB
#undef s5uG
#undef s5est
#undef zbuf
#undef gluT
#undef act
#undef mw13T
#undef mw2T
#undef mact
#undef xs8
#undef yrow
#undef rt_e
#undef rt_w
#undef rt_dest
#undef segcnt
#undef ecnt
#undef row_token
#undef tile_e
#undef ntile
#undef WSB
#undef S5TABBASE
#undef out
#undef modl
#ifndef HOST_EMU
#ifndef MULTI_LAUNCH
constexpr int MEGA_LDS = pg8::STAGE_BYTES + 512;
struct MegaArgs { const void* p[37]; };
__global__ void __launch_bounds__(512, 2) mega_fwd(MegaArgs a) {
    extern __shared__ __attribute__((aligned(16))) unsigned char shm[];
    PG8_LAS unsigned char* lds = (PG8_LAS unsigned char*)shm;
    volatile LAS unsigned* xbw = (volatile LAS unsigned*)(lds + pg8::STAGE_BYTES);
    if (threadIdx.x < 4) xbw[threadIdx.x] = 0u;
    if (threadIdx.x < 37) ((PG8_LAS unsigned long long*)(lds + pg8::STAGE_BYTES + 64))[threadIdx.x] = (unsigned long long)a.p[threadIdx.x];
    __syncthreads();
    Ctx cx; cx.lds = lds;
    cx.bar = xcd_barrier_post((unsigned*)((unsigned char*)cx.inp<36>() + WS.ctl), xbw);
    cx.gtid = (int)(blockIdx.x * blockDim.x + threadIdx.x); cx.nthr = (int)(gridDim.x * blockDim.x);
    forward(cx);
}
#endif
extern "C" void kernel_launch(void* const* d_in, const int* in_sizes, int n_in, void* d_out, int out_size, void* d_ws, size_t ws_size, hipStream_t stream) {
    static int ncu = 0;
    if (ncu == 0) { int dev = 0; (void)hipGetDevice(&dev); (void)hipDeviceGetAttribute(&ncu, hipDeviceAttributeMultiprocessorCount, dev); if (ncu <= 0) ncu = 256;
#ifndef MULTI_LAUNCH
        if (hipFuncSetAttribute((const void*)mega_fwd, hipFuncAttributeMaxDynamicSharedMemorySize, MEGA_LDS) != hipSuccess) { fprintf(stderr, "kernel_launch: hipFuncSetAttribute failed\n"); }
#endif
    }
    if (n_in != 35 || ws_size < WS.end || out_size != NB * SEQ * D) { fprintf(stderr, "kernel_launch: unexpected sizes n_in %d ws %zu (need %zu) out %d\n", n_in, ws_size, (size_t)WS.end, out_size); return; }
#ifdef MULTI_LAUNCH
    const void* tbl[37]; for (int i = 0; i < 35; ++i) tbl[i] = d_in[i]; tbl[35] = d_out; tbl[36] = d_ws;
    Ctx cx{stream, ncu, tbl};
    forward(cx);
#else
    (void)hipMemsetAsync((unsigned char*)d_ws + WS.ctl, 0, 1 << 20, stream);
    MegaArgs a{}; for (int i = 0; i < 35; ++i) a.p[i] = d_in[i];
    a.p[35] = d_out; a.p[36] = d_ws;
    hipLaunchKernelGGL(mega_fwd, dim3(ncu), dim3(512), MEGA_LDS, stream, a);
#endif
}
#endif
```

```cpp
#ifndef HOST_EMU
#include <hip/hip_runtime.h>
#define HD __host__ __device__ __forceinline__
#define UNROLL _Pragma("unroll")
#else
#include <cmath>
#include <cstdio>
#include <cstdlib>
#include <cstring>
#include <cstdint>
#define HD inline
#define UNROLL
#endif
#include <math.h>
#include <stdint.h>
#include <stddef.h>
#include <stdio.h>

#ifndef CFG_NB
#define CFG_NB 8
#endif
#ifndef CFG_SEQ
#define CFG_SEQ 4096
#endif
#ifndef CFG_CTX
#define CFG_CTX 256
#endif
#ifndef CFG_DEPTH
#define CFG_DEPTH 4
#endif
constexpr int NB = CFG_NB, SEQ = CFG_SEQ, CTX = CFG_CTX, DEPTH = CFG_DEPTH;
constexpr int D = 1024, GRID_W = 64;
constexpr int RPB = CTX + SEQ;
constexpr int NR = NB * RPB;
constexpr int NBLK = RPB / 64, CB = CTX / 64;
constexpr int DPROJ = 2976, PS = 3072;
constexpr int GQ = 0, GK = 192, GV = 384, GLR = 768, GG = 784, SU = 1168, MQ = 1424, MK = 1808, MV = 2192, MO = 2576, MG = 2960;
constexpr int DFF = 2816, NE = 8;
constexpr int NMOD = NB + 1;
constexpr float EPS = 1e-6f;
constexpr int MOE_MAXT = (2 * NR + NE * 255) / 256 + 1;
#ifndef FP8_DOWN_DENSE
#define FP8_DOWN_DENSE 1
#endif
#ifndef FP8_DOWN_MOE
#define FP8_DOWN_MOE 1
#endif
constexpr int MOE_XT = MOE_MAXT;

typedef unsigned short bf16;
struct __attribute__((aligned(16))) U4 { uint32_t x, y, z, w; };
HD float bf2f(bf16 v) { uint32_t u = ((uint32_t)v) << 16; float f; memcpy(&f, &u, 4); return f; }
HD bf16 f2bf(float f) { uint32_t u; memcpy(&u, &f, 4); u += 0x7fffu + ((u >> 16) & 1u); return (bf16)(u >> 16); }
#if defined(HOST_EMU)
HD float siluf(float x) { return x / (1.0f + expf(-x)); }
HD float sigmoidf_(float x) { return 1.0f / (1.0f + expf(-x)); }
HD float logsigmoidf_(float x) { return x < 0.f ? x - log1pf(expf(x)) : -log1pf(expf(-x)); }
HD float fexp(float x) { return expf(x); }
#else
__host__ __device__ __forceinline__ float fexp(float x) { return __builtin_amdgcn_exp2f(x * 1.4426950408889634f); }
__host__ __device__ __forceinline__ float siluf(float x) { return x * __builtin_amdgcn_rcpf(1.0f + fexp(-x)); }
__host__ __device__ __forceinline__ float sigmoidf_(float x) { return __builtin_amdgcn_rcpf(1.0f + fexp(-x)); }
__host__ __device__ __forceinline__ float logsigmoidf_(float x) { return fminf(x, 0.f) - 0.6931471805599453f * __builtin_amdgcn_logf(1.0f + fexp(-fabsf(x))); }
#endif
HD float gelu_tanhf(float x) { return 0.5f * x * (1.0f + tanhf(0.7978845608028654f * (x + 0.044715f * x * x * x))); }
#ifndef HOST_EMU
typedef float f4_t __attribute__((ext_vector_type(4)));
__device__ __forceinline__ unsigned cvt_pk_bf16(float lo, float hi) { unsigned r; asm("v_cvt_pk_bf16_f32 %0, %1, %2" : "=v"(r) : "v"(lo), "v"(hi)); return r; }
__device__ __forceinline__ void store8_bf16(bf16* dst, const float* v) { uint4 w; w.x = cvt_pk_bf16(v[0], v[1]); w.y = cvt_pk_bf16(v[2], v[3]); w.z = cvt_pk_bf16(v[4], v[5]); w.w = cvt_pk_bf16(v[6], v[7]); *(uint4*)dst = w; }
__device__ __forceinline__ void load8_bf16(const bf16* src, float* v) { const uint4 w = *(const uint4*)src; const unsigned u[4] = {w.x, w.y, w.z, w.w};
#pragma unroll
    for (int i = 0; i < 4; ++i) { v[2 * i] = __uint_as_float(u[i] << 16); v[2 * i + 1] = __uint_as_float(u[i] & 0xffff0000u); } }
__device__ __forceinline__ float fast_silu(float x) { return x * __builtin_amdgcn_rcpf(1.0f + __expf(-x)); }
__device__ __forceinline__ float fast_sigmoid(float x) { return __builtin_amdgcn_rcpf(1.0f + __expf(-x)); }
#endif
HD int mod_index(int r) { const int b = r / RPB, t = r % RPB; return t < CTX ? NB : b; }
HD int chain_blk(int d, int step) { return d == 0 ? step : (step < CB ? CB - 1 - step : NBLK - 1 - (step - CB)); }
HD int blk_row(int b, int blk, int d, int pp) { return b * RPB + blk * 64 + (d == 0 ? pp : 63 - pp); }

constexpr size_t LA_NI = (size_t)NB * NBLK * 4;
HD size_t tile_off(int row, int col, int KT) { return ((size_t)((row >> 4) * KT + (col >> 5)) * 64 + (size_t)((((col & 31) >> 3) << 4) + (row & 15))) * 8 + (col & 7); }
template <int DKP, int NV> struct LaLay {
    static constexpr int KQ = DKP / 32;
    static constexpr size_t qin = 0;
    static constexpr size_t kin = qin + (size_t)2 * NR * 4 * DKP;
    static constexpr size_t koutT = kin + (size_t)2 * NR * 4 * DKP;
    static constexpr size_t vT = koutT + (size_t)2 * LA_NI * DKP * 64;
    static constexpr size_t sT = vT + LA_NI * NV * 64;
    static constexpr size_t dec = sT + (size_t)2 * LA_NI * NV * DKP;
    static constexpr size_t end = dec + (size_t)2 * 2 * LA_NI * DKP;
    HD static size_t q_at(int d, size_t item, int tok, int i) { return qin + ((size_t)d * LA_NI + item) * 64 * DKP + tile_off(tok, i, KQ); }
    HD static size_t k_at(int d, size_t item, int tok, int i) { return kin + ((size_t)d * LA_NI + item) * 64 * DKP + tile_off(tok, i, KQ); }
    HD static size_t kt_at(int d, size_t item, int i, int tok) { return koutT + ((size_t)d * LA_NI + item) * DKP * 64 + tile_off(i, tok, 2); }
    HD static size_t v_at(size_t item, int j, int tok) { return vT + item * NV * 64 + tile_off(j, tok, 2); }
    HD static size_t s_at(int d, size_t item, int j, int i) { return sT + ((size_t)d * LA_NI + item) * NV * DKP + tile_off(j, i, KQ); }
};
constexpr size_t al256(size_t x) { return (x + 255) & ~(size_t)255; }
struct WsMap {
    size_t ctl, mod, silc, postab, h, abuf, winT, woutT, w13T, w2T, uni, end_fixed;
    size_t pbuf, lab, labg, obuf, s5tab, s5uG, s5est, zbuf, end_mix;
    size_t act, end_ffn;
    size_t mw13T, mw2T, xs8, mact, yrow, rt_e, rt_w, rt_dest, segcnt, ecnt, row_token, tile_e, ntile, end_moe;
    size_t end;
};
constexpr WsMap make_map() {
    WsMap m{}; size_t o = 0;
    m.ctl = o; o += 1 << 20;
    m.mod = o; o += al256((size_t)DEPTH * NMOD * 6 * D * 4);
    m.silc = o; o += al256((size_t)NMOD * D * 4);
    m.postab = o; o += al256((size_t)2 * GRID_W * 512 * 4);
    m.h = o; o += al256((size_t)NR * D * 4);
    m.abuf = o;
    m.winT = o; o += al256((size_t)DEPTH * PS * D * 2);
    m.woutT = o; o += al256((size_t)DEPTH * D * D * 2);
    m.w13T = o; o += al256((size_t)((DEPTH + 1) / 2) * 2 * DFF * D * 2);
    m.w2T = o; o += al256((size_t)((DEPTH + 1) / 2) * D * DFF * 2);
    m.uni = o; m.end_fixed = o;
    o = m.uni;
    m.pbuf = o; o += al256((size_t)NR * PS * 2);
    m.lab = o;
    { size_t o2 = m.lab;
      m.s5uG = o2; o2 += al256((size_t)16 * ((NB * NBLK + 255) / 256 * 256) * 1280 * 2);
      m.s5est = o2; o2 += al256((size_t)16 * ((NB * NBLK + 255) / 256 * 256) * 256 * 4);
      m.zbuf = o2; o2 += al256((size_t)NR * 256 * 2);
      const size_t la_bytes = al256(LaLay<96, 112>::end * 2);
      o = m.lab + (la_bytes > o2 - m.lab ? la_bytes : o2 - m.lab); }
    m.labg = o; o += al256(LaLay<64, 96>::end * 2);
    m.obuf = o;
#ifdef HOST_EMU
    o += al256((size_t)NR * 384 * 4);
    m.s5tab = o; o += (size_t)64 << 20;
#endif
    m.end_mix = o;
    o = m.uni;
    m.act = o; o += al256((size_t)NR * DFF * 2);
    m.end_ffn = o;
    o = m.uni;
    m.mw13T = o; o += al256((size_t)NE * 2 * DFF * D);
#ifdef HOST_EMU
    o += al256((size_t)NE * 2 * DFF * D);
#endif
    m.mw2T = o; o += al256((size_t)NE * D * DFF * 2);
    m.xs8 = o; o += al256((size_t)MOE_XT * 256 * D);
#if FP8_DOWN_MOE && !defined(HOST_EMU)
    m.mact = o; o += al256((size_t)MOE_MAXT * 256 * DFF);
#else
    m.mact = o; o += al256((size_t)MOE_MAXT * 256 * DFF * 2);
#endif
    m.yrow = o; o += al256((size_t)MOE_MAXT * 256 * D * 2);
    m.rt_e = o; o += al256((size_t)NR * 2 * 4);
    m.rt_w = o; o += al256((size_t)NR * 2 * 4);
    m.rt_dest = o; o += al256((size_t)NR * 2 * 4);
    m.segcnt = o; o += al256((size_t)NE * (NR / 64 + 1) * 4);
    m.ecnt = o; o += al256((size_t)64 * 4);
    m.row_token = o; o += al256((size_t)MOE_MAXT * 256 * 4);
    m.tile_e = o; o += al256((size_t)MOE_MAXT * 4);
    m.ntile = o; o += 256;
    m.end_moe = o;
    m.end = m.end_mix > m.end_moe ? m.end_mix : m.end_moe; if (m.end_ffn > m.end) m.end = m.end_ffn;
    return m;
}
constexpr WsMap WS = make_map();
struct S5Tab { size_t disc, K, apow, bbar, TB, EB, gluT, end; };
constexpr S5Tab make_s5tab() { S5Tab t{}; size_t o = 0;
    t.disc = o; o += al256((size_t)2 * 16 * 64 * 4 * 4); t.K = o; o += al256((size_t)2 * 16 * 64 * 256 * 4); t.apow = o; o += al256((size_t)2 * 16 * 65 * 64 * 2 * 4); t.bbar = o; o += al256((size_t)2 * 16 * 64 * 16 * 2 * 4);
    t.TB = o; o += al256((size_t)16 * 1024 * 1280 * 2); t.EB = o; o += al256((size_t)16 * 256 * 1024 * 2); t.gluT = o; o += al256((size_t)256 * 256 * 2); t.end = o; return t; }
constexpr S5Tab S5T = make_s5tab();
constexpr size_t ABUF_BYTES = al256((size_t)NR * D * 2);
#ifndef HOST_EMU
static_assert(ABUF_BYTES + S5T.end <= (size_t)NB * SEQ * D * 4, "the bf16 row buffer and the S5 tables must fit in d_out");
#endif

struct PosTab { long n; float* tab;
    HD void operator()(long i) const { const int cc = (int)(i % 512); const int pos = (int)((i / 512) % GRID_W); const int j = cc & 255; const float omega = expf(-9.210340371976184f * (float)j / 256.0f); const float ang = (float)pos * omega;
        tab[i] = (cc & 256) ? cosf(ang) : sinf(ang); } };
struct __attribute__((aligned(16))) F4 { float x, y, z, w; };
struct InitH { long n; const float* x; const float* ctx; const float* tab; float* h;
    HD void operator()(long i) const { const int r = (int)(i / (D / 4)), c = (int)(i % (D / 4)) * 4; const int b = r / RPB, t = r % RPB; F4 v;
        if (t < CTX) v = *(const F4*)(ctx + ((size_t)b * CTX + t) * D + c);
        else { const int tl = t - CTX, row = tl / GRID_W, col = tl % GRID_W; const F4 xv = *(const F4*)(x + ((size_t)b * SEQ + tl) * D + c);
            const F4 pe = *(const F4*)(tab + (c < 512 ? (size_t)row * 512 + c : (size_t)(GRID_W + col) * 512 + (c - 512))); v.x = xv.x + pe.x; v.y = xv.y + pe.y; v.z = xv.z + pe.z; v.w = xv.w + pe.w; }
        *(F4*)(h + (size_t)r * D + c) = v; } };
struct ModK { long n; const float* c; const float* cctx; const float* w_ada; const float* b_ada; float* mod;
    HD void operator()(long i) const { const int l = (int)(i / (6 * D)), j = (int)(i % (6 * D));
        float acc[NMOD];
        for (int m = 0; m < NMOD; ++m) acc[m] = b_ada[(size_t)l * 6 * D + j];
        const float* w = w_ada + (size_t)l * D * 6 * D + j;
        for (int k = 0; k < D; ++k) { const float wv = w[(size_t)k * 6 * D];
            for (int m = 0; m < NMOD; ++m) { const float cv = (m < NB) ? c[m * D + k] : cctx[k]; acc[m] += siluf(cv) * wv; } }
        for (int m = 0; m < NMOD; ++m) mod[((size_t)l * NMOD + m) * 6 * D + j] = acc[m]; } };
struct TransposeK { long n; const float* a; const float* b; bf16* dst; int K, N, NP, pad;
    HD void operator()(long i) const { const int nn = (int)(i / K), k = (int)(i % K);
        float v = 0.f;
        if (b) { const int j = nn >> 1; v = (nn & 1) ? b[(size_t)k * N + j] : a[(size_t)k * N + j]; }
        else if (nn < N) v = a[(size_t)k * N + nn];
        dst[i] = f2bf(v); } };
struct NormModK { long n; const float* h; const float* g; const float* mod; int sh_off, sc_off; bf16* out; const float* wr; int* rt_e; float* rt_w; int skip_ctx, nseg; int* segcnt;
    HD void operator()(long r) const { const float* hr = h + (size_t)r * D; float ss = 0.f;
        for (int k = 0; k < D; ++k) ss += hr[k] * hr[k];
        const float rstd = 1.0f / sqrtf(ss / D + EPS); const float* m = mod + (size_t)mod_index((int)r) * 6 * D;
        float lg[NE]; for (int e = 0; e < NE; ++e) lg[e] = 0.f;
        for (int k = 0; k < D; ++k) { const float v = hr[k] * rstd * g[k] * (1.0f + m[sc_off + k]) + m[sh_off + k]; out[(size_t)r * D + k] = f2bf(v);
            if (wr) for (int e = 0; e < NE; ++e) lg[e] += v * wr[k * NE + e]; }
        if (wr) { int e0 = 0; float b0 = lg[0]; for (int e = 1; e < NE; ++e) if (lg[e] > b0) { b0 = lg[e]; e0 = e; }
            int e1 = -1; float b1 = -3.0e38f; for (int e = 0; e < NE; ++e) if (e != e0 && lg[e] > b1) { b1 = lg[e]; e1 = e; }
            const float w1 = 1.0f / (1.0f + expf(b1 - b0));
            const bool skip = skip_ctx && ((int)(r % RPB) < CTX);
            rt_e[2 * r] = skip ? -1 : e0; rt_e[2 * r + 1] = skip ? -1 : e1; rt_w[2 * r] = w1; rt_w[2 * r + 1] = 1.0f - w1;
            if (!skip) { __atomic_fetch_add(&segcnt[(size_t)e0 * nseg + r / 64], 1, __ATOMIC_RELAXED); __atomic_fetch_add(&segcnt[(size_t)e1 * nseg + r / 64], 1, __ATOMIC_RELAXED); } } } };

struct SiluC { long n; const float* c; const float* cctx; float* sc;
    HD void operator()(long i) const { const int m = (int)(i / D), k = (int)(i % D); sc[i] = siluf(m < NB ? c[m * D + k] : cctx[k]); } };
constexpr int A8S = 2;
constexpr int W8S = 6;
constexpr int MODKC = 8;
struct ModPart { long n; const float* sc; const float* w_ada; float* part;
    HD void operator()(long i) const { const int j = (int)(i % (6 * D)); long y = i / (6 * D); const int l = (int)(y % DEPTH), kc = (int)(y / DEPTH);
        float acc[NMOD]; for (int m = 0; m < NMOD; ++m) acc[m] = 0.f;
        const float* w = w_ada + ((size_t)l * D + (size_t)kc * (D / MODKC)) * 6 * D + j; const float* s0 = sc + kc * (D / MODKC);
        for (int k = 0; k < D / MODKC; ++k) { const float wv = w[(size_t)k * 6 * D];
            for (int m = 0; m < NMOD; ++m) acc[m] += s0[m * D + k] * wv; }
        for (int m = 0; m < NMOD; ++m) part[(((size_t)kc * DEPTH + l) * NMOD + m) * 6 * D + j] = acc[m]; } };
struct ModReduce { long n; const float* part; const float* b_ada; float* mod;
    HD void operator()(long i) const { const int j = (int)(i % (6 * D)); long y = i / (6 * D); const int m = (int)(y % NMOD), l = (int)(y / NMOD); float a = b_ada[(size_t)l * 6 * D + j];
        for (int kc = 0; kc < MODKC; ++kc) a += part[(((size_t)kc * DEPTH + l) * NMOD + m) * 6 * D + j];
        mod[i] = a; } };
struct ZeroBf16 { long n; bf16* p; HD void operator()(long i) const { p[i] = 0; } };
HD uint32_t pk2(float lo, float hi) { return (uint32_t)f2bf(lo) | ((uint32_t)f2bf(hi) << 16); }
struct GlaFused { long n; const bf16* p; const float* wa2; const float* ba; bf16* lab;
    struct Ld { U4 l0[4], l1[4]; bf16 q[4], k[4]; };
    HD void load4(Ld& L_, const bf16* pe, int pstep, int j) const { UNROLL for (int e = 0; e < 4; ++e) { const bf16* pt = pe + e * pstep; const U4* lr = (const U4*)(pt + GLR); L_.l0[e] = lr[0]; L_.l1[e] = lr[1]; L_.q[e] = pt[GQ + j]; L_.k[e] = pt[GK + j]; } }
    HD void operator()(long x) const { typedef LaLay<64, 96> L; const int xi = (int)x; const int j = xi % 192; int y = xi / 192; const int blk = y % NBLK; y /= NBLK; const int b = y % NB, d = y / NB;
        const int hh = j / 48, i = j % 48; const size_t item = (size_t)(b * NBLK + blk) * 4 + hh; float w[16]; UNROLL for (int q = 0; q < 16; ++q) w[q] = wa2[(d * 16 + q) * 192 + j];
        const float bj = ba[d * 192 + j]; float c = 0.f;
        const int s_first = d == 0 ? 0 : 63, dir = d == 0 ? 1 : -1; const int r_first = b * RPB + blk * 64 + s_first;
        const bf16* pr = p + (size_t)r_first * PS; const int pstep = dir * PS; Ld cur, nxt; load4(cur, pr, pstep, j); float ko[8];
        for (int g4 = 0; g4 < 16; ++g4) {
            if (g4 < 15) load4(nxt, pr + 4 * pstep, pstep, j);
            UNROLL for (int e = 0; e < 4; ++e) { const uint32_t u[8] = {cur.l0[e].x, cur.l0[e].y, cur.l0[e].z, cur.l0[e].w, cur.l1[e].x, cur.l1[e].y, cur.l1[e].z, cur.l1[e].w}; float z = bj;
                UNROLL for (int q = 0; q < 8; ++q) { z += bf2f((bf16)(u[q] & 0xffffu)) * w[2 * q]; z += bf2f((bf16)(u[q] >> 16)) * w[2 * q + 1]; }
                c += logsigmoidf_(z) * (1.0f / 16.0f); const float kk = bf2f(cur.k[e]) * fexp(-c); const int tok = s_first + dir * (g4 * 4 + e);
                lab[L::q_at(d, item, tok, i)] = f2bf(bf2f(cur.q[e]) * 0.14433756729740643f * fexp(c)); lab[L::k_at(d, item, tok, i)] = f2bf(kk); ko[(g4 & 1) * 4 + e] = kk;
                if (i < 16) { lab[L::q_at(d, item, tok, 48 + i)] = 0; lab[L::k_at(d, item, tok, 48 + i)] = 0; } }
            pr += 4 * pstep;
            if (g4 & 1) { U4 v; const int c8 = g4 >> 1; const int s0 = d == 0 ? c8 * 8 : 56 - c8 * 8;
                v.x = d == 0 ? pk2(ko[0], ko[1]) : pk2(ko[7], ko[6]); v.y = d == 0 ? pk2(ko[2], ko[3]) : pk2(ko[5], ko[4]); v.z = d == 0 ? pk2(ko[4], ko[5]) : pk2(ko[3], ko[2]); v.w = d == 0 ? pk2(ko[6], ko[7]) : pk2(ko[1], ko[0]);
                *(U4*)(lab + L::kt_at(d, item, i, s0)) = v; if (i < 16) { U4 zz; zz.x = zz.y = zz.z = zz.w = 0u; *(U4*)(lab + L::kt_at(d, item, 48 + i, s0)) = zz; } }
            cur = nxt; }
        float* dec = (float*)(lab + L::dec) + ((size_t)d * LA_NI + item) * 64; dec[i] = fexp(c); if (i < 16) dec[48 + i] = 0.f; } };
template <int NV, int VOFF> struct VTFused { long n; const bf16* p; bf16* vT;
    HD void operator()(long x) const { const int xi = (int)x; const int j = xi % NV; const int item = xi / NV; const int hh = item % 4; const int bb = item / 4; const int r0 = (bb / NBLK) * RPB + (bb % NBLK) * 64;
        const bf16* pc = p + (size_t)r0 * PS + VOFF + hh * 96 + (j < 96 ? j : 0); const uint32_t fill = j == 96 ? 0x3f803f80u : 0u; uint32_t t[32];
        UNROLL for (int q = 0; q < 32; ++q) t[q] = (uint32_t)pc[(2 * q) * PS] | ((uint32_t)pc[(2 * q + 1) * PS] << 16);
        UNROLL for (int c8 = 0; c8 < 8; ++c8) { U4 v; v.x = j < 96 ? t[4 * c8] : fill; v.y = j < 96 ? t[4 * c8 + 1] : fill; v.z = j < 96 ? t[4 * c8 + 2] : fill; v.w = j < 96 ? t[4 * c8 + 3] : fill;
            *(U4*)(vT + (size_t)item * NV * 64 + tile_off(j, 8 * c8, 2)) = v; } } };
struct MlFused { long n; const bf16* p; const float* cw; const float* cb; const float* gb; bf16* lab;
    struct Ld { bf16 q[4][3], k[4][3], gi[4], gf[4]; };
    HD void load4(Ld& L_, const bf16* pe, int pstep, int t0, int dir, int cq, int ck, int gi, int gf) const {
        UNROLL for (int e = 0; e < 4; ++e) { const int t = t0 + dir * e; const bool first = (t == 0 || t == CTX), last = (t == CTX - 1 || t == RPB - 1); const bf16* pt = pe + e * pstep;
            L_.q[e][1] = pt[cq]; L_.k[e][1] = pt[ck]; L_.q[e][0] = first ? (bf16)0 : pt[cq - PS]; L_.k[e][0] = first ? (bf16)0 : pt[ck - PS]; L_.q[e][2] = last ? (bf16)0 : pt[cq + PS]; L_.k[e][2] = last ? (bf16)0 : pt[ck + PS];
            L_.gi[e] = pt[gi]; L_.gf[e] = pt[gf]; } }
    HD void operator()(long x) const { typedef LaLay<96, 112> L; const int xi = (int)x; const int i = xi % 96; int y = xi / 96; const int hh = y % 4; y /= 4; const int blk = y % NBLK; y /= NBLK; const int b = y % NB, d = y / NB;
        const size_t item = (size_t)(b * NBLK + blk) * 4 + hh; const int cq = MQ + hh * 96 + i, ck = MQ + 384 + hh * 96 + i;
        const float q0 = cw[cq - MQ], q1 = cw[768 + cq - MQ], q2 = cw[1536 + cq - MQ], qb = cb[cq - MQ], k0 = cw[ck - MQ], k1 = cw[768 + ck - MQ], k2 = cw[1536 + ck - MQ], kb = cb[ck - MQ];
        const int gi = MG + (2 * d) * 4 + hh, gf = MG + (2 * d + 1) * 4 + hh; const float bi = gb[(2 * d) * 4 + hh], bf_ = gb[(2 * d + 1) * 4 + hh]; float Fc = 0.f;
        const int s_first = d == 0 ? 0 : 63, dir = d == 0 ? 1 : -1; const int t_first = blk * 64 + s_first; const int r_first = b * RPB + t_first;
        const bf16* pr = p + (size_t)r_first * PS; const int pstep = dir * PS; Ld cur, nxt; load4(cur, pr, pstep, t_first, dir, cq, ck, gi, gf); float ko[8];
        for (int g4 = 0; g4 < 16; ++g4) {
            if (g4 < 15) load4(nxt, pr + 4 * pstep, pstep, t_first + dir * (g4 * 4 + 4), dir, cq, ck, gi, gf);
            UNROLL for (int e = 0; e < 4; ++e) { const float yq = q0 * bf2f(cur.q[e][0]) + q1 * bf2f(cur.q[e][1]) + q2 * bf2f(cur.q[e][2]), yk = k0 * bf2f(cur.k[e][0]) + k1 * bf2f(cur.k[e][1]) + k2 * bf2f(cur.k[e][2]);
                const float qc = siluf(yq + qb), kc = siluf(yk + kb) * 0.10206207261596577f; Fc += logsigmoidf_(bf2f(cur.gf[e]) + bf_); const float kk = kc * fexp(bf2f(cur.gi[e]) + bi - Fc); const int tok = s_first + dir * (g4 * 4 + e);
                lab[L::q_at(d, item, tok, i)] = f2bf(qc * fexp(Fc)); lab[L::k_at(d, item, tok, i)] = f2bf(kk); ko[(g4 & 1) * 4 + e] = kk; }
            pr += 4 * pstep;
            if (g4 & 1) { U4 v; const int c8 = g4 >> 1; const int s0 = d == 0 ? c8 * 8 : 56 - c8 * 8;
                v.x = d == 0 ? pk2(ko[0], ko[1]) : pk2(ko[7], ko[6]); v.y = d == 0 ? pk2(ko[2], ko[3]) : pk2(ko[5], ko[4]); v.z = d == 0 ? pk2(ko[4], ko[5]) : pk2(ko[3], ko[2]); v.w = d == 0 ? pk2(ko[6], ko[7]) : pk2(ko[1], ko[0]);
                *(U4*)(lab + L::kt_at(d, item, i, s0)) = v; }
            cur = nxt; }
        ((float*)(lab + L::dec))[((size_t)d * LA_NI + item) * 96 + i] = fexp(Fc); } };
template <int DKP, int NV> struct StatesRef { long n; bf16* lab;
    HD void operator()(long x) const { typedef LaLay<DKP, NV> L; const int i = (int)(x % DKP); long y = x / DKP; const int j = (int)(y % NV); y /= NV; const size_t item = (size_t)(y % LA_NI); const int d = (int)(y / LA_NI); float acc = 0.f;
        for (int sx = 0; sx < 64; ++sx) acc += bf2f(lab[L::v_at(item, j, sx)]) * bf2f(lab[L::kt_at(d, item, i, sx)]);
        lab[L::s_at(d, item, j, i)] = f2bf(acc); } };
constexpr int CARRY_CH = (NBLK % 17 == 0) ? 17 : ((NBLK % 4 == 0) ? 4 : 1);
template <int DKP, int NV> struct CarryT { long n; bf16* lab;
    HD void operator()(long x) const { typedef LaLay<DKP, NV> L; const int xi = (int)x; const int i = xi % DKP; int y = xi / DKP; const int j = y % NV; y /= NV; const int hh = y % 4; y /= 4; const int b = y % NB, d = y / NB;
        const float* dec = (const float*)(lab + L::dec); float sv = 0.f;
        for (int step = 0; step < NBLK; ++step) { const size_t item = (size_t)(b * NBLK + chain_blk(d, step)) * 4 + hh; const size_t o = L::s_at(d, item, j, i);
            const float tv = bf2f(lab[o]), dv = dec[((size_t)d * LA_NI + item) * DKP + i]; lab[o] = f2bf(sv); sv = dv * (sv + tv); } } };
template <int DKP, int NV, bool ISML> struct OutRef { long n; const bf16* lab; float* obuf;
    HD void operator()(long x) const { typedef LaLay<DKP, NV> L; const int j = (int)(x % 96); long y = x / 96; const int hh = (int)(y % 4); const int r = (int)(y / 4); const int b = r / RPB, t = r % RPB, blk = t / 64, tt = t % 64;
        const size_t item = ((size_t)b * NBLK + blk) * 4 + hh; float hv = 0.f;
        for (int d = 0; d < 2; ++d) { float num = 0.f, den = 0.f;
            for (int sx = 0; sx < 64; ++sx) { const bool valid = d == 0 ? (sx <= tt) : (sx >= tt); if (!valid) continue;
                float a = 0.f; for (int i = 0; i < DKP; ++i) a += bf2f(lab[L::q_at(d, item, tt, i)]) * bf2f(lab[L::k_at(d, item, sx, i)]);
                a = bf2f(f2bf(a)); num += a * bf2f(lab[L::v_at(item, j, sx)]); if (ISML) den += a * bf2f(lab[L::v_at(item, 96, sx)]); }
            for (int i = 0; i < DKP; ++i) { const float qv = bf2f(lab[L::q_at(d, item, tt, i)]); num += qv * bf2f(lab[L::s_at(d, item, j, i)]); if (ISML) den += qv * bf2f(lab[L::s_at(d, item, 96, i)]); }
            hv += ISML ? num / fmaxf(fabsf(den), 1.0f) : num; }
        obuf[x] = hv; } };
struct HeadFin { long n; const bf16* p; const float* obuf; const float* gain; bf16* mix; int mode, pad;
    HD void operator()(long x) const { const int hh = (int)(x % 4), r = (int)(x / 4); const float* o = obuf + (size_t)r * 384 + hh * 96; float ss = 0.f;
        for (int j = 0; j < 96; ++j) ss += o[j] * o[j];
        const float rstd = 1.0f / sqrtf(ss / 96.0f + EPS);
        for (int j = 0; j < 96; ++j) { const float gv = bf2f(p[(size_t)r * PS + (mode ? MO : GG) + hh * 96 + j]); const float gt = mode ? sigmoidf_(gv) : siluf(gv);
            mix[(size_t)r * D + (mode ? 640 : 0) + hh * 96 + j] = f2bf(o[j] * rstd * gain[j] * gt); } } };

struct S5Disc { long n; const float* lre; const float* lim; const float* ldt; float* disc;
    HD void operator()(long x) const { const int nn = (int)(x % 64); const int dg = (int)(x / 64); const float dt = expf(ldt[dg]); const float lr = lre[x], li = lim[x];
        const float mag = expf(lr * dt), ar = mag * cosf(li * dt), ai = mag * sinf(li * dt), den = lr * lr + li * li, pr = ar - 1.0f, pi = ai;
        disc[x * 4 + 0] = lr * dt; disc[x * 4 + 1] = li * dt; disc[x * 4 + 2] = (pr * lr + pi * li) / den; disc[x * 4 + 3] = (pi * lr - pr * li) / den; (void)nn; } };
HD void s5_apow(const float* disc4, float tau, float& ar, float& ai) { const float mag = expf(disc4[0] * tau); ar = mag * cosf(disc4[1] * tau); ai = mag * sinf(disc4[1] * tau); }
struct ZeroInt { long n; int* p; HD void operator()(long i) const { p[i] = 0; } };
struct MoePrefix { long n; int* segcnt; int* ecnt; int nseg, pad;
    HD void operator()(long e) const { int c = 0; for (int sg = 0; sg < nseg; ++sg) { const int v = segcnt[(size_t)e * nseg + sg]; segcnt[(size_t)e * nseg + sg] = c; c += v; } ecnt[e] = c; } };
struct MoeTiles2 { long n; const int* ecnt; int* tile_e; int* ntile;
    HD void operator()(long t) const { int acc = 0, ef = 0; for (int e = 0; e < NE; ++e) { const int nt = (ecnt[e] + 255) / 256; if (t >= acc && t < acc + nt) ef = e; acc += nt; } tile_e[t] = ef; if (t == 0) ntile[0] = acc; } };
struct MoeFillNeg { long n; int* row_token; HD void operator()(long i) const { row_token[i] = -1; } };
struct MoeAssign { long n; const int* rt_e; const int* segcnt; const int* ecnt; int* rt_dest; int* row_token; int nseg, pad;
    HD void operator()(long x) const { const int seg = (int)(x % nseg), e = (int)(x / nseg); int pstart = 0; for (int q = 0; q < e; ++q) pstart += (ecnt[q] + 255) / 256 * 256;
        int pos = pstart + segcnt[(size_t)e * nseg + seg];
        for (int r = seg * 64; r < seg * 64 + 64 && r < NR; ++r) for (int k = 0; k < 2; ++k) if (rt_e[2 * r + k] == e) { rt_dest[2 * r + k] = pos; row_token[pos] = r; ++pos; } } };
struct MoeGather8 { long n; const unsigned char* f8; const int* row_token; unsigned char* xs; int row0, pad;
    HD void operator()(long i) const { const int lr = (int)(i / (D / 16)), c = (int)(i % (D / 16)) * 16; const int tok = row_token[row0 + lr];
        U4 v; v.x = v.y = v.z = v.w = 0u; if (tok >= 0) v = *(const U4*)(f8 + (size_t)tok * D + c); *(U4*)(xs + (size_t)lr * D + c) = v; } };
struct MoeCombine { long n; float* h; const bf16* yrow; const int* rt_e; const float* rt_w; const int* rt_dest; const float* mod; int g_off, pad;
    HD void operator()(long i) const { const int r = (int)(i / (D / 8)), c = (int)(i % (D / 8)) * 8; if (rt_e[2 * r] < 0) return;
        const U4 y0 = *(const U4*)(yrow + (size_t)rt_dest[2 * r] * D + c), y1 = *(const U4*)(yrow + (size_t)rt_dest[2 * r + 1] * D + c); const float w0 = rt_w[2 * r], w1 = rt_w[2 * r + 1];
        const float* g = mod + (size_t)mod_index(r) * 6 * D + g_off + c; float* hp = h + (size_t)r * D + c; const F4 g0 = *(const F4*)g, g1 = *(const F4*)(g + 4); F4 h0 = *(const F4*)hp, h1 = *(const F4*)(hp + 4);
        const uint32_t a[4] = {y0.x, y0.y, y0.z, y0.w}, bq[4] = {y1.x, y1.y, y1.z, y1.w}; float yv[8];
        UNROLL for (int q = 0; q < 4; ++q) { yv[2 * q] = w0 * bf2f((bf16)(a[q] & 0xffffu)) + w1 * bf2f((bf16)(bq[q] & 0xffffu)); yv[2 * q + 1] = w0 * bf2f((bf16)(a[q] >> 16)) + w1 * bf2f((bf16)(bq[q] >> 16)); }
        h0.x += g0.x * yv[0]; h0.y += g0.y * yv[1]; h0.z += g0.z * yv[2]; h0.w += g0.w * yv[3]; h1.x += g1.x * yv[4]; h1.y += g1.y * yv[5]; h1.z += g1.z * yv[6]; h1.w += g1.w * yv[7];
        *(F4*)hp = h0; *(F4*)(hp + 4) = h1; } };
struct FinalNorm { long n; const float* h; const float* g; float* out;
    HD void operator()(long x) const { const int b = (int)(x / SEQ), tl = (int)(x % SEQ); const float* hr = h + ((size_t)b * RPB + CTX + tl) * D; float ss = 0.f;
        for (int k = 0; k < D; ++k) ss += hr[k] * hr[k];
        const float rstd = 1.0f / sqrtf(ss / D + EPS); for (int k = 0; k < D; ++k) out[(size_t)x * D + k] = hr[k] * rstd * g[k]; } };

struct EpiStoreBf16 { bf16* out; int ld; int row_off;
    HD void apply8(int row, int col0, const float* v) const { bf16* o = out + (size_t)(row - row_off) * ld + col0;
#ifndef HOST_EMU
        store8_bf16(o, v);
#else
        for (int i = 0; i < 8; ++i) o[i] = f2bf(v[i]);
#endif
    } };
struct EpiSwiGLU { bf16* out; int ld; int row_off;
    HD void apply8(int row, int col0, const float* v) const { bf16* o = out + (size_t)(row - row_off) * ld + col0 / 2;
#ifndef HOST_EMU
        uint2 w; w.x = cvt_pk_bf16(fast_silu(v[0]) * v[1], fast_silu(v[2]) * v[3]); w.y = cvt_pk_bf16(fast_silu(v[4]) * v[5], fast_silu(v[6]) * v[7]); *(uint2*)o = w;
#else
        for (int i = 0; i < 4; ++i) o[i] = f2bf(siluf(v[2 * i]) * v[2 * i + 1]);
#endif
    } };
#ifndef HOST_EMU
struct EpiSwiGLU8 { unsigned char* out; int ld; int row_off;
    __device__ __forceinline__ void apply8(int row, int col0, const float* v) const { unsigned char* o = out + (size_t)(row - row_off) * ld + col0 / 2; const float sc = (float)(1 << A8S);
        float a0 = fast_silu(v[0]) * v[1] * sc, a1 = fast_silu(v[2]) * v[3] * sc, a2 = fast_silu(v[4]) * v[5] * sc, a3 = fast_silu(v[6]) * v[7] * sc;
        a0 = __builtin_amdgcn_fmed3f(a0, -440.f, 440.f); a1 = __builtin_amdgcn_fmed3f(a1, -440.f, 440.f); a2 = __builtin_amdgcn_fmed3f(a2, -440.f, 440.f); a3 = __builtin_amdgcn_fmed3f(a3, -440.f, 440.f);
        int w = 0; w = __builtin_amdgcn_cvt_pk_fp8_f32(a0, a1, w, false); w = __builtin_amdgcn_cvt_pk_fp8_f32(a2, a3, w, true); *(unsigned*)o = (unsigned)w; } };
#endif
struct EpiResid { float* h; const float* mod; int g_off, pad;
    HD void apply8(int row, int col0, const float* v) const { float* o = h + (size_t)row * D + col0; const float* g = mod + (size_t)mod_index(row) * 6 * D + g_off + col0;
#ifndef HOST_EMU
        const f4_t g0 = *(const f4_t*)g, g1 = *(const f4_t*)(g + 4); f4_t h0 = *(const f4_t*)o, h1 = *(const f4_t*)(o + 4);
        h0 += g0 * (f4_t){v[0], v[1], v[2], v[3]}; h1 += g1 * (f4_t){v[4], v[5], v[6], v[7]}; *(f4_t*)o = h0; *(f4_t*)(o + 4) = h1;
#else
        for (int i = 0; i < 8; ++i) o[i] += g[i] * v[i];
#endif
    } };

struct GemmDesc { const bf16* A; const bf16* Bt; const int* tile_e; const int* ntile; const int* arow; size_t e_stride; int M, N, K, tile0, lda, ldb, tdiv, pad; };
HD GemmDesc mk_gemm(const bf16* A, int lda, const bf16* Bt, int ldb, int M, int N, int K) { return GemmDesc{A, Bt, nullptr, nullptr, nullptr, 0, M, N, K, 0, lda, ldb, 0, 0}; }

constexpr int S5RB = NB * NBLK;
constexpr int S5RG = (S5RB + 255) / 256 * 256;
constexpr int S5K_ = 1280;
HD void s5_bbar(const float* d4, float br, float bi, float& bbr, float& bbi) { bbr = d4[2] * br - d4[3] * bi; bbi = d4[2] * bi + d4[3] * br; }
struct S5Apow { long n; const float* lre; const float* lim; const float* ldt; float* apow;
    HD void operator()(long x) const { const int nn = (int)(x % 64); long y = x / 64; const int tau = (int)(y % 65); const int dg = (int)(y / 65); const float dt = expf(ldt[dg]);
        const float lr = lre[(size_t)dg * 64 + nn] * dt, li = lim[(size_t)dg * 64 + nn] * dt; const float mag = expf(lr * (float)tau); apow[x * 2] = mag * cosf(li * (float)tau); apow[x * 2 + 1] = mag * sinf(li * (float)tau); } };
struct S5Bbar { long n; const float* disc; const float* bre; const float* bim; float* bbar;
    HD void operator()(long x) const { const int pp = (int)(x % 16); long y = x / 16; const int nn = (int)(y % 64); y /= 64; const int g = (int)(y % 16), d = (int)(y / 16); (void)d;
        const float* d4 = disc + (y * 64 + nn) * 4; float br, bi; s5_bbar(d4, bre[((size_t)g * 64 + nn) * 16 + pp], bim[((size_t)g * 64 + nn) * 16 + pp], br, bi); bbar[x * 2] = br; bbar[x * 2 + 1] = bi; } };
struct S5K2 { long n; const float* apow; const float* bbar; const float* cre; const float* cim; float* Kt;
    HD void operator()(long x) const { const int p2 = (int)(x % 16); long y = x / 16; const int p1 = (int)(y % 16); y /= 16; const int tau = (int)(y % 64); y /= 64; const int g = (int)(y % 16), d = (int)(y / 16); float acc = 0.f;
        const float* ap = apow + (((size_t)d * 16 + g) * 65 + tau) * 64 * 2; const float* bb = bbar + (((size_t)d * 16 + g) * 64) * 16 * 2;
        for (int nn = 0; nn < 64; ++nn) { const float ar = ap[nn * 2], ai = ap[nn * 2 + 1], bbr = bb[(nn * 16 + p2) * 2], bbi = bb[(nn * 16 + p2) * 2 + 1];
            acc += cre[((size_t)g * 16 + p1) * 64 + nn] * (ar * bbr - ai * bbi) - cim[((size_t)g * 16 + p1) * 64 + nn] * (ar * bbi + ai * bbr); }
        Kt[x] = acc; } };
struct S5BuildTB { long n; const float* apow; const float* cre; const float* cim; const float* Kt; bf16* TB;
    HD void operator()(long x) const { const int k0 = (int)(x % (S5K_ / 8)) * 8; long y = x / (S5K_ / 8); const int tp = (int)(y % 1024), g = (int)(y / 1024); const int t = tp >> 4, p1 = tp & 15; float v[8];
        if (k0 < 1024) { const int sx = k0 >> 4, p2 = k0 & 15; const float* kf = Kt + ((((size_t)0 * 16 + g) * 64 + (sx <= t ? t - sx : 0)) * 16 + p1) * 16 + p2; const float* kb = Kt + ((((size_t)1 * 16 + g) * 64 + (sx >= t ? sx - t : 0)) * 16 + p1) * 16 + p2;
            UNROLL for (int q = 0; q < 8; ++q) v[q] = (sx <= t ? kf[q] : 0.f) + (sx >= t ? kb[q] : 0.f);
        } else { const int kk = k0 - 1024, d = kk >> 7, n0 = (kk & 127) >> 1; const int pt = d == 0 ? t : 63 - t; const float* ap = apow + ((((size_t)d * 16 + g) * 65 + pt + 1) * 64 + n0) * 2;
            UNROLL for (int q = 0; q < 4; ++q) { const float ar = ap[2 * q], ai = ap[2 * q + 1], cr = cre[((size_t)g * 16 + p1) * 64 + n0 + q], ci = cim[((size_t)g * 16 + p1) * 64 + n0 + q]; v[2 * q] = cr * ar - ci * ai; v[2 * q + 1] = -(cr * ai + ci * ar); } }
        U4 o; o.x = pk2(v[0], v[1]); o.y = pk2(v[2], v[3]); o.z = pk2(v[4], v[5]); o.w = pk2(v[6], v[7]); *(U4*)(TB + x * 8) = o; } };
struct S5BuildEB { long n; const float* apow; const float* bbar; bf16* EB;
    HD void operator()(long x) const { const int k0 = (int)(x % 128) * 8; long y = x / 128; const int col = (int)(y % 256), g = (int)(y / 256); const int d = col >> 7, nn = (col & 127) >> 1, ri = col & 1, sx = k0 >> 4, p2 = k0 & 15;
        const float* ap = apow + ((((size_t)d * 16 + g) * 65 + (d == 0 ? 63 - sx : sx)) * 64 + nn) * 2; const float* bb = bbar + ((((size_t)d * 16 + g) * 64 + nn) * 16 + p2) * 2; const float ar = ap[0], ai = ap[1]; float v[8];
        UNROLL for (int q = 0; q < 8; ++q) { const float bbr = bb[2 * q], bbi = bb[2 * q + 1]; v[q] = ri == 0 ? (ar * bbr - ai * bbi) : (ar * bbi + ai * bbr); }
        U4 o; o.x = pk2(v[0], v[1]); o.y = pk2(v[2], v[3]); o.z = pk2(v[4], v[5]); o.w = pk2(v[6], v[7]); *(U4*)(EB + x * 8) = o; } };
struct S5BuildU { long n; const bf16* p; bf16* uG;
    HD void operator()(long x) const { const int k0 = (int)(x % 128) * 8; long y = x / 128; const int rb = (int)(y % S5RB), g = (int)(y / S5RB); const int b = rb / NBLK, blk = rb % NBLK;
        *(U4*)(uG + ((size_t)g * S5RG + rb) * S5K_ + k0) = *(const U4*)(p + ((size_t)b * RPB + blk * 64 + (k0 >> 4)) * PS + SU + g * 16 + (k0 & 15)); } };
struct S5Carry2 { long n; const float* apow; const float* est; bf16* uG;
    HD void operator()(long x) const { const int nn = (int)(x % 64); long y = x / 64; const int d = (int)(y % 2); y /= 2; const int g = (int)(y % 16), b = (int)(y / 16);
        const float* ap = apow + ((((size_t)d * 16 + g) * 65 + 64) * 64 + nn) * 2; const float ar = ap[0], ai = ap[1]; float sr = 0.f, si = 0.f;
        for (int s0 = 0; s0 < NBLK; s0 += CARRY_CH) { float tr[CARRY_CH], ti[CARRY_CH];
            UNROLL for (int e = 0; e < CARRY_CH; ++e) { const size_t row = (size_t)g * S5RG + (size_t)b * NBLK + chain_blk(d, s0 + e); tr[e] = est[row * 256 + d * 128 + 2 * nn]; ti[e] = est[row * 256 + d * 128 + 2 * nn + 1]; }
            UNROLL for (int e = 0; e < CARRY_CH; ++e) { const size_t row = (size_t)g * S5RG + (size_t)b * NBLK + chain_blk(d, s0 + e);
                uG[row * S5K_ + 1024 + d * 128 + 2 * nn] = f2bf(sr); uG[row * S5K_ + 1024 + d * 128 + 2 * nn + 1] = f2bf(si);
                const float nr = ar * sr - ai * si + tr[e], ni = ar * si + ai * sr + ti[e]; sr = nr; si = ni; } } } };
struct EpiStoreF32 { float* out; int ld; int pad;
    HD void apply8(int row, int col0, const float* v) const { float* o = out + (size_t)row * ld + col0;
#ifndef HOST_EMU
        *(f4_t*)o = (f4_t){v[0], v[1], v[2], v[3]}; *(f4_t*)(o + 4) = (f4_t){v[4], v[5], v[6], v[7]};
#else
        for (int i = 0; i < 8; ++i) o[i] = v[i];
#endif
    } };
struct EpiS5Z { const bf16* p; const float* dskip; bf16* zbuf;
    HD void apply8(int row, int col0, const float* v) const { const int g = row / S5RG, rb = row % S5RG; if (rb >= S5RB) return; const int b = rb / NBLK, blk = rb % NBLK, t = col0 >> 4, p0 = col0 & 15;
        const size_t r = (size_t)b * RPB + blk * 64 + t; const int c = g * 16 + p0;
#ifndef HOST_EMU
        float u[8], z[8]; load8_bf16(p + r * PS + SU + c, u); const f4_t d0 = *(const f4_t*)(dskip + c), d1 = *(const f4_t*)(dskip + c + 4); const float dd[8] = {d0.x, d0.y, d0.z, d0.w, d1.x, d1.y, d1.z, d1.w};
#pragma unroll
        for (int i = 0; i < 8; ++i) { const float x = v[i] + dd[i] * u[i]; const float y = 0.7978845608028654f * (x + 0.044715f * x * x * x); const float th = 1.0f - 2.0f * __builtin_amdgcn_rcpf(1.0f + __expf(2.0f * y)); z[i] = 0.5f * x * (1.0f + th); }
        store8_bf16(zbuf + r * 256 + c, z);
#else
        for (int i = 0; i < 8; ++i) zbuf[r * 256 + c + i] = f2bf(gelu_tanhf(v[i] + dskip[c + i] * bf2f(p[r * PS + SU + c + i])));
#endif
    } };
struct EpiGlu { const bf16* zbuf; const float* gb; bf16* mix;
    HD void apply8(int row, int col0, const float* v) const {
#ifndef HOST_EMU
        float z[8], o[8]; load8_bf16(zbuf + (size_t)row * 256 + col0, z); const f4_t b0 = *(const f4_t*)(gb + col0), b1 = *(const f4_t*)(gb + col0 + 4); const float bb[8] = {b0.x, b0.y, b0.z, b0.w, b1.x, b1.y, b1.z, b1.w};
#pragma unroll
        for (int i = 0; i < 8; ++i) o[i] = z[i] * fast_sigmoid(v[i] + bb[i]);
        store8_bf16(mix + (size_t)row * D + 384 + col0, o);
#else
        for (int i = 0; i < 8; ++i) mix[(size_t)row * D + 384 + col0 + i] = f2bf(bf2f(zbuf[(size_t)row * 256 + col0 + i]) * sigmoidf_(v[i] + gb[col0 + i]));
#endif
    } };

#ifndef HOST_EMU
namespace pg8 {
#define PG8_LAS __attribute__((address_space(3)))
typedef short bf16x8 __attribute__((ext_vector_type(8)));
typedef float f32x4 __attribute__((ext_vector_type(4)));
typedef int v4i_t __attribute__((ext_vector_type(4)));
typedef int v8i_t __attribute__((ext_vector_type(8)));
constexpr int BM = 256, BK = 64, HALF = 128, HTB = HALF * BK * 2, STAGE_BYTES = 8 * HTB, NXCD = 8, WGM = 8;
__device__ __forceinline__ int lds_byte(int r, int c) { const int st = (r >> 4) * 2 + (c >> 5), rr = r & 15, cc = c & 31, ob = rr * 64 + cc * 2; return st * 1024 + (ob ^ (((ob >> 9) & 1) << 5)); }
__device__ __forceinline__ void stage_rc(int b, int& R, int& C) { const int st = b / 1024, sb = b % 1024, swz = sb ^ (((sb >> 9) & 1) << 5); R = (st >> 1) * 16 + swz / 64; C = (st & 1) * 32 + (swz % 64) / 2; }
__device__ __forceinline__ int perm32(int rho) { const int n = rho >> 4, i = rho & 15; return 8 * (i >> 2) + 4 * n + (i & 3); }
struct Unit { int pm, pn; };
struct StaticOrder {
    int nM, nN, nwg, G, c;
    __device__ void init(int M, int N, int G_, int c_) { nM = M / BM; nN = N / BM; nwg = nM * nN; G = G_; c = c_; }
    __device__ bool next(int i, Unit& u) const {
        const long L = (long)i * G + c; if (L >= nwg) return false;
        int wgid = (int)L; { const int q = nwg / NXCD, r = nwg % NXCD, xcd = wgid % NXCD, off = wgid / NXCD; wgid = (xcd < r ? xcd * (q + 1) : r * (q + 1) + (xcd - r) * q) + off; }
        const int nig = WGM * nN, gid = wgid / nig, fm = gid * WGM, gsz = (nM - fm) < WGM ? (nM - fm) : WGM;
        u.pm = fm + ((wgid % nig) % gsz); u.pn = (wgid % nig) / gsz; return true;
    }
};
template <class F> __device__ __forceinline__ void epi_apply(const F& f, const f32x4 (&acc)[2][2][4][2], const Unit& u, int wr, int wc, int fr, int fq) {
    const int row0 = u.pm * BM + wr * 64 + fr, col0 = u.pn * BM + wc * 32 + 8 * fq;
#pragma unroll
    for (int ai = 0; ai < 2; ++ai)
#pragma unroll
        for (int m = 0; m < 4; ++m)
#pragma unroll
            for (int bj = 0; bj < 2; ++bj) { const f32x4 v0 = acc[ai][bj][m][0], v1 = acc[ai][bj][m][1];
                const float v[8] = {v0[0], v0[1], v0[2], v0[3], v1[0], v1[1], v1[2], v1[3]};
                f.apply8(row0 + ai * HALF + m * 16, col0 + bj * HALF, v); }
}
#ifndef PG8_SP2
#define PG8_SP2 true
#endif
#ifndef PG8_ALIGN
#define PG8_ALIGN true
#endif
template <class F, bool FP8 = false, bool GATHER = false, bool SP2 = PG8_SP2, bool ALIGN_EPI = PG8_ALIGN>
__device__ __forceinline__ void gemm_phase(PG8_LAS unsigned char* lds, const GemmDesc g, const F& E, int G_, int c_) {
    int tid_ = threadIdx.x; asm volatile("" : "+v"(tid_));
    const int tid = tid_, wid = __builtin_amdgcn_readfirstlane(tid >> 6), lane = tid & 63, wr = wid >> 2, wc = wid & 3, fr = lane & 15, fq = lane >> 4;
    const int K = g.K, nt = FP8 ? K / 128 : K / BK; constexpr unsigned EB = FP8 ? 1u : 2u;
    int M = g.M; if (g.ntile) { int ntl = g.ntile[0] - g.tile0; ntl = ntl < 0 ? 0 : ntl; if (ntl * BM < M) M = ntl * BM; }
    StaticOrder S; S.init(M, g.N, G_, c_);
    unsigned voffB[1]; int RA[2]; unsigned CA[2];
#pragma unroll
    for (int i = 0; i < 2; ++i) { int R, C; stage_rc(tid * 16 + i * 8192, R, C); const int Rb = (R & ~31) + perm32(R & 31);
        RA[i] = R; CA[i] = (unsigned)C * 2u; if (i == 0) voffB[0] = (unsigned)Rb * (unsigned)g.ldb * EB + (unsigned)C * 2u; }
    const size_t pieceB = (size_t)64 * g.ldb * EB;
    const unsigned lda2 = (unsigned)g.lda * EB;
    const size_t kstep = (size_t)(BK * 2);
    const size_t hstepA = (size_t)HALF * g.lda * EB, hstepB = (size_t)HALF * g.ldb * EB;
    const size_t tstepA = 2 * hstepA, tstepB = 2 * hstepB;
    const unsigned ldsw = (unsigned)wid * 1024u; int sc8v = (127 + g.pad / 2) * 0x01010101;
    if constexpr (FP8) asm volatile("" : "+v"(sc8v));
    const int aoff = lds_byte(wr * 64 + fr, fq * 8), boff = lds_byte(wc * 32 + fr, fq * 8);
#define PG8_SA(b, h) (((b) * 2 + (h)) * HTB)
#define PG8_SB(b, h) ((4 + (b) * 2 + (h)) * HTB)
#define PG8_STAGE(bufoff, gbase, voff) do { _Pragma("unroll") for (int _i = 0; _i < 2; ++_i) \
        __builtin_amdgcn_global_load_lds((const unsigned*)((const char*)(gbase) + (voff)[_i]), (PG8_LAS unsigned*)(lds + (bufoff) + ldsw + _i * 8192), 16, 0, 0); } while (0)
#define PG8_STAGEB(bufoff, gbase) do { _Pragma("unroll") for (int _i = 0; _i < 2; ++_i) \
        __builtin_amdgcn_global_load_lds((const unsigned*)((const char*)(gbase) + _i * pieceB + voffB[0]), (PG8_LAS unsigned*)(lds + (bufoff) + ldsw + _i * 8192), 16, 0, 0); } while (0)
#define PG8_RD(off) (*(const PG8_LAS bf16x8*)(lds + (off)))
#define PG8_LDA(dst, b, h) do { if constexpr (FP8) { _Pragma("unroll") for (int m = 0; m < 4; ++m) { dst##8[m].lo = __builtin_bit_cast(v4i_t, PG8_RD(PG8_SA(b, h) + aoff + m * 2048)); dst##8[m].hi = __builtin_bit_cast(v4i_t, PG8_RD(PG8_SA(b, h) + aoff + m * 2048 + 1024)); } } else { \
        _Pragma("unroll") for (int m = 0; m < 4; ++m) _Pragma("unroll") for (int k = 0; k < 2; ++k) dst[m][k] = PG8_RD(PG8_SA(b, h) + aoff + m * 2048 + k * 1024); } } while (0)
#define PG8_LDB(dst, b, h) do { if constexpr (FP8) { _Pragma("unroll") for (int n = 0; n < 2; ++n) { dst##8[n].lo = __builtin_bit_cast(v4i_t, PG8_RD(PG8_SB(b, h) + boff + n * 2048)); dst##8[n].hi = __builtin_bit_cast(v4i_t, PG8_RD(PG8_SB(b, h) + boff + n * 2048 + 1024)); } } else { \
        _Pragma("unroll") for (int n = 0; n < 2; ++n) _Pragma("unroll") for (int k = 0; k < 2; ++k) dst[n][k] = PG8_RD(PG8_SB(b, h) + boff + n * 2048 + k * 1024); } } while (0)
#define PG8_CAT(x0, x1) __builtin_shufflevector(__builtin_bit_cast(v4i_t, x0), __builtin_bit_cast(v4i_t, x1), 0, 1, 2, 3, 4, 5, 6, 7)
#define PG8_MMA(ai, bj, At, Bt) do { __builtin_amdgcn_s_setprio(1); if constexpr (FP8) { _Pragma("unroll") for (int m = 0; m < 4; ++m) _Pragma("unroll") for (int n = 0; n < 2; ++n) \
        asm volatile("v_mfma_scale_f32_16x16x128_f8f6f4 %0, %1, %2, %0, %3, %4 op_sel_hi:[0,0,0]" : "+v"(acc[ai][bj][m][n]) : "v"(Bt##8[n]), "v"(At##8[m]), "v"(sc8v), "v"(sc8v)); } else { \
        _Pragma("unroll") for (int m = 0; m < 4; ++m) _Pragma("unroll") for (int n = 0; n < 2; ++n) _Pragma("unroll") for (int k = 0; k < 2; ++k) \
        acc[ai][bj][m][n] = __builtin_amdgcn_mfma_f32_16x16x32_bf16(Bt[n][k], At[m][k], acc[ai][bj][m][n], 0, 0, 0); } __builtin_amdgcn_s_setprio(0); } while (0)
#define PG8_WAIT_V(n) asm volatile("s_waitcnt vmcnt(" #n ")" ::: "memory")
#define PG8_WAIT_L(n) asm volatile("s_waitcnt lgkmcnt(" #n ")" ::: "memory")
#define PG8_BAR __builtin_amdgcn_s_barrier()
#define PG8_SCHED __builtin_amdgcn_sched_barrier(0)
#define PG8_MKVO(u, vo, base) do { if constexpr (GATHER) { base = (const char*)g.A; int _t = tid; asm volatile("" : "+v"(_t));     \
            _Pragma("unroll") for (int _i = 0; _i < 2; ++_i) { int _R, _C; stage_rc(_t * 16 + _i * 8192, _R, _C); _Pragma("unroll") for (int _h = 0; _h < 2; ++_h) { \
            int _row = g.arow[(size_t)(g.tile0 + (u).pm) * BM + _h * HALF + _R]; _row = _row < 0 ? 0 : _row; vo[_h][_i] = (unsigned)_row * lda2 + (unsigned)_C * 2u; } } } \
        else { base = (const char*)g.A + (size_t)(u).pm * tstepA; _Pragma("unroll") for (int _h = 0; _h < 2; ++_h) _Pragma("unroll") for (int _i = 0; _i < 2; ++_i) vo[_h][_i] = (unsigned)(_h * HALF + RA[_i]) * lda2 + CA[_i]; } } while (0)
#define PG8_BBASE(u) ((const char*)g.Bt + (g.tile_e ? (size_t)g.tile_e[g.tile0 + (u).pm] * g.e_stride * 2 : (g.tdiv ? (size_t)((u).pm / g.tdiv) * g.e_stride * 2 : (size_t)0)) + (size_t)(u).pn * tstepB)
    Unit cur, nxt; int ui = 0;
    if (!S.next(0, cur)) return;
    f32x4 acc[2][2][4][2];
#pragma unroll
    for (int a = 0; a < 2; ++a)
#pragma unroll
        for (int b = 0; b < 2; ++b)
#pragma unroll
            for (int m = 0; m < 4; ++m)
#pragma unroll
                for (int n = 0; n < 2; ++n) acc[a][b][m][n] = (f32x4){0.f, 0.f, 0.f, 0.f};
    bf16x8 At[4][2], B0[2][2], B1[2][2]; v8i_t At8[4], B08[2], B18[2];
    const char* cA; unsigned voC[2][2], voN[2][2]; PG8_MKVO(cur, voC, cA); const char* cB = PG8_BBASE(cur);
    if constexpr (SP2) {
        PG8_STAGEB(PG8_SB(0, 0), cB); PG8_STAGEB(PG8_SB(0, 1), cB + hstepB); PG8_STAGE(PG8_SA(0, 0), cA, voC[0]); PG8_STAGE(PG8_SA(0, 1), cA, voC[1]);
        if (wr == 1) PG8_BAR;
        PG8_WAIT_V(2); PG8_BAR;
        PG8_STAGEB(PG8_SB(1, 0), cB + kstep); PG8_STAGE(PG8_SA(1, 0), cA + kstep, voC[0]); PG8_STAGEB(PG8_SB(1, 1), cB + hstepB + kstep);
        PG8_WAIT_V(6); PG8_BAR;
    } else {
    PG8_STAGEB(PG8_SB(0, 0), cB); PG8_STAGE(PG8_SA(0, 0), cA, voC[0]); PG8_STAGEB(PG8_SB(0, 1), cB + hstepB); PG8_STAGE(PG8_SA(0, 1), cA, voC[1]);
    if (wr == 1) PG8_BAR;
    PG8_WAIT_V(4); PG8_BAR;
    PG8_STAGEB(PG8_SB(1, 0), cB + kstep); PG8_STAGE(PG8_SA(1, 0), cA + kstep, voC[0]); PG8_STAGEB(PG8_SB(1, 1), cB + hstepB + kstep);
    PG8_WAIT_V(6); PG8_BAR;
    }
    for (;;) {
        const bool has_next = S.next(ui + 1, nxt);
        const char* nA = cA; if constexpr (!GATHER) { if (has_next) nA = (const char*)g.A + (size_t)nxt.pm * tstepA; } else if (has_next) PG8_MKVO(nxt, voN, nA); else { _Pragma("unroll") for (int _h = 0; _h < 2; ++_h) _Pragma("unroll") for (int _i = 0; _i < 2; ++_i) voN[_h][_i] = voC[_h][_i]; }
        const char* nB = has_next ? PG8_BBASE(nxt) : cB;
        for (int t = 0; t < nt; t += 2) {
            const bool last = (t == nt - 2);
            const char* a1 = cA + (size_t)(t + 1) * kstep;
            const char* a2 = last ? nA : cA + (size_t)(t + 2) * kstep; const char* b2 = last ? nB : cB + (size_t)(t + 2) * kstep;
            const char* a3 = a2 + kstep; const char* b3 = b2 + kstep;
            if constexpr (SP2) {
            PG8_LDB(B0, 0, 0); PG8_LDB(B1, 0, 1); PG8_SCHED; PG8_LDA(At, 0, 0); PG8_STAGE(PG8_SA(1, 1), a1, voC[1]);
            if constexpr (GATHER) if (last) { _Pragma("unroll") for (int _h = 0; _h < 2; ++_h) _Pragma("unroll") for (int _i = 0; _i < 2; ++_i) voC[_h][_i] = voN[_h][_i]; }
            PG8_WAIT_V(8); PG8_WAIT_L(0); PG8_BAR; PG8_MMA(0, 0, At, B0); PG8_MMA(0, 1, At, B1); PG8_BAR; PG8_SCHED;
            PG8_LDA(At, 0, 1); PG8_STAGEB(PG8_SB(0, 0), b2); PG8_STAGEB(PG8_SB(0, 1), b2 + hstepB); PG8_STAGE(PG8_SA(0, 0), a2, voC[0]);
            PG8_WAIT_V(8); PG8_WAIT_L(0); PG8_BAR; PG8_MMA(1, 0, At, B0); PG8_MMA(1, 1, At, B1); PG8_BAR; PG8_SCHED;
            PG8_LDB(B0, 1, 0); PG8_LDB(B1, 1, 1); PG8_SCHED; PG8_LDA(At, 1, 0); PG8_STAGE(PG8_SA(0, 1), a2, voC[1]);
            PG8_WAIT_V(8); PG8_WAIT_L(0); PG8_BAR; PG8_MMA(0, 0, At, B0); PG8_MMA(0, 1, At, B1); PG8_BAR; PG8_SCHED;
            PG8_LDA(At, 1, 1); PG8_STAGEB(PG8_SB(1, 0), b3); PG8_STAGEB(PG8_SB(1, 1), b3 + hstepB); PG8_STAGE(PG8_SA(1, 0), a3, voC[0]);
            PG8_WAIT_V(8); PG8_WAIT_L(0); PG8_BAR; PG8_MMA(1, 0, At, B0); PG8_MMA(1, 1, At, B1); PG8_BAR; PG8_SCHED;
            } else {
            PG8_LDB(B0, 0, 0); PG8_SCHED; PG8_LDA(At, 0, 0); PG8_STAGE(PG8_SA(1, 1), a1, voC[1]);
            if constexpr (GATHER) if (last) { _Pragma("unroll") for (int _h = 0; _h < 2; ++_h) _Pragma("unroll") for (int _i = 0; _i < 2; ++_i) voC[_h][_i] = voN[_h][_i]; }
            PG8_WAIT_L(8); PG8_BAR; PG8_WAIT_L(0); PG8_MMA(0, 0, At, B0); PG8_BAR; PG8_SCHED;
            PG8_LDB(B1, 0, 1); PG8_STAGEB(PG8_SB(0, 0), b2);
            PG8_BAR; PG8_WAIT_L(0); PG8_MMA(0, 1, At, B1); PG8_BAR;
            PG8_LDA(At, 0, 1); PG8_STAGE(PG8_SA(0, 0), a2, voC[0]);
            PG8_BAR; PG8_WAIT_L(0); PG8_MMA(1, 0, At, B0); PG8_BAR; PG8_SCHED;
            PG8_STAGEB(PG8_SB(0, 1), b2 + hstepB);
            PG8_WAIT_V(6); PG8_BAR; PG8_MMA(1, 1, At, B1); PG8_BAR;
            PG8_LDB(B0, 1, 0); PG8_SCHED; PG8_LDA(At, 1, 0); PG8_STAGE(PG8_SA(0, 1), a2, voC[1]);
            PG8_WAIT_L(8); PG8_BAR; PG8_WAIT_L(0); PG8_MMA(0, 0, At, B0); PG8_BAR; PG8_SCHED;
            PG8_LDB(B1, 1, 1); PG8_STAGEB(PG8_SB(1, 0), b3);
            PG8_BAR; PG8_WAIT_L(0); PG8_MMA(0, 1, At, B1); PG8_BAR;
            PG8_LDA(At, 1, 1); PG8_STAGE(PG8_SA(1, 0), a3, voC[0]);
            PG8_BAR; PG8_WAIT_L(0); PG8_MMA(1, 0, At, B0); PG8_BAR; PG8_SCHED;
            PG8_STAGEB(PG8_SB(1, 1), b3 + hstepB);
            PG8_WAIT_V(6); PG8_BAR; PG8_MMA(1, 1, At, B1); PG8_BAR;
            }
        }
        if constexpr (ALIGN_EPI) { if (wr == 0) PG8_BAR; }
        if constexpr (FP8) asm volatile("s_nop 15\n\ts_nop 15" ::: "memory");
        epi_apply(E, acc, cur, wr, wc, fr, fq);
        if (!has_next) break;
#pragma unroll
        for (int a = 0; a < 2; ++a)
#pragma unroll
            for (int b = 0; b < 2; ++b)
#pragma unroll
                for (int m = 0; m < 4; ++m)
#pragma unroll
                    for (int n = 0; n < 2; ++n) acc[a][b][m][n] = (f32x4){0.f, 0.f, 0.f, 0.f};
        cur = nxt; cA = nA; cB = nB; ++ui;
        if constexpr (ALIGN_EPI) { if (wr == 1) PG8_BAR; }
    }
    PG8_WAIT_V(0);
    if constexpr (!ALIGN_EPI) { if (wr == 0) PG8_BAR; }
    PG8_BAR;
#undef PG8_SA
#undef PG8_SB
#undef PG8_STAGE
#undef PG8_STAGEB
#undef PG8_LDA
#undef PG8_LDB
#undef PG8_MMA
#undef PG8_CAT
#undef PG8_RD
#undef PG8_WAIT_V
#undef PG8_WAIT_L
#undef PG8_BAR
#undef PG8_SCHED
#undef PG8_BBASE
#undef PG8_MKVO
}
}

#define XB_TMO      128
#define XB_XCNT(j)  (256  + 64 * (j))
#define XB_XSUB(j)  (1280 + 64 * (j))
#define XB_XGEN(j)  (2304 + 64 * (j))
#define XB_TOP      3328
#define XB_TOPGEN   3392
#define XCD_BAR_WORDS 3456
#define XB_SPIN_CAP (1u << 20)
#define LAS __attribute__((address_space(3)))
__device__ __forceinline__ unsigned xb_ld(unsigned* p)              { return __hip_atomic_load(p, __ATOMIC_RELAXED, __HIP_MEMORY_SCOPE_AGENT); }
__device__ __forceinline__ unsigned xb_add(unsigned* p, unsigned v) { return __hip_atomic_fetch_add(p, v, __ATOMIC_RELAXED, __HIP_MEMORY_SCOPE_AGENT); }
__device__ __forceinline__ unsigned xb_xcc_id() { return (unsigned)__builtin_amdgcn_s_getreg((3 << 11) | 20) & 0xFu; }
#define XB_SPIN(cond, bar) do { unsigned _sp = 0; while (cond) { __builtin_amdgcn_s_sleep(1); \
    if ((++_sp & 255u) == 0u) { if (xb_ld(&(bar)[XB_TMO])) break; if (_sp > XB_SPIN_CAP) { atomicAdd(&(bar)[XB_TMO], 1u); break; } } } } while (0)
struct XcdBarrier { unsigned* bar; unsigned x; volatile LAS unsigned* st; };
__device__ __forceinline__ XcdBarrier xcd_barrier_post(unsigned* bar, volatile LAS unsigned* st) {
    XcdBarrier b; b.bar = bar; b.x = xb_xcc_id(); b.st = st;
    if (threadIdx.x == 0) (void)xb_add(&bar[XB_XCNT(b.x)], 1u);
    return b;
}
__device__ __forceinline__ void xcd_barrier_complete(unsigned* bar, unsigned x, unsigned& nloc, unsigned& nx) {
    const unsigned G = gridDim.x * gridDim.y * gridDim.z;
    unsigned sum, cnt, mine, sp = 0u;
    for (;;) {
        sum = 0u; cnt = 0u; mine = 0u;
#pragma unroll
        for (unsigned j = 0; j < 16; ++j) { const unsigned c = xb_ld(&bar[XB_XCNT(j)]); sum += c; cnt += (c > 0u) ? 1u : 0u; mine = (j == x) ? c : mine; }
        if (sum == G) break;
        __builtin_amdgcn_s_sleep(1);
        if ((++sp & 255u) == 0u) { if (xb_ld(&bar[XB_TMO])) break; if (sp > XB_SPIN_CAP) { atomicAdd(&bar[XB_TMO], 1u); break; } }
    }
    nloc = mine > 0u ? mine : 1u; nx = cnt > 0u ? cnt : 1u;
}
__device__ __forceinline__ void xcd_barrier(const XcdBarrier& b) {
    asm volatile("s_waitcnt vmcnt(0)" ::: "memory");
    __syncthreads();
    if (threadIdx.x == 0) {
        unsigned* bar = b.bar; asm volatile("" : "+s"(bar));
        __builtin_amdgcn_s_waitcnt(0);
        unsigned nloc = b.st[0], nx = b.st[1];
        if (nloc == 0u) { xcd_barrier_complete(bar, b.x, nloc, nx); b.st[0] = nloc; b.st[1] = nx; }
        const unsigned old = xb_add(&bar[XB_XSUB(b.x)], 1u);
        const unsigned gen = old / nloc;
        if (old + 1u == (gen + 1u) * nloc) {
            __builtin_amdgcn_fence(__ATOMIC_RELEASE, "agent");
            asm volatile("s_waitcnt vmcnt(0)" ::: "memory");
            const unsigned og = xb_add(&bar[XB_TOP], 1u);
            const unsigned tg = og / nx;
            if (og + 1u == (tg + 1u) * nx) xb_add(&bar[XB_TOPGEN], 1u);
            else XB_SPIN(xb_ld(&bar[XB_TOPGEN]) == tg, bar);
            __builtin_amdgcn_fence(__ATOMIC_ACQUIRE, "agent");
            xb_add(&bar[XB_XGEN(b.x)], 1u);
            asm volatile("s_waitcnt vmcnt(0)" ::: "memory");
        } else {
            XB_SPIN(xb_ld(&bar[XB_XGEN(b.x)]) == gen, bar);
            __builtin_amdgcn_fence(__ATOMIC_ACQUIRE, "agent");
            asm volatile("s_waitcnt vmcnt(0)" ::: "memory");
        }
    }
    __syncthreads();
}

__device__ __forceinline__ float wave_sum(float v) {
#pragma unroll
    for (int o = 1; o < 64; o <<= 1) v += __shfl_xor(v, o);
    return v;
}
typedef float f32x4v __attribute__((ext_vector_type(4)));
__device__ __forceinline__ unsigned pk2bf(float lo, float hi) { return (unsigned)f2bf(lo) | ((unsigned)f2bf(hi) << 16); }
#define LDS_WAIT() asm volatile("s_waitcnt lgkmcnt(0)" ::: "memory")
struct NormModW { int n; int sh_off; int sc_off; int skip_ctx; const float* h; const float* g; const float* mod; bf16* out; const float* wr; int* rt_e; float* rt_w; int* segcnt; int nseg, f8;
    __device__ __forceinline__ void wave(int it, int lane, PG8_LAS unsigned char*) const {
        f32x4v v[2][4]; float ss[2] = {0.f, 0.f};
#pragma unroll
        for (int q = 0; q < 2; ++q) { const f32x4v* hr = (const f32x4v*)(h + (size_t)(2 * it + q) * D) + lane;
#pragma unroll
            for (int j = 0; j < 4; ++j) v[q][j] = hr[64 * j]; }
#pragma unroll
        for (int q = 0; q < 2; ++q) {
#pragma unroll
            for (int j = 0; j < 4; ++j) ss[q] += (v[q][j].x * v[q][j].x + v[q][j].y * v[q][j].y) + (v[q][j].z * v[q][j].z + v[q][j].w * v[q][j].w); }
#pragma unroll
        for (int q = 0; q < 2; ++q) { const int r = 2 * it + q;
        const float rstd = 1.0f / sqrtf(wave_sum(ss[q]) * (1.0f / D) + EPS); const float* m = mod + (size_t)mod_index(r) * 6 * D;
        float lg[NE];
#pragma unroll
        for (int e = 0; e < NE; ++e) lg[e] = 0.f;
#pragma unroll
        for (int j = 0; j < 4; ++j) { const int k0 = 4 * (lane + 64 * j); const f32x4v g4 = *(const f32x4v*)(g + k0), sc4 = *(const f32x4v*)(m + sc_off + k0), sh4 = *(const f32x4v*)(m + sh_off + k0);
            const f32x4v o = v[q][j] * rstd * g4 * (sc4 + 1.0f) + sh4;
            if (f8) { int w8 = 0; w8 = __builtin_amdgcn_cvt_pk_fp8_f32(o.x, o.y, w8, false); w8 = __builtin_amdgcn_cvt_pk_fp8_f32(o.z, o.w, w8, true); *(int*)((unsigned char*)out + (size_t)r * D + k0) = w8; }
            else *(uint2*)(out + (size_t)r * D + k0) = make_uint2(cvt_pk_bf16(o.x, o.y), cvt_pk_bf16(o.z, o.w));
            if (wr) {
#pragma unroll
                for (int i = 0; i < 4; ++i) { const f32x4v w0 = *(const f32x4v*)(wr + (size_t)(k0 + i) * NE), w1 = *(const f32x4v*)(wr + (size_t)(k0 + i) * NE + 4); const float ov = o[i];
                    lg[0] += ov * w0.x; lg[1] += ov * w0.y; lg[2] += ov * w0.z; lg[3] += ov * w0.w; lg[4] += ov * w1.x; lg[5] += ov * w1.y; lg[6] += ov * w1.z; lg[7] += ov * w1.w; } } }
        if (wr) {
#pragma unroll
            for (int e = 0; e < NE; ++e) lg[e] = wave_sum(lg[e]);
            int e0 = 0; float b0 = lg[0];
#pragma unroll
            for (int e = 1; e < NE; ++e) if (lg[e] > b0) { b0 = lg[e]; e0 = e; }
            int e1 = -1; float b1 = -3.0e38f;
#pragma unroll
            for (int e = 0; e < NE; ++e) if (e != e0 && lg[e] > b1) { b1 = lg[e]; e1 = e; }
            const float w1 = 1.0f / (1.0f + expf(b1 - b0)); const bool skip = skip_ctx && ((r % RPB) < CTX);
            if (lane == 0) { rt_e[2 * r] = skip ? -1 : e0; rt_e[2 * r + 1] = skip ? -1 : e1; rt_w[2 * r] = w1; rt_w[2 * r + 1] = 1.0f - w1;
                if (!skip) { atomicAdd(&segcnt[(size_t)e0 * nseg + r / 64], 1); atomicAdd(&segcnt[(size_t)e1 * nseg + r / 64], 1); } } }
        }
    } };
struct MoePrefixW { int n; int nseg; int* segcnt; int* ecnt;
    __device__ __forceinline__ void wave(int e, int lane, PG8_LAS unsigned char*) const { constexpr int PER = ((NR + 63) / 64 + 63) / 64; int v[PER]; int tot = 0;
#pragma unroll
        for (int k = 0; k < PER; ++k) { const int sg = lane * PER + k; v[k] = sg < nseg ? segcnt[(size_t)e * nseg + sg] : 0; tot += v[k]; }
        int incl = tot;
#pragma unroll
        for (int o = 1; o < 64; o <<= 1) { const int t = __shfl_up(incl, o); if (lane >= o) incl += t; }
        int run = incl - tot;
#pragma unroll
        for (int k = 0; k < PER; ++k) { const int sg = lane * PER + k; if (sg < nseg) segcnt[(size_t)e * nseg + sg] = run; run += v[k]; }
        if (lane == 63) ecnt[e] = incl; } };
struct CombineNormW { int n; int mode; int g_off; int pad; float* h; const bf16* yrow; const int* rt_e; const float* rt_w; const int* rt_dest; const float* modc; const float* gn; const float* modn; bf16* outb; float* outf;
    __device__ __forceinline__ void wave(int r, int lane, PG8_LAS unsigned char*) const {
        const int t = r % RPB; if (mode == 1 && t < CTX) return;
        f32x4v* hr = (f32x4v*)(h + (size_t)r * D) + lane; f32x4v v[4];
#pragma unroll
        for (int j = 0; j < 4; ++j) v[j] = hr[64 * j];
        const int e0 = rt_e[2 * r];
        if (e0 >= 0) { const size_t d0 = (size_t)rt_dest[2 * r], d1 = (size_t)rt_dest[2 * r + 1]; const float w0 = rt_w[2 * r], w1 = rt_w[2 * r + 1]; const float* gt = modc + (size_t)mod_index(r) * 6 * D + g_off;
            uint2 y0[4], y1[4]; f32x4v g4[4];
#pragma unroll
            for (int j = 0; j < 4; ++j) { const int k0 = 4 * (lane + 64 * j); y0[j] = *(const uint2*)(yrow + d0 * D + k0); y1[j] = *(const uint2*)(yrow + d1 * D + k0); g4[j] = *(const f32x4v*)(gt + k0); }
#pragma unroll
            for (int j = 0; j < 4; ++j) { f32x4v y;
                y.x = w0 * __uint_as_float(y0[j].x << 16) + w1 * __uint_as_float(y1[j].x << 16); y.y = w0 * __uint_as_float(y0[j].x & 0xffff0000u) + w1 * __uint_as_float(y1[j].x & 0xffff0000u);
                y.z = w0 * __uint_as_float(y0[j].y << 16) + w1 * __uint_as_float(y1[j].y << 16); y.w = w0 * __uint_as_float(y0[j].y & 0xffff0000u) + w1 * __uint_as_float(y1[j].y & 0xffff0000u);
                v[j] += g4[j] * y; }
            if (mode == 0) {
#pragma unroll
                for (int j = 0; j < 4; ++j) hr[64 * j] = v[j]; } }
        float ss = 0.f;
#pragma unroll
        for (int j = 0; j < 4; ++j) ss += (v[j].x * v[j].x + v[j].y * v[j].y) + (v[j].z * v[j].z + v[j].w * v[j].w);
        const float rstd = 1.0f / sqrtf(wave_sum(ss) * (1.0f / D) + EPS);
        if (mode == 0) { const float* m = modn + (size_t)mod_index(r) * 6 * D;
#pragma unroll
            for (int j = 0; j < 4; ++j) { const int k0 = 4 * (lane + 64 * j); const f32x4v g4 = *(const f32x4v*)(gn + k0), sc4 = *(const f32x4v*)(m + D + k0), sh4 = *(const f32x4v*)(m + k0);
                const f32x4v o = v[j] * rstd * g4 * (sc4 + 1.0f) + sh4; *(uint2*)(outb + (size_t)r * D + k0) = make_uint2(cvt_pk_bf16(o.x, o.y), cvt_pk_bf16(o.z, o.w)); }
        } else { const int b = r / RPB, tl = t - CTX;
#pragma unroll
            for (int j = 0; j < 4; ++j) { const int k0 = 4 * (lane + 64 * j); *(f32x4v*)(outf + ((size_t)b * SEQ + tl) * D + k0) = v[j] * rstd * *(const f32x4v*)(gn + k0); } } } };
struct FinalNormW { int n; int pad; const float* h; const float* g; float* out;
    __device__ __forceinline__ void wave(int x, int lane, PG8_LAS unsigned char*) const { const int b = x / SEQ, tl = x % SEQ;
        const f32x4v* hr = (const f32x4v*)(h + ((size_t)b * RPB + CTX + tl) * D) + lane; f32x4v v[4]; float ss = 0.f;
#pragma unroll
        for (int j = 0; j < 4; ++j) { v[j] = hr[64 * j]; ss += (v[j].x * v[j].x + v[j].y * v[j].y) + (v[j].z * v[j].z + v[j].w * v[j].w); }
        const float rstd = 1.0f / sqrtf(wave_sum(ss) * (1.0f / D) + EPS);
#pragma unroll
        for (int j = 0; j < 4; ++j) { const int k0 = 4 * (lane + 64 * j); *(f32x4v*)(out + (size_t)x * D + k0) = v[j] * rstd * *(const f32x4v*)(g + k0); } } };
struct TransW { int n; int K, N, rs, ro, f8; const float* src; bf16* dst; size_t sstride, dstride;
    __device__ __forceinline__ void loadt(f32x4v (&v)[8], int tile, int lane) const { const int nblk = N / 32, ipm = (K / 64) * nblk; const int mat = tile / ipm, r = tile % ipm, kb = r / nblk, nb = r % nblk;
        const float* W = src + (size_t)mat * sstride + (size_t)(64 * kb + (lane >> 3)) * N + 32 * nb + 4 * (lane & 7);
#pragma unroll
        for (int i = 0; i < 8; ++i) v[i] = *(const f32x4v*)(W + (size_t)(8 * i) * N); }
    __device__ __forceinline__ void emit(const f32x4v (&v)[8], int tile, int lane, PG8_LAS float* scr) const { const int nblk = N / 32, ipm = (K / 64) * nblk; const int mat = tile / ipm, r = tile % ipm, kb = r / nblk, nb = r % nblk, k0 = 64 * kb, n0 = 32 * nb;
        const int kr = lane >> 3, nq = lane & 7;
#pragma unroll
        for (int i = 0; i < 8; ++i) { PG8_LAS float* sp = scr + (8 * i + kr) * 33 + 4 * nq; sp[0] = v[i].x; sp[1] = v[i].y; sp[2] = v[i].z; sp[3] = v[i].w; }
        LDS_WAIT();
        const int c = lane & 7;
        if (f8) { unsigned char* WT8 = (unsigned char*)dst + (size_t)mat * dstride; const float sc = __builtin_amdgcn_ldexpf(1.0f, f8);
#pragma unroll
            for (int j = 0; j < 4; ++j) { const int nn = (lane >> 3) + 8 * j; const PG8_LAS float* sp = scr + (8 * c) * 33 + nn; int w0 = 0, w1 = 0;
                w0 = __builtin_amdgcn_cvt_pk_fp8_f32(sp[0 * 33] * sc, sp[1 * 33] * sc, w0, false); w0 = __builtin_amdgcn_cvt_pk_fp8_f32(sp[2 * 33] * sc, sp[3 * 33] * sc, w0, true);
                w1 = __builtin_amdgcn_cvt_pk_fp8_f32(sp[4 * 33] * sc, sp[5 * 33] * sc, w1, false); w1 = __builtin_amdgcn_cvt_pk_fp8_f32(sp[6 * 33] * sc, sp[7 * 33] * sc, w1, true);
                *(uint2*)(WT8 + ((size_t)(n0 + nn) * rs + ro) * K + k0 + 8 * c) = make_uint2((unsigned)w0, (unsigned)w1); }
        } else { bf16* WT = dst + (size_t)mat * dstride;
#pragma unroll
            for (int j = 0; j < 4; ++j) { const int nn = (lane >> 3) + 8 * j; const PG8_LAS float* sp = scr + (8 * c) * 33 + nn;
                uint4 o; o.x = cvt_pk_bf16(sp[0 * 33], sp[1 * 33]); o.y = cvt_pk_bf16(sp[2 * 33], sp[3 * 33]); o.z = cvt_pk_bf16(sp[4 * 33], sp[5 * 33]); o.w = cvt_pk_bf16(sp[6 * 33], sp[7 * 33]);
                *(uint4*)(WT + ((size_t)(n0 + nn) * rs + ro) * K + k0 + 8 * c) = o; } }
        LDS_WAIT(); }
    __device__ __forceinline__ void wave(int item, int lane, PG8_LAS unsigned char* lw) const {
        PG8_LAS float* scr = (PG8_LAS float*)lw;
        const int t0 = 2 * item, t1 = 2 * item + 1; const bool two = t1 < tiles; f32x4v va[8], vb[8];
        loadt(va, t0, lane); if (two) loadt(vb, t1, lane);
        emit(va, t0, lane, scr); if (two) emit(vb, t1, lane, scr);
    } int tiles, pad2; };

template <int MT, int NT, int KS, class PA, class PB>
__device__ __forceinline__ void wave_mma(PA A, int lda, PB Bt, int ldb, pg8::f32x4 (&acc)[MT][NT], int lane) {
    const int r = lane & 15, q = lane >> 4;
#pragma unroll
    for (int ks = 0; ks < KS; ++ks) { pg8::bf16x8 a[MT], b[NT];
#pragma unroll
        for (int m = 0; m < MT; ++m) a[m] = *(const pg8::bf16x8*)(A + (size_t)(m * 16 + r) * lda + ks * 32 + q * 8);
#pragma unroll
        for (int n = 0; n < NT; ++n) b[n] = *(const pg8::bf16x8*)(Bt + (size_t)(n * 16 + r) * ldb + ks * 32 + q * 8);
#pragma unroll
        for (int m = 0; m < MT; ++m)
#pragma unroll
            for (int n = 0; n < NT; ++n) acc[m][n] = __builtin_amdgcn_mfma_f32_16x16x32_bf16(a[m], b[n], acc[m][n], 0, 0, 0); }
}
__device__ __forceinline__ float chunk_cumsum(float x, int d, int lane, float& tot) { float pre = x;
#pragma unroll
    for (int o = 1; o < 64; o <<= 1) { const float t = __shfl_up(pre, o); if (lane >= o) pre += t; }
    tot = __shfl(pre, 63); return d == 0 ? pre : tot - pre + x; }
struct MlPrepW2 { int n; int pad; const bf16* p; const float* cw; const float* cb; const float* gb; bf16* lab;
    __device__ __forceinline__ void wave(int it, int lane, PG8_LAS unsigned char* lw) const { typedef LaLay<96, 112> L;
        const int hh = it & 3; int y = it >> 2; const int blk = y % NBLK; y /= NBLK; const int b = y % NB, d = y / NB; const size_t item = ((size_t)b * NBLK + blk) * 4 + hh;
        const int tb = blk * 64; const size_t rb = (size_t)b * RPB + tb; const bool first_blk = (tb == 0 || tb == CTX), last_blk = (tb + 63 == CTX - 1 || tb + 63 == RPB - 1);
        PG8_LAS bf16* X = (PG8_LAS bf16*)lw; PG8_LAS float* SQ = (PG8_LAS float*)(lw + 14336); PG8_LAS float* SK = SQ + 64;
        { const bf16* pr = p + (rb + lane) * PS; const float gI = bf2f(pr[MG + (2 * d) * 4 + hh]) + gb[(2 * d) * 4 + hh], gF = bf2f(pr[MG + (2 * d + 1) * 4 + hh]) + gb[(2 * d + 1) * 4 + hh];
          float tot; const float Fc = chunk_cumsum(logsigmoidf_(gF), d, lane, tot); SQ[lane] = fexp(Fc); SK[lane] = fexp(gI - Fc) * 0.10206207261596577f;
          float* dec = (float*)(lab + L::dec) + ((size_t)d * LA_NI + item) * 96; const float dv = fexp(tot); dec[lane] = dv; if (lane < 32) dec[64 + lane] = dv; }
#pragma unroll 1
        for (int mat = 0; mat < 2; ++mat) { const int col0 = MQ + mat * 384 + hh * 96;
            pg8::v4i_t v[13];
#pragma unroll
            for (int k = 0; k < 13; ++k) { const int pi = lane + 64 * k, rw = pi / 12, c = pi % 12; const bool zero = (pi >= 792) || (rw == 0 && first_blk) || (rw == 65 && last_blk);
                v[k] = (pg8::v4i_t){0, 0, 0, 0}; if (!zero) v[k] = *(const pg8::v4i_t*)(p + (rb + rw - 1) * PS + col0 + c * 8); }
#pragma unroll
            for (int k = 0; k < 13; ++k) { const int pi = lane + 64 * k, rw = pi / 12, c = pi % 12; if (pi < 792) *(PG8_LAS pg8::v4i_t*)(X + rw * 104 + c * 8) = v[k]; }
            LDS_WAIT();
            unsigned o0[32], o1[32];
            const PG8_LAS float* SC = mat ? SK : SQ;
#pragma unroll
            for (int ps = 0; ps < 2; ++ps) { const int i = lane + 64 * ps; const bool act = i < 96; const int ci = mat * 384 + hh * 96 + (act ? i : 0);
                const float w0 = cw[ci], w1 = cw[768 + ci], w2 = cw[1536 + ci], bs = cb[ci]; const PG8_LAS bf16* xc = X + (act ? i : 0);
                float xa = bf2f(xc[0]), xb = bf2f(xc[104]);
#pragma unroll
                for (int s2 = 0; s2 < 32; ++s2) { const float x2 = bf2f(xc[(2 * s2 + 2) * 104]), x3 = bf2f(xc[(2 * s2 + 3) * 104]);
                    const float va = siluf(w0 * xa + w1 * xb + w2 * x2 + bs) * SC[2 * s2], vb = siluf(w0 * xb + w1 * x2 + w2 * x3 + bs) * SC[2 * s2 + 1];
                    const unsigned pk = cvt_pk_bf16(va, vb); if (ps == 0) o0[s2] = pk; else o1[s2] = pk; xa = x2; xb = x3; } }
            LDS_WAIT();
#pragma unroll
            for (int s2 = 0; s2 < 32; ++s2) { const int c0 = lane, t0 = 2 * s2;
                X[((t0 >> 4) * 3 + (c0 >> 5)) * 512 + ((((c0 & 31) >> 3) << 4) + (t0 & 15)) * 8 + (c0 & 7)] = (bf16)(o0[s2] & 0xffffu); X[((t0 >> 4) * 3 + (c0 >> 5)) * 512 + ((((c0 & 31) >> 3) << 4) + ((t0 + 1) & 15)) * 8 + (c0 & 7)] = (bf16)(o0[s2] >> 16);
                if (lane < 32) { const int c1 = 64 + lane; X[((t0 >> 4) * 3 + (c1 >> 5)) * 512 + ((((c1 & 31) >> 3) << 4) + (t0 & 15)) * 8 + (c1 & 7)] = (bf16)(o1[s2] & 0xffffu); X[((t0 >> 4) * 3 + (c1 >> 5)) * 512 + ((((c1 & 31) >> 3) << 4) + ((t0 + 1) & 15)) * 8 + (c1 & 7)] = (bf16)(o1[s2] >> 16); } }
            LDS_WAIT();
            { bf16* dst = lab + (mat ? L::kin : L::qin) + ((size_t)d * LA_NI + item) * 64 * 96;
#pragma unroll
              for (int k = 0; k < 12; ++k) { const int pi = lane + 64 * k; const pg8::v4i_t w = *(const PG8_LAS pg8::v4i_t*)(X + pi * 8); *(pg8::v4i_t*)(dst + (size_t)pi * 8) = w; } }
            LDS_WAIT();
            if (mat == 1) {
#pragma unroll
                for (int s2 = 0; s2 < 32; ++s2) { const int c0 = lane, t0 = 2 * s2;
                    *(PG8_LAS unsigned*)(X + ((c0 >> 4) * 2 + (t0 >> 5)) * 512 + ((((t0 & 31) >> 3) << 4) + (c0 & 15)) * 8 + (t0 & 7)) = o0[s2];
                    if (lane < 32) { const int c1 = 64 + lane; *(PG8_LAS unsigned*)(X + ((c1 >> 4) * 2 + (t0 >> 5)) * 512 + ((((t0 & 31) >> 3) << 4) + (c1 & 15)) * 8 + (t0 & 7)) = o1[s2]; } }
                LDS_WAIT();
                bf16* dst = lab + L::koutT + ((size_t)d * LA_NI + item) * 96 * 64;
#pragma unroll
                for (int k = 0; k < 12; ++k) { const int pi = lane + 64 * k; const pg8::v4i_t w = *(const PG8_LAS pg8::v4i_t*)(X + pi * 8); *(pg8::v4i_t*)(dst + (size_t)pi * 8) = w; }
                LDS_WAIT(); } } } };

struct GlaPrepW2 { int n; int pad; const bf16* p; const float* wa2; const float* ba; bf16* lab;
    __device__ __forceinline__ void wave(int it, int lane, PG8_LAS unsigned char* lw) const { typedef LaLay<64, 96> L;
        const int hh = it & 3; int y = it >> 2; const int blk = y % NBLK; y /= NBLK; const int b = y % NB, d = y / NB; const size_t item = ((size_t)b * NBLK + blk) * 4 + hh; const size_t rb = (size_t)b * RPB + blk * 64;
        PG8_LAS bf16* LR = (PG8_LAS bf16*)lw; PG8_LAS bf16* Q = LR + 64 * 16; PG8_LAS bf16* K = Q + 64 * 48; PG8_LAS bf16* X = (PG8_LAS bf16*)lw;
        pg8::v4i_t v[14];
#pragma unroll
        for (int k = 0; k < 2; ++k) { const int pi = lane + 64 * k; v[k] = *(const pg8::v4i_t*)(p + (rb + (pi >> 1)) * PS + GLR + (pi & 1) * 8); }
#pragma unroll
        for (int k = 0; k < 6; ++k) { const int pi = lane + 64 * k, rw = pi / 6, c = pi % 6; v[2 + k] = *(const pg8::v4i_t*)(p + (rb + rw) * PS + GQ + hh * 48 + c * 8); v[8 + k] = *(const pg8::v4i_t*)(p + (rb + rw) * PS + GK + hh * 48 + c * 8); }
#pragma unroll
        for (int k = 0; k < 2; ++k) { const int pi = lane + 64 * k; *(PG8_LAS pg8::v4i_t*)(LR + pi * 8) = v[k]; }
#pragma unroll
        for (int k = 0; k < 6; ++k) { const int pi = lane + 64 * k; *(PG8_LAS pg8::v4i_t*)(Q + pi * 8) = v[2 + k]; *(PG8_LAS pg8::v4i_t*)(K + pi * 8) = v[8 + k]; }
        LDS_WAIT();
        const bool act = lane < 48; const int i = act ? lane : 0; const int j = hh * 48 + i; float w[16];
#pragma unroll
        for (int q = 0; q < 16; ++q) w[q] = wa2[((size_t)d * 16 + q) * 192 + j];
        const float bj = ba[d * 192 + j]; float c = 0.f; unsigned oq[32], ok[32];
#pragma unroll
        for (int p2 = 0; p2 < 32; ++p2) { float qv[2], kv[2];
#pragma unroll
            for (int h2 = 0; h2 < 2; ++h2) { const int pp = 2 * p2 + h2; const int tok = d == 0 ? pp : 63 - pp; const pg8::v4i_t l0 = *(const PG8_LAS pg8::v4i_t*)(LR + tok * 16), l1 = *(const PG8_LAS pg8::v4i_t*)(LR + tok * 16 + 8);
                const unsigned u[8] = {(unsigned)l0.x, (unsigned)l0.y, (unsigned)l0.z, (unsigned)l0.w, (unsigned)l1.x, (unsigned)l1.y, (unsigned)l1.z, (unsigned)l1.w}; float z = bj;
#pragma unroll
                for (int q = 0; q < 8; ++q) { z += __uint_as_float(u[q] << 16) * w[2 * q]; z += __uint_as_float(u[q] & 0xffff0000u) * w[2 * q + 1]; }
                c += logsigmoidf_(z) * (1.0f / 16.0f); qv[h2] = bf2f(Q[tok * 48 + i]) * 0.14433756729740643f * fexp(c); kv[h2] = bf2f(K[tok * 48 + i]) * fexp(-c); }
            oq[p2] = act ? cvt_pk_bf16(qv[0], qv[1]) : 0u; ok[p2] = act ? cvt_pk_bf16(kv[0], kv[1]) : 0u; }
        { float* dec = (float*)(lab + L::dec) + ((size_t)d * LA_NI + item) * 64; dec[lane] = act ? fexp(c) : 0.f; }
        LDS_WAIT();
#pragma unroll 1
        for (int im = 0; im < 2; ++im) {
#pragma unroll
            for (int p2 = 0; p2 < 32; ++p2) { const unsigned o = im ? ok[p2] : oq[p2]; const int ta = d == 0 ? 2 * p2 : 63 - 2 * p2, tb2 = d == 0 ? 2 * p2 + 1 : 62 - 2 * p2; const int cb = (lane >> 5) * 512 + (((lane & 31) >> 3) << 4) * 8 + (lane & 7);
                X[(ta >> 4) * 1024 + cb + (ta & 15) * 8] = (bf16)(o & 0xffffu); X[(tb2 >> 4) * 1024 + cb + (tb2 & 15) * 8] = (bf16)(o >> 16); }
            LDS_WAIT();
            bf16* dst = lab + (im ? L::kin : L::qin) + ((size_t)d * LA_NI + item) * 64 * 64;
#pragma unroll
            for (int k = 0; k < 8; ++k) { const int pi = lane + 64 * k; const pg8::v4i_t wv = *(const PG8_LAS pg8::v4i_t*)(X + pi * 8); *(pg8::v4i_t*)(dst + (size_t)pi * 8) = wv; }
            LDS_WAIT(); }
#pragma unroll
        for (int p2 = 0; p2 < 32; ++p2) { const unsigned o = ok[p2]; const int tl = d == 0 ? 2 * p2 : 62 - 2 * p2; const unsigned ov = d == 0 ? o : ((o >> 16) | (o << 16));
            *(PG8_LAS unsigned*)(X + ((lane >> 4) * 2 + (tl >> 5)) * 512 + ((((tl & 31) >> 3) << 4) + (lane & 15)) * 8 + (tl & 7)) = ov; }
        LDS_WAIT();
        { bf16* dst = lab + L::koutT + ((size_t)d * LA_NI + item) * 64 * 64;
#pragma unroll
          for (int k = 0; k < 8; ++k) { const int pi = lane + 64 * k; const pg8::v4i_t wv = *(const PG8_LAS pg8::v4i_t*)(X + pi * 8); *(pg8::v4i_t*)(dst + (size_t)pi * 8) = wv; } }
        LDS_WAIT(); } };

template <int NV, int VOFF> struct VTW { int n; int pad; const bf16* p; bf16* vT;
    __device__ __forceinline__ void wave(int it, int lane, PG8_LAS unsigned char* lw) const { const int hh = it & 3; const int bb = it >> 2; const size_t r0 = (size_t)(bb / NBLK) * RPB + (bb % NBLK) * 64;
        PG8_LAS bf16* t = (PG8_LAS bf16*)lw; pg8::v4i_t v[12];
#pragma unroll
        for (int k = 0; k < 12; ++k) { const int pi = lane + 64 * k, rw = pi / 12, c = pi % 12; v[k] = *(const pg8::v4i_t*)(p + (r0 + rw) * PS + VOFF + hh * 96 + c * 8); }
#pragma unroll
        for (int k = 0; k < 12; ++k) { const int pi = lane + 64 * k, rw = pi / 12, c = pi % 12; *(PG8_LAS pg8::v4i_t*)(t + rw * 104 + c * 8) = v[k]; }
        LDS_WAIT();
        bf16* o = vT + (size_t)it * NV * 64 + (size_t)lane * 8; const int jr = lane & 15, sq = (lane >> 4) * 8;
#pragma unroll
        for (int jt = 0; jt < 6; ++jt)
#pragma unroll
            for (int ks = 0; ks < 2; ++ks) { const PG8_LAS bf16* c0 = t + (ks * 32 + sq) * 104 + jt * 16 + jr; pg8::v4i_t w;
                w.x = (int)((unsigned)c0[0] | ((unsigned)c0[104] << 16)); w.y = (int)((unsigned)c0[208] | ((unsigned)c0[312] << 16)); w.z = (int)((unsigned)c0[416] | ((unsigned)c0[520] << 16)); w.w = (int)((unsigned)c0[624] | ((unsigned)c0[728] << 16));
                *(pg8::v4i_t*)(o + (jt * 2 + ks) * 512) = w; }
        if (NV > 96) { const int f = jr == 0 ? 0x3f803f80 : 0; const pg8::v4i_t w = {f, f, f, f};
#pragma unroll
            for (int ks = 0; ks < 2; ++ks) *(pg8::v4i_t*)(o + (12 + ks) * 512) = w; }
        LDS_WAIT(); } };

template <int DKP, int NV, int NG, int MR = 1> struct ChainW { int n; int pad; bf16* lab;
    static constexpr int CG = DKP / (16 * NG), MT = NV / 16, MG = (MT + MR - 1) / MR;
    struct Fr { pg8::bf16x8 a[MR][2]; pg8::bf16x8 b[NG][2]; float dc[NG]; };
    __device__ __forceinline__ static int jt_of(int jg, int i) { const int j = jg * MR + i; return j < MT ? j : MT - 1; }
    __device__ __forceinline__ void load(Fr& f, int d, int b, int hh, int jg, int cg, int step, int r, int q) const { typedef LaLay<DKP, NV> L; const int blk = chain_blk(d, step); const size_t item = ((size_t)b * NBLK + blk) * 4 + hh; const int ln = q * 16 + r;
        const bf16* Bt = lab + L::koutT + ((size_t)d * LA_NI + item) * DKP * 64 + ((size_t)(cg * NG * 2) * 64 + ln) * 8;
        const float* dec = (const float*)(lab + L::dec) + ((size_t)d * LA_NI + item) * DKP + cg * (16 * NG) + r;
#pragma unroll
        for (int i = 0; i < MR; ++i) { const bf16* A = lab + L::vT + item * NV * 64 + ((size_t)(jt_of(jg, i) * 2) * 64 + ln) * 8;
#pragma unroll
            for (int ks = 0; ks < 2; ++ks) f.a[i][ks] = *(const pg8::bf16x8*)(A + ks * 512); }
#pragma unroll
        for (int nn = 0; nn < NG; ++nn) {
#pragma unroll
            for (int ks = 0; ks < 2; ++ks) f.b[nn][ks] = *(const pg8::bf16x8*)(Bt + (nn * 2 + ks) * 512);
            f.dc[nn] = dec[nn * 16]; } }
    __device__ __forceinline__ void process(const Fr& f, pg8::f32x4 (&S)[MR][NG], int d, int b, int hh, int jg, int cg, int step, int r, int q, PG8_LAS unsigned char* lw) const { typedef LaLay<DKP, NV> L;
        pg8::f32x4 acc[MR][NG];
#pragma unroll
        for (int i = 0; i < MR; ++i)
#pragma unroll
            for (int nn = 0; nn < NG; ++nn) acc[i][nn] = (pg8::f32x4){0.f, 0.f, 0.f, 0.f};
#pragma unroll
        for (int ks = 0; ks < 2; ++ks)
#pragma unroll
            for (int i = 0; i < MR; ++i)
#pragma unroll
                for (int nn = 0; nn < NG; ++nn) acc[i][nn] = __builtin_amdgcn_mfma_f32_16x16x32_bf16(f.a[i][ks], f.b[nn][ks], acc[i][nn], 0, 0, 0);
        const int blk = chain_blk(d, step); const size_t item = ((size_t)b * NBLK + blk) * 4 + hh; PG8_LAS bf16* lt = (PG8_LAS bf16*)lw;
#pragma unroll
        for (int i = 0; i < MR; ++i)
#pragma unroll
            for (int nn = 0; nn < NG; ++nn)
#pragma unroll
                for (int e = 0; e < 4; ++e) { const int col = nn * 16 + r; lt[i * (NG / 2) * 512 + (col >> 5) * 512 + ((((col & 31) >> 3) << 4) + q * 4 + e) * 8 + (col & 7)] = f2bf(S[i][nn][e]); S[i][nn][e] = f.dc[nn] * (S[i][nn][e] + acc[i][nn][e]); }
        LDS_WAIT();
#pragma unroll
        for (int i = 0; i < MR; ++i) { bf16* out = lab + L::sT + ((size_t)d * LA_NI + item) * NV * DKP + ((size_t)(jt_of(jg, i) * (DKP / 32) + cg * (NG / 2)) * 64 + q * 16 + r) * 8;
#pragma unroll
            for (int tl = 0; tl < NG / 2; ++tl) { const pg8::v4i_t pv = *(const PG8_LAS pg8::v4i_t*)(lt + ((i * (NG / 2) + tl) * 64 + q * 16 + r) * 8); *(pg8::v4i_t*)(out + tl * 512) = pv; } }
        LDS_WAIT(); }
    __device__ __forceinline__ void wave(int it, int lane, PG8_LAS unsigned char* lw) const {
        const int cg = it % CG; int c = it / CG; const int jt = c % MG; c /= MG; const int hh = c % 4; c /= 4; const int b = c % NB, d = c / NB; const int r = lane & 15, q = lane >> 4;
        pg8::f32x4 S[MR][NG];
#pragma unroll
        for (int i = 0; i < MR; ++i)
#pragma unroll
            for (int nn = 0; nn < NG; ++nn) S[i][nn] = (pg8::f32x4){0.f, 0.f, 0.f, 0.f};
        auto cl = [](int st) { return st < NBLK ? st : NBLK - 1; };
        Fr f0, f1, f2, f3; load(f0, d, b, hh, jt, cg, 0, r, q); load(f1, d, b, hh, jt, cg, cl(1), r, q); load(f2, d, b, hh, jt, cg, cl(2), r, q);
        static_assert(NBLK % 4 == 0 || NBLK < 4, "ChainW walks the chain four blocks per trip");
        for (int step = 0; step + 3 < NBLK; step += 4) {
            load(f3, d, b, hh, jt, cg, step + 3, r, q);
            process(f0, S, d, b, hh, jt, cg, step, r, q, lw);
            load(f0, d, b, hh, jt, cg, cl(step + 4), r, q);
            process(f1, S, d, b, hh, jt, cg, step + 1, r, q, lw);
            load(f1, d, b, hh, jt, cg, cl(step + 5), r, q);
            process(f2, S, d, b, hh, jt, cg, step + 2, r, q, lw);
            load(f2, d, b, hh, jt, cg, cl(step + 6), r, q);
            process(f3, S, d, b, hh, jt, cg, step + 3, r, q, lw); }
        if (NBLK < 4) { process(f0, S, d, b, hh, jt, cg, 0, r, q, lw); if (NBLK > 1) process(f1, S, d, b, hh, jt, cg, 1, r, q, lw); if (NBLK > 2) process(f2, S, d, b, hh, jt, cg, 2, r, q, lw); } } };
template <class C, int IPC, int WPG, int L0, int LN> struct ChainPlace { int n; C c;
    __device__ __forceinline__ void wave(int slot, int lane, PG8_LAS unsigned char* lw) const {
        const int wg = slot >> 3, wid = slot & 7, xcd = wg & 7, local = wg >> 3; constexpr int GPC = IPC / WPG;
        if (local < L0 || local >= LN || wid >= WPG) return;
        const int l2 = local - L0; const int chain = (l2 / GPC) * 8 + xcd, j = (l2 % GPC) * WPG + wid; const int item = chain * IPC + j;
        if (item < c.n) c.wave(item, lane, lw); } };
template <int DKP, int NV, bool ISML> struct OutW { int n; int pad; const bf16* lab; const bf16* p; const float* gain; bf16* mix;
    __device__ __forceinline__ void wave(int it, int lane, PG8_LAS unsigned char* lw) const { typedef LaLay<DKP, NV> L; constexpr int NT = NV / 16, KQ = DKP / 32; typedef pg8::bf16x8 frag;
        const size_t item = (size_t)(it >> 1); const int half = it & 1, hh = (int)(item % 4); const size_t bb = item / 4; const size_t r0 = (bb / NBLK) * RPB + (bb % NBLK) * 64; const int t0 = half * 32;
        const int r = lane & 15, q = lane >> 4; PG8_LAS bf16* latt = (PG8_LAS bf16*)lw;
        pg8::f32x4 acc[2][NT], hs[2][6];
#pragma unroll
        for (int m = 0; m < 2; ++m) {
#pragma unroll
            for (int nn = 0; nn < NT; ++nn) acc[m][nn] = (pg8::f32x4){0.f, 0.f, 0.f, 0.f};
#pragma unroll
            for (int nn = 0; nn < 6; ++nn) hs[m][nn] = (pg8::f32x4){0.f, 0.f, 0.f, 0.f}; }
        const bf16* vp = lab + L::vT + item * NV * 64 + (size_t)lane * 8;
#pragma unroll
        for (int d = 0; d < 2; ++d) {
            const bf16* qp = lab + L::qin + ((size_t)d * LA_NI + item) * 64 * DKP + ((size_t)(t0 / 16) * KQ * 64 + lane) * 8; const bf16* kp = lab + L::kin + ((size_t)d * LA_NI + item) * 64 * DKP + (size_t)lane * 8;
            const bf16* sp = lab + L::sT + ((size_t)d * LA_NI + item) * NV * DKP + (size_t)lane * 8;
            frag qa[2][KQ], sf[NT][KQ];
#pragma unroll
            for (int m = 0; m < 2; ++m)
#pragma unroll
                for (int ks = 0; ks < KQ; ++ks) qa[m][ks] = *(const frag*)(qp + (m * KQ + ks) * 512);
#pragma unroll
            for (int nn = 0; nn < NT; ++nn)
#pragma unroll
                for (int ks = 0; ks < KQ; ++ks) sf[nn][ks] = *(const frag*)(sp + (nn * KQ + ks) * 512);
            frag kf[4][KQ], vf[NT][2];
            if constexpr (!ISML) {
#pragma unroll
                for (int nn = 0; nn < 4; ++nn)
#pragma unroll
                    for (int ks = 0; ks < KQ; ++ks) kf[nn][ks] = *(const frag*)(kp + (nn * KQ + ks) * 512);
#pragma unroll
                for (int nn = 0; nn < NT; ++nn)
#pragma unroll
                    for (int ks = 0; ks < 2; ++ks) vf[nn][ks] = *(const frag*)(vp + (nn * 2 + ks) * 512); }
#pragma unroll
            for (int ks = 0; ks < KQ; ++ks)
#pragma unroll
                for (int m = 0; m < 2; ++m)
#pragma unroll
                    for (int nn = 0; nn < NT; ++nn) acc[m][nn] = __builtin_amdgcn_mfma_f32_16x16x32_bf16(qa[m][ks], sf[nn][ks], acc[m][nn], 0, 0, 0);
            if constexpr (ISML) {
#pragma unroll
            for (int nn = 0; nn < 4; ++nn)
#pragma unroll
                for (int ks = 0; ks < KQ; ++ks) kf[nn][ks] = *(const frag*)(kp + (nn * KQ + ks) * 512); }
            pg8::f32x4 at[2][4];
#pragma unroll
            for (int m = 0; m < 2; ++m)
#pragma unroll
                for (int nn = 0; nn < 4; ++nn) at[m][nn] = (pg8::f32x4){0.f, 0.f, 0.f, 0.f};
#pragma unroll
            for (int ks = 0; ks < KQ; ++ks)
#pragma unroll
                for (int m = 0; m < 2; ++m)
#pragma unroll
                    for (int nn = 0; nn < 4; ++nn) at[m][nn] = __builtin_amdgcn_mfma_f32_16x16x32_bf16(qa[m][ks], kf[nn][ks], at[m][nn], 0, 0, 0);
            if constexpr (ISML) {
#pragma unroll
            for (int nn = 0; nn < NT; ++nn)
#pragma unroll
                for (int ks = 0; ks < 2; ++ks) vf[nn][ks] = *(const frag*)(vp + (nn * 2 + ks) * 512); }
#pragma unroll
            for (int m = 0; m < 2; ++m)
#pragma unroll
                for (int nn = 0; nn < 4; ++nn)
#pragma unroll
                    for (int e = 0; e < 4; ++e) { const int tl = m * 16 + q * 4 + e, tt = t0 + tl, sx = nn * 16 + r; const bool valid = d == 0 ? (sx <= tt) : (sx >= tt);
                        latt[tl * 72 + sx] = f2bf(valid ? at[m][nn][e] : 0.f); }
            LDS_WAIT();
            frag af[2][2];
#pragma unroll
            for (int m = 0; m < 2; ++m)
#pragma unroll
                for (int ks = 0; ks < 2; ++ks) af[m][ks] = *(const PG8_LAS frag*)(latt + (m * 16 + r) * 72 + ks * 32 + q * 8);
#pragma unroll
            for (int ks = 0; ks < 2; ++ks)
#pragma unroll
                for (int m = 0; m < 2; ++m)
#pragma unroll
                    for (int nn = 0; nn < NT; ++nn) acc[m][nn] = __builtin_amdgcn_mfma_f32_16x16x32_bf16(af[m][ks], vf[nn][ks], acc[m][nn], 0, 0, 0);
            LDS_WAIT();
            if (ISML) {
#pragma unroll
                for (int m = 0; m < 2; ++m)
#pragma unroll
                    for (int e = 0; e < 4; ++e) { const float den = __shfl(acc[m][NT - 1][e], lane & 48); const float inv = 1.0f / fmaxf(fabsf(den), 1.0f);
#pragma unroll
                        for (int nn = 0; nn < 6; ++nn) { hs[m][nn][e] += acc[m][nn][e] * inv; acc[m][nn][e] = 0.f; }
                        acc[m][NT - 1][e] = 0.f; } } }
#pragma unroll
        for (int m = 0; m < 2; ++m)
#pragma unroll
            for (int e = 0; e < 4; ++e) { float ss = 0.f;
#pragma unroll
                for (int nn = 0; nn < 6; ++nn) { const float o = ISML ? hs[m][nn][e] : acc[m][nn][e]; ss += o * o; }
                ss += __shfl_xor(ss, 1); ss += __shfl_xor(ss, 2); ss += __shfl_xor(ss, 4); ss += __shfl_xor(ss, 8);
                const float rstd = 1.0f / sqrtf(ss * (1.0f / 96.0f) + EPS); PG8_LAS float* fo = (PG8_LAS float*)lw + (m * 16 + q * 4 + e) * 100;
#pragma unroll
                for (int nn = 0; nn < 6; ++nn) { const int j = nn * 16 + r; const float o = ISML ? hs[m][nn][e] : acc[m][nn][e]; fo[j] = o * rstd * gain[j]; } }
        LDS_WAIT();
        uint4 gv[6];
#pragma unroll
        for (int k = 0; k < 6; ++k) { const int pi = lane + 64 * k, rw = pi / 12, c8 = pi % 12; gv[k] = *(const uint4*)(p + (r0 + t0 + rw) * PS + (ISML ? MO : GG) + hh * 96 + c8 * 8); }
#pragma unroll
        for (int k = 0; k < 6; ++k) { const int pi = lane + 64 * k, rw = pi / 12, c8 = pi % 12; const PG8_LAS float* fr = (const PG8_LAS float*)lw + rw * 100 + c8 * 8;
            const pg8::f32x4 a0 = *(const PG8_LAS pg8::f32x4*)fr, a1 = *(const PG8_LAS pg8::f32x4*)(fr + 4); const unsigned gw[4] = {gv[k].x, gv[k].y, gv[k].z, gv[k].w}; float gt[8];
#pragma unroll
            for (int e = 0; e < 4; ++e) { const float g0 = __uint_as_float(gw[e] << 16), g1 = __uint_as_float(gw[e] & 0xffff0000u); gt[2 * e] = ISML ? fast_sigmoid(g0) : fast_silu(g0); gt[2 * e + 1] = ISML ? fast_sigmoid(g1) : fast_silu(g1); }
            uint4 ov; ov.x = cvt_pk_bf16(a0[0] * gt[0], a0[1] * gt[1]); ov.y = cvt_pk_bf16(a0[2] * gt[2], a0[3] * gt[3]); ov.z = cvt_pk_bf16(a1[0] * gt[4], a1[1] * gt[5]); ov.w = cvt_pk_bf16(a1[2] * gt[6], a1[3] * gt[7]);
            *(uint4*)(mix + (r0 + t0 + rw) * D + (ISML ? 640 : 0) + hh * 96 + c8 * 8) = ov; }
        LDS_WAIT(); } };

struct OutWG { int n; int pad; const bf16* lab; const bf16* p; const float* gain; bf16* mix;
    __device__ __forceinline__ void wave(int it, int lane, PG8_LAS unsigned char* lw) const { constexpr int DKP = 64, NV = 96; typedef LaLay<DKP, NV> L; constexpr int NT = 6, KQ = 2; typedef pg8::bf16x8 frag;
        const size_t item = (size_t)it; const int hh = (int)(item % 4); const size_t bb = item / 4; const size_t r0 = (bb / NBLK) * RPB + (bb % NBLK) * 64;
        const int r = lane & 15, q = lane >> 4; PG8_LAS bf16* latt = (PG8_LAS bf16*)lw;
        pg8::f32x4 acc[4][NT];
#pragma unroll
        for (int m = 0; m < 4; ++m)
#pragma unroll
            for (int nn = 0; nn < NT; ++nn) acc[m][nn] = (pg8::f32x4){0.f, 0.f, 0.f, 0.f};
        const bf16* vp = lab + L::vT + item * NV * 64 + (size_t)lane * 8;
#pragma unroll
        for (int d = 0; d < 2; ++d) {
            const bf16* qp = lab + L::qin + ((size_t)d * LA_NI + item) * 64 * DKP + (size_t)lane * 8; const bf16* kp = lab + L::kin + ((size_t)d * LA_NI + item) * 64 * DKP + (size_t)lane * 8;
            const bf16* sp = lab + L::sT + ((size_t)d * LA_NI + item) * NV * DKP + (size_t)lane * 8;
            frag qa[4][KQ], kf[4][KQ];
            { frag sf[NT][KQ];
#pragma unroll
            for (int m = 0; m < 4; ++m)
#pragma unroll
                for (int ks = 0; ks < KQ; ++ks) qa[m][ks] = *(const frag*)(qp + (m * KQ + ks) * 512);
#pragma unroll
            for (int nn = 0; nn < NT; ++nn)
#pragma unroll
                for (int ks = 0; ks < KQ; ++ks) sf[nn][ks] = *(const frag*)(sp + (nn * KQ + ks) * 512);
#pragma unroll
            for (int nn = 0; nn < 4; ++nn)
#pragma unroll
                for (int ks = 0; ks < KQ; ++ks) kf[nn][ks] = *(const frag*)(kp + (nn * KQ + ks) * 512);
#pragma unroll
            for (int ks = 0; ks < KQ; ++ks)
#pragma unroll
                for (int m = 0; m < 4; ++m)
#pragma unroll
                    for (int nn = 0; nn < NT; ++nn) acc[m][nn] = __builtin_amdgcn_mfma_f32_16x16x32_bf16(qa[m][ks], sf[nn][ks], acc[m][nn], 0, 0, 0); }
            __builtin_amdgcn_sched_barrier(0);
            frag vf[NT][2];
#pragma unroll
            for (int hp = 0; hp < 2; ++hp) { pg8::f32x4 at[2][4];
                if (hp == 1) { __builtin_amdgcn_sched_barrier(0);
#pragma unroll
                    for (int nn = 0; nn < NT; ++nn)
#pragma unroll
                        for (int ks = 0; ks < 2; ++ks) vf[nn][ks] = *(const frag*)(vp + (nn * 2 + ks) * 512);
                    __builtin_amdgcn_sched_barrier(0); }
#pragma unroll
                for (int m = 0; m < 2; ++m)
#pragma unroll
                    for (int nn = 0; nn < 4; ++nn) at[m][nn] = (pg8::f32x4){0.f, 0.f, 0.f, 0.f};
#pragma unroll
                for (int ks = 0; ks < KQ; ++ks)
#pragma unroll
                    for (int m = 0; m < 2; ++m)
#pragma unroll
                        for (int nn = 0; nn < 4; ++nn) at[m][nn] = __builtin_amdgcn_mfma_f32_16x16x32_bf16(qa[2 * hp + m][ks], kf[nn][ks], at[m][nn], 0, 0, 0);
#pragma unroll
                for (int m = 0; m < 2; ++m)
#pragma unroll
                    for (int nn = 0; nn < 4; ++nn)
#pragma unroll
                        for (int e = 0; e < 4; ++e) { const int tt = hp * 32 + m * 16 + q * 4 + e, sx = nn * 16 + r; const bool valid = d == 0 ? (sx <= tt) : (sx >= tt);
                            latt[tt * 72 + sx] = f2bf(valid ? at[m][nn][e] : 0.f); } }
            LDS_WAIT();
            frag af[4][2];
#pragma unroll
            for (int m = 0; m < 4; ++m)
#pragma unroll
                for (int ks = 0; ks < 2; ++ks) af[m][ks] = *(const PG8_LAS frag*)(latt + (m * 16 + r) * 72 + ks * 32 + q * 8);
#pragma unroll
            for (int ks = 0; ks < 2; ++ks)
#pragma unroll
                for (int m = 0; m < 4; ++m)
#pragma unroll
                    for (int nn = 0; nn < NT; ++nn) acc[m][nn] = __builtin_amdgcn_mfma_f32_16x16x32_bf16(af[m][ks], vf[nn][ks], acc[m][nn], 0, 0, 0);
            LDS_WAIT(); }
#pragma unroll
        for (int hp = 0; hp < 2; ++hp) { const int t0 = hp * 32;
#pragma unroll
            for (int m = 0; m < 2; ++m)
#pragma unroll
                for (int e = 0; e < 4; ++e) { float ss = 0.f;
#pragma unroll
                    for (int nn = 0; nn < 6; ++nn) { const float o = acc[2 * hp + m][nn][e]; ss += o * o; }
                    ss += __shfl_xor(ss, 1); ss += __shfl_xor(ss, 2); ss += __shfl_xor(ss, 4); ss += __shfl_xor(ss, 8);
                    const float rstd = 1.0f / sqrtf(ss * (1.0f / 96.0f) + EPS); PG8_LAS float* fo = (PG8_LAS float*)lw + (m * 16 + q * 4 + e) * 100;
#pragma unroll
                    for (int nn = 0; nn < 6; ++nn) { const int j = nn * 16 + r; fo[j] = acc[2 * hp + m][nn][e] * rstd * gain[j]; } }
            LDS_WAIT();
            uint4 gv[6];
#pragma unroll
            for (int k = 0; k < 6; ++k) { const int pi = lane + 64 * k, rw = pi / 12, c8 = pi % 12; gv[k] = *(const uint4*)(p + (r0 + t0 + rw) * PS + GG + hh * 96 + c8 * 8); }
#pragma unroll
            for (int k = 0; k < 6; ++k) { const int pi = lane + 64 * k, rw = pi / 12, c8 = pi % 12; const PG8_LAS float* fr = (const PG8_LAS float*)lw + rw * 100 + c8 * 8;
                const pg8::f32x4 a0 = *(const PG8_LAS pg8::f32x4*)fr, a1 = *(const PG8_LAS pg8::f32x4*)(fr + 4); const unsigned gw[4] = {gv[k].x, gv[k].y, gv[k].z, gv[k].w}; float gt[8];
#pragma unroll
                for (int e = 0; e < 4; ++e) { const float g0 = __uint_as_float(gw[e] << 16), g1 = __uint_as_float(gw[e] & 0xffff0000u); gt[2 * e] = fast_silu(g0); gt[2 * e + 1] = fast_silu(g1); }
                uint4 ov; ov.x = cvt_pk_bf16(a0[0] * gt[0], a0[1] * gt[1]); ov.y = cvt_pk_bf16(a0[2] * gt[2], a0[3] * gt[3]); ov.z = cvt_pk_bf16(a1[0] * gt[4], a1[1] * gt[5]); ov.w = cvt_pk_bf16(a1[2] * gt[6], a1[3] * gt[7]);
                *(uint4*)(mix + (r0 + t0 + rw) * D + hh * 96 + c8 * 8) = ov; }
            LDS_WAIT(); } } };

#ifdef MULTI_LAUNCH
template <class F> __global__ void __launch_bounds__(256) k_run(F f) {
    for (long i = (long)blockIdx.x * blockDim.x + threadIdx.x; i < f.n; i += (long)gridDim.x * blockDim.x) f(i);
}
template <class F> __global__ void __launch_bounds__(512, 2) k_wrun(F f) {
    extern __shared__ __attribute__((aligned(16))) unsigned char shm[];
    const int wid = threadIdx.x >> 6, lane = threadIdx.x & 63;
    for (int it = blockIdx.x * 8 + wid; it < f.n; it += gridDim.x * 8) f.wave(it, lane, (PG8_LAS unsigned char*)shm + wid * 16384);
}
template <class F> __global__ void __launch_bounds__(512, 2) k_gemm(GemmDesc g, F e) {
    extern __shared__ __attribute__((aligned(16))) unsigned char shm[];
    pg8::gemm_phase<F>((PG8_LAS unsigned char*)shm, g, e, (int)gridDim.x, (int)blockIdx.x);
}
struct Ctx { hipStream_t stream; int ncu; const void* const* tbl;
    void mark(int) const {} void probe_out(float*) const {}
    template <int I> const float* inp() const { return (const float*)tbl[I]; }
    template <class F> void run(const F& f, bool sync = true, int ioff = 0) {
        if (f.n <= 0) return; long nb = (f.n + 255) / 256; if (nb > 256L * 32) nb = 256L * 32;
        hipLaunchKernelGGL(k_run<F>, dim3((unsigned)nb), dim3(256), 0, stream, f); }
    template <class F> void wrun(const F& f, bool sync = true, int woff = 0) {
        static bool attr_set = false;
        if (!attr_set) { (void)hipFuncSetAttribute((const void*)k_wrun<F>, hipFuncAttributeMaxDynamicSharedMemorySize, pg8::STAGE_BYTES); attr_set = true; }
        hipLaunchKernelGGL(k_wrun<F>, dim3(ncu), dim3(512), pg8::STAGE_BYTES, stream, f); }
    template <class F> void gemm(const GemmDesc& g, const F& e) {
        static bool attr_set = false;
        if (!attr_set) { (void)hipFuncSetAttribute((const void*)k_gemm<F>, hipFuncAttributeMaxDynamicSharedMemorySize, pg8::STAGE_BYTES); attr_set = true; }
        hipLaunchKernelGGL(k_gemm<F>, dim3(ncu), dim3(512), pg8::STAGE_BYTES, stream, g, e); }
};
#else
#ifndef PROBE_A
#define PROBE_A -1
#endif
#ifndef PROBE_B
#define PROBE_B -1
#endif
struct Ctx { XcdBarrier bar; PG8_LAS unsigned char* lds; int gtid, nthr;
    __device__ __forceinline__ void mark(int id) const { if (PROBE_A >= 0 && blockIdx.x == 0 && threadIdx.x == 0) { volatile PG8_LAS unsigned long long* t = (volatile PG8_LAS unsigned long long*)(lds + pg8::STAGE_BYTES + 400);
            if (id == PROBE_A) t[0] = __builtin_amdgcn_s_memrealtime(); if (id == PROBE_B) t[1] = __builtin_amdgcn_s_memrealtime(); } }
    __device__ __forceinline__ void probe_out(float* o) const { if (PROBE_A >= 0 && blockIdx.x == 0 && threadIdx.x == 0) { volatile PG8_LAS unsigned long long* t = (volatile PG8_LAS unsigned long long*)(lds + pg8::STAGE_BYTES + 400);
            o[0] += (float)(t[1] - t[0]) * 0.1f; } }
    template <int I> __device__ __forceinline__ const float* inp() const { unsigned off = pg8::STAGE_BYTES + 64 + 8 * I; asm volatile("" : "+v"(off));
        const PG8_LAS unsigned* t = (const PG8_LAS unsigned*)(lds + off);
        const unsigned lo = __builtin_amdgcn_readfirstlane(t[0]), hi = __builtin_amdgcn_readfirstlane(t[1]);
        return (const float*)(const __attribute__((address_space(1))) float*)(((unsigned long long)hi << 32) | lo); }
    template <class F> __device__ __forceinline__ void run(const F& f, bool sync = true, int ioff = 0) {
        int i0 = gtid - ioff; asm volatile("" : "+v"(i0)); if (i0 < 0) i0 += nthr;
        const int n = (int)f.n; int st = (int)nthr; asm volatile("" : "+s"(st));
        for (int i = i0; i < n; i += st) f((long)i);
        if (sync) xcd_barrier(bar); }
    template <class F> __device__ __forceinline__ void wrun(const F& f, bool sync = true, int woff = 0) {
        int t0 = threadIdx.x; asm volatile("" : "+v"(t0));
        const int wid = __builtin_amdgcn_readfirstlane(t0 >> 6), lane = t0 & 63; const int nw = (int)gridDim.x * 8; int w0 = (int)blockIdx.x * 8 + wid - woff; if (w0 < 0) w0 += nw;
        for (int it = w0; it < f.n; it += nw) { int ln = lane; asm volatile("" : "+v"(ln));
            f.wave(it, ln, lds + wid * 16384); }
        if (sync) xcd_barrier(bar); }
    template <class F> __device__ __forceinline__ void gemm(const GemmDesc& g, const F& e) {
        pg8::gemm_phase<F>(lds, g, e, (int)gridDim.x, (int)blockIdx.x);
        xcd_barrier(bar); }
    template <class F> __device__ __forceinline__ void gemm8(const GemmDesc& g, const F& e) {
        pg8::gemm_phase<F, true, false>(lds, g, e, (int)gridDim.x, (int)blockIdx.x);
        xcd_barrier(bar); }
};
#endif
#else
struct Ctx { const void* const* tbl;
void mark(int) const {} void probe_out(float*) const {}
template <int I> const float* inp() const { return (const float*)tbl[I]; }
template <class F> void run(const F& f, bool sync = true, int ioff = 0) {
#pragma omp parallel for schedule(static)
    for (long i = 0; i < f.n; ++i) f(i);
}
template <class F> void gemm(const GemmDesc& g, const F& e) {
    int M = g.M; if (g.ntile) { int nt = g.ntile[0] - g.tile0; if (nt < 0) nt = 0; if (nt * 256 < M) M = nt * 256; }
#pragma omp parallel for schedule(dynamic, 4)
    for (int r = 0; r < M; ++r) {
        int ar = r; if (g.arow) { ar = g.arow[(size_t)g.tile0 * 256 + r]; if (ar < 0) ar = 0; }
        const bf16* a = g.A + (size_t)ar * g.lda; const bf16* B = g.Bt + (g.tile_e ? (size_t)g.tile_e[g.tile0 + r / 256] * g.e_stride : (g.tdiv ? (size_t)((r / 256) / g.tdiv) * g.e_stride : 0));
        static thread_local float af[4096]; for (int k = 0; k < g.K; ++k) af[k] = bf2f(a[k]);
        for (int c0 = 0; c0 < g.N; c0 += 8) { float v[8];
            for (int j = 0; j < 8; ++j) { const bf16* bt = B + (size_t)(c0 + j) * g.ldb; float s = 0.f; for (int k = 0; k < g.K; ++k) s += af[k] * bf2f(bt[k]); v[j] = s; }
            e.apply8(r, c0, v); }
    }
}
};
#endif

struct Inputs { const float *x, *c, *ctx, *c_ctx, *w_ada, *b_ada, *norm1, *norm2, *w_in, *w_out, *gla_wa2, *gla_ba, *gla_norm, *s5_lam_re, *s5_lam_im, *s5_log_dt, *s5_b_re, *s5_b_im,
    *s5_c_re, *s5_c_im, *s5_d, *s5_glu_w, *s5_glu_b, *ml_conv_w, *ml_conv_b, *ml_gate_b, *ml_norm, *ffn_w1, *ffn_w3, *ffn_w2, *moe_router, *moe_w1, *moe_w3, *moe_w2, *norm_f; };

#define INP(name) (cx.template inp<offsetof(Inputs, name) / 8>())
#ifndef PROBE_REP
#define PROBE_REP -1
#endif
#ifndef PROBE_L
#define PROBE_L -1
#endif
#define REPEAT(k) if constexpr (false) {} else for (int rep_ = 0; rep_ < 1; ++rep_)
#define SEC_BEGIN(k) { auto sec_ = [&]() __attribute__((always_inline)) {
#define SEC_END(k) }; sec_(); if constexpr (PROBE_REP == (k) && (PROBE_L == l || PROBE_L < 0)) sec_(); }
#define WSB ((unsigned char*)cx.template inp<36>())
#ifdef HOST_EMU
#define S5TABBASE (WSB + WS.s5tab)
#else
#define S5TABBASE ((unsigned char*)cx.template inp<35>() + ABUF_BYTES)
#endif
#define out ((float*)cx.template inp<35>())
#define mod ((float*)(WSB + WS.mod))
#define h ((float*)(WSB + WS.h))
#define abuf ((bf16*)cx.template inp<35>())
#define winT ((bf16*)(WSB + WS.winT))
#define woutT ((bf16*)(WSB + WS.woutT))
#define w13T ((bf16*)(WSB + WS.w13T))
#define w2T ((bf16*)(WSB + WS.w2T))
#define pbuf ((bf16*)(WSB + WS.pbuf))
#define obuf ((float*)(WSB + WS.obuf))
#define lab ((bf16*)(WSB + WS.lab))
#define labg ((bf16*)(WSB + WS.labg))
#define s5disc ((float*)(S5TABBASE + S5T.disc))
#define s5K ((float*)(S5TABBASE + S5T.K))
#define s5apow ((float*)(S5TABBASE + S5T.apow))
#define s5bbar ((float*)(S5TABBASE + S5T.bbar))
#define s5TB ((bf16*)(S5TABBASE + S5T.TB))
#define s5EB ((bf16*)(S5TABBASE + S5T.EB))
#define s5uG ((bf16*)(WSB + WS.s5uG))
#define s5est ((float*)(WSB + WS.s5est))
#define zbuf ((bf16*)(WSB + WS.zbuf))
#define gluT ((bf16*)(S5TABBASE + S5T.gluT))
#define act ((bf16*)(WSB + WS.act))
#define mw13T ((bf16*)(WSB + WS.mw13T))
#define mw2T ((bf16*)(WSB + WS.mw2T))
#define mact ((bf16*)(WSB + WS.mact))
#define xs8 ((unsigned char*)(WSB + WS.xs8))
#define yrow ((bf16*)(WSB + WS.yrow))
#define rt_e ((int*)(WSB + WS.rt_e))
#define rt_w ((float*)(WSB + WS.rt_w))
#define rt_dest ((int*)(WSB + WS.rt_dest))
#define segcnt ((int*)(WSB + WS.segcnt))
#define ecnt ((int*)(WSB + WS.ecnt))
#define row_token ((int*)(WSB + WS.row_token))
#define tile_e ((int*)(WSB + WS.tile_e))
#define ntile ((int*)(WSB + WS.ntile))
#define modl (mod + (size_t)l * NMOD * 6 * D)
#define silc ((float*)(WSB + WS.silc))
#define postab ((float*)(WSB + WS.postab))
#define modpart ((float*)(WSB + WS.uni))
template <int l, class X> HD void layer_fwd(X& cx) {
    constexpr bool last = (l == DEPTH - 1);
    cx.mark(10 * (l + 1));
        REPEAT(1) {
#ifdef HOST_EMU
        cx.run(NormModK{(long)NR, h, INP(norm1) + (size_t)l * D, modl, 0, D, abuf, nullptr, nullptr, nullptr, 0, 0, nullptr});
#else
        if constexpr (!(l > 0 && (l - 1) % 2 == 1)) cx.wrun(NormModW{NR / 2, 0, D, 0, h, INP(norm1) + (size_t)l * D, modl, abuf, nullptr, nullptr, nullptr, nullptr, 0, 0});
#endif
        }
        cx.mark(10 * (l + 1) + 1);
        SEC_BEGIN(2) cx.gemm(GemmDesc{abuf, winT + (size_t)l * PS * D, nullptr, nullptr, nullptr, 0, NR, PS, D, 0, D, D, 0, 0}, EpiStoreBf16{pbuf, PS, 0}); SEC_END(2)
        cx.mark(10 * (l + 1) + 2);
        SEC_BEGIN(3) { typedef LaLay<64, 96> LG; typedef LaLay<96, 112> LM;
#ifdef HOST_EMU
        cx.run(GlaFused{(long)2 * NB * NBLK * 192, pbuf, INP(gla_wa2) + (size_t)l * 2 * 16 * 192, INP(gla_ba) + (size_t)l * 2 * 192, labg}, false);
#else
        cx.wrun(GlaPrepW2{2 * NB * NBLK * 4, 0, pbuf, INP(gla_wa2) + (size_t)l * 2 * 16 * 192, INP(gla_ba) + (size_t)l * 2 * 192, labg}, false);
#endif
#ifdef HOST_EMU
        cx.run(MlFused{(long)2 * NB * NBLK * 384, pbuf, INP(ml_conv_w) + (size_t)l * 3 * 768, INP(ml_conv_b) + (size_t)l * 768, INP(ml_gate_b) + (size_t)l * 16, lab}, false, 77824);
#else
        cx.wrun(MlPrepW2{2 * NB * NBLK * 4, 0, pbuf, INP(ml_conv_w) + (size_t)l * 3 * 768, INP(ml_conv_b) + (size_t)l * 768, INP(ml_gate_b) + (size_t)l * 16, lab}, false, (2 * NB * NBLK * 4) % 2048);
#endif
#ifdef HOST_EMU
        cx.run(VTFused<96, GV>{(long)LA_NI * 96, pbuf, labg + LG::vT}, false, 102400);
#else
        cx.wrun(VTW<96, GV>{(int)LA_NI, 0, pbuf, labg + LG::vT}, false, (4 * NB * NBLK * 4) % 2048);
#endif
        cx.run(S5Disc{(long)2 * 16 * 64, INP(s5_lam_re) + (size_t)l * 2048, INP(s5_lam_im) + (size_t)l * 2048, INP(s5_log_dt) + (size_t)l * 32, s5disc}, false);
        cx.run(S5Apow{(long)2 * 16 * 65 * 64, INP(s5_lam_re) + (size_t)l * 2048, INP(s5_lam_im) + (size_t)l * 2048, INP(s5_log_dt) + (size_t)l * 32, s5apow}, false);
        cx.run(TransposeK{(long)256 * 256, INP(s5_glu_w) + (size_t)l * 65536, nullptr, gluT, 256, 256, 256}, false);
#ifdef HOST_EMU
        cx.run(VTFused<112, MV>{(long)LA_NI * 112, pbuf, lab + LM::vT}, true, 49152);
#else
        cx.wrun(VTW<112, MV>{(int)LA_NI, 0, pbuf, lab + LM::vT}, true, (4 * NB * NBLK * 4 + (int)LA_NI) % 2048);
#endif
#ifdef HOST_EMU
        cx.run(S5Bbar{(long)2 * 16 * 64 * 16, s5disc, INP(s5_b_re) + (size_t)l * 16384, INP(s5_b_im) + (size_t)l * 16384, s5bbar}, false);
        cx.run(StatesRef<64, 96>{(long)2 * LA_NI * 96 * 64, labg});
        cx.run(StatesRef<96, 112>{(long)2 * LA_NI * 112 * 96, lab});
        cx.run(CarryT<96, 112>{(long)2 * NB * 4 * 112 * 96, lab}, false);
        cx.run(CarryT<64, 96>{(long)2 * NB * 4 * 96 * 64, labg});
#else
        cx.run(S5Bbar{(long)2 * 16 * 64 * 16, s5disc, INP(s5_b_re) + (size_t)l * 16384, INP(s5_b_im) + (size_t)l * 16384, s5bbar}, false);
        static_assert(2 * NB * 4 == 64, "ChainPlace assumes 64 chains");
        cx.wrun(ChainPlace<ChainW<96, 112, 2, 2>, 12, 6, 0, 16>{2048, ChainW<96, 112, 2, 2>{2 * NB * 4 * 4 * 3, 0, lab}}, false);
        cx.wrun(ChainPlace<ChainW<64, 96, 2, 2>, 6, 6, 16, 24>{2048, ChainW<64, 96, 2, 2>{2 * NB * 4 * 3 * 2, 0, labg}}, true);
#endif
        cx.run(S5K2{(long)2 * 16 * 64 * 256, s5apow, s5bbar, INP(s5_c_re) + (size_t)l * 16384, INP(s5_c_im) + (size_t)l * 16384, s5K}, false);
        cx.run(S5BuildEB{(long)16 * 256 * 128, s5apow, s5bbar, s5EB}, false);
#ifdef HOST_EMU
        cx.run(OutRef<64, 96, false>{(long)NR * 384, labg, obuf});
        cx.run(HeadFin{(long)NR * 4, pbuf, obuf, INP(gla_norm) + (size_t)l * 96, abuf, 0});
        cx.run(OutRef<96, 112, true>{(long)NR * 384, lab, obuf});
        cx.run(HeadFin{(long)NR * 4, pbuf, obuf, INP(ml_norm) + (size_t)l * 96, abuf, 1});
#else
        cx.wrun(OutW<96, 112, true>{2 * (int)LA_NI, 0, lab, pbuf, INP(ml_norm) + (size_t)l * 96, abuf}, false);
        cx.wrun(OutWG{(int)LA_NI, 0, labg, pbuf, INP(gla_norm) + (size_t)l * 96, abuf}, true, (2 * (int)LA_NI) % 2048);
#endif
        } SEC_END(3)
        cx.mark(10 * (l + 1) + 3);
        cx.mark(10 * (l + 1) + 4);
        SEC_BEGIN(5) {
        cx.run(S5BuildTB{(long)16 * 1024 * (S5K_ / 8), s5apow, INP(s5_c_re) + (size_t)l * 16384, INP(s5_c_im) + (size_t)l * 16384, s5K, s5TB}, false);
        cx.run(S5BuildU{(long)16 * S5RB * 128, pbuf, s5uG});
        cx.gemm(GemmDesc{s5uG, s5EB, nullptr, nullptr, nullptr, (size_t)256 * 1024, 16 * S5RG, 256, 1024, 0, S5K_, 1024, S5RG / 256, 0}, EpiStoreF32{s5est, 256, 0});
        cx.run(S5Carry2{(long)NB * 16 * 2 * 64, s5apow, s5est, s5uG});
        cx.gemm(GemmDesc{s5uG, s5TB, nullptr, nullptr, nullptr, (size_t)1024 * S5K_, 16 * S5RG, 1024, S5K_, 0, S5K_, S5K_, S5RG / 256, 0}, EpiS5Z{pbuf, INP(s5_d) + (size_t)l * 256, zbuf});
        cx.gemm(mk_gemm(zbuf, 256, gluT, 256, NR, 256, 256), EpiGlu{zbuf, INP(s5_glu_b) + (size_t)l * 256, abuf});
        } SEC_END(5)
        cx.mark(10 * (l + 1) + 5);
        cx.gemm(GemmDesc{abuf, woutT + (size_t)l * D * D, nullptr, nullptr, nullptr, 0, NR, D, D, 0, D, D, 0, 0}, EpiResid{h, modl, 2 * D});
        cx.mark(10 * (l + 1) + 6);
        if constexpr (l % 2 == 0) { constexpr int j = l / 2;
            SEC_BEGIN(6) {
#ifdef HOST_EMU
            cx.run(NormModK{(long)NR, h, INP(norm2) + (size_t)l * D, modl, 3 * D, 4 * D, abuf, nullptr, nullptr, nullptr, 0, 0, nullptr});
#else
            cx.wrun(NormModW{NR / 2, 3 * D, 4 * D, 0, h, INP(norm2) + (size_t)l * D, modl, abuf, nullptr, nullptr, nullptr, nullptr, 0, 1});
#endif
#ifdef HOST_EMU
            cx.gemm(GemmDesc{abuf, w13T + (size_t)j * 2 * DFF * D, nullptr, nullptr, nullptr, 0, NR, 2 * DFF, D, 0, D, D, 0, 0}, EpiSwiGLU{act, DFF, 0});
#else
            cx.gemm8(GemmDesc{abuf, (const bf16*)((const unsigned char*)w13T + (size_t)j * 2 * DFF * D), nullptr, nullptr, nullptr, 0, NR, 2 * DFF, D, 0, D, D, 0, -W8S},
#if FP8_DOWN_DENSE
                EpiSwiGLU8{(unsigned char*)act, DFF, 0});
#else
                EpiSwiGLU{act, DFF, 0});
#endif
#endif
            } SEC_END(6)
#if FP8_DOWN_DENSE && !defined(HOST_EMU)
            cx.gemm8(GemmDesc{act, (const bf16*)((const unsigned char*)w2T + (size_t)j * D * DFF), nullptr, nullptr, nullptr, 0, NR, D, DFF, 0, DFF, DFF, 0, -(W8S + A8S)}, EpiResid{h, modl, 5 * D});
#else
            cx.gemm(GemmDesc{act, w2T + (size_t)j * D * DFF, nullptr, nullptr, nullptr, 0, NR, D, DFF, 0, DFF, DFF, 0, 0}, EpiResid{h, modl, 5 * D});
#endif
        } else { constexpr int j = l / 2; const int nseg = (NR + 63) / 64;
            SEC_BEGIN(7) {
#ifdef HOST_EMU
            for (int e = 0; e < NE; ++e) { const size_t wo = ((size_t)j * NE + e) * D * DFF;
                cx.run(TransposeK{(long)2 * DFF * D, INP(moe_w1) + wo, INP(moe_w3) + wo, mw13T + (size_t)e * 2 * DFF * D, D, DFF, 2 * DFF});
                cx.run(TransposeK{(long)D * DFF, INP(moe_w2) + wo, nullptr, mw2T + (size_t)e * D * DFF, DFF, D, D}); }
            cx.run(ZeroInt{(long)NE * nseg, segcnt});
            cx.run(MoeFillNeg{(long)MOE_MAXT * 256, row_token});
            cx.run(NormModK{(long)NR, h, INP(norm2) + (size_t)l * D, modl, 3 * D, 4 * D, abuf, INP(moe_router) + (size_t)j * D * NE, rt_e, rt_w, last ? 1 : 0, nseg, segcnt});
            cx.run(MoePrefix{(long)NE, segcnt, ecnt, nseg});
#else
            cx.wrun(TransW{((NE * (D / 64) * (DFF / 32)) + 1) / 2, D, DFF, 2, 0, W8S, INP(moe_w1) + (size_t)j * NE * D * DFF, mw13T, (size_t)D * DFF, (size_t)2 * DFF * D, (NE * (D / 64) * (DFF / 32)), 0}, false);
            cx.wrun(TransW{((NE * (D / 64) * (DFF / 32)) + 1) / 2, D, DFF, 2, 1, W8S, INP(moe_w3) + (size_t)j * NE * D * DFF, mw13T, (size_t)D * DFF, (size_t)2 * DFF * D, (NE * (D / 64) * (DFF / 32)), 0}, false);
            cx.wrun(TransW{((NE * (DFF / 64) * (D / 32)) + 1) / 2, DFF, D, 1, 0, FP8_DOWN_MOE ? W8S : 0, INP(moe_w2) + (size_t)j * NE * DFF * D, mw2T, (size_t)DFF * D, (size_t)D * DFF, (NE * (DFF / 64) * (D / 32)), 0}, false);
            cx.run(MoeFillNeg{(long)MOE_MAXT * 256, row_token}, false);
            cx.run(ZeroInt{(long)NE * nseg, segcnt});
            cx.wrun(NormModW{NR / 2, 3 * D, 4 * D, last ? 1 : 0, h, INP(norm2) + (size_t)l * D, modl, abuf, INP(moe_router) + (size_t)j * D * NE, rt_e, rt_w, segcnt, nseg, 1});
            cx.wrun(MoePrefixW{NE, nseg, segcnt, ecnt});
#endif
            cx.run(MoeTiles2{(long)MOE_MAXT, ecnt, tile_e, ntile}, false);
            cx.run(MoeAssign{(long)NE * nseg, rt_e, segcnt, ecnt, rt_dest, row_token, nseg});
#ifdef HOST_EMU
            cx.gemm(GemmDesc{abuf, mw13T, tile_e, ntile, row_token, (size_t)2 * DFF * D, MOE_MAXT * 256, 2 * DFF, D, 0, D, D, 0, 0}, EpiSwiGLU{mact, DFF, 0});
#else
            for (int t0 = 0; t0 < MOE_MAXT; t0 += MOE_XT) { const int nt = (MOE_MAXT - t0 < MOE_XT) ? MOE_MAXT - t0 : MOE_XT;
                cx.run(MoeGather8{(long)nt * 256 * (D / 16), (const unsigned char*)abuf, row_token, xs8, t0 * 256, 0});
                cx.gemm8(GemmDesc{(const bf16*)xs8, mw13T, tile_e, ntile, nullptr, (size_t)2 * DFF * D / 2, nt * 256, 2 * DFF, D, t0, D, D, 0, -W8S},
#if FP8_DOWN_MOE
                    EpiSwiGLU8{(unsigned char*)mact + (size_t)t0 * 256 * DFF, DFF, 0}); }
#else
                    EpiSwiGLU{mact + (size_t)t0 * 256 * DFF, DFF, 0}); }
#endif
#endif
#if FP8_DOWN_MOE && !defined(HOST_EMU)
            cx.gemm8(GemmDesc{mact, mw2T, tile_e, ntile, nullptr, (size_t)D * DFF / 2, MOE_MAXT * 256, D, DFF, 0, DFF, DFF, 0, -(W8S + A8S)}, EpiStoreBf16{yrow, D, 0});
#else
            cx.gemm(GemmDesc{mact, mw2T, tile_e, ntile, nullptr, (size_t)D * DFF, MOE_MAXT * 256, D, DFF, 0, DFF, DFF, 0, 0}, EpiStoreBf16{yrow, D, 0});
#endif
            } SEC_END(7)
#ifdef HOST_EMU
            cx.run(MoeCombine{(long)NR * D / 8, h, yrow, rt_e, rt_w, rt_dest, modl, 5 * D});
#else
            if constexpr (last) cx.wrun(CombineNormW{NR, 1, 5 * D, 0, h, yrow, rt_e, rt_w, rt_dest, modl, INP(norm_f), modl, abuf, out});
            else cx.wrun(CombineNormW{NR, 0, 5 * D, 0, h, yrow, rt_e, rt_w, rt_dest, modl, INP(norm1) + (size_t)(l + 1) * D, mod + (size_t)(l + 1) * NMOD * 6 * D, abuf, out});
#endif
        }
        cx.mark(10 * (l + 1) + 7);
    }
template <class X> HD void forward(X& cx) {
    cx.mark(0);
    constexpr int l = 0; (void)l;
    cx.run(PosTab{(long)2 * GRID_W * 512, postab}, false);
    cx.run(SiluC{(long)NMOD * D, INP(c), INP(c_ctx), silc});
    cx.run(InitH{(long)NR * D / 4, INP(x), INP(ctx), postab, h}, false);
#ifdef HOST_EMU
    for (int l = 0; l < DEPTH; ++l) {
        cx.run(TransposeK{(long)PS * D, INP(w_in) + (size_t)l * D * DPROJ, nullptr, winT + (size_t)l * PS * D, D, DPROJ, PS});
        cx.run(TransposeK{(long)D * D, INP(w_out) + (size_t)l * D * D, nullptr, woutT + (size_t)l * D * D, D, D, D});
        if (l % 2 == 0) { const int j = l / 2;
            cx.run(TransposeK{(long)2 * DFF * D, INP(ffn_w1) + (size_t)j * D * DFF, INP(ffn_w3) + (size_t)j * D * DFF, w13T + (size_t)j * 2 * DFF * D, D, DFF, 2 * DFF});
            cx.run(TransposeK{(long)D * DFF, INP(ffn_w2) + (size_t)j * DFF * D, nullptr, w2T + (size_t)j * D * DFF, DFF, D, D}); }
    }
#else
    cx.wrun(TransW{((DEPTH * (D / 64) * (DPROJ / 32)) + 1) / 2, D, DPROJ, 1, 0, 0, INP(w_in), winT, (size_t)D * DPROJ, (size_t)PS * D, (DEPTH * (D / 64) * (DPROJ / 32)), 0}, false);
    for (int l = 0; l < DEPTH; ++l) cx.run(ZeroBf16{(long)(PS - DPROJ) * D, winT + ((size_t)l * PS + DPROJ) * D}, false);
    cx.wrun(TransW{((DEPTH * (D / 64) * (D / 32)) + 1) / 2, D, D, 1, 0, 0, INP(w_out), woutT, (size_t)D * D, (size_t)D * D, (DEPTH * (D / 64) * (D / 32)), 0}, false);
    cx.wrun(TransW{((((DEPTH + 1) / 2) * (D / 64) * (DFF / 32)) + 1) / 2, D, DFF, 2, 0, W8S, INP(ffn_w1), w13T, (size_t)D * DFF, (size_t)2 * DFF * D, (((DEPTH + 1) / 2) * (D / 64) * (DFF / 32)), 0}, false);
    cx.wrun(TransW{((((DEPTH + 1) / 2) * (D / 64) * (DFF / 32)) + 1) / 2, D, DFF, 2, 1, W8S, INP(ffn_w3), w13T, (size_t)D * DFF, (size_t)2 * DFF * D, (((DEPTH + 1) / 2) * (D / 64) * (DFF / 32)), 0}, false);
    cx.wrun(TransW{((((DEPTH + 1) / 2) * (DFF / 64) * (D / 32)) + 1) / 2, DFF, D, 1, 0, FP8_DOWN_DENSE ? W8S : 0, INP(ffn_w2), w2T, (size_t)DFF * D, (size_t)D * DFF, (((DEPTH + 1) / 2) * (DFF / 64) * (D / 32)), 0}, false);
#endif
    cx.run(ModPart{(long)MODKC * DEPTH * 6 * D, silc, INP(w_ada), modpart});
    cx.run(ModReduce{(long)DEPTH * NMOD * 6 * D, modpart, INP(b_ada), mod});
    cx.mark(1);
    layer_fwd<0>(cx);
    if constexpr (DEPTH > 1) layer_fwd<1>(cx);
    if constexpr (DEPTH > 2) layer_fwd<2>(cx);
    if constexpr (DEPTH > 3) layer_fwd<3>(cx);
    static_assert(DEPTH <= 4, "unrolled for DEPTH <= 4");
#ifdef HOST_EMU
    cx.run(FinalNorm{(long)NB * SEQ, h, INP(norm_f), out});
#else
    if constexpr ((DEPTH - 1) % 2 == 0) cx.wrun(FinalNormW{NB * SEQ, 0, h, INP(norm_f), out});
#endif
    cx.mark(99);
    cx.probe_out(out);
}

#undef silc
#undef postab
#undef modpart
#undef mod
#undef h
#undef abuf
#undef winT
#undef woutT
#undef w13T
#undef w2T
#undef pbuf
#undef obuf
#undef lab
#undef labg
#undef s5disc
#undef s5K
#undef s5apow
#undef s5bbar
#undef s5TB
#undef s5EB
#undef s5uG
#undef s5est
#undef zbuf
#undef gluT
#undef act
#undef mw13T
#undef mw2T
#undef mact
#undef xs8
#undef yrow
#undef rt_e
#undef rt_w
#undef rt_dest
#undef segcnt
#undef ecnt
#undef row_token
#undef tile_e
#undef ntile
#undef WSB
#undef S5TABBASE
#undef out
#undef modl
#ifndef HOST_EMU
#ifndef MULTI_LAUNCH
constexpr int MEGA_LDS = pg8::STAGE_BYTES + 512;
struct MegaArgs { const void* p[37]; };
__global__ void __launch_bounds__(512, 2) mega_fwd(MegaArgs a) {
    extern __shared__ __attribute__((aligned(16))) unsigned char shm[];
    PG8_LAS unsigned char* lds = (PG8_LAS unsigned char*)shm;
    volatile LAS unsigned* xbw = (volatile LAS unsigned*)(lds + pg8::STAGE_BYTES);
    if (threadIdx.x < 4) xbw[threadIdx.x] = 0u;
    if (threadIdx.x < 37) ((PG8_LAS unsigned long long*)(lds + pg8::STAGE_BYTES + 64))[threadIdx.x] = (unsigned long long)a.p[threadIdx.x];
    __syncthreads();
    Ctx cx; cx.lds = lds;
    cx.bar = xcd_barrier_post((unsigned*)((unsigned char*)cx.inp<36>() + WS.ctl), xbw);
    cx.gtid = (int)(blockIdx.x * blockDim.x + threadIdx.x); cx.nthr = (int)(gridDim.x * blockDim.x);
    forward(cx);
}
#endif
extern "C" void kernel_launch(void* const* d_in, const int* in_sizes, int n_in, void* d_out, int out_size, void* d_ws, size_t ws_size, hipStream_t stream) {
    static int ncu = 0;
    if (ncu == 0) { int dev = 0; (void)hipGetDevice(&dev); (void)hipDeviceGetAttribute(&ncu, hipDeviceAttributeMultiprocessorCount, dev); if (ncu <= 0) ncu = 256;
#ifndef MULTI_LAUNCH
        if (hipFuncSetAttribute((const void*)mega_fwd, hipFuncAttributeMaxDynamicSharedMemorySize, MEGA_LDS) != hipSuccess) { fprintf(stderr, "kernel_launch: hipFuncSetAttribute failed\n"); }
#endif
    }
    if (n_in != 35 || ws_size < WS.end || out_size != NB * SEQ * D) { fprintf(stderr, "kernel_launch: unexpected sizes n_in %d ws %zu (need %zu) out %d\n", n_in, ws_size, (size_t)WS.end, out_size); return; }
#ifdef MULTI_LAUNCH
    const void* tbl[37]; for (int i = 0; i < 35; ++i) tbl[i] = d_in[i]; tbl[35] = d_out; tbl[36] = d_ws;
    Ctx cx{stream, ncu, tbl};
    forward(cx);
#else
    (void)hipMemsetAsync((unsigned char*)d_ws + WS.ctl, 0, 1 << 20, stream);
    MegaArgs a{}; for (int i = 0; i < 35; ++i) a.p[i] = d_in[i];
    a.p[35] = d_out; a.p[36] = d_ws;
    hipLaunchKernelGGL(mega_fwd, dim3(ncu), dim3(512), MEGA_LDS, stream, a);
#endif
}
#endif
```
